# Optimizing an MI355X kernel written in HIP

```python
import math
import jax, jax.numpy as jnp
from jax import lax
import numpy as np

D_MODEL = 1024
BATCH = 2
SEQ = 16384
DEPTH = 1

ATTN_HEADS = 8
ATTN_HEAD_DIM = D_MODEL // 16
ATTN_WIDTH = ATTN_HEADS * ATTN_HEAD_DIM
RET_HEADS = 4
RET_HEAD_DIM = D_MODEL // 8
RET_WIDTH = RET_HEADS * RET_HEAD_DIM
MIX_WIDTH = ATTN_WIDTH + RET_WIDTH
N_IN_SLICES = 7
MOBA_BLOCK = 256
MOBA_TOPK = 3
Q_BLOCK = 128
RET_CHUNK = 256
REL_BUCKETS = 32
REL_MAX_DIST = 128
ROPE_BASE = 10000.0
N_GROUPS = 4
EXPERTS_PER_GROUP = 8
N_EXPERTS = N_GROUPS * EXPERTS_PER_GROUP
D_EXPERT = D_MODEL // 2
TOP_K_INNER = 2
ALPHA = (2.0 * DEPTH) ** 0.25
BETA = (8.0 * DEPTH) ** -0.25
LN_EPS = 1e-5

kernel_name = "hymba_moba_retnet_hmoe_deepnorm"


def layer_norm(x, g, b):
    xf = x.astype(jnp.float32)
    mu = jnp.mean(xf, -1, keepdims=True)
    var = jnp.mean(jnp.square(xf - mu), -1, keepdims=True)
    return ((xf - mu) * lax.rsqrt(var + LN_EPS) * g + b).astype(x.dtype)


def rms_norm(x, g):
    xf = x.astype(jnp.float32)
    return (xf * lax.rsqrt(jnp.mean(jnp.square(xf), -1, keepdims=True) + LN_EPS) * g).astype(x.dtype)


def t5_bucket(dist):
    n = jnp.maximum(dist, 0)
    max_exact = REL_BUCKETS // 2
    nf = jnp.maximum(n, 1).astype(jnp.float32)
    large = max_exact + (jnp.log(nf / max_exact) / math.log(REL_MAX_DIST / max_exact)
                         * (REL_BUCKETS - max_exact)).astype(jnp.int32)
    large = jnp.minimum(large, REL_BUCKETS - 1)
    return jnp.where(n < max_exact, n, large)


def rope(t, pos):
    half = t.shape[-1] // 2
    inv = ROPE_BASE ** (-jnp.arange(half, dtype=jnp.float32) / half)
    ang = pos[:, None].astype(jnp.float32) * inv[None, :]
    cos, sin = jnp.cos(ang), jnp.sin(ang)
    tf = t.astype(jnp.float32)
    t1, t2 = tf[..., :half], tf[..., half:]
    return jnp.concatenate([t1 * cos - t2 * sin, t1 * sin + t2 * cos], -1).astype(t.dtype)


def moba_attention(q, k, v, rel_table):
    B, H, S, Dh = q.shape
    L = MOBA_BLOCK
    nb = S // L
    topk = min(MOBA_TOPK, nb)
    scale = Dh ** -0.5
    k_blk = k.reshape(B, H, nb, L, Dh)
    v_blk = v.reshape(B, H, nb, L, Dh)
    k_mean = jnp.mean(k_blk.astype(jnp.float32), axis=3)
    n_chunks = S // Q_BLOCK
    q_chunks = q.reshape(B, H, n_chunks, Q_BLOCK, Dh).transpose(2, 0, 1, 3, 4)
    table_t = rel_table.astype(jnp.float32).T
    head_idx = jnp.arange(H)[None, :, None, None, None]
    gather = jax.vmap(jax.vmap(lambda kb, idx: kb[idx]))

    def one_chunk(args):
        qc, c = args
        q_pos = c * Q_BLOCK + jnp.arange(Q_BLOCK)
        own = (c * Q_BLOCK) // L
        gate = jnp.einsum('bhqd,bhnd->bhqn', qc.astype(jnp.float32), k_mean)
        gate = jnp.where(jnp.arange(nb) < own, gate, -jnp.inf)
        _, sel = lax.top_k(gate, topk)
        sel_valid = sel < own
        k_sel = gather(k_blk, sel)
        v_sel = gather(v_blk, sel)
        s_sel = jnp.einsum('bhqd,bhqtld->bhqtl', qc, k_sel).astype(jnp.float32) * scale
        k_pos_sel = sel[..., None] * L + jnp.arange(L)
        bucket_sel = t5_bucket(q_pos[None, None, :, None, None] - k_pos_sel)
        s_sel = s_sel + table_t[head_idx, bucket_sel]
        s_sel = jnp.where(sel_valid[..., None], s_sel, -jnp.inf)
        start = own * L
        k_own = lax.dynamic_slice_in_dim(k, start, L, axis=2)
        v_own = lax.dynamic_slice_in_dim(v, start, L, axis=2)
        s_own = jnp.einsum('bhqd,bhld->bhql', qc, k_own).astype(jnp.float32) * scale
        dist_own = q_pos[:, None] - (start + jnp.arange(L))[None, :]
        s_own = s_own + table_t[:, t5_bucket(dist_own)][None]
        s_own = jnp.where(dist_own[None, None] >= 0, s_own, -jnp.inf)
        logits = jnp.concatenate([s_sel.reshape(B, H, Q_BLOCK, topk * L), s_own], -1)
        p = jax.nn.softmax(logits, axis=-1)
        p_sel = p[..., :topk * L].reshape(B, H, Q_BLOCK, topk, L).astype(v.dtype)
        p_own = p[..., topk * L:].astype(v.dtype)
        return (jnp.einsum('bhqtl,bhqtld->bhqd', p_sel, v_sel)
                + jnp.einsum('bhql,bhld->bhqd', p_own, v_own))

    out = lax.map(one_chunk, (q_chunks, jnp.arange(n_chunks)))
    return out.transpose(1, 2, 0, 3, 4).reshape(B, H, S, Dh)


def retention_chunkwise(q, k, v):
    B, H, S, Dk = q.shape
    Dv = v.shape[-1]
    C = RET_CHUNK
    n = S // C
    gammas = 1.0 - jnp.exp(jnp.linspace(math.log(1.0 / 32), math.log(1.0 / 512), H, dtype=jnp.float32))
    log_g = jnp.log(gammas)
    idx = jnp.arange(C, dtype=jnp.float32)
    diff = idx[:, None] - idx[None, :]
    decay_inner = jnp.where(diff[None] >= 0, jnp.exp(jnp.maximum(diff, 0.0)[None] * log_g[:, None, None]), 0.0)
    q_decay = jnp.exp((idx[None, :] + 1.0) * log_g[:, None])[None, :, :, None]
    k_decay = jnp.exp((C - 1.0 - idx[None, :]) * log_g[:, None])[None, :, :, None]
    chunk_decay = jnp.exp(C * log_g)[None, :, None, None]

    def to_chunks(t):
        return t.astype(jnp.float32).reshape(B, H, n, C, t.shape[-1]).transpose(2, 0, 1, 3, 4)

    def step(R, xs):
        qi, ki, vi = xs
        s = jnp.einsum('bhqd,bhkd->bhqk', qi, ki) * decay_inner
        inner = jnp.einsum('bhqk,bhkv->bhqv', s, vi)
        cross = jnp.einsum('bhqd,bhdv->bhqv', qi * q_decay, R)
        R = R * chunk_decay + jnp.einsum('bhkd,bhkv->bhdv', ki * k_decay, vi)
        return R, inner + cross

    R0 = jnp.zeros((B, H, Dk, Dv), jnp.float32)
    _, out = lax.scan(step, R0, (to_chunks(q), to_chunks(k), to_chunks(v)))
    return out.transpose(1, 2, 0, 3, 4).reshape(B, H, S, Dv)


def hybrid_mixer(h, w_in, attn_out_gain, rel_table, w_out):
    B, S, _ = h.shape
    proj = jnp.einsum('bsd,de->bse', h, w_in)
    pad = (-S) % MOBA_BLOCK
    proj = jnp.pad(proj, ((0, 0), (0, pad), (0, 0)))
    Sp = S + pad
    aq, ak, av, rq, rk, rv, rg = jnp.split(proj, N_IN_SLICES, axis=-1)

    def heads(t, nh):
        return t.reshape(B, Sp, nh, -1).transpose(0, 2, 1, 3)

    attn = moba_attention(heads(aq, ATTN_HEADS), heads(ak, ATTN_HEADS), heads(av, ATTN_HEADS), rel_table)
    attn = rms_norm(attn.transpose(0, 2, 1, 3).reshape(B, Sp, ATTN_WIDTH), attn_out_gain)
    pos = jnp.arange(Sp)
    rqh = rope(heads(rq, RET_HEADS), pos)
    rkh = rope(heads(rk, RET_HEADS), pos) * (RET_HEAD_DIM ** -0.5)
    ret = retention_chunkwise(rqh, rkh, heads(rv, RET_HEADS))
    mu = jnp.mean(ret, -1, keepdims=True)
    var = jnp.mean(jnp.square(ret - mu), -1, keepdims=True)
    ret = (ret - mu) * lax.rsqrt(var + LN_EPS)
    ret = ret.transpose(0, 2, 1, 3).reshape(B, Sp, RET_WIDTH)
    ret = (jax.nn.silu(rg.astype(jnp.float32)) * ret).astype(h.dtype)
    cat = jnp.concatenate([attn, ret], -1)[:, :S]
    return jnp.einsum('bse,ed->bsd', cat, w_out)


def hierarchical_moe(x2d, w_rg, b_rg, w_re, b_re, w_gu, w_dn):
    T, D = x2d.shape
    g_prob = jax.nn.softmax((x2d @ w_rg).astype(jnp.float32) + b_rg.astype(jnp.float32), axis=-1)
    g_p, g_idx = lax.top_k(g_prob, 1)
    e_logits = ((x2d @ w_re).astype(jnp.float32) + b_re.astype(jnp.float32)).reshape(T, N_GROUPS, EXPERTS_PER_GROUP)
    e_logits = jnp.take_along_axis(e_logits, jnp.broadcast_to(g_idx[:, :, None], (T, 1, EXPERTS_PER_GROUP)), axis=1)[:, 0]
    e_prob = jax.nn.softmax(e_logits, axis=-1)
    e_p, e_idx = lax.top_k(e_prob, TOP_K_INNER)
    e_p = e_p / jnp.sum(e_p, -1, keepdims=True)
    weights = g_p * e_p
    flat_e = (g_idx * EXPERTS_PER_GROUP + e_idx).reshape(-1)
    order = jnp.argsort(flat_e)
    xs = x2d[order // TOP_K_INNER]
    sizes = jnp.bincount(flat_e, length=N_EXPERTS).astype(jnp.int32)
    gu = lax.ragged_dot(xs, w_gu, sizes)
    hid = jax.nn.silu(gu[:, :D_EXPERT]) * gu[:, D_EXPERT:]
    y = lax.ragged_dot(hid, w_dn, sizes)
    y = jnp.zeros_like(y).at[order].set(y).reshape(T, TOP_K_INNER, D)
    return jnp.sum(y * weights[..., None].astype(y.dtype), axis=1)


def setup_inputs(seed: int = 0) -> dict:
    key = jax.random.key(seed)
    ks = jax.random.split(key, 16)
    f32 = jnp.float32
    x = jax.random.normal(ks[0], (BATCH, SEQ, D_MODEL), f32)
    w_in = jax.random.normal(ks[1], (DEPTH, D_MODEL, N_IN_SLICES * ATTN_WIDTH), f32) * D_MODEL ** -0.5
    col = jnp.arange(N_IN_SLICES * ATTN_WIDTH) // ATTN_WIDTH
    v_cols = (col == 2) | (col == 5)
    w_in = w_in * jnp.where(v_cols, BETA, 1.0).astype(f32)
    attn_out_gain = 1.0 + 0.02 * jax.random.normal(ks[2], (DEPTH, ATTN_WIDTH), f32)
    rel_bias_table = 0.5 * jax.random.normal(ks[3], (REL_BUCKETS, ATTN_HEADS), f32)
    w_out = jax.random.normal(ks[4], (DEPTH, MIX_WIDTH, D_MODEL), f32) * MIX_WIDTH ** -0.5 * BETA
    ln1_g = 1.0 + 0.02 * jax.random.normal(ks[5], (DEPTH, D_MODEL), f32)
    ln1_b = 0.02 * jax.random.normal(ks[6], (DEPTH, D_MODEL), f32)
    w_router_group = jax.random.normal(ks[7], (DEPTH, D_MODEL, N_GROUPS), f32) * D_MODEL ** -0.5
    b_router_group = 0.01 * jax.random.normal(ks[8], (DEPTH, N_GROUPS), f32)
    w_router_expert = jax.random.normal(ks[9], (DEPTH, D_MODEL, N_EXPERTS), f32) * D_MODEL ** -0.5
    b_router_expert = 0.01 * jax.random.normal(ks[10], (DEPTH, N_EXPERTS), f32)
    w_gate_up = jax.random.normal(ks[11], (DEPTH, N_EXPERTS, D_MODEL, 2 * D_EXPERT), f32) * D_MODEL ** -0.5 * BETA
    w_down = jax.random.normal(ks[12], (DEPTH, N_EXPERTS, D_EXPERT, D_MODEL), f32) * D_EXPERT ** -0.5 * BETA
    ln2_g = 1.0 + 0.02 * jax.random.normal(ks[13], (DEPTH, D_MODEL), f32)
    ln2_b = 0.02 * jax.random.normal(ks[14], (DEPTH, D_MODEL), f32)
    return {"x": x, "w_in": w_in, "attn_out_gain": attn_out_gain, "rel_bias_table": rel_bias_table,
            "w_out": w_out, "ln1_g": ln1_g, "ln1_b": ln1_b, "w_router_group": w_router_group,
            "b_router_group": b_router_group, "w_router_expert": w_router_expert,
            "b_router_expert": b_router_expert, "w_gate_up": w_gate_up, "w_down": w_down,
            "ln2_g": ln2_g, "ln2_b": ln2_b}


def reference(x, w_in, attn_out_gain, rel_bias_table, w_out, ln1_g, ln1_b, w_router_group,
              b_router_group, w_router_expert, b_router_expert, w_gate_up, w_down, ln2_g, ln2_b):
    B, S, D = x.shape
    h = x
    for l in range(DEPTH):
        mix = hybrid_mixer(h, w_in[l], attn_out_gain[l], rel_bias_table, w_out[l])
        h = layer_norm(ALPHA * h + mix, ln1_g[l], ln1_b[l])
        ffn = hierarchical_moe(h.reshape(B * S, D), w_router_group[l], b_router_group[l],
                               w_router_expert[l], b_router_expert[l], w_gate_up[l], w_down[l]).reshape(B, S, D)
        h = layer_norm(ALPHA * h + ffn, ln2_g[l], ln2_b[l])
    return h
```

```cpp
#include <hip/hip_runtime.h>
#include <cstdint>
#include <cstdio>

#ifndef MK_LAUNCHES
#define MK_LAUNCHES 1
#endif

#define DI __device__ __forceinline__
#define LAS __attribute__((address_space(3)))
typedef _Float16 f16;
typedef _Float16 h8 __attribute__((ext_vector_type(8)));
typedef _Float16 h4 __attribute__((ext_vector_type(4)));
typedef short s4v __attribute__((ext_vector_type(4)));
typedef float f32x2 __attribute__((ext_vector_type(2)));
typedef float f32x4 __attribute__((ext_vector_type(4)));
typedef float f32x8 __attribute__((ext_vector_type(8)));
typedef float f32x16 __attribute__((ext_vector_type(16)));

constexpr int NB = 2, SEQ = 16384, DM = 1024, NTOK = NB * SEQ, NPJ = 3584;
constexpr int C_AQ = 0, C_AK = 512, C_AV = 1024, C_RQ = 1536, C_RK = 2048, C_RV = 2560, C_RG = 3072;
constexpr int NBLK = SEQ / 256;
constexpr int NE = 32, DE = 512;
constexpr float ALPHA = 1.189207115002721f, LN_EPS = 1e-5f, LOG2E = 1.4426950408889634f;
constexpr int NPHASE = 10;

constexpr size_t MiB = 1u << 20;
constexpr size_t WS_CTL = 0, CTL_ZERO_BYTES = 128 * 1024;
constexpr size_t WS_ROPEC = 1 * MiB, WS_ROPES = 5 * MiB, WS_XSUM = 9 * MiB, WS_KMEAN = 10 * MiB, WS_WRT = 10 * MiB + 512 * 1024;
constexpr size_t WS_SUMSQ = 11 * MiB, WS_WTS = 12 * MiB, WS_ELIST = 13 * MiB, WS_MLIST = 17 * MiB, WS_PML = 33 * MiB;
constexpr size_t WS_WINT = 39 * MiB, WS_WOT = 46 * MiB, WS_WGUT = 48 * MiB, WS_WDNT = 112 * MiB;
constexpr size_t WS_PJ = 144 * MiB, WS_XH = 368 * MiB, WS_CAT = 368 * MiB, WS_KV = 432 * MiB, WS_R = 464 * MiB;
constexpr size_t WS_HH = 144 * MiB, WS_HID = 208 * MiB, WS_Y = 280 * MiB, WS_END = 480 * MiB;
constexpr int MLIST_PER_BH = 516096;
constexpr int CW_BAR = 4096, CW_LCNT = 8192, CW_ECNT = 12288;

constexpr int SCR_BYTES = 155648;
constexpr int BIAS_OFF = SCR_BYTES;
constexpr int MISC_OFF = BIAS_OFF + 8 * 132 * 4 + 128;
constexpr int LDS_BYTES = MISC_OFF + 256;
static_assert(LDS_BYTES <= 163840, "LDS");

__device__ const unsigned char T5_BUCKET[129] = {0,1,2,3,4,5,6,7,8,9,10,11,12,13,14,15,16,16,16,17,17,18,18,18,19,19,19,20,20,20,20,21,21,21,21,22,22,22,22,22,23,23,23,23,23,23,24,24,24,24,24,24,25,25,25,25,25,25,25,26,26,26,26,26,26,26,26,27,27,27,27,27,27,27,27,27,27,28,28,28,28,28,28,28,28,28,28,29,29,29,29,29,29,29,29,29,29,29,29,30,30,30,30,30,30,30,30,30,30,30,30,30,30,31,31,31,31,31,31,31,31,31,31,31,31,31,31,31,31};
__device__ const float ROPE_INV[64] = {1.0f,0.865964353f,0.749894202f,0.649381638f,0.562341332f,0.486967534f,0.421696514f,0.365174115f,0.316227764f,0.273841977f,0.237137377f,0.2053525f,0.177827939f,0.153992653f,0.133352146f,0.115478195f,0.100000001f,0.0865964293f,0.0749894232f,0.0649381652f,0.0562341325f,0.0486967526f,0.0421696492f,0.0365174115f,0.0316227749f,0.0273841955f,0.0237137377f,0.0205352511f,0.0177827943f,0.0153992651f,0.013335214f,0.0115478197f,0.00999999978f,0.00865964312f,0.00749894232f,0.00649381615f,0.00562341325f,0.00486967526f,0.00421696482f,0.00365174119f,0.00316227763f,0.00273841969f,0.00237137382f,0.00205352507f,0.00177827943f,0.00153992651f,0.00133352145f,0.00115478202f,0.00100000005f,0.000865964335f,0.000749894185f,0.000649381604f,0.000562341302f,0.000486967532f,0.000421696517f,0.000365174114f,0.000316227757f,0.000273841957f,0.00023713737f,0.00020535251f,0.00017782794f,0.00015399266f,0.00013335215f,0.0001154782f};

struct Args {
    const float *x, *w_in, *gain, *rel, *w_out, *ln1g, *ln1b, *wrg, *brg, *wre, *bre, *wgu, *wdn, *ln2g, *ln2b;
    float* out; unsigned char* ws; int ph_lo, ph_hi;
};

#define LDS_WAIT() asm volatile("s_waitcnt lgkmcnt(0)" ::: "memory")
#define MFMA32(a, b, c) __builtin_amdgcn_mfma_f32_32x32x16_f16((a), (b), (c), 0, 0, 0)
#define MFMA16(a, b, c) __builtin_amdgcn_mfma_f32_16x16x32_f16((a), (b), (c), 0, 0, 0)
DI int crow(int reg, int hp) { return (reg & 3) + 8 * (reg >> 2) + 4 * hp; }
DI h8 cvt8(f32x4 a, f32x4 b) { const f32x8 v = {a[0], a[1], a[2], a[3], b[0], b[1], b[2], b[3]}; return __builtin_convertvector(v, h8); }
DI float wave_sum(float v) {
#pragma unroll
    for (int o = 1; o < 64; o <<= 1) v += __shfl_xor(v, o);
    return v;
}
DI h4 tr_read(LAS const unsigned char* p) {
    typedef LAS s4v lds_s4;
    const s4v v = __builtin_amdgcn_ds_read_tr16_b64_v4i16((lds_s4*)p);
    return __builtin_bit_cast(h4, v);
}
DI h8 cat44(h4 a, h4 b) { return __builtin_shufflevector(a, b, 0, 1, 2, 3, 4, 5, 6, 7); }
DI float fexp2(float x) { return __builtin_amdgcn_exp2f(x); }
DI float gamma_log2(int h) { return __builtin_log2f(1.0f - fexp2(-(5.0f + (4.0f / 3.0f) * (float)h))); }

#define XB_TMO      128
#define XB_XCNT(j)  (256  + 64 * (j))
#define XB_XSUB(j)  (1280 + 64 * (j))
#define XB_XGEN(j)  (2304 + 64 * (j))
#define XB_TOP      3328
#define XB_TOPGEN   3392
#define XCD_BAR_WORDS 3456
#define XB_SPIN_CAP (1u << 18)
__device__ __forceinline__ unsigned xb_ld(unsigned* p)              { return __hip_atomic_load(p, __ATOMIC_RELAXED, __HIP_MEMORY_SCOPE_AGENT); }
__device__ __forceinline__ unsigned xb_add(unsigned* p, unsigned v) { return __hip_atomic_fetch_add(p, v, __ATOMIC_RELAXED, __HIP_MEMORY_SCOPE_AGENT); }
__device__ __forceinline__ unsigned xb_xcc_id() { return (unsigned)__builtin_amdgcn_s_getreg((3 << 11) | 20) & 0xFu; }
#define XB_SPIN(cond, bar) do { unsigned _sp = 0; while (cond) { __builtin_amdgcn_s_sleep(1); \
    if ((++_sp & 255u) == 0u) { if (xb_ld(&(bar)[XB_TMO])) break; if (_sp > XB_SPIN_CAP) { atomicAdd(&(bar)[XB_TMO], 1u); break; } } } } while (0)
struct XcdBarrier { unsigned* bar; unsigned x; volatile LAS unsigned* st; };
__device__ __forceinline__ XcdBarrier xcd_barrier_post(unsigned* bar, volatile LAS unsigned* st) {
    XcdBarrier b; b.bar = bar; b.x = xb_xcc_id(); b.st = st;
    if (threadIdx.x == 0) (void)xb_add(&bar[XB_XCNT(b.x)], 1u);
    return b;
}
__device__ __forceinline__ void xcd_barrier_complete(unsigned* bar, unsigned x, unsigned& nloc, unsigned& nx) {
    const unsigned G = gridDim.x * gridDim.y * gridDim.z;
    unsigned sum, cnt, mine, sp = 0u;
    for (;;) {
        sum = 0u; cnt = 0u; mine = 0u;
#pragma unroll
        for (unsigned j = 0; j < 16; ++j) { const unsigned c = xb_ld(&bar[XB_XCNT(j)]); sum += c; cnt += (c > 0u) ? 1u : 0u; mine = (j == x) ? c : mine; }
        if (sum == G) break;
        __builtin_amdgcn_s_sleep(1);
        if ((++sp & 255u) == 0u) { if (xb_ld(&bar[XB_TMO])) break; if (sp > XB_SPIN_CAP) { atomicAdd(&bar[XB_TMO], 1u); break; } }
    }
    nloc = mine > 0u ? mine : 1u; nx = cnt > 0u ? cnt : 1u;
}
__device__ __forceinline__ void xcd_barrier(const XcdBarrier& b) {
    asm volatile("s_waitcnt vmcnt(0)" ::: "memory");
    __syncthreads();
    if (threadIdx.x == 0) {
        unsigned* bar = b.bar;
        __builtin_amdgcn_s_waitcnt(0);
        unsigned nloc = b.st[0], nx = b.st[1];
        if (nloc == 0u) { xcd_barrier_complete(bar, b.x, nloc, nx); b.st[0] = nloc; b.st[1] = nx; }
        const unsigned old = xb_add(&bar[XB_XSUB(b.x)], 1u);
        const unsigned gen = old / nloc;
        if (old + 1u == (gen + 1u) * nloc) {
            __builtin_amdgcn_fence(__ATOMIC_RELEASE, "agent");
            asm volatile("s_waitcnt vmcnt(0)" ::: "memory");
            const unsigned og = xb_add(&bar[XB_TOP], 1u);
            const unsigned tg = og / nx;
            if (og + 1u == (tg + 1u) * nx) xb_add(&bar[XB_TOPGEN], 1u);
            else XB_SPIN(xb_ld(&bar[XB_TOPGEN]) == tg, bar);
            __builtin_amdgcn_fence(__ATOMIC_ACQUIRE, "agent");
            xb_add(&bar[XB_XGEN(b.x)], 1u);
            asm volatile("s_waitcnt vmcnt(0)" ::: "memory");
        } else {
            XB_SPIN(xb_ld(&bar[XB_XGEN(b.x)]) == gen, bar);
            __builtin_amdgcn_fence(__ATOMIC_ACQUIRE, "agent");
            asm volatile("s_waitcnt vmcnt(0)" ::: "memory");
        }
    }
    __syncthreads();
}

namespace pg8 {
constexpr int BM = 256, BK = 64, HALF = 128, HTB = HALF * BK * 2, STAGE_BYTES = 8 * HTB, NXCD = 8, WGM = 8;
DI int lds_byte(int r, int c) { const int st = (r >> 4) * 2 + (c >> 5), rr = r & 15, cc = c & 31, ob = rr * 64 + cc * 2; return st * 1024 + (ob ^ (((ob >> 9) & 1) << 5)); }
DI void stage_rc(int b, int& R, int& C) { const int st = b / 1024, sb = b % 1024, swz = sb ^ (((sb >> 9) & 1) << 5); R = (st >> 1) * 16 + swz / 64; C = (st & 1) * 32 + (swz % 64) / 2; }
DI int perm32(int rho) { const int n = rho >> 4, i = rho & 15; return 8 * (i >> 2) + 4 * n + (i & 3); }

struct Unit { const char* a; const char* b; int i0, i1, i2, i3; };

struct StaticOrder {
    const char* A; const char* Bt; int lda, ldb, nM, nN, nwg, G, c;
    DI void init(const void* A_, const void* Bt_, int lda_, int ldb_, int M, int N, int G_, int c_) { A = (const char*)A_; Bt = (const char*)Bt_; lda = lda_; ldb = ldb_; nM = M / BM; nN = N / BM; nwg = nM * nN; G = G_; c = c_; }
    DI bool next(int i, Unit& u) const {
        const long L = (long)i * G + c; if (L >= nwg) return false;
        int wgid = (int)L; { const int q = nwg / NXCD, r = nwg % NXCD, xcd = wgid % NXCD, off = wgid / NXCD; wgid = (xcd < r ? xcd * (q + 1) : r * (q + 1) + (xcd - r) * q) + off; }
        const int nig = WGM * nN, gid = wgid / nig, fm = gid * WGM, gsz = (nM - fm) < WGM ? (nM - fm) : WGM;
        u.i0 = fm + ((wgid % nig) % gsz); u.i1 = (wgid % nig) / gsz; u.i2 = 0; u.i3 = 0;
        u.a = A + (size_t)u.i0 * BM * lda * 2; u.b = Bt + (size_t)u.i1 * BM * ldb * 2; return true;
    }
    DI void aoff(const Unit&, unsigned (&vo)[2][2]) const {
#pragma unroll
        for (int i = 0; i < 2; ++i) { int R, C; stage_rc((int)threadIdx.x * 16 + i * 8192, R, C);
#pragma unroll
            for (int h = 0; h < 2; ++h) vo[h][i] = (unsigned)((h * HALF + R) * lda + C) * 2u; }
    }
};

template <class Epi, class Sched, bool ALIGN_EPI>
DI void gemm_phase(LAS unsigned char* lds, const int ldb, const int nt, const Sched& S, const Epi& E) {
    const int tid = threadIdx.x, wid = __builtin_amdgcn_readfirstlane(tid >> 6), lane = tid & 63, wr = wid >> 2, wc = wid & 3, fr = lane & 15, fq = lane >> 4;
    unsigned voffB[2];
#pragma unroll
    for (int i = 0; i < 2; ++i) { int R, C; stage_rc(tid * 16 + i * 8192, R, C); const int Rb = (R & ~31) + perm32(R & 31); voffB[i] = (unsigned)(Rb * ldb + C) * 2u; }
    const size_t kstep = (size_t)(BK * 2);
    const size_t hstep = (size_t)HALF * ldb * 2;
    const unsigned ldsw = (unsigned)wid * 1024u;
    const int aoff = lds_byte(wr * 64 + fr, fq * 8), boff = lds_byte(wc * 32 + fr, fq * 8);
#define PG8_SA(b, h) (((b) * 2 + (h)) * HTB)
#define PG8_SB(b, h) ((4 + (b) * 2 + (h)) * HTB)
#define PG8_STAGE(bufoff, gbase, voff) do { _Pragma("unroll") for (int _i = 0; _i < 2; ++_i) \
        __builtin_amdgcn_global_load_lds((const unsigned*)((const char*)(gbase) + (voff)[_i]), (LAS unsigned*)(lds + (bufoff) + ldsw + _i * 8192), 16, 0, 0); } while (0)
#define PG8_LDA(dst, b, h) do { _Pragma("unroll") for (int m = 0; m < 4; ++m) _Pragma("unroll") for (int k = 0; k < 2; ++k) dst[m][k] = *(const LAS h8*)(lds + PG8_SA(b, h) + aoff + m * 2048 + k * 1024); } while (0)
#define PG8_LDB(dst, b, h) do { _Pragma("unroll") for (int n = 0; n < 2; ++n) _Pragma("unroll") for (int k = 0; k < 2; ++k) dst[n][k] = *(const LAS h8*)(lds + PG8_SB(b, h) + boff + n * 2048 + k * 1024); } while (0)
#define PG8_MMA(ai, bj, At, Bt) do { __builtin_amdgcn_s_setprio(1); _Pragma("unroll") for (int m = 0; m < 4; ++m) _Pragma("unroll") for (int n = 0; n < 2; ++n) _Pragma("unroll") for (int k = 0; k < 2; ++k) \
        acc[ai][bj][m][n] = __builtin_amdgcn_mfma_f32_16x16x32_f16(Bt[n][k], At[m][k], acc[ai][bj][m][n], 0, 0, 0); __builtin_amdgcn_s_setprio(0); } while (0)
#define PG8_WAIT_V(n) asm volatile("s_waitcnt vmcnt(" #n ")" ::: "memory")
#define PG8_WAIT_L(n) asm volatile("s_waitcnt lgkmcnt(" #n ")" ::: "memory")
#define PG8_BAR __builtin_amdgcn_s_barrier()
#define PG8_SCHED __builtin_amdgcn_sched_barrier(0)
    Unit cur, nxt; int ui = 0;
    if (!S.next(0, cur)) return;
    f32x4 acc[2][2][4][2];
#pragma unroll
    for (int a = 0; a < 2; ++a)
#pragma unroll
        for (int b = 0; b < 2; ++b)
#pragma unroll
            for (int m = 0; m < 4; ++m)
#pragma unroll
                for (int n = 0; n < 2; ++n) acc[a][b][m][n] = (f32x4){0.f, 0.f, 0.f, 0.f};
    h8 At[4][2], B0[2][2], B1[2][2];
    unsigned voc[2][2], von[2][2];
    S.aoff(cur, voc);
    const char* cA = cur.a; const char* cB = cur.b;
    PG8_STAGE(PG8_SB(0, 0), cB, voffB); PG8_STAGE(PG8_SB(0, 1), cB + hstep, voffB); PG8_STAGE(PG8_SA(0, 0), cA, voc[0]); PG8_STAGE(PG8_SA(0, 1), cA, voc[1]);
    if (wr == 1) PG8_BAR;
    PG8_WAIT_V(2); PG8_BAR;
    PG8_STAGE(PG8_SB(1, 0), cB + kstep, voffB); PG8_STAGE(PG8_SA(1, 0), cA + kstep, voc[0]); PG8_STAGE(PG8_SB(1, 1), cB + hstep + kstep, voffB);
    PG8_WAIT_V(6); PG8_BAR;
    for (;;) {
        const bool has_next = S.next(ui + 1, nxt);
        const char* nA = has_next ? nxt.a : cA; const char* nB = has_next ? nxt.b : cB;
        if (has_next) S.aoff(nxt, von);
        else {
#pragma unroll
            for (int h = 0; h < 2; ++h)
#pragma unroll
                for (int i = 0; i < 2; ++i) von[h][i] = voc[h][i]; }
        for (int t = 0; t < nt; t += 2) {
            if constexpr (Epi::MIDK > 0) { if (t == Epi::MIDK) E.midk(acc, cur, wr, wc, fr, fq); }
            const bool last = (t == nt - 2);
            const char* a1 = cA + (size_t)(t + 1) * kstep;
            const char* a2 = last ? nA : cA + (size_t)(t + 2) * kstep; const char* b2 = last ? nB : cB + (size_t)(t + 2) * kstep;
            const char* a3 = a2 + kstep; const char* b3 = b2 + kstep;
            unsigned v2[2][2];
#pragma unroll
            for (int h = 0; h < 2; ++h)
#pragma unroll
                for (int i = 0; i < 2; ++i) v2[h][i] = last ? von[h][i] : voc[h][i];
            PG8_LDB(B0, 0, 0); PG8_LDB(B1, 0, 1); PG8_SCHED; PG8_LDA(At, 0, 0); PG8_STAGE(PG8_SA(1, 1), a1, voc[1]);
            PG8_WAIT_V(8); PG8_WAIT_L(0); PG8_BAR; PG8_MMA(0, 0, At, B0); PG8_MMA(0, 1, At, B1); PG8_BAR; PG8_SCHED;
            PG8_LDA(At, 0, 1); PG8_STAGE(PG8_SB(0, 0), b2, voffB); PG8_STAGE(PG8_SB(0, 1), b2 + hstep, voffB); PG8_STAGE(PG8_SA(0, 0), a2, v2[0]);
            PG8_WAIT_V(8); PG8_WAIT_L(0); PG8_BAR; PG8_MMA(1, 0, At, B0); PG8_MMA(1, 1, At, B1); PG8_BAR; PG8_SCHED;
            PG8_LDB(B0, 1, 0); PG8_LDB(B1, 1, 1); PG8_SCHED; PG8_LDA(At, 1, 0); PG8_STAGE(PG8_SA(0, 1), a2, v2[1]);
            PG8_WAIT_V(8); PG8_WAIT_L(0); PG8_BAR; PG8_MMA(0, 0, At, B0); PG8_MMA(0, 1, At, B1); PG8_BAR; PG8_SCHED;
            PG8_LDA(At, 1, 1); PG8_STAGE(PG8_SB(1, 0), b3, voffB); PG8_STAGE(PG8_SB(1, 1), b3 + hstep, voffB); PG8_STAGE(PG8_SA(1, 0), a3, v2[0]);
            PG8_WAIT_V(8); PG8_WAIT_L(0); PG8_BAR; PG8_MMA(1, 0, At, B0); PG8_MMA(1, 1, At, B1); PG8_BAR; PG8_SCHED;
        }
        if constexpr (ALIGN_EPI) { if (wr == 0) PG8_BAR; }
        E(acc, cur, wr, wc, fr, fq);
        if (!has_next) break;
#pragma unroll
        for (int a = 0; a < 2; ++a)
#pragma unroll
            for (int b = 0; b < 2; ++b)
#pragma unroll
                for (int m = 0; m < 4; ++m)
#pragma unroll
                    for (int n = 0; n < 2; ++n) acc[a][b][m][n] = (f32x4){0.f, 0.f, 0.f, 0.f};
        cur = nxt; cA = nA; cB = nB; ++ui;
#pragma unroll
        for (int h = 0; h < 2; ++h)
#pragma unroll
            for (int i = 0; i < 2; ++i) voc[h][i] = von[h][i];
        if constexpr (ALIGN_EPI) { if (wr == 1) PG8_BAR; }
    }
    PG8_WAIT_V(0);
    if constexpr (!ALIGN_EPI) { if (wr == 0) PG8_BAR; }
    PG8_BAR;
#undef PG8_SA
#undef PG8_SB
#undef PG8_STAGE
#undef PG8_LDA
#undef PG8_LDB
#undef PG8_MMA
#undef PG8_WAIT_V
#undef PG8_WAIT_L
#undef PG8_BAR
#undef PG8_SCHED
}
}

struct EpiProj {
    static constexpr int MIDK = 0;
    f16* PJ; const float* cosT; const float* sinT;
    DI void midk(f32x4 (&)[2][2][4][2], const pg8::Unit&, int, int, int, int) const {}
    DI void operator()(const f32x4 (&acc)[2][2][4][2], const pg8::Unit& u, int wr, int wc, int fr, int fq) const {
        const int pn = u.i1, row0 = u.i0 * 256 + wr * 64 + fr;
        if (pn < 6 || pn > 9) {
            const int col0 = pn * 256 + wc * 32 + 8 * fq;
#pragma unroll
            for (int ai = 0; ai < 2; ++ai)
#pragma unroll
                for (int m = 0; m < 4; ++m) { f16* rowp = PJ + (size_t)(row0 + ai * 128 + m * 16) * NPJ + col0;
#pragma unroll
                    for (int bj = 0; bj < 2; ++bj) *(h8*)(rowp + bj * 128) = cvt8(acc[ai][bj][m][0], acc[ai][bj][m][1]); }
        } else {
            const float sc = (pn >= 8) ? 0.08838834764831845f : 1.0f;
            const int i0 = 32 * (wc & 1) + 8 * fq;
            const int lcol = pn * 256 + (wc >> 1) * 128 + i0;
#pragma unroll
            for (int ai = 0; ai < 2; ++ai)
#pragma unroll
                for (int m = 0; m < 4; ++m) { const int row = row0 + ai * 128 + m * 16; const int pos = row & (SEQ - 1);
                    const f32x4 c0 = *(const f32x4*)(cosT + pos * 64 + i0) * sc, c1 = *(const f32x4*)(cosT + pos * 64 + i0 + 4) * sc;
                    const f32x4 s0 = *(const f32x4*)(sinT + pos * 64 + i0) * sc, s1 = *(const f32x4*)(sinT + pos * 64 + i0 + 4) * sc;
                    const f32x4 x10 = acc[ai][0][m][0], x11 = acc[ai][0][m][1], x20 = acc[ai][1][m][0], x21 = acc[ai][1][m][1];
                    f16* rowp = PJ + (size_t)row * NPJ + lcol;
                    *(h8*)(rowp) = cvt8(x10 * c0 - x20 * s0, x11 * c1 - x21 * s1);
                    *(h8*)(rowp + 64) = cvt8(x10 * s0 + x20 * c0, x11 * s1 + x21 * c1); }
        }
    }
};
struct EpiZ {
    static constexpr int MIDK = 8;
    const float* x; float* z; const float* sumsq;
    DI void midk(f32x4 (&acc)[2][2][4][2], const pg8::Unit& u, int wr, int wc, int fr, int fq) const {
#pragma unroll
        for (int ai = 0; ai < 2; ++ai)
#pragma unroll
            for (int m = 0; m < 4; ++m) { const int row = u.i0 * 256 + ai * 128 + wr * 64 + m * 16 + fr;
                const f32x4 s0 = *(const f32x4*)(sumsq + (size_t)row * 8), s1 = *(const f32x4*)(sumsq + (size_t)row * 8 + 4);
                const float ss = ((s0[0] + s0[1]) + (s0[2] + s0[3])) + ((s1[0] + s1[1]) + (s1[2] + s1[3]));
                const float rinv = 1.0f / sqrtf(ss * (1.0f / 512.0f) + LN_EPS);
#pragma unroll
                for (int bj = 0; bj < 2; ++bj)
#pragma unroll
                    for (int n = 0; n < 2; ++n) acc[ai][bj][m][n] *= rinv; }
    }
    DI void operator()(const f32x4 (&acc)[2][2][4][2], const pg8::Unit& u, int wr, int wc, int fr, int fq) const {
        const int row0 = u.i0 * 256 + wr * 64 + fr, col0 = u.i1 * 256 + wc * 32 + 8 * fq;
#pragma unroll
        for (int ai = 0; ai < 2; ++ai)
#pragma unroll
            for (int m = 0; m < 4; ++m) { const size_t off = (size_t)(row0 + ai * 128 + m * 16) * DM + col0;
#pragma unroll
                for (int bj = 0; bj < 2; ++bj) {
                    const f32x4 x0 = *(const f32x4*)(x + off + bj * 128), x1 = *(const f32x4*)(x + off + bj * 128 + 4);
                    *(f32x4*)(z + off + bj * 128) = x0 * ALPHA + acc[ai][bj][m][0]; *(f32x4*)(z + off + bj * 128 + 4) = x1 * ALPHA + acc[ai][bj][m][1]; } }
    }
};
struct MoeSched {
    LAS const int* tab; const int* elist; const char* A; const char* Bt; size_t b_expert_bytes; int lda, ldb, G, c; bool gather;
    DI bool next(int i, pg8::Unit& u) const {
        const int MT = tab[64]; const int wpx = G >> 3, xcd = c & 7, w = c >> 3;
        const int q = w + wpx * i, g = (q >> 2) * 8 + xcd, nt = q & 3;
        if (g >= MT) return false;
        int e = 0;
#pragma unroll 1
        for (int k = 1; k < 32; ++k) e += (tab[32 + k] <= g) ? 1 : 0;
        u.i0 = g; u.i1 = nt; u.i2 = e; u.i3 = g - tab[32 + e];
        u.a = gather ? A : A + (size_t)g * 256 * lda * 2;
        u.b = Bt + (size_t)e * b_expert_bytes + (size_t)nt * 256 * ldb * 2; return true;
    }
    DI void aoff(const pg8::Unit& u, unsigned (&vo)[2][2]) const {
        const int cnt = tab[u.i2];
#pragma unroll
        for (int i = 0; i < 2; ++i) { int R, C; pg8::stage_rc((int)threadIdx.x * 16 + i * 8192, R, C);
#pragma unroll
            for (int h = 0; h < 2; ++h) {
                if (gather) { int idx = u.i3 * 256 + h * 128 + R; idx = idx < cnt ? idx : 0; const int tok = elist[u.i2 * NTOK + idx] >> 1; vo[h][i] = (unsigned)(tok * lda + C) * 2u; }
                else vo[h][i] = (unsigned)((h * 128 + R) * lda + C) * 2u; } }
    }
};
struct EpiGU {
    static constexpr int MIDK = 0;
    f16* hid;
    DI void midk(f32x4 (&)[2][2][4][2], const pg8::Unit&, int, int, int, int) const {}
    DI void operator()(const f32x4 (&acc)[2][2][4][2], const pg8::Unit& u, int wr, int wc, int fr, int fq) const {
        const int row0 = u.i0 * 256 + wr * 64 + fr, col0 = u.i1 * 128 + wc * 32 + 8 * fq;
#pragma unroll
        for (int ai = 0; ai < 2; ++ai)
#pragma unroll
            for (int m = 0; m < 4; ++m) { f32x4 o[2];
#pragma unroll
                for (int n = 0; n < 2; ++n) { const f32x4 g = acc[ai][0][m][n], up = acc[ai][1][m][n];
#pragma unroll
                    for (int e = 0; e < 4; ++e) o[n][e] = g[e] * up[e] / (1.0f + fexp2(-g[e] * LOG2E)); }
                *(h8*)(hid + (size_t)(row0 + ai * 128 + m * 16) * DE + col0) = cvt8(o[0], o[1]); }
    }
};
struct EpiDown {
    static constexpr int MIDK = 0;
    f16* y; const int* elist; const float* wts; LAS const int* tab;
    DI void midk(f32x4 (&)[2][2][4][2], const pg8::Unit&, int, int, int, int) const {}
    DI void operator()(const f32x4 (&acc)[2][2][4][2], const pg8::Unit& u, int wr, int wc, int fr, int fq) const {
        const int cnt = tab[u.i2], col0 = u.i1 * 256 + wc * 32 + 8 * fq;
#pragma unroll
        for (int ai = 0; ai < 2; ++ai)
#pragma unroll
            for (int m = 0; m < 4; ++m) { const int idx = u.i3 * 256 + ai * 128 + wr * 64 + m * 16 + fr;
                if (idx < cnt) { const int ent = elist[u.i2 * NTOK + idx]; const float w = wts[ent]; f16* rowp = y + (size_t)ent * DM + col0;
#pragma unroll
                    for (int bj = 0; bj < 2; ++bj) *(h8*)(rowp + bj * 128) = cvt8(acc[ai][bj][m][0] * w, acc[ai][bj][m][1] * w); } }
    }
};

DI void tr_item(const float* W, int ldw, int k0, int nsrc0, f16* WT, int ldt, int prow0, const float* ks, LAS float* scr, int lane) {
#pragma unroll 8
    for (int i = 0; i < 32; ++i) { const int kk = 2 * i + (lane >> 5); float v = W[(size_t)(k0 + kk) * ldw + nsrc0 + (lane & 31)]; if (ks) v *= ks[k0 + kk]; scr[kk * 33 + (lane & 31)] = v; }
    LDS_WAIT(); asm volatile("" ::: "memory");
    const int c = lane & 7;
#pragma unroll
    for (int j = 0; j < 4; ++j) { const int n = (lane >> 3) + 8 * j; const LAS float* s = scr + (8 * c) * 33 + n;
        h8 o; o[0] = (f16)s[0]; o[1] = (f16)s[33]; o[2] = (f16)s[66]; o[3] = (f16)s[99]; o[4] = (f16)s[132]; o[5] = (f16)s[165]; o[6] = (f16)s[198]; o[7] = (f16)s[231];
        *(h8*)(WT + (size_t)(prow0 + n) * ldt + k0 + 8 * c) = o; }
    LDS_WAIT(); asm volatile("" ::: "memory");
}

constexpr int KP64 = 144, VP64 = 192;
template <bool OWN>
DI void attn_tile(LAS const unsigned char* Kl, LAS const unsigned char* Vl, LAS const float* biasd, const h8 (&qf)[4], int rel, int w, int lane, float& m2, float& lsum, f32x16 (&o)[2]) {
    const int r = lane & 31, hp = lane >> 5;
    f32x16 st[8];
    const float b31 = biasd[128];
    float mx = -3.0e38f;
#pragma unroll
    for (int kt = 0; kt < 8; ++kt) {
        if (!OWN || kt <= w) {
            f32x16 a;
#pragma unroll
            for (int i = 0; i < 16; ++i) a[i] = 0.f;
#pragma unroll
            for (int ks = 0; ks < 4; ++ks) { const h8 kf = *(const LAS h8*)(Kl + (32 * kt + r) * KP64 + 32 * ks + 16 * hp); a = MFMA32(kf, qf[ks], a); }
            const bool far = __all(rel - (32 * kt + 31) >= 128) != 0;
            if (far) {
#pragma unroll
                for (int i = 0; i < 16; ++i) a[i] = a[i] * (0.125f * LOG2E) + b31;
            } else {
#pragma unroll
                for (int i = 0; i < 16; ++i) { const int dist = rel - (32 * kt + crow(i, hp)); const int dd = dist < 0 ? 0 : (dist > 128 ? 128 : dist);
                    const float v = a[i] * (0.125f * LOG2E) + biasd[dd]; a[i] = (OWN && dist < 0) ? -3.0e38f : v; }
            }
#pragma unroll
            for (int i = 0; i < 16; ++i) mx = fmaxf(mx, a[i]);
            st[kt] = a;
        }
    }
    mx = fmaxf(mx, __shfl_xor(mx, 32));
    float ls = 0.f;
#pragma unroll
    for (int dt = 0; dt < 2; ++dt)
#pragma unroll
        for (int i = 0; i < 16; ++i) o[dt][i] = 0.f;
    const int i16 = lane & 15, q4 = i16 >> 2, p4 = i16 & 3, cb = (lane >> 4) & 1;
    LAS const unsigned char* vbase = Vl + (4 * hp + q4) * VP64 + 2 * (16 * cb + 4 * p4);
#pragma unroll
    for (int kt = 0; kt < 8; ++kt) {
        if (!OWN || kt <= w) {
            f32x16 p = st[kt];
#pragma unroll
            for (int i = 0; i < 16; ++i) { p[i] = fexp2(p[i] - mx); ls += p[i]; }
#pragma unroll
            for (int s = 0; s < 2; ++s) {
                const f32x8 pv = {p[8 * s], p[8 * s + 1], p[8 * s + 2], p[8 * s + 3], p[8 * s + 4], p[8 * s + 5], p[8 * s + 6], p[8 * s + 7]};
                const h8 pf = __builtin_convertvector(pv, h8);
#pragma unroll
                for (int dt = 0; dt < 2; ++dt) {
                    LAS const unsigned char* vp = vbase + (32 * kt + 16 * s) * VP64 + 64 * dt;
                    const h8 vf = cat44(tr_read(vp), tr_read(vp + 8 * VP64));
                    o[dt] = MFMA32(vf, pf, o[dt]);
                }
            }
        }
    }
    ls += __shfl_xor(ls, 32);
    m2 = mx; lsum = ls;
}
template <int P>
DI void stage64(LAS unsigned char* dst, const f16* src, int src_ld, int tid) {
#pragma unroll
    for (int i = 0; i < 4; ++i) { const int q = tid + 512 * i, row = q >> 3, ch = q & 7; *(LAS h8*)(dst + row * P + 16 * ch) = *(const h8*)(src + (size_t)row * src_ld + 8 * ch); }
}

DI void own_scores(LAS const unsigned char* Kl, LAS const float* biasd, const h8 (&qf)[4], int ql, int kt, int r, int hp, f32x16& a) {
#pragma unroll
    for (int i = 0; i < 16; ++i) a[i] = 0.f;
#pragma unroll
    for (int ks = 0; ks < 4; ++ks) { const h8 kf = *(const LAS h8*)(Kl + (32 * kt + r) * KP64 + 32 * ks + 16 * hp); a = MFMA32(kf, qf[ks], a); }
#pragma unroll
    for (int i = 0; i < 16; ++i) { const int dist = ql - (32 * kt + crow(i, hp)); const int dd = dist < 0 ? 0 : (dist > 128 ? 128 : dist);
        const float v = a[i] * (0.125f * LOG2E) + biasd[dd]; a[i] = dist < 0 ? -3.0e38f : v; }
}
DI void attn_own(LAS const unsigned char* Kl, LAS const unsigned char* Vl, LAS const float* biasd, const h8 (&qf)[4], int ql, int w, int lane, float& m2, float& lsum, f32x16 (&o)[2]) {
    const int r = lane & 31, hp = lane >> 5;
    float mx = -3.0e38f;
#pragma unroll 1
    for (int kt = 0; kt <= w; ++kt) { f32x16 a; own_scores(Kl, biasd, qf, ql, kt, r, hp, a);
#pragma unroll
        for (int i = 0; i < 16; ++i) mx = fmaxf(mx, a[i]); }
    mx = fmaxf(mx, __shfl_xor(mx, 32));
    float ls = 0.f;
#pragma unroll
    for (int dt = 0; dt < 2; ++dt)
#pragma unroll
        for (int i = 0; i < 16; ++i) o[dt][i] = 0.f;
    const int i16 = lane & 15, q4 = i16 >> 2, p4 = i16 & 3, cb = (lane >> 4) & 1;
    LAS const unsigned char* vbase = Vl + (4 * hp + q4) * VP64 + 2 * (16 * cb + 4 * p4);
#pragma unroll 1
    for (int kt = 0; kt <= w; ++kt) {
        f32x16 p; own_scores(Kl, biasd, qf, ql, kt, r, hp, p);
#pragma unroll
        for (int i = 0; i < 16; ++i) { p[i] = fexp2(p[i] - mx); ls += p[i]; }
#pragma unroll
        for (int s = 0; s < 2; ++s) {
            const f32x8 pv = {p[8 * s], p[8 * s + 1], p[8 * s + 2], p[8 * s + 3], p[8 * s + 4], p[8 * s + 5], p[8 * s + 6], p[8 * s + 7]};
            const h8 pf = __builtin_convertvector(pv, h8);
#pragma unroll
            for (int dt = 0; dt < 2; ++dt) {
                LAS const unsigned char* vp = vbase + (32 * kt + 16 * s) * VP64 + 64 * dt;
                const h8 vf = cat44(tr_read(vp), tr_read(vp + 8 * VP64));
                o[dt] = MFMA32(vf, pf, o[dt]);
            }
        }
    }
    ls += __shfl_xor(ls, 32);
    m2 = mx; lsum = ls;
}
__global__ void __launch_bounds__(512, 2) fwd(Args a) {
    extern __shared__ __attribute__((aligned(16))) unsigned char smem[];
    LAS unsigned char* lds = (LAS unsigned char*)smem;
    volatile LAS unsigned* MISC = (volatile LAS unsigned*)(lds + MISC_OFF);
    LAS float* biasl = (LAS float*)(lds + BIAS_OFF);
    const int tid = threadIdx.x, lane = tid & 63, wave = __builtin_amdgcn_readfirstlane(tid >> 6);
    const int G = gridDim.x, bid = blockIdx.x;
    unsigned char* ws = a.ws;
    unsigned* ctl = (unsigned*)(ws + WS_CTL);
    float* ropeC = (float*)(ws + WS_ROPEC); float* ropeS = (float*)(ws + WS_ROPES); float* xsum = (float*)(ws + WS_XSUM);
    f16* kmean = (f16*)(ws + WS_KMEAN); f16* WrT = (f16*)(ws + WS_WRT); float* sumsq = (float*)(ws + WS_SUMSQ); float* wts = (float*)(ws + WS_WTS);
    int* elist = (int*)(ws + WS_ELIST); unsigned short* mlist = (unsigned short*)(ws + WS_MLIST); f32x2* pml = (f32x2*)(ws + WS_PML);
    f16* WinT = (f16*)(ws + WS_WINT); f16* WoT = (f16*)(ws + WS_WOT); f16* WguT = (f16*)(ws + WS_WGUT); f16* WdnT = (f16*)(ws + WS_WDNT);
    f16* PJ = (f16*)(ws + WS_PJ); f16* xh = (f16*)(ws + WS_XH); f16* cat = (f16*)(ws + WS_CAT); float* kvbuf = (float*)(ws + WS_KV); f16* Rbuf = (f16*)(ws + WS_R);
    f16* hh = (f16*)(ws + WS_HH); f16* hid = (f16*)(ws + WS_HID); f16* ybuf = (f16*)(ws + WS_Y);
    f16* pO = (f16*)a.out;
    float* zbuf = a.out;
    unsigned* lcnt = ctl + CW_LCNT; unsigned* ecnt = ctl + CW_ECNT;

    if (tid < 64) MISC[tid] = 0u;
    for (int idx = tid; idx < 8 * 132; idx += 512) { const int h = idx / 132, d = idx % 132, dd = d > 128 ? 128 : d; biasl[idx] = a.rel[(int)T5_BUCKET[dd] * 8 + h] * LOG2E; }
    __syncthreads();
    const int lo = a.ph_lo, hi = a.ph_hi;
    XcdBarrier bar; bar.bar = ctl + CW_BAR; bar.x = 0; bar.st = MISC + 8;
    if (hi - lo > 1) bar = xcd_barrier_post(ctl + CW_BAR, MISC + 8);
#ifndef PH_MASK
#define PH_MASK 0x3ff
#endif
#define IN(k) ((((PH_MASK) >> (k)) & 1) && lo <= (k) && (k) < hi)
#define SEAM(k) do { if (IN(k) && IN((k) + 1)) xcd_barrier(bar); } while (0)

    if (IN(0)) {
        for (int hb = bid; hb < 256; hb += G) {
            const int c4 = tid & 255, rp = tid >> 8;
            const float* src = a.x + (size_t)hb * 128 * DM + c4 * 4; f16* dst = xh + (size_t)hb * 128 * DM + c4 * 4;
            f32x4 s = {0.f, 0.f, 0.f, 0.f};
#pragma unroll 8
            for (int r = rp; r < 128; r += 2) { const f32x4 v = *(const f32x4*)(src + (size_t)r * DM); s += v; *(h4*)(dst + (size_t)r * DM) = __builtin_convertvector(v, h4); }
            LAS f32x4* red = (LAS f32x4*)lds;
            if (rp == 1) red[c4] = s;
            __syncthreads();
            if (rp == 0) { s += red[c4]; *(f32x4*)(xsum + (size_t)hb * DM + c4 * 4) = s; }
            __syncthreads();
        }
        for (int idx = bid * 512 + tid; idx < SEQ * 64; idx += G * 512) {
            const int pos = idx >> 6, i = idx & 63;
            const float ang = (float)pos * ROPE_INV[i];
            const double xd = (double)ang, kd = __builtin_rint(xd * 0.6366197723675814);
            double rr = __builtin_fma(-kd, 1.5707963267948966, xd); rr = __builtin_fma(-kd, 6.123233995736766e-17, rr);
            const double r2 = rr * rr;
            const double sp = rr * (1.0 + r2 * (-1.0 / 6 + r2 * (1.0 / 120 + r2 * (-1.0 / 5040 + r2 * (1.0 / 362880 + r2 * (-1.0 / 39916800 + r2 * (1.0 / 6227020800.0)))))));
            const double cp = 1.0 + r2 * (-0.5 + r2 * (1.0 / 24 + r2 * (-1.0 / 720 + r2 * (1.0 / 40320 + r2 * (-1.0 / 3628800 + r2 * (1.0 / 479001600.0 + r2 * (-1.0 / 87178291200.0)))))));
            const int q = (int)kd & 3;
            const double sv = (q == 0) ? sp : (q == 1) ? cp : (q == 2) ? -sp : -cp;
            const double cv = (q == 0) ? cp : (q == 1) ? -sp : (q == 2) ? -cp : sp;
            ropeC[idx] = (float)cv; ropeS[idx] = (float)sv;
        }
        for (int idx = bid * 512 + tid; idx < 48 * DM; idx += G * 512) {
            const int n = idx >> 10, k = idx & 1023;
            const float v = (n < 4) ? a.wrg[k * 4 + n] : (n < 36) ? a.wre[k * 32 + (n - 4)] : 0.f;
            WrT[idx] = (f16)v;
        }
        {
            LAS float* scr = (LAS float*)(lds + wave * 16384);
            constexpr int I_IN = 16 * 112, I_O = 16 * 32, I_GU = 32 * 512, I_DN = 32 * 256, NIT = I_IN + I_O + I_GU + I_DN;
            for (int it = bid * 8 + wave; it < NIT; it += G * 8) {
                int r = it;
                if (r < I_IN) { const int kb = r / 112, nb = r % 112, pn = nb >> 3, g = nb & 7;
                    const int nsrc = (pn >= 6 && pn <= 9) ? pn * 256 + 128 * ((g >> 1) & 1) + 64 * (g >> 2) + 32 * (g & 1) : 32 * nb;
                    tr_item(a.w_in, NPJ, 64 * kb, nsrc, WinT, DM, 32 * nb, nullptr, scr, lane); continue; } r -= I_IN;
                if (r < I_O) { const int kb = r / 32, nb = r % 32; tr_item(a.w_out, DM, 64 * kb, 32 * nb, WoT, DM, 32 * nb, kb < 8 ? a.gain : nullptr, scr, lane); continue; } r -= I_O;
                if (r < I_GU) { const int e = r >> 9, rr = r & 511, kb = rr >> 5, nb = rr & 31, pn = nb >> 3, g = nb & 7;
                    const int nsrc = (g >> 2) * 512 + 128 * pn + 32 * (g & 3);
                    tr_item(a.wgu + (size_t)e * DM * DM, DM, 64 * kb, nsrc, WguT + (size_t)e * DM * DM, DM, 32 * nb, nullptr, scr, lane); continue; } r -= I_GU;
                { const int e = r >> 8, rr = r & 255, kb = rr >> 5, nb = rr & 31;
                    tr_item(a.wdn + (size_t)e * DE * DM, DM, 64 * kb, 32 * nb, WdnT + (size_t)e * DM * DE, DE, 32 * nb, nullptr, scr, lane); }
            }
        }
        __syncthreads();
    }
    SEAM(0);

    if (IN(1)) {
        for (int job = bid; job < 256; job += G) {
            const int blk = job >> 1, ch = job & 1;
            LAS float* xm = (LAS float*)lds;
            for (int k = tid; k < DM; k += 512) xm[k] = (xsum[(size_t)(2 * blk) * DM + k] + xsum[(size_t)(2 * blk + 1) * DM + k]) * (1.0f / 256.0f);
            __syncthreads();
            const int col = tid & 255, kh = tid >> 8;
            const float* wp = a.w_in + (size_t)(kh * 512) * NPJ + C_AK + ch * 256 + col;
            float acc = 0.f;
#pragma unroll 8
            for (int k = 0; k < 512; ++k) acc += xm[kh * 512 + k] * wp[(size_t)k * NPJ];
            LAS float* red = xm + 1024;
            if (kh) red[col] = acc;
            __syncthreads();
            if (!kh) { acc += red[col]; const int c = ch * 256 + col, h = c >> 6, d = c & 63, b = blk >> 6, j = blk & 63; kmean[((size_t)(b * 8 + h) * 64 + j) * 64 + d] = (f16)acc; }
            __syncthreads();
        }
        pg8::StaticOrder S; S.init(xh, WinT, DM, DM, NTOK, NPJ, G, bid);
        EpiProj E{PJ, ropeC, ropeS};
        pg8::gemm_phase<EpiProj, pg8::StaticOrder, true>(lds, DM, DM / 64, S, E);
    }
    SEAM(1);

    if (IN(2)) {
        constexpr int NU_G = 16 * 63, NU_KV = 8 * 64;
        for (int u = bid; u < NU_G + NU_KV; u += G) {
            if (u < NU_KV) {
                const int bh = u >> 6, ci = u & 63, b = bh >> 2, h = bh & 3;
                const float lg = gamma_log2(h);
                const f16* kp = PJ + (size_t)(b * SEQ + ci * 256) * NPJ + C_RK + h * 128;
                const f16* vp = PJ + (size_t)(b * SEQ + ci * 256) * NPJ + C_RV + h * 128;
                LAS unsigned char* Kl = lds; LAS unsigned char* Vl = lds + 128 * 320;
                const int dvt = wave & 3, dk0 = 2 * (wave >> 2);
                f32x16 acc[2];
#pragma unroll
                for (int t = 0; t < 2; ++t)
#pragma unroll
                    for (int i = 0; i < 16; ++i) acc[t][i] = 0.f;
                const int r = lane & 31, hp = lane >> 5, i16 = lane & 15, q4 = i16 >> 2, p4 = i16 & 3, cb = (lane >> 4) & 1;
                for (int half = 0; half < 2; ++half) {
#pragma unroll
                    for (int i = 0; i < 4; ++i) { const int q = tid + 512 * i, row = q >> 4, ch = q & 15; const int key = half * 128 + row;
                        const h8 kv = *(const h8*)(kp + (size_t)key * NPJ + 8 * ch); const float sc = fexp2(lg * (float)(255 - key));
                        const f32x8 kf = __builtin_convertvector(kv, f32x8) * sc;
                        *(LAS h8*)(Kl + row * 320 + 16 * ch) = __builtin_convertvector(kf, h8);
                        *(LAS h8*)(Vl + row * 320 + 16 * ch) = *(const h8*)(vp + (size_t)key * NPJ + 8 * ch); }
                    __syncthreads();
#pragma unroll
                    for (int s = 0; s < 8; ++s) {
                        LAS const unsigned char* ap = Vl + (16 * s + 8 * hp + q4) * 320 + 2 * (32 * dvt + 16 * cb + 4 * p4);
                        const h8 af = cat44(tr_read(ap), tr_read(ap + 4 * 320));
#pragma unroll
                        for (int t = 0; t < 2; ++t) {
                            LAS const unsigned char* bp = Kl + (16 * s + 8 * hp + q4) * 320 + 2 * (32 * (dk0 + t) + 16 * cb + 4 * p4);
                            const h8 bf = cat44(tr_read(bp), tr_read(bp + 4 * 320));
                            acc[t] = MFMA32(af, bf, acc[t]);
                        }
                    }
                    __syncthreads();
                }
                float* dst = kvbuf + (size_t)u * 128 * 128;
#pragma unroll
                for (int t = 0; t < 2; ++t)
#pragma unroll
                    for (int i = 0; i < 16; ++i) dst[(32 * dvt + crow(i, hp)) * 128 + 32 * (dk0 + t) + r] = acc[t][i];
            } else {
                const int uu = u - NU_KV, bh = uu / 63, c = 1 + uu % 63, b = bh >> 3, h = bh & 7;
                const int r = lane & 31, hp = lane >> 5;
                const int s = 256 * c + 32 * wave + r;
                const f16* qrow = PJ + (size_t)(b * SEQ + s) * NPJ + C_AQ + h * 64;
                h8 qf[4];
#pragma unroll
                for (int ks = 0; ks < 4; ++ks) qf[ks] = *(const h8*)(qrow + 16 * ks + 8 * hp);
                const f16* km = kmean + (size_t)bh * 64 * 64;
                float v[2][16];
#pragma unroll
                for (int t = 0; t < 2; ++t) {
                    f32x16 g;
#pragma unroll
                    for (int i = 0; i < 16; ++i) g[i] = 0.f;
                    if (t == 0 || c > 32) {
#pragma unroll
                        for (int ks = 0; ks < 4; ++ks) { const h8 kf = *(const h8*)(km + (32 * t + r) * 64 + 16 * ks + 8 * hp); g = MFMA32(kf, qf[ks], g); }
                    }
#pragma unroll
                    for (int i = 0; i < 16; ++i) v[t][i] = (32 * t + crow(i, hp) < c) ? g[i] : -3.0e38f;
                }
                int sel[3]; bool sval[3];
#pragma unroll
                for (int rd = 0; rd < 3; ++rd) {
                    float mv = -3.0e38f; int mi = 1 << 20;
#pragma unroll
                    for (int t = 0; t < 2; ++t)
#pragma unroll
                        for (int i = 0; i < 16; ++i) { const int idx = 32 * t + crow(i, hp); const float val = v[t][i]; if (val > mv || (val == mv && idx < mi)) { mv = val; mi = idx; } }
                    const float ov = __shfl_xor(mv, 32); const int oi = __shfl_xor(mi, 32);
                    if (ov > mv || (ov == mv && oi < mi)) { mv = ov; mi = oi; }
                    sel[rd] = mi; sval[rd] = mv > -1.0e38f;
#pragma unroll
                    for (int t = 0; t < 2; ++t)
#pragma unroll
                        for (int i = 0; i < 16; ++i) if (32 * t + crow(i, hp) == mi) v[t][i] = -3.0e38f;
                }
#pragma unroll
                for (int rd = 0; rd < 3; ++rd) {
                    bool pend = sval[rd] && (hp == 0);
                    const int blk = sel[rd];
                    for (;;) {
                        const unsigned long long pm = __ballot(pend);
                        if (pm == 0ull) break;
                        const int leader = __builtin_ctzll(pm);
                        const int lb = __shfl(blk, leader);
                        const unsigned long long mm = __ballot(pend && blk == lb);
                        unsigned base = 0u;
                        if (lane == leader) base = atomicAdd(lcnt + bh * 64 + lb, (unsigned)__builtin_popcountll(mm));
                        base = __shfl(base, leader);
                        if (pend && blk == lb) {
                            const unsigned pos = base + (unsigned)__builtin_popcountll(mm & ((1ull << lane) - 1ull));
                            mlist[(size_t)bh * MLIST_PER_BH + (size_t)lb * SEQ - 128 * lb * (lb + 1) + pos] = (unsigned short)((s << 2) | rd);
                            pend = false;
                        }
                    }
                }
            }
        }
    }
    SEAM(2);

    if (IN(3)) {
        for (int gid = bid * 512 + tid; gid < 8 * 16384; gid += G * 512) {
            const int bh = gid >> 14, e = gid & 16383, h = bh & 3;
            const float cd = fexp2(256.0f * gamma_log2(h));
            const float* src = kvbuf + (size_t)bh * 64 * 16384 + e; f16* dst = Rbuf + (size_t)bh * 64 * 16384 + e;
            float run = 0.f;
#pragma unroll 8
            for (int i = 0; i < 64; ++i) { dst[(size_t)i * 16384] = (f16)run; run = run * cd + src[(size_t)i * 16384]; }
        }
        LAS int* pre = (LAS int*)(lds + 100 * 1024);
        LAS int* wsum = pre + 1032;
        {
            const int c0 = (int)lcnt[2 * tid], c1 = (int)lcnt[2 * tid + 1];
            const int n0 = (c0 + 255) >> 8, n1 = (c1 + 255) >> 8;
            int v = n0 + n1, incl = v;
#pragma unroll
            for (int o = 1; o < 64; o <<= 1) { const int t = __shfl_up(incl, o); if (lane >= o) incl += t; }
            if (lane == 63) wsum[wave] = incl;
            __syncthreads();
            int woff = 0;
            for (int k = 0; k < wave; ++k) woff += wsum[k];
            const int ex = woff + incl - v;
            pre[2 * tid] = ex; pre[2 * tid + 1] = ex + n0;
            if (tid == 511) pre[1024] = ex + v;
            __syncthreads();
        }
        const int U = pre[1024];
        const int u_lo = (int)(((long)U * bid) / G), u_hi = (int)(((long)U * (bid + 1)) / G);
        LAS unsigned char* Kl = lds; LAS unsigned char* Vl = lds + 256 * KP64;
        int staged = -1;
        for (int u = u_lo; u < u_hi; ++u) {
            int l = 0;
#pragma unroll 1
            for (int step = 512; step > 0; step >>= 1) if (l + step <= 1023 && pre[l + step] <= u) l += step;
            const int bh = l >> 6, j = l & 63, b = bh >> 3, h = bh & 7, chunk = u - pre[l];
            const int cnt = (int)lcnt[l];
            if (l != staged) {
                __syncthreads();
                stage64<KP64>(Kl, PJ + (size_t)(b * SEQ + j * 256) * NPJ + C_AK + h * 64, NPJ, tid);
                stage64<VP64>(Vl, PJ + (size_t)(b * SEQ + j * 256) * NPJ + C_AV + h * 64, NPJ, tid);
                __syncthreads();
                staged = l;
            }
            const int rows = cnt - 256 * chunk;
            if (32 * wave < rows) {
                const int r = lane & 31, hp = lane >> 5;
                const int ri = 32 * wave + r; const bool valid = ri < rows;
                const unsigned ent = mlist[(size_t)bh * MLIST_PER_BH + (size_t)j * SEQ - 128 * j * (j + 1) + 256 * chunk + (valid ? ri : 0)];
                const int s = (int)(ent >> 2), slot = (int)(ent & 3u);
                const f16* qrow = PJ + (size_t)(b * SEQ + s) * NPJ + C_AQ + h * 64;
                h8 qf[4];
#pragma unroll
                for (int ks = 0; ks < 4; ++ks) qf[ks] = *(const h8*)(qrow + 16 * ks + 8 * hp);
                float m2, ls; f32x16 o[2];
                attn_tile<false>(Kl, Vl, biasl + h * 132, qf, s - 256 * j, 0, lane, m2, ls, o);
                if (valid) {
                    const size_t pidx = ((size_t)bh * SEQ + s) * 3 + slot;
                    if (hp == 0) pml[pidx] = (f32x2){m2, ls};
                    const float inv = 1.0f / ls; f16* po = pO + pidx * 64;
#pragma unroll
                    for (int dt = 0; dt < 2; ++dt)
#pragma unroll
                        for (int g = 0; g < 4; ++g) { const f32x4 vv = {o[dt][4 * g] * inv, o[dt][4 * g + 1] * inv, o[dt][4 * g + 2] * inv, o[dt][4 * g + 3] * inv};
                            *(h4*)(po + 32 * dt + 8 * g + 4 * hp) = __builtin_convertvector(vv, h4); }
                }
            }
        }
        __syncthreads();
    }
    SEAM(3);

    if (IN(4)) {
        constexpr int NU_A = 16 * 64, NU_R = 8 * 64;
        for (int u = bid; u < NU_A + NU_R; u += G) {
            __syncthreads();
            if (u < NU_R) {
#ifndef P4_NO_RET
                const int bh = u >> 6, ci = u & 63, b = bh >> 2, h = bh & 3;
                const float lg = gamma_log2(h);
                const size_t row0 = (size_t)b * SEQ + ci * 256;
                LAS unsigned char* Kl = lds; LAS unsigned char* Vl = lds + 256 * 272;
#pragma unroll
                for (int i = 0; i < 8; ++i) { const int q = tid + 512 * i, row = q >> 4, ch = q & 15;
                    *(LAS h8*)(Kl + row * 272 + 16 * ch) = *(const h8*)(PJ + (row0 + row) * NPJ + C_RK + h * 128 + 8 * ch);
                    *(LAS h8*)(Vl + row * 320 + 16 * ch) = *(const h8*)(PJ + (row0 + row) * NPJ + C_RV + h * 128 + 8 * ch); }
                __syncthreads();
                const int r = lane & 31, hp = lane >> 5, i16 = lane & 15, q4 = i16 >> 2, p4 = i16 & 3, cb = (lane >> 4) & 1;
                const int ql = 32 * wave + r;
                const f16* qrow = PJ + (row0 + ql) * NPJ + C_RQ + h * 128;
                h8 qf[8];
#pragma unroll
                for (int ks = 0; ks < 8; ++ks) qf[ks] = *(const h8*)(qrow + 16 * ks + 8 * hp);
                f32x16 o[4];
#pragma unroll
                for (int t = 0; t < 4; ++t)
#pragma unroll
                    for (int i = 0; i < 16; ++i) o[t][i] = 0.f;
                const f16* Rt = Rbuf + (size_t)u * 128 * 128;
#pragma unroll
                for (int t = 0; t < 4; ++t)
#pragma unroll
                    for (int ks = 0; ks < 8; ++ks) { const h8 rf = *(const h8*)(Rt + (32 * t + r) * 128 + 16 * ks + 8 * hp); o[t] = MFMA32(rf, qf[ks], o[t]); }
                const float qd = fexp2(lg * (float)(ql + 1));
#pragma unroll
                for (int t = 0; t < 4; ++t)
#pragma unroll
                    for (int i = 0; i < 16; ++i) o[t][i] *= qd;
                LAS const unsigned char* vbase = Vl + (4 * hp + q4) * 320 + 2 * (16 * cb + 4 * p4);
                for (int kt = 0; kt <= wave; ++kt) {
                    f32x16 st;
#pragma unroll
                    for (int i = 0; i < 16; ++i) st[i] = 0.f;
#pragma unroll
                    for (int ks = 0; ks < 8; ++ks) { const h8 kf = *(const LAS h8*)(Kl + (32 * kt + r) * 272 + 32 * ks + 16 * hp); st = MFMA32(kf, qf[ks], st); }
#pragma unroll
                    for (int i = 0; i < 16; ++i) { const int dist = ql - (32 * kt + crow(i, hp)); st[i] = dist >= 0 ? st[i] * fexp2(lg * (float)dist) : 0.f; }
#pragma unroll
                    for (int s = 0; s < 2; ++s) {
                        const f32x8 pv = {st[8 * s], st[8 * s + 1], st[8 * s + 2], st[8 * s + 3], st[8 * s + 4], st[8 * s + 5], st[8 * s + 6], st[8 * s + 7]};
                        const h8 pf = __builtin_convertvector(pv, h8);
#pragma unroll
                        for (int t = 0; t < 4; ++t) {
                            LAS const unsigned char* vp = vbase + (32 * kt + 16 * s) * 320 + 64 * t;
                            const h8 vf = cat44(tr_read(vp), tr_read(vp + 8 * 320));
                            o[t] = MFMA32(vf, pf, o[t]);
                        }
                    }
                }
                float sm = 0.f;
#pragma unroll
                for (int t = 0; t < 4; ++t)
#pragma unroll
                    for (int i = 0; i < 16; ++i) sm += o[t][i];
                sm += __shfl_xor(sm, 32);
                const float mu = sm * (1.0f / 128.0f);
                float sq = 0.f;
#pragma unroll
                for (int t = 0; t < 4; ++t)
#pragma unroll
                    for (int i = 0; i < 16; ++i) { const float d = o[t][i] - mu; sq += d * d; }
                sq += __shfl_xor(sq, 32);
                const float rstd = 1.0f / sqrtf(sq * (1.0f / 128.0f) + LN_EPS);
                const f16* grow = PJ + (row0 + ql) * NPJ + C_RG + h * 128;
                f16* crow_ = cat + (row0 + ql) * DM + 512 + h * 128;
#pragma unroll
                for (int t = 0; t < 4; ++t)
#pragma unroll
                    for (int g = 0; g < 4; ++g) { const int d0 = 32 * t + 8 * g + 4 * hp;
                        const h4 gv = *(const h4*)(grow + d0); f32x4 ov;
#pragma unroll
                        for (int e = 0; e < 4; ++e) { const float gg = (float)gv[e]; const float sl = gg / (1.0f + fexp2(-gg * LOG2E)); ov[e] = sl * (o[t][4 * g + e] - mu) * rstd; }
                        *(h4*)(crow_ + d0) = __builtin_convertvector(ov, h4); }
#endif
            } else {
#ifndef P4_NO_ATT
                const int uu = u - NU_R, bh = uu >> 6, c = uu & 63, b = bh >> 3, h = bh & 7;
                LAS unsigned char* Kl = lds; LAS unsigned char* Vl = lds + 256 * KP64;
                stage64<KP64>(Kl, PJ + (size_t)(b * SEQ + c * 256) * NPJ + C_AK + h * 64, NPJ, tid);
                stage64<VP64>(Vl, PJ + (size_t)(b * SEQ + c * 256) * NPJ + C_AV + h * 64, NPJ, tid);
                __syncthreads();
                const int r = lane & 31, hp = lane >> 5;
                const int ql = 32 * wave + r, s = 256 * c + ql;
                const f16* qrow = PJ + (size_t)(b * SEQ + s) * NPJ + C_AQ + h * 64;
                h8 qf[4];
#pragma unroll
                for (int ks = 0; ks < 4; ++ks) qf[ks] = *(const h8*)(qrow + 16 * ks + 8 * hp);
                float m2, ls; f32x16 o[2];
                attn_own(Kl, Vl, biasl + h * 132, qf, ql, wave, lane, m2, ls, o);
                const int nsel = c < 3 ? c : 3;
                const size_t pidx = ((size_t)bh * SEQ + s) * 3;
                float pm[3], pl[3]; float M = m2;
#pragma unroll
                for (int t = 0; t < 3; ++t) { pm[t] = -3.0e38f; pl[t] = 0.f; if (t < nsel) { const f32x2 v = pml[pidx + t]; pm[t] = v[0]; pl[t] = v[1]; M = fmaxf(M, pm[t]); } }
                const float e0 = fexp2(m2 - M); float L = ls * e0;
#pragma unroll
                for (int dt = 0; dt < 2; ++dt)
#pragma unroll
                    for (int i = 0; i < 16; ++i) o[dt][i] *= e0;
#pragma unroll
                for (int t = 0; t < 3; ++t) if (t < nsel) {
                    const float wt = pl[t] * fexp2(pm[t] - M); L += wt; const f16* po = pO + (pidx + t) * 64;
#pragma unroll
                    for (int dt = 0; dt < 2; ++dt)
#pragma unroll
                        for (int g = 0; g < 4; ++g) { const h4 pv = *(const h4*)(po + 32 * dt + 8 * g + 4 * hp);
#pragma unroll
                            for (int e = 0; e < 4; ++e) o[dt][4 * g + e] += wt * (float)pv[e]; }
                }
                const float invL = 1.0f / L; float sq = 0.f;
                f16* crow_ = cat + (size_t)(b * SEQ + s) * DM + h * 64;
#pragma unroll
                for (int dt = 0; dt < 2; ++dt)
#pragma unroll
                    for (int g = 0; g < 4; ++g) { f32x4 ov;
#pragma unroll
                        for (int e = 0; e < 4; ++e) { ov[e] = o[dt][4 * g + e] * invL; sq += ov[e] * ov[e]; }
                        *(h4*)(crow_ + 32 * dt + 8 * g + 4 * hp) = __builtin_convertvector(ov, h4); }
                sq += __shfl_xor(sq, 32);
                if (hp == 0) sumsq[(size_t)(b * SEQ + s) * 8 + h] = sq;
#endif
            }
        }
        __syncthreads();
    }
    SEAM(4);

    if (IN(5)) {
        pg8::StaticOrder S; S.init(cat, WoT, DM, DM, NTOK, DM, G, bid);
        EpiZ E{a.x, zbuf, sumsq};
        pg8::gemm_phase<EpiZ, pg8::StaticOrder, true>(lds, DM, DM / 64, S, E);
    }
    SEAM(5);

    if (IN(6)) {
        LAS unsigned char* Ht = lds;
        LAS float* lg = (LAS float*)(lds + 32 * 2064);
        f32x4 gv[4], bv[4];
#pragma unroll
        for (int j = 0; j < 4; ++j) { gv[j] = *(const f32x4*)(a.ln1g + 4 * lane + 256 * j); bv[j] = *(const f32x4*)(a.ln1b + 4 * lane + 256 * j); }
        for (int u = bid; u < NTOK / 32; u += G) {
            __syncthreads();
#pragma unroll 1
            for (int rr = 0; rr < 4; ++rr) {
                const int rl = 4 * wave + rr; const size_t row = (size_t)u * 32 + rl;
                f32x4 v[4]; float s = 0.f;
#pragma unroll
                for (int j = 0; j < 4; ++j) { v[j] = *(const f32x4*)(zbuf + row * DM + 4 * lane + 256 * j); s += (v[j][0] + v[j][1]) + (v[j][2] + v[j][3]); }
                const float mean = wave_sum(s) * (1.0f / DM); float s2 = 0.f;
#pragma unroll
                for (int j = 0; j < 4; ++j) { v[j] = v[j] - mean; s2 += (v[j][0] * v[j][0] + v[j][1] * v[j][1]) + (v[j][2] * v[j][2] + v[j][3] * v[j][3]); }
                const float rstd = 1.0f / sqrtf(wave_sum(s2) * (1.0f / DM) + LN_EPS);
#pragma unroll
                for (int j = 0; j < 4; ++j) { const h4 hv = __builtin_convertvector(v[j] * rstd * gv[j] + bv[j], h4);
                    *(h4*)(hh + row * DM + 4 * lane + 256 * j) = hv; *(LAS h4*)(Ht + rl * 2064 + 2 * (4 * lane + 256 * j)) = hv; }
            }
            __syncthreads();
            if (wave < 6) {
                const int rt = wave / 3, ct = wave % 3, fr = lane & 15, fq = lane >> 4;
                f32x4 acc = {0.f, 0.f, 0.f, 0.f};
#pragma unroll 8
                for (int ks = 0; ks < 32; ++ks) { const h8 af = *(const LAS h8*)(Ht + (16 * rt + fr) * 2064 + 2 * (32 * ks + 8 * fq));
                    const h8 bf = *(const h8*)(WrT + (size_t)(16 * ct + fr) * DM + 32 * ks + 8 * fq); acc = MFMA16(af, bf, acc); }
#pragma unroll
                for (int e = 0; e < 4; ++e) lg[(16 * rt + 4 * fq + e) * 48 + 16 * ct + fr] = acc[e];
            }
            __syncthreads();
            if (tid < 32) {
                const int tok = u * 32 + tid; LAS const float* L = lg + tid * 48;
                float g4[4]; int gi = 0; float gm = -3.0e38f;
#pragma unroll
                for (int k = 0; k < 4; ++k) { g4[k] = L[k] + a.brg[k]; if (g4[k] > gm) { gm = g4[k]; gi = k; } }
                float gs = 0.f;
#pragma unroll
                for (int k = 0; k < 4; ++k) gs += __expf(g4[k] - gm);
                const float gp = 1.0f / gs;
                float l1 = -3.0e38f, l2 = -3.0e38f; int i1 = 0, i2 = 0;
                for (int k = 0; k < 8; ++k) { const float v = L[4 + 8 * gi + k] + a.bre[8 * gi + k]; if (v > l1) { l2 = l1; i2 = i1; l1 = v; i1 = k; } else if (v > l2) { l2 = v; i2 = k; } }
                const float w1 = 1.0f / (1.0f + __expf(l2 - l1)), w2 = 1.0f - w1;
                const int e1 = 8 * gi + i1, e2 = 8 * gi + i2;
                const unsigned p1 = atomicAdd(ecnt + e1, 1u), p2 = atomicAdd(ecnt + e2, 1u);
                elist[e1 * NTOK + (int)p1] = tok * 2; elist[e2 * NTOK + (int)p2] = tok * 2 + 1;
                wts[tok * 2] = gp * w1; wts[tok * 2 + 1] = gp * w2;
            }
        }
        __syncthreads();
    }
    SEAM(6);

    LAS int* mtab = (LAS int*)(lds + pg8::STAGE_BYTES + 1024);
    if (IN(7) || IN(8)) {
        if (tid == 0) { int acc = 0; for (int e = 0; e < 32; ++e) { const int c = (int)ecnt[e]; mtab[e] = c; mtab[32 + e] = acc; acc += (c + 255) >> 8; } mtab[64] = acc; }
        __syncthreads();
    }
    if (IN(7)) {
        MoeSched S{mtab, elist, (const char*)hh, (const char*)WguT, (size_t)DM * DM * 2, DM, DM, G, bid, true};
        EpiGU E{hid};
        pg8::gemm_phase<EpiGU, MoeSched, true>(lds, DM, DM / 64, S, E);
    }
    SEAM(7);
    if (IN(8)) {
        MoeSched S{mtab, elist, (const char*)hid, (const char*)WdnT, (size_t)DM * DE * 2, DE, DE, G, bid, false};
        EpiDown E{ybuf, elist, wts, mtab};
        pg8::gemm_phase<EpiDown, MoeSched, true>(lds, DE, DE / 64, S, E);
    }
    SEAM(8);

    if (IN(9)) {
        f32x4 gv[4], bv[4];
#pragma unroll
        for (int j = 0; j < 4; ++j) { gv[j] = *(const f32x4*)(a.ln2g + 4 * lane + 256 * j); bv[j] = *(const f32x4*)(a.ln2b + 4 * lane + 256 * j); }
        for (int row = bid * 8 + wave; row < NTOK; row += G * 8) {
            f32x4 v[4]; float s = 0.f;
#pragma unroll
            for (int j = 0; j < 4; ++j) { const size_t c = 4 * lane + 256 * j;
                const f32x4 hv = __builtin_convertvector(*(const h4*)(hh + (size_t)row * DM + c), f32x4);
                const f32x4 y0 = __builtin_convertvector(*(const h4*)(ybuf + (size_t)(2 * row) * DM + c), f32x4);
                const f32x4 y1 = __builtin_convertvector(*(const h4*)(ybuf + (size_t)(2 * row + 1) * DM + c), f32x4);
                v[j] = hv * ALPHA + (y0 + y1); s += (v[j][0] + v[j][1]) + (v[j][2] + v[j][3]); }
            const float mean = wave_sum(s) * (1.0f / DM); float s2 = 0.f;
#pragma unroll
            for (int j = 0; j < 4; ++j) { v[j] = v[j] - mean; s2 += (v[j][0] * v[j][0] + v[j][1] * v[j][1]) + (v[j][2] * v[j][2] + v[j][3] * v[j][3]); }
            const float rstd = 1.0f / sqrtf(wave_sum(s2) * (1.0f / DM) + LN_EPS);
#pragma unroll
            for (int j = 0; j < 4; ++j) *(f32x4*)(a.out + (size_t)row * DM + 4 * lane + 256 * j) = v[j] * rstd * gv[j] + bv[j];
        }
    }
#undef IN
#undef SEAM
}

extern "C" void kernel_launch(void* const* d_in, const int* in_sizes, int n_in, void* d_out, int out_size, void* d_ws, size_t ws_size, hipStream_t stream) {
    static int grid = 0;
    if (grid == 0) {
        if (n_in != 15 || in_sizes[0] != NTOK * DM || out_size != NTOK * DM || ws_size < WS_END) { fprintf(stderr, "kernel_launch: unexpected problem (n_in %d, ws %zu)\n", n_in, ws_size); grid = -1; return; }
        int dev = 0, cus = 0, per_cu = 0;
        if (hipGetDevice(&dev) != hipSuccess || hipDeviceGetAttribute(&cus, hipDeviceAttributeMultiprocessorCount, dev) != hipSuccess) { grid = -1; return; }
        if (hipFuncSetAttribute((const void*)fwd, hipFuncAttributeMaxDynamicSharedMemorySize, LDS_BYTES) != hipSuccess) { fprintf(stderr, "kernel_launch: hipFuncSetAttribute failed\n"); grid = -1; return; }
        if (hipOccupancyMaxActiveBlocksPerMultiprocessor(&per_cu, (const void*)fwd, 512, LDS_BYTES) != hipSuccess || per_cu < 1) { fprintf(stderr, "kernel_launch: occupancy query says %d\n", per_cu); (void)hipGetLastError(); grid = -1; return; }
        grid = cus;
    }
    if (grid < 0) return;
    (void)hipMemsetAsync((char*)d_ws + WS_CTL, 0, CTL_ZERO_BYTES, stream);
    Args a{};
    a.x = (const float*)d_in[0]; a.w_in = (const float*)d_in[1]; a.gain = (const float*)d_in[2]; a.rel = (const float*)d_in[3]; a.w_out = (const float*)d_in[4];
    a.ln1g = (const float*)d_in[5]; a.ln1b = (const float*)d_in[6]; a.wrg = (const float*)d_in[7]; a.brg = (const float*)d_in[8]; a.wre = (const float*)d_in[9];
    a.bre = (const float*)d_in[10]; a.wgu = (const float*)d_in[11]; a.wdn = (const float*)d_in[12]; a.ln2g = (const float*)d_in[13]; a.ln2b = (const float*)d_in[14];
    a.out = (float*)d_out; a.ws = (unsigned char*)d_ws;
#if MK_LAUNCHES == 1
    a.ph_lo = 0; a.ph_hi = NPHASE;
    hipLaunchKernelGGL(fwd, dim3(grid), dim3(512), LDS_BYTES, stream, a);
#else
    for (int p = 0; p < NPHASE; ++p) { a.ph_lo = p; a.ph_hi = p + 1; hipLaunchKernelGGL(fwd, dim3(grid), dim3(512), LDS_BYTES, stream, a); }
#endif
}
```

```cpp
#include <hip/hip_runtime.h>
#include <cstdint>
#include <cstdio>

#ifndef MK_LAUNCHES
#define MK_LAUNCHES 1
#endif

#define DI __device__ __forceinline__
#define LAS __attribute__((address_space(3)))
typedef _Float16 f16;
typedef _Float16 h8 __attribute__((ext_vector_type(8)));
typedef _Float16 h4 __attribute__((ext_vector_type(4)));
typedef short s4v __attribute__((ext_vector_type(4)));
typedef float f32x2 __attribute__((ext_vector_type(2)));
typedef float f32x4 __attribute__((ext_vector_type(4)));
typedef float f32x8 __attribute__((ext_vector_type(8)));
typedef float f32x16 __attribute__((ext_vector_type(16)));

constexpr int NB = 2, SEQ = 16384, DM = 1024, NTOK = NB * SEQ, NPJ = 3584;
constexpr int C_AQ = 0, C_AK = 512, C_AV = 1024, C_RQ = 1536, C_RK = 2048, C_RV = 2560, C_RG = 3072;
constexpr int NBLK = SEQ / 256;
constexpr int NE = 32, DE = 512;
constexpr float ALPHA = 1.189207115002721f, LN_EPS = 1e-5f, LOG2E = 1.4426950408889634f;
constexpr int NPHASE = 10;

constexpr size_t MiB = 1u << 20;
constexpr size_t WS_CTL = 0, CTL_ZERO_BYTES = 128 * 1024;
constexpr size_t WS_ROPEC = 1 * MiB, WS_ROPES = 5 * MiB, WS_XSUM = 9 * MiB, WS_KMEAN = 10 * MiB, WS_WRT = 10 * MiB + 512 * 1024;
constexpr size_t WS_SUMSQ = 11 * MiB, WS_WTS = 12 * MiB, WS_ELIST = 13 * MiB, WS_MLIST = 17 * MiB, WS_PML = 33 * MiB;
constexpr size_t WS_WINT = 39 * MiB, WS_WOT = 46 * MiB, WS_WGUT = 48 * MiB, WS_WDNT = 112 * MiB;
constexpr size_t WS_PJ = 144 * MiB, WS_XH = 368 * MiB, WS_CAT = 368 * MiB, WS_KV = 432 * MiB, WS_R = 464 * MiB;
constexpr size_t WS_HH = 144 * MiB, WS_HID = 208 * MiB, WS_Y = 280 * MiB, WS_END = 480 * MiB;
constexpr int MLIST_PER_BH = 516096;
constexpr int CW_BAR = 4096, CW_LCNT = 8192, CW_ECNT = 12288;

constexpr int SCR_BYTES = 155648;
constexpr int BIAS_OFF = SCR_BYTES;
constexpr int MISC_OFF = BIAS_OFF + 8 * 132 * 4 + 128;
constexpr int LDS_BYTES = MISC_OFF + 256;
static_assert(LDS_BYTES <= 163840, "LDS");

__device__ const unsigned char T5_BUCKET[129] = {0,1,2,3,4,5,6,7,8,9,10,11,12,13,14,15,16,16,16,17,17,18,18,18,19,19,19,20,20,20,20,21,21,21,21,22,22,22,22,22,23,23,23,23,23,23,24,24,24,24,24,24,25,25,25,25,25,25,25,26,26,26,26,26,26,26,26,27,27,27,27,27,27,27,27,27,27,28,28,28,28,28,28,28,28,28,28,29,29,29,29,29,29,29,29,29,29,29,29,30,30,30,30,30,30,30,30,30,30,30,30,30,30,31,31,31,31,31,31,31,31,31,31,31,31,31,31,31,31};
__device__ const float ROPE_INV[64] = {1.0f,0.865964353f,0.749894202f,0.649381638f,0.562341332f,0.486967534f,0.421696514f,0.365174115f,0.316227764f,0.273841977f,0.237137377f,0.2053525f,0.177827939f,0.153992653f,0.133352146f,0.115478195f,0.100000001f,0.0865964293f,0.0749894232f,0.0649381652f,0.0562341325f,0.0486967526f,0.0421696492f,0.0365174115f,0.0316227749f,0.0273841955f,0.0237137377f,0.0205352511f,0.0177827943f,0.0153992651f,0.013335214f,0.0115478197f,0.00999999978f,0.00865964312f,0.00749894232f,0.00649381615f,0.00562341325f,0.00486967526f,0.00421696482f,0.00365174119f,0.00316227763f,0.00273841969f,0.00237137382f,0.00205352507f,0.00177827943f,0.00153992651f,0.00133352145f,0.00115478202f,0.00100000005f,0.000865964335f,0.000749894185f,0.000649381604f,0.000562341302f,0.000486967532f,0.000421696517f,0.000365174114f,0.000316227757f,0.000273841957f,0.00023713737f,0.00020535251f,0.00017782794f,0.00015399266f,0.00013335215f,0.0001154782f};

struct Args {
    const float *x, *w_in, *gain, *rel, *w_out, *ln1g, *ln1b, *wrg, *brg, *wre, *bre, *wgu, *wdn, *ln2g, *ln2b;
    float* out; unsigned char* ws; int ph_lo, ph_hi;
};

#define LDS_WAIT() asm volatile("s_waitcnt lgkmcnt(0)" ::: "memory")
#define MFMA32(a, b, c) __builtin_amdgcn_mfma_f32_32x32x16_f16((a), (b), (c), 0, 0, 0)
#define MFMA16(a, b, c) __builtin_amdgcn_mfma_f32_16x16x32_f16((a), (b), (c), 0, 0, 0)
DI int crow(int reg, int hp) { return (reg & 3) + 8 * (reg >> 2) + 4 * hp; }
DI h8 cvt8(f32x4 a, f32x4 b) { const f32x8 v = {a[0], a[1], a[2], a[3], b[0], b[1], b[2], b[3]}; return __builtin_convertvector(v, h8); }
DI float wave_sum(float v) {
#pragma unroll
    for (int o = 1; o < 64; o <<= 1) v += __shfl_xor(v, o);
    return v;
}
DI h4 tr_read(LAS const unsigned char* p) {
    typedef LAS s4v lds_s4;
    const s4v v = __builtin_amdgcn_ds_read_tr16_b64_v4i16((lds_s4*)p);
    return __builtin_bit_cast(h4, v);
}
DI h8 cat44(h4 a, h4 b) { return __builtin_shufflevector(a, b, 0, 1, 2, 3, 4, 5, 6, 7); }
DI float fexp2(float x) { return __builtin_amdgcn_exp2f(x); }
DI float gamma_log2(int h) { return __builtin_log2f(1.0f - fexp2(-(5.0f + (4.0f / 3.0f) * (float)h))); }

#define XB_TMO      128
#define XB_XCNT(j)  (256  + 64 * (j))
#define XB_XSUB(j)  (1280 + 64 * (j))
#define XB_XGEN(j)  (2304 + 64 * (j))
#define XB_TOP      3328
#define XB_TOPGEN   3392
#define XCD_BAR_WORDS 3456
#define XB_SPIN_CAP (1u << 18)
__device__ __forceinline__ unsigned xb_ld(unsigned* p)              { return __hip_atomic_load(p, __ATOMIC_RELAXED, __HIP_MEMORY_SCOPE_AGENT); }
__device__ __forceinline__ unsigned xb_add(unsigned* p, unsigned v) { return __hip_atomic_fetch_add(p, v, __ATOMIC_RELAXED, __HIP_MEMORY_SCOPE_AGENT); }
__device__ __forceinline__ unsigned xb_xcc_id() { return (unsigned)__builtin_amdgcn_s_getreg((3 << 11) | 20) & 0xFu; }
#define XB_SPIN(cond, bar) do { unsigned _sp = 0; while (cond) { __builtin_amdgcn_s_sleep(1); \
    if ((++_sp & 255u) == 0u) { if (xb_ld(&(bar)[XB_TMO])) break; if (_sp > XB_SPIN_CAP) { atomicAdd(&(bar)[XB_TMO], 1u); break; } } } } while (0)
struct XcdBarrier { unsigned* bar; unsigned x; volatile LAS unsigned* st; };
__device__ __forceinline__ XcdBarrier xcd_barrier_post(unsigned* bar, volatile LAS unsigned* st) {
    XcdBarrier b; b.bar = bar; b.x = xb_xcc_id(); b.st = st;
    if (threadIdx.x == 0) (void)xb_add(&bar[XB_XCNT(b.x)], 1u);
    return b;
}
__device__ __forceinline__ void xcd_barrier_complete(unsigned* bar, unsigned x, unsigned& nloc, unsigned& nx) {
    const unsigned G = gridDim.x * gridDim.y * gridDim.z;
    unsigned sum, cnt, mine, sp = 0u;
    for (;;) {
        sum = 0u; cnt = 0u; mine = 0u;
#pragma unroll
        for (unsigned j = 0; j < 16; ++j) { const unsigned c = xb_ld(&bar[XB_XCNT(j)]); sum += c; cnt += (c > 0u) ? 1u : 0u; mine = (j == x) ? c : mine; }
        if (sum == G) break;
        __builtin_amdgcn_s_sleep(1);
        if ((++sp & 255u) == 0u) { if (xb_ld(&bar[XB_TMO])) break; if (sp > XB_SPIN_CAP) { atomicAdd(&bar[XB_TMO], 1u); break; } }
    }
    nloc = mine > 0u ? mine : 1u; nx = cnt > 0u ? cnt : 1u;
}
__device__ __forceinline__ void xcd_barrier(const XcdBarrier& b) {
    asm volatile("s_waitcnt vmcnt(0)" ::: "memory");
    __syncthreads();
    if (threadIdx.x == 0) {
        unsigned* bar = b.bar;
        __builtin_amdgcn_s_waitcnt(0);
        unsigned nloc = b.st[0], nx = b.st[1];
        if (nloc == 0u) { xcd_barrier_complete(bar, b.x, nloc, nx); b.st[0] = nloc; b.st[1] = nx; }
        const unsigned old = xb_add(&bar[XB_XSUB(b.x)], 1u);
        const unsigned gen = old / nloc;
        if (old + 1u == (gen + 1u) * nloc) {
            __builtin_amdgcn_fence(__ATOMIC_RELEASE, "agent");
            asm volatile("s_waitcnt vmcnt(0)" ::: "memory");
            const unsigned og = xb_add(&bar[XB_TOP], 1u);
            const unsigned tg = og / nx;
            if (og + 1u == (tg + 1u) * nx) xb_add(&bar[XB_TOPGEN], 1u);
            else XB_SPIN(xb_ld(&bar[XB_TOPGEN]) == tg, bar);
            __builtin_amdgcn_fence(__ATOMIC_ACQUIRE, "agent");
            xb_add(&bar[XB_XGEN(b.x)], 1u);
            asm volatile("s_waitcnt vmcnt(0)" ::: "memory");
        } else {
            XB_SPIN(xb_ld(&bar[XB_XGEN(b.x)]) == gen, bar);
            __builtin_amdgcn_fence(__ATOMIC_ACQUIRE, "agent");
            asm volatile("s_waitcnt vmcnt(0)" ::: "memory");
        }
    }
    __syncthreads();
}

namespace pg8 {
constexpr int BM = 256, BK = 64, HALF = 128, HTB = HALF * BK * 2, STAGE_BYTES = 8 * HTB, NXCD = 8, WGM = 8;
DI int lds_byte(int r, int c) { const int st = (r >> 4) * 2 + (c >> 5), rr = r & 15, cc = c & 31, ob = rr * 64 + cc * 2; return st * 1024 + (ob ^ (((ob >> 9) & 1) << 5)); }
DI void stage_rc(int b, int& R, int& C) { const int st = b / 1024, sb = b % 1024, swz = sb ^ (((sb >> 9) & 1) << 5); R = (st >> 1) * 16 + swz / 64; C = (st & 1) * 32 + (swz % 64) / 2; }
DI int perm32(int rho) { const int n = rho >> 4, i = rho & 15; return 8 * (i >> 2) + 4 * n + (i & 3); }

struct Unit { const char* a; const char* b; int i0, i1, i2, i3; };

struct StaticOrder {
    const char* A; const char* Bt; int lda, ldb, nM, nN, nwg, G, c;
    DI void init(const void* A_, const void* Bt_, int lda_, int ldb_, int M, int N, int G_, int c_) { A = (const char*)A_; Bt = (const char*)Bt_; lda = lda_; ldb = ldb_; nM = M / BM; nN = N / BM; nwg = nM * nN; G = G_; c = c_; }
    DI bool next(int i, Unit& u) const {
        const long L = (long)i * G + c; if (L >= nwg) return false;
        int wgid = (int)L; { const int q = nwg / NXCD, r = nwg % NXCD, xcd = wgid % NXCD, off = wgid / NXCD; wgid = (xcd < r ? xcd * (q + 1) : r * (q + 1) + (xcd - r) * q) + off; }
        const int nig = WGM * nN, gid = wgid / nig, fm = gid * WGM, gsz = (nM - fm) < WGM ? (nM - fm) : WGM;
        u.i0 = fm + ((wgid % nig) % gsz); u.i1 = (wgid % nig) / gsz; u.i2 = 0; u.i3 = 0;
        u.a = A + (size_t)u.i0 * BM * lda * 2; u.b = Bt + (size_t)u.i1 * BM * ldb * 2; return true;
    }
    DI void aoff(const Unit&, unsigned (&vo)[2][2]) const {
#pragma unroll
        for (int i = 0; i < 2; ++i) { int R, C; stage_rc((int)threadIdx.x * 16 + i * 8192, R, C);
#pragma unroll
            for (int h = 0; h < 2; ++h) vo[h][i] = (unsigned)((h * HALF + R) * lda + C) * 2u; }
    }
};

template <class Epi, class Sched, bool ALIGN_EPI>
DI void gemm_phase(LAS unsigned char* lds, const int ldb, const int nt, const Sched& S, const Epi& E) {
    const int tid = threadIdx.x, wid = __builtin_amdgcn_readfirstlane(tid >> 6), lane = tid & 63, wr = wid >> 2, wc = wid & 3, fr = lane & 15, fq = lane >> 4;
    unsigned voffB[2];
#pragma unroll
    for (int i = 0; i < 2; ++i) { int R, C; stage_rc(tid * 16 + i * 8192, R, C); const int Rb = (R & ~31) + perm32(R & 31); voffB[i] = (unsigned)(Rb * ldb + C) * 2u; }
    const size_t kstep = (size_t)(BK * 2);
    const size_t hstep = (size_t)HALF * ldb * 2;
    const unsigned ldsw = (unsigned)wid * 1024u;
    const int aoff = lds_byte(wr * 64 + fr, fq * 8), boff = lds_byte(wc * 32 + fr, fq * 8);
#define PG8_SA(b, h) (((b) * 2 + (h)) * HTB)
#define PG8_SB(b, h) ((4 + (b) * 2 + (h)) * HTB)
#define PG8_STAGE(bufoff, gbase, voff) do { _Pragma("unroll") for (int _i = 0; _i < 2; ++_i) \
        __builtin_amdgcn_global_load_lds((const unsigned*)((const char*)(gbase) + (voff)[_i]), (LAS unsigned*)(lds + (bufoff) + ldsw + _i * 8192), 16, 0, 0); } while (0)
#define PG8_LDA(dst, b, h) do { _Pragma("unroll") for (int m = 0; m < 4; ++m) _Pragma("unroll") for (int k = 0; k < 2; ++k) dst[m][k] = *(const LAS h8*)(lds + PG8_SA(b, h) + aoff + m * 2048 + k * 1024); } while (0)
#define PG8_LDB(dst, b, h) do { _Pragma("unroll") for (int n = 0; n < 2; ++n) _Pragma("unroll") for (int k = 0; k < 2; ++k) dst[n][k] = *(const LAS h8*)(lds + PG8_SB(b, h) + boff + n * 2048 + k * 1024); } while (0)
#define PG8_MMA(ai, bj, At, Bt) do { __builtin_amdgcn_s_setprio(1); _Pragma("unroll") for (int m = 0; m < 4; ++m) _Pragma("unroll") for (int n = 0; n < 2; ++n) _Pragma("unroll") for (int k = 0; k < 2; ++k) \
        acc[ai][bj][m][n] = __builtin_amdgcn_mfma_f32_16x16x32_f16(Bt[n][k], At[m][k], acc[ai][bj][m][n], 0, 0, 0); __builtin_amdgcn_s_setprio(0); } while (0)
#define PG8_WAIT_V(n) asm volatile("s_waitcnt vmcnt(" #n ")" ::: "memory")
#define PG8_WAIT_L(n) asm volatile("s_waitcnt lgkmcnt(" #n ")" ::: "memory")
#define PG8_BAR __builtin_amdgcn_s_barrier()
#define PG8_SCHED __builtin_amdgcn_sched_barrier(0)
    Unit cur, nxt; int ui = 0;
    if (!S.next(0, cur)) return;
    f32x4 acc[2][2][4][2];
#pragma unroll
    for (int a = 0; a < 2; ++a)
#pragma unroll
        for (int b = 0; b < 2; ++b)
#pragma unroll
            for (int m = 0; m < 4; ++m)
#pragma unroll
                for (int n = 0; n < 2; ++n) acc[a][b][m][n] = (f32x4){0.f, 0.f, 0.f, 0.f};
    h8 At[4][2], B0[2][2], B1[2][2];
    unsigned voc[2][2], von[2][2];
    S.aoff(cur, voc);
    const char* cA = cur.a; const char* cB = cur.b;
    PG8_STAGE(PG8_SB(0, 0), cB, voffB); PG8_STAGE(PG8_SB(0, 1), cB + hstep, voffB); PG8_STAGE(PG8_SA(0, 0), cA, voc[0]); PG8_STAGE(PG8_SA(0, 1), cA, voc[1]);
    if (wr == 1) PG8_BAR;
    PG8_WAIT_V(2); PG8_BAR;
    PG8_STAGE(PG8_SB(1, 0), cB + kstep, voffB); PG8_STAGE(PG8_SA(1, 0), cA + kstep, voc[0]); PG8_STAGE(PG8_SB(1, 1), cB + hstep + kstep, voffB);
    PG8_WAIT_V(6); PG8_BAR;
    for (;;) {
        const bool has_next = S.next(ui + 1, nxt);
        const char* nA = has_next ? nxt.a : cA; const char* nB = has_next ? nxt.b : cB;
        if (has_next) S.aoff(nxt, von);
        else {
#pragma unroll
            for (int h = 0; h < 2; ++h)
#pragma unroll
                for (int i = 0; i < 2; ++i) von[h][i] = voc[h][i]; }
        for (int t = 0; t < nt; t += 2) {
            if constexpr (Epi::MIDK > 0) { if (t == Epi::MIDK) E.midk(acc, cur, wr, wc, fr, fq); }
            const bool last = (t == nt - 2);
            const char* a1 = cA + (size_t)(t + 1) * kstep;
            const char* a2 = last ? nA : cA + (size_t)(t + 2) * kstep; const char* b2 = last ? nB : cB + (size_t)(t + 2) * kstep;
            const char* a3 = a2 + kstep; const char* b3 = b2 + kstep;
            unsigned v2[2][2];
#pragma unroll
            for (int h = 0; h < 2; ++h)
#pragma unroll
                for (int i = 0; i < 2; ++i) v2[h][i] = last ? von[h][i] : voc[h][i];
            PG8_LDB(B0, 0, 0); PG8_LDB(B1, 0, 1); PG8_SCHED; PG8_LDA(At, 0, 0); PG8_STAGE(PG8_SA(1, 1), a1, voc[1]);
            PG8_WAIT_V(8); PG8_WAIT_L(0); PG8_BAR; PG8_MMA(0, 0, At, B0); PG8_MMA(0, 1, At, B1); PG8_BAR; PG8_SCHED;
            PG8_LDA(At, 0, 1); PG8_STAGE(PG8_SB(0, 0), b2, voffB); PG8_STAGE(PG8_SB(0, 1), b2 + hstep, voffB); PG8_STAGE(PG8_SA(0, 0), a2, v2[0]);
            PG8_WAIT_V(8); PG8_WAIT_L(0); PG8_BAR; PG8_MMA(1, 0, At, B0); PG8_MMA(1, 1, At, B1); PG8_BAR; PG8_SCHED;
            PG8_LDB(B0, 1, 0); PG8_LDB(B1, 1, 1); PG8_SCHED; PG8_LDA(At, 1, 0); PG8_STAGE(PG8_SA(0, 1), a2, v2[1]);
            PG8_WAIT_V(8); PG8_WAIT_L(0); PG8_BAR; PG8_MMA(0, 0, At, B0); PG8_MMA(0, 1, At, B1); PG8_BAR; PG8_SCHED;
            PG8_LDA(At, 1, 1); PG8_STAGE(PG8_SB(1, 0), b3, voffB); PG8_STAGE(PG8_SB(1, 1), b3 + hstep, voffB); PG8_STAGE(PG8_SA(1, 0), a3, v2[0]);
            PG8_WAIT_V(8); PG8_WAIT_L(0); PG8_BAR; PG8_MMA(1, 0, At, B0); PG8_MMA(1, 1, At, B1); PG8_BAR; PG8_SCHED;
        }
        if constexpr (ALIGN_EPI) { if (wr == 0) PG8_BAR; }
        E(acc, cur, wr, wc, fr, fq);
        if (!has_next) break;
#pragma unroll
        for (int a = 0; a < 2; ++a)
#pragma unroll
            for (int b = 0; b < 2; ++b)
#pragma unroll
                for (int m = 0; m < 4; ++m)
#pragma unroll
                    for (int n = 0; n < 2; ++n) acc[a][b][m][n] = (f32x4){0.f, 0.f, 0.f, 0.f};
        cur = nxt; cA = nA; cB = nB; ++ui;
#pragma unroll
        for (int h = 0; h < 2; ++h)
#pragma unroll
            for (int i = 0; i < 2; ++i) voc[h][i] = von[h][i];
        if constexpr (ALIGN_EPI) { if (wr == 1) PG8_BAR; }
    }
    PG8_WAIT_V(0);
    if constexpr (!ALIGN_EPI) { if (wr == 0) PG8_BAR; }
    PG8_BAR;
#undef PG8_SA
#undef PG8_SB
#undef PG8_STAGE
#undef PG8_LDA
#undef PG8_LDB
#undef PG8_MMA
#undef PG8_WAIT_V
#undef PG8_WAIT_L
#undef PG8_BAR
#undef PG8_SCHED
}
}

struct EpiProj {
    static constexpr int MIDK = 0;
    f16* PJ; const float* cosT; const float* sinT;
    DI void midk(f32x4 (&)[2][2][4][2], const pg8::Unit&, int, int, int, int) const {}
    DI void operator()(const f32x4 (&acc)[2][2][4][2], const pg8::Unit& u, int wr, int wc, int fr, int fq) const {
        const int pn = u.i1, row0 = u.i0 * 256 + wr * 64 + fr;
        if (pn < 6 || pn > 9) {
            const int col0 = pn * 256 + wc * 32 + 8 * fq;
#pragma unroll
            for (int ai = 0; ai < 2; ++ai)
#pragma unroll
                for (int m = 0; m < 4; ++m) { f16* rowp = PJ + (size_t)(row0 + ai * 128 + m * 16) * NPJ + col0;
#pragma unroll
                    for (int bj = 0; bj < 2; ++bj) *(h8*)(rowp + bj * 128) = cvt8(acc[ai][bj][m][0], acc[ai][bj][m][1]); }
        } else {
            const float sc = (pn >= 8) ? 0.08838834764831845f : 1.0f;
            const int i0 = 32 * (wc & 1) + 8 * fq;
            const int lcol = pn * 256 + (wc >> 1) * 128 + i0;
#pragma unroll
            for (int ai = 0; ai < 2; ++ai)
#pragma unroll
                for (int m = 0; m < 4; ++m) { const int row = row0 + ai * 128 + m * 16; const int pos = row & (SEQ - 1);
                    const f32x4 c0 = *(const f32x4*)(cosT + pos * 64 + i0) * sc, c1 = *(const f32x4*)(cosT + pos * 64 + i0 + 4) * sc;
                    const f32x4 s0 = *(const f32x4*)(sinT + pos * 64 + i0) * sc, s1 = *(const f32x4*)(sinT + pos * 64 + i0 + 4) * sc;
                    const f32x4 x10 = acc[ai][0][m][0], x11 = acc[ai][0][m][1], x20 = acc[ai][1][m][0], x21 = acc[ai][1][m][1];
                    f16* rowp = PJ + (size_t)row * NPJ + lcol;
                    *(h8*)(rowp) = cvt8(x10 * c0 - x20 * s0, x11 * c1 - x21 * s1);
                    *(h8*)(rowp + 64) = cvt8(x10 * s0 + x20 * c0, x11 * s1 + x21 * c1); }
        }
    }
};
struct EpiZ {
    static constexpr int MIDK = 8;
    const float* x; f16* z; const float* sumsq;
    DI void midk(f32x4 (&acc)[2][2][4][2], const pg8::Unit& u, int wr, int wc, int fr, int fq) const {
#pragma unroll
        for (int ai = 0; ai < 2; ++ai)
#pragma unroll
            for (int m = 0; m < 4; ++m) { const int row = u.i0 * 256 + ai * 128 + wr * 64 + m * 16 + fr;
                const f32x4 s0 = *(const f32x4*)(sumsq + (size_t)row * 8), s1 = *(const f32x4*)(sumsq + (size_t)row * 8 + 4);
                const float ss = ((s0[0] + s0[1]) + (s0[2] + s0[3])) + ((s1[0] + s1[1]) + (s1[2] + s1[3]));
                const float rinv = 1.0f / sqrtf(ss * (1.0f / 512.0f) + LN_EPS);
#pragma unroll
                for (int bj = 0; bj < 2; ++bj)
#pragma unroll
                    for (int n = 0; n < 2; ++n) acc[ai][bj][m][n] *= rinv; }
    }
    DI void operator()(const f32x4 (&acc)[2][2][4][2], const pg8::Unit& u, int wr, int wc, int fr, int fq) const {
        const int row0 = u.i0 * 256 + wr * 64 + fr, col0 = u.i1 * 256 + wc * 32 + 8 * fq;
#pragma unroll
        for (int ai = 0; ai < 2; ++ai)
#pragma unroll
            for (int m = 0; m < 4; ++m) { const size_t off = (size_t)(row0 + ai * 128 + m * 16) * DM + col0;
#pragma unroll
                for (int bj = 0; bj < 2; ++bj) {
                    const f32x4 x0 = *(const f32x4*)(x + off + bj * 128), x1 = *(const f32x4*)(x + off + bj * 128 + 4);
                    *(h8*)(z + off + bj * 128) = cvt8(x0 * ALPHA + acc[ai][bj][m][0], x1 * ALPHA + acc[ai][bj][m][1]); } }
    }
};
struct MoeSched {
    LAS const int* tab; const int* elist; const char* A; const char* Bt; size_t b_expert_bytes; int lda, ldb, G, c; bool gather;
    DI bool next(int i, pg8::Unit& u) const {
        const int MT = tab[64]; const int wpx = G >> 3, xcd = c & 7, w = c >> 3;
        const int q = w + wpx * i, g = (q >> 2) * 8 + xcd, nt = q & 3;
        if (g >= MT) return false;
        int e = 0;
#pragma unroll 1
        for (int k = 1; k < 32; ++k) e += (tab[32 + k] <= g) ? 1 : 0;
        u.i0 = g; u.i1 = nt; u.i2 = e; u.i3 = g - tab[32 + e];
        u.a = gather ? A : A + (size_t)g * 256 * lda * 2;
        u.b = Bt + (size_t)e * b_expert_bytes + (size_t)nt * 256 * ldb * 2; return true;
    }
    DI void aoff(const pg8::Unit& u, unsigned (&vo)[2][2]) const {
        const int cnt = tab[u.i2];
#pragma unroll
        for (int i = 0; i < 2; ++i) { int R, C; pg8::stage_rc((int)threadIdx.x * 16 + i * 8192, R, C);
#pragma unroll
            for (int h = 0; h < 2; ++h) {
                if (gather) { int idx = u.i3 * 256 + h * 128 + R; idx = idx < cnt ? idx : 0; const int tok = elist[u.i2 * NTOK + idx] >> 1; vo[h][i] = (unsigned)(tok * lda + C) * 2u; }
                else vo[h][i] = (unsigned)((h * 128 + R) * lda + C) * 2u; } }
    }
};
struct EpiGU {
    static constexpr int MIDK = 0;
    f16* hid;
    DI void midk(f32x4 (&)[2][2][4][2], const pg8::Unit&, int, int, int, int) const {}
    DI void operator()(const f32x4 (&acc)[2][2][4][2], const pg8::Unit& u, int wr, int wc, int fr, int fq) const {
        const int row0 = u.i0 * 256 + wr * 64 + fr, col0 = u.i1 * 128 + wc * 32 + 8 * fq;
#pragma unroll
        for (int ai = 0; ai < 2; ++ai)
#pragma unroll
            for (int m = 0; m < 4; ++m) { f32x4 o[2];
#pragma unroll
                for (int n = 0; n < 2; ++n) { const f32x4 g = acc[ai][0][m][n], up = acc[ai][1][m][n];
#pragma unroll
                    for (int e = 0; e < 4; ++e) o[n][e] = g[e] * up[e] / (1.0f + fexp2(-g[e] * LOG2E)); }
                *(h8*)(hid + (size_t)(row0 + ai * 128 + m * 16) * DE + col0) = cvt8(o[0], o[1]); }
    }
};
struct EpiDown {
    static constexpr int MIDK = 0;
    f16* y; const int* elist; const float* wts; LAS const int* tab;
    DI void midk(f32x4 (&)[2][2][4][2], const pg8::Unit&, int, int, int, int) const {}
    DI void operator()(const f32x4 (&acc)[2][2][4][2], const pg8::Unit& u, int wr, int wc, int fr, int fq) const {
        const int cnt = tab[u.i2], col0 = u.i1 * 256 + wc * 32 + 8 * fq;
#pragma unroll
        for (int ai = 0; ai < 2; ++ai)
#pragma unroll
            for (int m = 0; m < 4; ++m) { const int idx = u.i3 * 256 + ai * 128 + wr * 64 + m * 16 + fr;
                if (idx < cnt) { const int ent = elist[u.i2 * NTOK + idx]; const float w = wts[ent]; f16* rowp = y + (size_t)ent * DM + col0;
#pragma unroll
                    for (int bj = 0; bj < 2; ++bj) *(h8*)(rowp + bj * 128) = cvt8(acc[ai][bj][m][0] * w, acc[ai][bj][m][1] * w); } }
    }
};

DI void tr_item(const float* W, int ldw, int k0, int nsrc0, f16* WT, int ldt, int prow0, const float* ks, LAS float* scr, int lane) {
#pragma unroll 8
    for (int i = 0; i < 32; ++i) { const int kk = 2 * i + (lane >> 5); float v = W[(size_t)(k0 + kk) * ldw + nsrc0 + (lane & 31)]; if (ks) v *= ks[k0 + kk]; scr[kk * 33 + (lane & 31)] = v; }
    LDS_WAIT(); asm volatile("" ::: "memory");
    const int c = lane & 7;
#pragma unroll
    for (int j = 0; j < 4; ++j) { const int n = (lane >> 3) + 8 * j; const LAS float* s = scr + (8 * c) * 33 + n;
        h8 o; o[0] = (f16)s[0]; o[1] = (f16)s[33]; o[2] = (f16)s[66]; o[3] = (f16)s[99]; o[4] = (f16)s[132]; o[5] = (f16)s[165]; o[6] = (f16)s[198]; o[7] = (f16)s[231];
        *(h8*)(WT + (size_t)(prow0 + n) * ldt + k0 + 8 * c) = o; }
    LDS_WAIT(); asm volatile("" ::: "memory");
}

constexpr int KP64 = 144, VP64 = 192;
template <bool OWN>
DI void attn_tile(LAS const unsigned char* Kl, LAS const unsigned char* Vl, LAS const float* biasd, const h8 (&qf)[4], int rel, int w, int lane, float& m2, float& lsum, f32x16 (&o)[2]) {
    const int r = lane & 31, hp = lane >> 5;
    f32x16 st[8];
    const float b31 = biasd[128];
    float mx = -3.0e38f;
#pragma unroll
    for (int kt = 0; kt < 8; ++kt) {
        if (!OWN || kt <= w) {
            f32x16 a;
#pragma unroll
            for (int i = 0; i < 16; ++i) a[i] = 0.f;
#pragma unroll
            for (int ks = 0; ks < 4; ++ks) { const h8 kf = *(const LAS h8*)(Kl + (32 * kt + r) * KP64 + 32 * ks + 16 * hp); a = MFMA32(kf, qf[ks], a); }
            const bool far = __all(rel - (32 * kt + 31) >= 128) != 0;
            if (far) {
#pragma unroll
                for (int i = 0; i < 16; ++i) a[i] = a[i] * (0.125f * LOG2E) + b31;
            } else {
#pragma unroll
                for (int i = 0; i < 16; ++i) { const int dist = rel - (32 * kt + crow(i, hp)); const int dd = dist < 0 ? 0 : (dist > 128 ? 128 : dist);
                    const float v = a[i] * (0.125f * LOG2E) + biasd[dd]; a[i] = (OWN && dist < 0) ? -3.0e38f : v; }
            }
#pragma unroll
            for (int i = 0; i < 16; ++i) mx = fmaxf(mx, a[i]);
            st[kt] = a;
        }
    }
    mx = fmaxf(mx, __shfl_xor(mx, 32));
    float ls = 0.f;
#pragma unroll
    for (int dt = 0; dt < 2; ++dt)
#pragma unroll
        for (int i = 0; i < 16; ++i) o[dt][i] = 0.f;
    const int i16 = lane & 15, q4 = i16 >> 2, p4 = i16 & 3, cb = (lane >> 4) & 1;
    LAS const unsigned char* vbase = Vl + (4 * hp + q4) * VP64 + 2 * (16 * cb + 4 * p4);
#pragma unroll
    for (int kt = 0; kt < 8; ++kt) {
        if (!OWN || kt <= w) {
            f32x16 p = st[kt];
#pragma unroll
            for (int i = 0; i < 16; ++i) { p[i] = fexp2(p[i] - mx); ls += p[i]; }
#pragma unroll
            for (int s = 0; s < 2; ++s) {
                const f32x8 pv = {p[8 * s], p[8 * s + 1], p[8 * s + 2], p[8 * s + 3], p[8 * s + 4], p[8 * s + 5], p[8 * s + 6], p[8 * s + 7]};
                const h8 pf = __builtin_convertvector(pv, h8);
#pragma unroll
                for (int dt = 0; dt < 2; ++dt) {
                    LAS const unsigned char* vp = vbase + (32 * kt + 16 * s) * VP64 + 64 * dt;
                    const h8 vf = cat44(tr_read(vp), tr_read(vp + 8 * VP64));
                    o[dt] = MFMA32(vf, pf, o[dt]);
                }
            }
        }
    }
    ls += __shfl_xor(ls, 32);
    m2 = mx; lsum = ls;
}
template <int P>
DI void stage64(LAS unsigned char* dst, const f16* src, int src_ld, int tid) {
#pragma unroll
    for (int i = 0; i < 4; ++i) { const int q = tid + 512 * i, row = q >> 3, ch = q & 7; *(LAS h8*)(dst + row * P + 16 * ch) = *(const h8*)(src + (size_t)row * src_ld + 8 * ch); }
}

DI void own_scores(LAS const unsigned char* Kl, LAS const float* biasd, const h8 (&qf)[4], int ql, int kt, int r, int hp, f32x16& a) {
#pragma unroll
    for (int i = 0; i < 16; ++i) a[i] = 0.f;
#pragma unroll
    for (int ks = 0; ks < 4; ++ks) { const h8 kf = *(const LAS h8*)(Kl + (32 * kt + r) * KP64 + 32 * ks + 16 * hp); a = MFMA32(kf, qf[ks], a); }
#pragma unroll
    for (int i = 0; i < 16; ++i) { const int dist = ql - (32 * kt + crow(i, hp)); const int dd = dist < 0 ? 0 : (dist > 128 ? 128 : dist);
        const float v = a[i] * (0.125f * LOG2E) + biasd[dd]; a[i] = dist < 0 ? -3.0e38f : v; }
}
DI void attn_own(LAS const unsigned char* Kl, LAS const unsigned char* Vl, LAS const float* biasd, const h8 (&qf)[4], int ql, int w, int lane, float& m2, float& lsum, f32x16 (&o)[2]) {
    const int r = lane & 31, hp = lane >> 5;
    float mx = -3.0e38f;
#pragma unroll 1
    for (int kt = 0; kt <= w; ++kt) { f32x16 a; own_scores(Kl, biasd, qf, ql, kt, r, hp, a);
#pragma unroll
        for (int i = 0; i < 16; ++i) mx = fmaxf(mx, a[i]); }
    mx = fmaxf(mx, __shfl_xor(mx, 32));
    float ls = 0.f;
#pragma unroll
    for (int dt = 0; dt < 2; ++dt)
#pragma unroll
        for (int i = 0; i < 16; ++i) o[dt][i] = 0.f;
    const int i16 = lane & 15, q4 = i16 >> 2, p4 = i16 & 3, cb = (lane >> 4) & 1;
    LAS const unsigned char* vbase = Vl + (4 * hp + q4) * VP64 + 2 * (16 * cb + 4 * p4);
#pragma unroll 1
    for (int kt = 0; kt <= w; ++kt) {
        f32x16 p; own_scores(Kl, biasd, qf, ql, kt, r, hp, p);
#pragma unroll
        for (int i = 0; i < 16; ++i) { p[i] = fexp2(p[i] - mx); ls += p[i]; }
#pragma unroll
        for (int s = 0; s < 2; ++s) {
            const f32x8 pv = {p[8 * s], p[8 * s + 1], p[8 * s + 2], p[8 * s + 3], p[8 * s + 4], p[8 * s + 5], p[8 * s + 6], p[8 * s + 7]};
            const h8 pf = __builtin_convertvector(pv, h8);
#pragma unroll
            for (int dt = 0; dt < 2; ++dt) {
                LAS const unsigned char* vp = vbase + (32 * kt + 16 * s) * VP64 + 64 * dt;
                const h8 vf = cat44(tr_read(vp), tr_read(vp + 8 * VP64));
                o[dt] = MFMA32(vf, pf, o[dt]);
            }
        }
    }
    ls += __shfl_xor(ls, 32);
    m2 = mx; lsum = ls;
}
__global__ void __launch_bounds__(512, 2) fwd(Args a) {
    extern __shared__ __attribute__((aligned(16))) unsigned char smem[];
    LAS unsigned char* lds = (LAS unsigned char*)smem;
    volatile LAS unsigned* MISC = (volatile LAS unsigned*)(lds + MISC_OFF);
    LAS float* biasl = (LAS float*)(lds + BIAS_OFF);
    const int tid = threadIdx.x, lane = tid & 63, wave = __builtin_amdgcn_readfirstlane(tid >> 6);
    const int G = gridDim.x, bid = blockIdx.x;
    unsigned char* ws = a.ws;
    unsigned* ctl = (unsigned*)(ws + WS_CTL);
    float* ropeC = (float*)(ws + WS_ROPEC); float* ropeS = (float*)(ws + WS_ROPES); float* xsum = (float*)(ws + WS_XSUM);
    f16* kmean = (f16*)(ws + WS_KMEAN); f16* WrT = (f16*)(ws + WS_WRT); float* sumsq = (float*)(ws + WS_SUMSQ); float* wts = (float*)(ws + WS_WTS);
    int* elist = (int*)(ws + WS_ELIST); unsigned short* mlist = (unsigned short*)(ws + WS_MLIST); f32x2* pml = (f32x2*)(ws + WS_PML);
    f16* WinT = (f16*)(ws + WS_WINT); f16* WoT = (f16*)(ws + WS_WOT); f16* WguT = (f16*)(ws + WS_WGUT); f16* WdnT = (f16*)(ws + WS_WDNT);
    f16* PJ = (f16*)(ws + WS_PJ); f16* xh = (f16*)(ws + WS_XH); f16* cat = (f16*)(ws + WS_CAT); float* kvbuf = (float*)(ws + WS_KV); f16* Rbuf = (f16*)(ws + WS_R);
    f16* hh = (f16*)(ws + WS_HH); f16* hid = (f16*)(ws + WS_HID); f16* ybuf = (f16*)(ws + WS_Y);
    f16* pO = (f16*)a.out;
    f16* zbuf = (f16*)a.out;
    unsigned* lcnt = ctl + CW_LCNT; unsigned* ecnt = ctl + CW_ECNT;

    if (tid < 64) MISC[tid] = 0u;
    for (int idx = tid; idx < 8 * 132; idx += 512) { const int h = idx / 132, d = idx % 132, dd = d > 128 ? 128 : d; biasl[idx] = a.rel[(int)T5_BUCKET[dd] * 8 + h] * LOG2E; }
    __syncthreads();
    const int lo = a.ph_lo, hi = a.ph_hi;
    XcdBarrier bar; bar.bar = ctl + CW_BAR; bar.x = 0; bar.st = MISC + 8;
    if (hi - lo > 1) bar = xcd_barrier_post(ctl + CW_BAR, MISC + 8);
#ifndef PH_MASK
#define PH_MASK 0x3ff
#endif
#define IN(k) ((((PH_MASK) >> (k)) & 1) && lo <= (k) && (k) < hi)
#ifndef DUP_PHASE
#define DUP_PHASE -1
#endif
#define REP(k) for (int rep_ = 0; rep_ < ((DUP_PHASE) == (k) ? 2 : 1); ++rep_)
#define SEAM(k) do { if (IN(k) && IN((k) + 1)) xcd_barrier(bar); } while (0)

    if (IN(0)) REP(0) {
        for (int hb = bid; hb < 256; hb += G) {
            const int c4 = tid & 255, rp = tid >> 8;
            const float* src = a.x + (size_t)hb * 128 * DM + c4 * 4; f16* dst = xh + (size_t)hb * 128 * DM + c4 * 4;
            f32x4 s = {0.f, 0.f, 0.f, 0.f};
#pragma unroll 8
            for (int r = rp; r < 128; r += 2) { const f32x4 v = *(const f32x4*)(src + (size_t)r * DM); s += v; *(h4*)(dst + (size_t)r * DM) = __builtin_convertvector(v, h4); }
            LAS f32x4* red = (LAS f32x4*)lds;
            if (rp == 1) red[c4] = s;
            __syncthreads();
            if (rp == 0) { s += red[c4]; *(f32x4*)(xsum + (size_t)hb * DM + c4 * 4) = s; }
            __syncthreads();
        }
        for (int idx = bid * 512 + tid; idx < SEQ * 64; idx += G * 512) {
            const int pos = idx >> 6, i = idx & 63;
            const float ang = (float)pos * ROPE_INV[i];
            const double xd = (double)ang, kd = __builtin_rint(xd * 0.6366197723675814);
            double rr = __builtin_fma(-kd, 1.5707963267948966, xd); rr = __builtin_fma(-kd, 6.123233995736766e-17, rr);
            const double r2 = rr * rr;
            const double sp = rr * (1.0 + r2 * (-1.0 / 6 + r2 * (1.0 / 120 + r2 * (-1.0 / 5040 + r2 * (1.0 / 362880 + r2 * (-1.0 / 39916800 + r2 * (1.0 / 6227020800.0)))))));
            const double cp = 1.0 + r2 * (-0.5 + r2 * (1.0 / 24 + r2 * (-1.0 / 720 + r2 * (1.0 / 40320 + r2 * (-1.0 / 3628800 + r2 * (1.0 / 479001600.0 + r2 * (-1.0 / 87178291200.0)))))));
            const int q = (int)kd & 3;
            const double sv = (q == 0) ? sp : (q == 1) ? cp : (q == 2) ? -sp : -cp;
            const double cv = (q == 0) ? cp : (q == 1) ? -sp : (q == 2) ? -cp : sp;
            ropeC[idx] = (float)cv; ropeS[idx] = (float)sv;
        }
        for (int idx = bid * 512 + tid; idx < 48 * DM; idx += G * 512) {
            const int n = idx >> 10, k = idx & 1023;
            const float v = (n < 4) ? a.wrg[k * 4 + n] : (n < 36) ? a.wre[k * 32 + (n - 4)] : 0.f;
            WrT[idx] = (f16)v;
        }
        {
            LAS float* scr = (LAS float*)(lds + wave * 16384);
            constexpr int I_IN = 16 * 112, I_O = 16 * 32, I_GU = 32 * 512, I_DN = 32 * 256, NIT = I_IN + I_O + I_GU + I_DN;
            for (int it = bid * 8 + wave; it < NIT; it += G * 8) {
                int r = it;
                if (r < I_IN) { const int kb = r / 112, nb = r % 112, pn = nb >> 3, g = nb & 7;
                    const int nsrc = (pn >= 6 && pn <= 9) ? pn * 256 + 128 * ((g >> 1) & 1) + 64 * (g >> 2) + 32 * (g & 1) : 32 * nb;
                    tr_item(a.w_in, NPJ, 64 * kb, nsrc, WinT, DM, 32 * nb, nullptr, scr, lane); continue; } r -= I_IN;
                if (r < I_O) { const int kb = r / 32, nb = r % 32; tr_item(a.w_out, DM, 64 * kb, 32 * nb, WoT, DM, 32 * nb, kb < 8 ? a.gain : nullptr, scr, lane); continue; } r -= I_O;
                if (r < I_GU) { const int e = r >> 9, rr = r & 511, kb = rr >> 5, nb = rr & 31, pn = nb >> 3, g = nb & 7;
                    const int nsrc = (g >> 2) * 512 + 128 * pn + 32 * (g & 3);
                    tr_item(a.wgu + (size_t)e * DM * DM, DM, 64 * kb, nsrc, WguT + (size_t)e * DM * DM, DM, 32 * nb, nullptr, scr, lane); continue; } r -= I_GU;
                { const int e = r >> 8, rr = r & 255, kb = rr >> 5, nb = rr & 31;
                    tr_item(a.wdn + (size_t)e * DE * DM, DM, 64 * kb, 32 * nb, WdnT + (size_t)e * DM * DE, DE, 32 * nb, nullptr, scr, lane); }
            }
        }
        __syncthreads();
    }
    SEAM(0);

    if (IN(1)) {
        REP(11) for (int job = bid; job < 256; job += G) {
            const int blk = job >> 1, ch = job & 1;
            LAS float* xm = (LAS float*)lds;
            for (int k = tid; k < DM; k += 512) xm[k] = (xsum[(size_t)(2 * blk) * DM + k] + xsum[(size_t)(2 * blk + 1) * DM + k]) * (1.0f / 256.0f);
            __syncthreads();
            const int col = tid & 255, kh = tid >> 8;
            const float* wp = a.w_in + (size_t)(kh * 512) * NPJ + C_AK + ch * 256 + col;
            float acc = 0.f;
#pragma unroll 8
            for (int k = 0; k < 512; ++k) acc += xm[kh * 512 + k] * wp[(size_t)k * NPJ];
            LAS float* red = xm + 1024;
            if (kh) red[col] = acc;
            __syncthreads();
            if (!kh) { acc += red[col]; const int c = ch * 256 + col, h = c >> 6, d = c & 63, b = blk >> 6, j = blk & 63; kmean[((size_t)(b * 8 + h) * 64 + j) * 64 + d] = (f16)acc; }
            __syncthreads();
        }
        pg8::StaticOrder S; S.init(xh, WinT, DM, DM, NTOK, NPJ, G, bid);
        EpiProj E{PJ, ropeC, ropeS};
        pg8::gemm_phase<EpiProj, pg8::StaticOrder, true>(lds, DM, DM / 64, S, E);
        if (DUP_PHASE == 1) pg8::gemm_phase<EpiProj, pg8::StaticOrder, true>(lds, DM, DM / 64, S, E);
    }
    SEAM(1);

    if (IN(2)) REP(2) {
        constexpr int NU_G = 16 * 63, NU_KV = 8 * 64;
        unsigned* lcnt_w = rep_ ? ctl + 16384 : lcnt; unsigned short* mlist_w = rep_ ? (unsigned short*)(ws + 480 * MiB) : mlist;
        for (int u = bid; u < NU_G + NU_KV; u += G) {
            if (u < NU_KV) {
                const int bh = u >> 6, ci = u & 63, b = bh >> 2, h = bh & 3;
                const float lg = gamma_log2(h);
                const f16* kp = PJ + (size_t)(b * SEQ + ci * 256) * NPJ + C_RK + h * 128;
                const f16* vp = PJ + (size_t)(b * SEQ + ci * 256) * NPJ + C_RV + h * 128;
                LAS unsigned char* Kl = lds; LAS unsigned char* Vl = lds + 128 * 320;
                const int dvt = wave & 3, dk0 = 2 * (wave >> 2);
                f32x16 acc[2];
#pragma unroll
                for (int t = 0; t < 2; ++t)
#pragma unroll
                    for (int i = 0; i < 16; ++i) acc[t][i] = 0.f;
                const int r = lane & 31, hp = lane >> 5, i16 = lane & 15, q4 = i16 >> 2, p4 = i16 & 3, cb = (lane >> 4) & 1;
                for (int half = 0; half < 2; ++half) {
#pragma unroll
                    for (int i = 0; i < 4; ++i) { const int q = tid + 512 * i, row = q >> 4, ch = q & 15; const int key = half * 128 + row;
                        const h8 kv = *(const h8*)(kp + (size_t)key * NPJ + 8 * ch); const float sc = fexp2(lg * (float)(255 - key));
                        const f32x8 kf = __builtin_convertvector(kv, f32x8) * sc;
                        *(LAS h8*)(Kl + row * 320 + 16 * ch) = __builtin_convertvector(kf, h8);
                        *(LAS h8*)(Vl + row * 320 + 16 * ch) = *(const h8*)(vp + (size_t)key * NPJ + 8 * ch); }
                    __syncthreads();
#pragma unroll
                    for (int s = 0; s < 8; ++s) {
                        LAS const unsigned char* ap = Vl + (16 * s + 8 * hp + q4) * 320 + 2 * (32 * dvt + 16 * cb + 4 * p4);
                        const h8 af = cat44(tr_read(ap), tr_read(ap + 4 * 320));
#pragma unroll
                        for (int t = 0; t < 2; ++t) {
                            LAS const unsigned char* bp = Kl + (16 * s + 8 * hp + q4) * 320 + 2 * (32 * (dk0 + t) + 16 * cb + 4 * p4);
                            const h8 bf = cat44(tr_read(bp), tr_read(bp + 4 * 320));
                            acc[t] = MFMA32(af, bf, acc[t]);
                        }
                    }
                    __syncthreads();
                }
                float* dst = kvbuf + (size_t)u * 128 * 128;
#pragma unroll
                for (int t = 0; t < 2; ++t)
#pragma unroll
                    for (int i = 0; i < 16; ++i) dst[(32 * dvt + crow(i, hp)) * 128 + 32 * (dk0 + t) + r] = acc[t][i];
            } else {
                const int uu = u - NU_KV, bh = uu / 63, c = 1 + uu % 63, b = bh >> 3, h = bh & 7;
                const int r = lane & 31, hp = lane >> 5;
                const int s = 256 * c + 32 * wave + r;
                const f16* qrow = PJ + (size_t)(b * SEQ + s) * NPJ + C_AQ + h * 64;
                h8 qf[4];
#pragma unroll
                for (int ks = 0; ks < 4; ++ks) qf[ks] = *(const h8*)(qrow + 16 * ks + 8 * hp);
                const f16* km = kmean + (size_t)bh * 64 * 64;
                float v[2][16];
#pragma unroll
                for (int t = 0; t < 2; ++t) {
                    f32x16 g;
#pragma unroll
                    for (int i = 0; i < 16; ++i) g[i] = 0.f;
                    if (t == 0 || c > 32) {
#pragma unroll
                        for (int ks = 0; ks < 4; ++ks) { const h8 kf = *(const h8*)(km + (32 * t + r) * 64 + 16 * ks + 8 * hp); g = MFMA32(kf, qf[ks], g); }
                    }
#pragma unroll
                    for (int i = 0; i < 16; ++i) v[t][i] = (32 * t + crow(i, hp) < c) ? g[i] : -3.0e38f;
                }
                int sel[3]; bool sval[3];
#pragma unroll
                for (int rd = 0; rd < 3; ++rd) {
                    float mv = -3.0e38f; int mi = 1 << 20;
#pragma unroll
                    for (int t = 0; t < 2; ++t)
#pragma unroll
                        for (int i = 0; i < 16; ++i) { const int idx = 32 * t + crow(i, hp); const float val = v[t][i]; if (val > mv || (val == mv && idx < mi)) { mv = val; mi = idx; } }
                    const float ov = __shfl_xor(mv, 32); const int oi = __shfl_xor(mi, 32);
                    if (ov > mv || (ov == mv && oi < mi)) { mv = ov; mi = oi; }
                    sel[rd] = mi; sval[rd] = mv > -1.0e38f;
#pragma unroll
                    for (int t = 0; t < 2; ++t)
#pragma unroll
                        for (int i = 0; i < 16; ++i) if (32 * t + crow(i, hp) == mi) v[t][i] = -3.0e38f;
                }
                LAS unsigned* hist = (LAS unsigned*)(lds + 96 * 1024);
                if (tid < 64) hist[tid] = 0u;
                __syncthreads();
                unsigned rank[3];
#pragma unroll
                for (int rd = 0; rd < 3; ++rd) { rank[rd] = 0u; if (sval[rd] && hp == 0) rank[rd] = __hip_atomic_fetch_add(hist + sel[rd], 1u, __ATOMIC_RELAXED, __HIP_MEMORY_SCOPE_WORKGROUP); }
                __syncthreads();
                if (tid < 64) { const unsigned n = hist[tid]; unsigned base = 0u; if (n) base = atomicAdd(lcnt_w + bh * 64 + tid, n); hist[64 + tid] = base; }
                __syncthreads();
#pragma unroll
                for (int rd = 0; rd < 3; ++rd) if (sval[rd] && hp == 0) { const int lb = sel[rd]; const unsigned pos = hist[64 + lb] + rank[rd];
                    mlist_w[(size_t)bh * MLIST_PER_BH + (size_t)lb * SEQ - 128 * lb * (lb + 1) + pos] = (unsigned short)((s << 2) | rd); }
            }
        }
    }
    SEAM(2);

    if (IN(3)) REP(3) {
        for (int gid = bid * 512 + tid; gid < 8 * 16384; gid += G * 512) {
            const int bh = gid >> 14, e = gid & 16383, h = bh & 3;
            const float cd = fexp2(256.0f * gamma_log2(h));
            const float* src = kvbuf + (size_t)bh * 64 * 16384 + e; f16* dst = Rbuf + (size_t)bh * 64 * 16384 + e;
            float run = 0.f;
#pragma unroll 8
            for (int i = 0; i < 64; ++i) { dst[(size_t)i * 16384] = (f16)run; run = run * cd + src[(size_t)i * 16384]; }
        }
        LAS int* pre = (LAS int*)(lds + 100 * 1024);
        LAS int* wsum = pre + 1032;
        {
            const int c0 = (int)lcnt[2 * tid], c1 = (int)lcnt[2 * tid + 1];
            const int n0 = (c0 + 255) >> 8, n1 = (c1 + 255) >> 8;
            int v = n0 + n1, incl = v;
#pragma unroll
            for (int o = 1; o < 64; o <<= 1) { const int t = __shfl_up(incl, o); if (lane >= o) incl += t; }
            if (lane == 63) wsum[wave] = incl;
            __syncthreads();
            int woff = 0;
            for (int k = 0; k < wave; ++k) woff += wsum[k];
            const int ex = woff + incl - v;
            pre[2 * tid] = ex; pre[2 * tid + 1] = ex + n0;
            if (tid == 511) pre[1024] = ex + v;
            __syncthreads();
        }
        const int U = pre[1024];
        const int u_lo = (int)(((long)U * bid) / G), u_hi = (int)(((long)U * (bid + 1)) / G);
        LAS unsigned char* Kl = lds; LAS unsigned char* Vl = lds + 256 * KP64;
        int staged = -1;
        for (int u = u_lo; u < u_hi; ++u) {
            int l = 0;
#pragma unroll 1
            for (int step = 512; step > 0; step >>= 1) if (l + step <= 1023 && pre[l + step] <= u) l += step;
            const int bh = l >> 6, j = l & 63, b = bh >> 3, h = bh & 7, chunk = u - pre[l];
            const int cnt = (int)lcnt[l];
            if (l != staged) {
                __syncthreads();
                stage64<KP64>(Kl, PJ + (size_t)(b * SEQ + j * 256) * NPJ + C_AK + h * 64, NPJ, tid);
                stage64<VP64>(Vl, PJ + (size_t)(b * SEQ + j * 256) * NPJ + C_AV + h * 64, NPJ, tid);
                __syncthreads();
                staged = l;
            }
            const int rows = cnt - 256 * chunk;
            if (32 * wave < rows) {
                const int r = lane & 31, hp = lane >> 5;
                const int ri = 32 * wave + r; const bool valid = ri < rows;
                const unsigned ent = mlist[(size_t)bh * MLIST_PER_BH + (size_t)j * SEQ - 128 * j * (j + 1) + 256 * chunk + (valid ? ri : 0)];
                const int s = (int)(ent >> 2), slot = (int)(ent & 3u);
                const f16* qrow = PJ + (size_t)(b * SEQ + s) * NPJ + C_AQ + h * 64;
                h8 qf[4];
#pragma unroll
                for (int ks = 0; ks < 4; ++ks) qf[ks] = *(const h8*)(qrow + 16 * ks + 8 * hp);
                float m2, ls; f32x16 o[2];
                attn_tile<false>(Kl, Vl, biasl + h * 132, qf, s - 256 * j, 0, lane, m2, ls, o);
                if (valid) {
                    const size_t pidx = ((size_t)bh * SEQ + s) * 3 + slot;
                    if (hp == 0) pml[pidx] = (f32x2){m2, ls};
                    const float inv = 1.0f / ls; f16* po = pO + pidx * 64;
#pragma unroll
                    for (int dt = 0; dt < 2; ++dt)
#pragma unroll
                        for (int g = 0; g < 4; ++g) { const f32x4 vv = {o[dt][4 * g] * inv, o[dt][4 * g + 1] * inv, o[dt][4 * g + 2] * inv, o[dt][4 * g + 3] * inv};
                            *(h4*)(po + 32 * dt + 8 * g + 4 * hp) = __builtin_convertvector(vv, h4); }
                }
            }
        }
        __syncthreads();
    }
    SEAM(3);

    if (IN(4)) REP(4) {
        constexpr int NU_A = 16 * 64, NU_R = 8 * 64;
        for (int u = bid; u < NU_A + NU_R; u += G) {
            __syncthreads();
            if (u < NU_R) {
#ifndef P4_NO_RET
                const int bh = u >> 6, ci = u & 63, b = bh >> 2, h = bh & 3;
                const float lg = gamma_log2(h);
                const size_t row0 = (size_t)b * SEQ + ci * 256;
                LAS unsigned char* Kl = lds; LAS unsigned char* Vl = lds + 256 * 272;
#pragma unroll
                for (int i = 0; i < 8; ++i) { const int q = tid + 512 * i, row = q >> 4, ch = q & 15;
                    *(LAS h8*)(Kl + row * 272 + 16 * ch) = *(const h8*)(PJ + (row0 + row) * NPJ + C_RK + h * 128 + 8 * ch);
                    *(LAS h8*)(Vl + row * 320 + 16 * ch) = *(const h8*)(PJ + (row0 + row) * NPJ + C_RV + h * 128 + 8 * ch); }
                __syncthreads();
                const int r = lane & 31, hp = lane >> 5, i16 = lane & 15, q4 = i16 >> 2, p4 = i16 & 3, cb = (lane >> 4) & 1;
                const int ql = 32 * wave + r;
                const f16* qrow = PJ + (row0 + ql) * NPJ + C_RQ + h * 128;
                h8 qf[8];
#pragma unroll
                for (int ks = 0; ks < 8; ++ks) qf[ks] = *(const h8*)(qrow + 16 * ks + 8 * hp);
                f32x16 o[4];
#pragma unroll
                for (int t = 0; t < 4; ++t)
#pragma unroll
                    for (int i = 0; i < 16; ++i) o[t][i] = 0.f;
                const f16* Rt = Rbuf + (size_t)u * 128 * 128;
#pragma unroll
                for (int t = 0; t < 4; ++t)
#pragma unroll
                    for (int ks = 0; ks < 8; ++ks) { const h8 rf = *(const h8*)(Rt + (32 * t + r) * 128 + 16 * ks + 8 * hp); o[t] = MFMA32(rf, qf[ks], o[t]); }
                const float qd = fexp2(lg * (float)(ql + 1));
#pragma unroll
                for (int t = 0; t < 4; ++t)
#pragma unroll
                    for (int i = 0; i < 16; ++i) o[t][i] *= qd;
                LAS const unsigned char* vbase = Vl + (4 * hp + q4) * 320 + 2 * (16 * cb + 4 * p4);
                for (int kt = 0; kt <= wave; ++kt) {
                    f32x16 st;
#pragma unroll
                    for (int i = 0; i < 16; ++i) st[i] = 0.f;
#pragma unroll
                    for (int ks = 0; ks < 8; ++ks) { const h8 kf = *(const LAS h8*)(Kl + (32 * kt + r) * 272 + 32 * ks + 16 * hp); st = MFMA32(kf, qf[ks], st); }
#pragma unroll
                    for (int i = 0; i < 16; ++i) { const int dist = ql - (32 * kt + crow(i, hp)); st[i] = dist >= 0 ? st[i] * fexp2(lg * (float)dist) : 0.f; }
#pragma unroll
                    for (int s = 0; s < 2; ++s) {
                        const f32x8 pv = {st[8 * s], st[8 * s + 1], st[8 * s + 2], st[8 * s + 3], st[8 * s + 4], st[8 * s + 5], st[8 * s + 6], st[8 * s + 7]};
                        const h8 pf = __builtin_convertvector(pv, h8);
#pragma unroll
                        for (int t = 0; t < 4; ++t) {
                            LAS const unsigned char* vp = vbase + (32 * kt + 16 * s) * 320 + 64 * t;
                            const h8 vf = cat44(tr_read(vp), tr_read(vp + 8 * 320));
                            o[t] = MFMA32(vf, pf, o[t]);
                        }
                    }
                }
                float sm = 0.f;
#pragma unroll
                for (int t = 0; t < 4; ++t)
#pragma unroll
                    for (int i = 0; i < 16; ++i) sm += o[t][i];
                sm += __shfl_xor(sm, 32);
                const float mu = sm * (1.0f / 128.0f);
                float sq = 0.f;
#pragma unroll
                for (int t = 0; t < 4; ++t)
#pragma unroll
                    for (int i = 0; i < 16; ++i) { const float d = o[t][i] - mu; sq += d * d; }
                sq += __shfl_xor(sq, 32);
                const float rstd = 1.0f / sqrtf(sq * (1.0f / 128.0f) + LN_EPS);
                const f16* grow = PJ + (row0 + ql) * NPJ + C_RG + h * 128;
                f16* crow_ = cat + (row0 + ql) * DM + 512 + h * 128;
#pragma unroll
                for (int t = 0; t < 4; ++t)
#pragma unroll
                    for (int g = 0; g < 4; ++g) { const int d0 = 32 * t + 8 * g + 4 * hp;
                        const h4 gv = *(const h4*)(grow + d0); f32x4 ov;
#pragma unroll
                        for (int e = 0; e < 4; ++e) { const float gg = (float)gv[e]; const float sl = gg / (1.0f + fexp2(-gg * LOG2E)); ov[e] = sl * (o[t][4 * g + e] - mu) * rstd; }
                        *(h4*)(crow_ + d0) = __builtin_convertvector(ov, h4); }
#endif
            } else {
#ifndef P4_NO_ATT
                const int uu = u - NU_R, bh = uu >> 6, c = uu & 63, b = bh >> 3, h = bh & 7;
                LAS unsigned char* Kl = lds; LAS unsigned char* Vl = lds + 256 * KP64;
                stage64<KP64>(Kl, PJ + (size_t)(b * SEQ + c * 256) * NPJ + C_AK + h * 64, NPJ, tid);
                stage64<VP64>(Vl, PJ + (size_t)(b * SEQ + c * 256) * NPJ + C_AV + h * 64, NPJ, tid);
                __syncthreads();
                const int r = lane & 31, hp = lane >> 5;
                const int ql = 32 * wave + r, s = 256 * c + ql;
                const f16* qrow = PJ + (size_t)(b * SEQ + s) * NPJ + C_AQ + h * 64;
                h8 qf[4];
#pragma unroll
                for (int ks = 0; ks < 4; ++ks) qf[ks] = *(const h8*)(qrow + 16 * ks + 8 * hp);
                float m2, ls; f32x16 o[2];
                attn_own(Kl, Vl, biasl + h * 132, qf, ql, wave, lane, m2, ls, o);
                const int nsel = c < 3 ? c : 3;
                const size_t pidx = ((size_t)bh * SEQ + s) * 3;
                float pm[3], pl[3]; float M = m2;
#pragma unroll
                for (int t = 0; t < 3; ++t) { pm[t] = -3.0e38f; pl[t] = 0.f; if (t < nsel) { const f32x2 v = pml[pidx + t]; pm[t] = v[0]; pl[t] = v[1]; M = fmaxf(M, pm[t]); } }
                const float e0 = fexp2(m2 - M); float L = ls * e0;
#pragma unroll
                for (int dt = 0; dt < 2; ++dt)
#pragma unroll
                    for (int i = 0; i < 16; ++i) o[dt][i] *= e0;
#pragma unroll
                for (int t = 0; t < 3; ++t) if (t < nsel) {
                    const float wt = pl[t] * fexp2(pm[t] - M); L += wt; const f16* po = pO + (pidx + t) * 64;
#pragma unroll
                    for (int dt = 0; dt < 2; ++dt)
#pragma unroll
                        for (int g = 0; g < 4; ++g) { const h4 pv = *(const h4*)(po + 32 * dt + 8 * g + 4 * hp);
#pragma unroll
                            for (int e = 0; e < 4; ++e) o[dt][4 * g + e] += wt * (float)pv[e]; }
                }
                const float invL = 1.0f / L; float sq = 0.f;
                f16* crow_ = cat + (size_t)(b * SEQ + s) * DM + h * 64;
#pragma unroll
                for (int dt = 0; dt < 2; ++dt)
#pragma unroll
                    for (int g = 0; g < 4; ++g) { f32x4 ov;
#pragma unroll
                        for (int e = 0; e < 4; ++e) { ov[e] = o[dt][4 * g + e] * invL; sq += ov[e] * ov[e]; }
                        *(h4*)(crow_ + 32 * dt + 8 * g + 4 * hp) = __builtin_convertvector(ov, h4); }
                sq += __shfl_xor(sq, 32);
                if (hp == 0) sumsq[(size_t)(b * SEQ + s) * 8 + h] = sq;
#endif
            }
        }
        __syncthreads();
    }
    SEAM(4);

    if (IN(5)) {
        pg8::StaticOrder S; S.init(cat, WoT, DM, DM, NTOK, DM, G, bid);
        EpiZ E{a.x, zbuf, sumsq};
        pg8::gemm_phase<EpiZ, pg8::StaticOrder, true>(lds, DM, DM / 64, S, E);
    }
    SEAM(5);

    if (IN(6)) REP(6) {
        unsigned* ecnt_w = rep_ ? ecnt + 64 : ecnt; int* elist_w = rep_ ? (int*)(ws + 496 * MiB) : elist; float* wts_w = rep_ ? (float*)(ws + 500 * MiB) : wts;
        LAS unsigned char* Ht = lds;
        LAS float* lg = (LAS float*)(lds + 32 * 2064);
        f32x8 gv[2], bv[2];
#pragma unroll
        for (int j = 0; j < 2; ++j) { gv[j] = *(const f32x8*)(a.ln1g + 8 * lane + 512 * j); bv[j] = *(const f32x8*)(a.ln1b + 8 * lane + 512 * j); }
        for (int u = bid; u < NTOK / 32; u += G) {
            __syncthreads();
            h8 zin[4][2];
#pragma unroll
            for (int rr = 0; rr < 4; ++rr)
#pragma unroll
                for (int j = 0; j < 2; ++j) zin[rr][j] = *(const h8*)(zbuf + ((size_t)u * 32 + 4 * wave + rr) * DM + 8 * lane + 512 * j);
#pragma unroll
            for (int rr = 0; rr < 4; ++rr) {
                const int rl = 4 * wave + rr; const size_t row = (size_t)u * 32 + rl;
                f32x8 v[2]; float s = 0.f;
#pragma unroll
                for (int j = 0; j < 2; ++j) { v[j] = __builtin_convertvector(zin[rr][j], f32x8);
#pragma unroll
                    for (int e = 0; e < 8; ++e) s += v[j][e]; }
                const float mean = wave_sum(s) * (1.0f / DM); float s2 = 0.f;
#pragma unroll
                for (int j = 0; j < 2; ++j) { v[j] = v[j] - mean;
#pragma unroll
                    for (int e = 0; e < 8; ++e) s2 += v[j][e] * v[j][e]; }
                const float rstd = 1.0f / sqrtf(wave_sum(s2) * (1.0f / DM) + LN_EPS);
#pragma unroll
                for (int j = 0; j < 2; ++j) { const h8 hv = __builtin_convertvector(v[j] * rstd * gv[j] + bv[j], h8);
                    *(h8*)(hh + row * DM + 8 * lane + 512 * j) = hv; *(LAS h8*)(Ht + rl * 2064 + 2 * (8 * lane + 512 * j)) = hv; }
            }
            __syncthreads();
            if (wave < 6) {
                const int rt = wave / 3, ct = wave % 3, fr = lane & 15, fq = lane >> 4;
                f32x4 acc = {0.f, 0.f, 0.f, 0.f};
#pragma unroll 8
                for (int ks = 0; ks < 32; ++ks) { const h8 af = *(const LAS h8*)(Ht + (16 * rt + fr) * 2064 + 2 * (32 * ks + 8 * fq));
                    const h8 bf = *(const h8*)(WrT + (size_t)(16 * ct + fr) * DM + 32 * ks + 8 * fq); acc = MFMA16(af, bf, acc); }
#pragma unroll
                for (int e = 0; e < 4; ++e) lg[(16 * rt + 4 * fq + e) * 48 + 16 * ct + fr] = acc[e];
            }
            __syncthreads();
            if (tid < 32) {
                const int tok = u * 32 + tid; LAS const float* L = lg + tid * 48;
                float g4[4]; int gi = 0; float gm = -3.0e38f;
#pragma unroll
                for (int k = 0; k < 4; ++k) { g4[k] = L[k] + a.brg[k]; if (g4[k] > gm) { gm = g4[k]; gi = k; } }
                float gs = 0.f;
#pragma unroll
                for (int k = 0; k < 4; ++k) gs += __expf(g4[k] - gm);
                const float gp = 1.0f / gs;
                float l1 = -3.0e38f, l2 = -3.0e38f; int i1 = 0, i2 = 0;
                for (int k = 0; k < 8; ++k) { const float v = L[4 + 8 * gi + k] + a.bre[8 * gi + k]; if (v > l1) { l2 = l1; i2 = i1; l1 = v; i1 = k; } else if (v > l2) { l2 = v; i2 = k; } }
                const float w1 = 1.0f / (1.0f + __expf(l2 - l1)), w2 = 1.0f - w1;
                const int e1 = 8 * gi + i1, e2 = 8 * gi + i2;
                const unsigned p1 = atomicAdd(ecnt_w + e1, 1u), p2 = atomicAdd(ecnt_w + e2, 1u);
                elist_w[e1 * NTOK + (int)p1] = tok * 2; elist_w[e2 * NTOK + (int)p2] = tok * 2 + 1;
                wts_w[tok * 2] = gp * w1; wts_w[tok * 2 + 1] = gp * w2;
            }
        }
        __syncthreads();
    }
    SEAM(6);

    LAS int* mtab = (LAS int*)(lds + pg8::STAGE_BYTES + 1024);
    if (IN(7) || IN(8)) {
        if (tid == 0) { int acc = 0; for (int e = 0; e < 32; ++e) { const int c = (int)ecnt[e]; mtab[e] = c; mtab[32 + e] = acc; acc += (c + 255) >> 8; } mtab[64] = acc; }
        __syncthreads();
    }
    if (IN(7)) {
        MoeSched S{mtab, elist, (const char*)hh, (const char*)WguT, (size_t)DM * DM * 2, DM, DM, G, bid, true};
        EpiGU E{hid};
        pg8::gemm_phase<EpiGU, MoeSched, true>(lds, DM, DM / 64, S, E);
        if (DUP_PHASE == 7) pg8::gemm_phase<EpiGU, MoeSched, true>(lds, DM, DM / 64, S, E);
    }
    SEAM(7);
    if (IN(8)) {
        MoeSched S{mtab, elist, (const char*)hid, (const char*)WdnT, (size_t)DM * DE * 2, DE, DE, G, bid, false};
        EpiDown E{ybuf, elist, wts, mtab};
        pg8::gemm_phase<EpiDown, MoeSched, true>(lds, DE, DE / 64, S, E);
        if (DUP_PHASE == 8) pg8::gemm_phase<EpiDown, MoeSched, true>(lds, DE, DE / 64, S, E);
    }
    SEAM(8);

    if (IN(9)) REP(9) {
        f32x4 gv[4], bv[4];
#pragma unroll
        for (int j = 0; j < 4; ++j) { gv[j] = *(const f32x4*)(a.ln2g + 4 * lane + 256 * j); bv[j] = *(const f32x4*)(a.ln2b + 4 * lane + 256 * j); }
        for (int row = bid * 8 + wave; row < NTOK; row += G * 8) {
            f32x4 v[4]; float s = 0.f;
#pragma unroll
            for (int j = 0; j < 4; ++j) { const size_t c = 4 * lane + 256 * j;
                const f32x4 hv = __builtin_convertvector(*(const h4*)(hh + (size_t)row * DM + c), f32x4);
                const f32x4 y0 = __builtin_convertvector(*(const h4*)(ybuf + (size_t)(2 * row) * DM + c), f32x4);
                const f32x4 y1 = __builtin_convertvector(*(const h4*)(ybuf + (size_t)(2 * row + 1) * DM + c), f32x4);
                v[j] = hv * ALPHA + (y0 + y1); s += (v[j][0] + v[j][1]) + (v[j][2] + v[j][3]); }
            const float mean = wave_sum(s) * (1.0f / DM); float s2 = 0.f;
#pragma unroll
            for (int j = 0; j < 4; ++j) { v[j] = v[j] - mean; s2 += (v[j][0] * v[j][0] + v[j][1] * v[j][1]) + (v[j][2] * v[j][2] + v[j][3] * v[j][3]); }
            const float rstd = 1.0f / sqrtf(wave_sum(s2) * (1.0f / DM) + LN_EPS);
#pragma unroll
            for (int j = 0; j < 4; ++j) *(f32x4*)(a.out + (size_t)row * DM + 4 * lane + 256 * j) = v[j] * rstd * gv[j] + bv[j];
        }
    }
#undef IN
#undef SEAM
}

extern "C" void kernel_launch(void* const* d_in, const int* in_sizes, int n_in, void* d_out, int out_size, void* d_ws, size_t ws_size, hipStream_t stream) {
    static int grid = 0;
    if (grid == 0) {
        if (n_in != 15 || in_sizes[0] != NTOK * DM || out_size != NTOK * DM || ws_size < WS_END) { fprintf(stderr, "kernel_launch: unexpected problem (n_in %d, ws %zu)\n", n_in, ws_size); grid = -1; return; }
        int dev = 0, cus = 0, per_cu = 0;
        if (hipGetDevice(&dev) != hipSuccess || hipDeviceGetAttribute(&cus, hipDeviceAttributeMultiprocessorCount, dev) != hipSuccess) { grid = -1; return; }
        if (hipFuncSetAttribute((const void*)fwd, hipFuncAttributeMaxDynamicSharedMemorySize, LDS_BYTES) != hipSuccess) { fprintf(stderr, "kernel_launch: hipFuncSetAttribute failed\n"); grid = -1; return; }
        if (hipOccupancyMaxActiveBlocksPerMultiprocessor(&per_cu, (const void*)fwd, 512, LDS_BYTES) != hipSuccess || per_cu < 1) { fprintf(stderr, "kernel_launch: occupancy query says %d\n", per_cu); (void)hipGetLastError(); grid = -1; return; }
        grid = cus;
    }
    if (grid < 0) return;
    (void)hipMemsetAsync((char*)d_ws + WS_CTL, 0, CTL_ZERO_BYTES, stream);
    Args a{};
    a.x = (const float*)d_in[0]; a.w_in = (const float*)d_in[1]; a.gain = (const float*)d_in[2]; a.rel = (const float*)d_in[3]; a.w_out = (const float*)d_in[4];
    a.ln1g = (const float*)d_in[5]; a.ln1b = (const float*)d_in[6]; a.wrg = (const float*)d_in[7]; a.brg = (const float*)d_in[8]; a.wre = (const float*)d_in[9];
    a.bre = (const float*)d_in[10]; a.wgu = (const float*)d_in[11]; a.wdn = (const float*)d_in[12]; a.ln2g = (const float*)d_in[13]; a.ln2b = (const float*)d_in[14];
    a.out = (float*)d_out; a.ws = (unsigned char*)d_ws;
#if MK_LAUNCHES == 1
    a.ph_lo = 0; a.ph_hi = NPHASE;
    hipLaunchKernelGGL(fwd, dim3(grid), dim3(512), LDS_BYTES, stream, a);
#else
    for (int p = 0; p < NPHASE; ++p) { a.ph_lo = p; a.ph_hi = p + 1; hipLaunchKernelGGL(fwd, dim3(grid), dim3(512), LDS_BYTES, stream, a); }
#endif
}
```

```cpp
#include <hip/hip_runtime.h>
#include <cstdint>
#include <cstdio>

#ifndef MK_LAUNCHES
#define MK_LAUNCHES 1
#endif

#define DI __device__ __forceinline__
#define LAS __attribute__((address_space(3)))
typedef _Float16 f16;
typedef _Float16 h8 __attribute__((ext_vector_type(8)));
typedef _Float16 h4 __attribute__((ext_vector_type(4)));
typedef short s4v __attribute__((ext_vector_type(4)));
typedef float f32x2 __attribute__((ext_vector_type(2)));
typedef float f32x4 __attribute__((ext_vector_type(4)));
typedef float f32x8 __attribute__((ext_vector_type(8)));
typedef float f32x16 __attribute__((ext_vector_type(16)));

constexpr int NB = 2, SEQ = 16384, DM = 1024, NTOK = NB * SEQ, NPJ = 3584;
constexpr int C_AQ = 0, C_AK = 512, C_AV = 1024, C_RQ = 1536, C_RK = 2048, C_RV = 2560, C_RG = 3072;
constexpr int NBLK = SEQ / 256;
constexpr int NE = 32, DE = 512;
constexpr float ALPHA = 1.189207115002721f, LN_EPS = 1e-5f, LOG2E = 1.4426950408889634f;
constexpr int NPHASE = 10;

constexpr size_t MiB = 1u << 20;
constexpr size_t WS_CTL = 0, CTL_ZERO_BYTES = 128 * 1024;
constexpr size_t WS_ROPEC = 1 * MiB, WS_ROPES = 5 * MiB, WS_XSUM = 9 * MiB, WS_KMEAN = 10 * MiB, WS_WRT = 10 * MiB + 512 * 1024;
constexpr size_t WS_SUMSQ = 11 * MiB, WS_WTS = 12 * MiB, WS_ELIST = 13 * MiB, WS_MLIST = 17 * MiB, WS_PML = 33 * MiB;
constexpr size_t WS_WINT = 39 * MiB, WS_WOT = 46 * MiB, WS_WGUT = 48 * MiB, WS_WDNT = 112 * MiB;
constexpr size_t WS_PJ = 144 * MiB, WS_XH = 368 * MiB, WS_CAT = 368 * MiB, WS_KV = 432 * MiB, WS_R = 464 * MiB;
constexpr size_t WS_HH = 144 * MiB, WS_HID = 208 * MiB, WS_Y = 280 * MiB, WS_END = 480 * MiB;
constexpr int MLIST_PER_BH = 516096;
constexpr int CW_BAR = 4096, CW_LCNT = 8192, CW_ECNT = 12288;

constexpr int SCR_BYTES = 155648;
constexpr int BIAS_OFF = SCR_BYTES;
constexpr int BTP = 224;
constexpr int MISC_OFF = BIAS_OFF + 8 * BTP * 4 + 128;
constexpr int LDS_BYTES = MISC_OFF + 256;
static_assert(LDS_BYTES <= 163840, "LDS");

__device__ const unsigned char T5_BUCKET[129] = {0,1,2,3,4,5,6,7,8,9,10,11,12,13,14,15,16,16,16,17,17,18,18,18,19,19,19,20,20,20,20,21,21,21,21,22,22,22,22,22,23,23,23,23,23,23,24,24,24,24,24,24,25,25,25,25,25,25,25,26,26,26,26,26,26,26,26,27,27,27,27,27,27,27,27,27,27,28,28,28,28,28,28,28,28,28,28,29,29,29,29,29,29,29,29,29,29,29,29,30,30,30,30,30,30,30,30,30,30,30,30,30,30,31,31,31,31,31,31,31,31,31,31,31,31,31,31,31,31};
__device__ const float ROPE_INV[64] = {1.0f,0.865964353f,0.749894202f,0.649381638f,0.562341332f,0.486967534f,0.421696514f,0.365174115f,0.316227764f,0.273841977f,0.237137377f,0.2053525f,0.177827939f,0.153992653f,0.133352146f,0.115478195f,0.100000001f,0.0865964293f,0.0749894232f,0.0649381652f,0.0562341325f,0.0486967526f,0.0421696492f,0.0365174115f,0.0316227749f,0.0273841955f,0.0237137377f,0.0205352511f,0.0177827943f,0.0153992651f,0.013335214f,0.0115478197f,0.00999999978f,0.00865964312f,0.00749894232f,0.00649381615f,0.00562341325f,0.00486967526f,0.00421696482f,0.00365174119f,0.00316227763f,0.00273841969f,0.00237137382f,0.00205352507f,0.00177827943f,0.00153992651f,0.00133352145f,0.00115478202f,0.00100000005f,0.000865964335f,0.000749894185f,0.000649381604f,0.000562341302f,0.000486967532f,0.000421696517f,0.000365174114f,0.000316227757f,0.000273841957f,0.00023713737f,0.00020535251f,0.00017782794f,0.00015399266f,0.00013335215f,0.0001154782f};

struct Args {
    const float *x, *w_in, *gain, *rel, *w_out, *ln1g, *ln1b, *wrg, *brg, *wre, *bre, *wgu, *wdn, *ln2g, *ln2b;
    float* out; unsigned char* ws; int ph_lo, ph_hi, alt, pad;
};

#define LDS_WAIT() asm volatile("s_waitcnt lgkmcnt(0)" ::: "memory")
#define MFMA32(a, b, c) __builtin_amdgcn_mfma_f32_32x32x16_f16((a), (b), (c), 0, 0, 0)
#define MFMA16(a, b, c) __builtin_amdgcn_mfma_f32_16x16x32_f16((a), (b), (c), 0, 0, 0)
DI int crow(int reg, int hp) { return (reg & 3) + 8 * (reg >> 2) + 4 * hp; }
DI h8 cvt8(f32x4 a, f32x4 b) { const f32x8 v = {a[0], a[1], a[2], a[3], b[0], b[1], b[2], b[3]}; return __builtin_convertvector(v, h8); }
DI float wave_sum(float v) {
#pragma unroll
    for (int o = 1; o < 64; o <<= 1) v += __shfl_xor(v, o);
    return v;
}
DI h4 tr_read(LAS const unsigned char* p) {
    typedef LAS s4v lds_s4;
    const s4v v = __builtin_amdgcn_ds_read_tr16_b64_v4i16((lds_s4*)p);
    return __builtin_bit_cast(h4, v);
}
DI h8 cat44(h4 a, h4 b) { return __builtin_shufflevector(a, b, 0, 1, 2, 3, 4, 5, 6, 7); }
DI float fexp2(float x) { return __builtin_amdgcn_exp2f(x); }
DI float gamma_log2(int h) { return __builtin_log2f(1.0f - fexp2(-(5.0f + (4.0f / 3.0f) * (float)h))); }

#define XB_TMO      128
#define XB_XCNT(j)  (256  + 64 * (j))
#define XB_XSUB(j)  (1280 + 64 * (j))
#define XB_XGEN(j)  (2304 + 64 * (j))
#define XB_TOP      3328
#define XB_TOPGEN   3392
#define XCD_BAR_WORDS 3456
#define XB_SPIN_CAP (1u << 18)
__device__ __forceinline__ unsigned xb_ld(unsigned* p)              { return __hip_atomic_load(p, __ATOMIC_RELAXED, __HIP_MEMORY_SCOPE_AGENT); }
__device__ __forceinline__ unsigned xb_add(unsigned* p, unsigned v) { return __hip_atomic_fetch_add(p, v, __ATOMIC_RELAXED, __HIP_MEMORY_SCOPE_AGENT); }
__device__ __forceinline__ unsigned xb_xcc_id() { return (unsigned)__builtin_amdgcn_s_getreg((3 << 11) | 20) & 0xFu; }
#define XB_SPIN(cond, bar) do { unsigned _sp = 0; while (cond) { __builtin_amdgcn_s_sleep(1); \
    if ((++_sp & 255u) == 0u) { if (xb_ld(&(bar)[XB_TMO])) break; if (_sp > XB_SPIN_CAP) { atomicAdd(&(bar)[XB_TMO], 1u); break; } } } } while (0)
struct XcdBarrier { unsigned* bar; unsigned x; volatile LAS unsigned* st; };
__device__ __forceinline__ XcdBarrier xcd_barrier_post(unsigned* bar, volatile LAS unsigned* st) {
    XcdBarrier b; b.bar = bar; b.x = xb_xcc_id(); b.st = st;
    if (threadIdx.x == 0) (void)xb_add(&bar[XB_XCNT(b.x)], 1u);
    return b;
}
__device__ __forceinline__ void xcd_barrier_complete(unsigned* bar, unsigned x, unsigned& nloc, unsigned& nx) {
    const unsigned G = gridDim.x * gridDim.y * gridDim.z;
    unsigned sum, cnt, mine, sp = 0u;
    for (;;) {
        sum = 0u; cnt = 0u; mine = 0u;
#pragma unroll
        for (unsigned j = 0; j < 16; ++j) { const unsigned c = xb_ld(&bar[XB_XCNT(j)]); sum += c; cnt += (c > 0u) ? 1u : 0u; mine = (j == x) ? c : mine; }
        if (sum == G) break;
        __builtin_amdgcn_s_sleep(1);
        if ((++sp & 255u) == 0u) { if (xb_ld(&bar[XB_TMO])) break; if (sp > XB_SPIN_CAP) { atomicAdd(&bar[XB_TMO], 1u); break; } }
    }
    nloc = mine > 0u ? mine : 1u; nx = cnt > 0u ? cnt : 1u;
}
__device__ __forceinline__ void xcd_barrier(const XcdBarrier& b) {
    asm volatile("s_waitcnt vmcnt(0)" ::: "memory");
    __syncthreads();
    if (threadIdx.x == 0) {
        unsigned* bar = b.bar;
        __builtin_amdgcn_s_waitcnt(0);
        unsigned nloc = b.st[0], nx = b.st[1];
        if (nloc == 0u) { xcd_barrier_complete(bar, b.x, nloc, nx); b.st[0] = nloc; b.st[1] = nx; }
        const unsigned old = xb_add(&bar[XB_XSUB(b.x)], 1u);
        const unsigned gen = old / nloc;
        if (old + 1u == (gen + 1u) * nloc) {
            __builtin_amdgcn_fence(__ATOMIC_RELEASE, "agent");
            asm volatile("s_waitcnt vmcnt(0)" ::: "memory");
            const unsigned og = xb_add(&bar[XB_TOP], 1u);
            const unsigned tg = og / nx;
            if (og + 1u == (tg + 1u) * nx) xb_add(&bar[XB_TOPGEN], 1u);
            else XB_SPIN(xb_ld(&bar[XB_TOPGEN]) == tg, bar);
            __builtin_amdgcn_fence(__ATOMIC_ACQUIRE, "agent");
            xb_add(&bar[XB_XGEN(b.x)], 1u);
            asm volatile("s_waitcnt vmcnt(0)" ::: "memory");
        } else {
            XB_SPIN(xb_ld(&bar[XB_XGEN(b.x)]) == gen, bar);
            __builtin_amdgcn_fence(__ATOMIC_ACQUIRE, "agent");
            asm volatile("s_waitcnt vmcnt(0)" ::: "memory");
        }
    }
    __syncthreads();
}

namespace pg8 {
constexpr int BM = 256, BK = 64, HALF = 128, HTB = HALF * BK * 2, STAGE_BYTES = 8 * HTB, NXCD = 8, WGM = 8;
DI int lds_byte(int r, int c) { const int st = (r >> 4) * 2 + (c >> 5), rr = r & 15, cc = c & 31, ob = rr * 64 + cc * 2; return st * 1024 + (ob ^ (((ob >> 9) & 1) << 5)); }
DI void stage_rc(int b, int& R, int& C) { const int st = b / 1024, sb = b % 1024, swz = sb ^ (((sb >> 9) & 1) << 5); R = (st >> 1) * 16 + swz / 64; C = (st & 1) * 32 + (swz % 64) / 2; }
DI int perm32(int rho) { const int n = rho >> 4, i = rho & 15; return 8 * (i >> 2) + 4 * n + (i & 3); }

struct Unit { const char* a; const char* b; int i0, i1, i2, i3; };

struct StaticOrder {
    const char* A; const char* Bt; int lda, ldb, nM, nN, nwg, G, c;
    DI void init(const void* A_, const void* Bt_, int lda_, int ldb_, int M, int N, int G_, int c_) { A = (const char*)A_; Bt = (const char*)Bt_; lda = lda_; ldb = ldb_; nM = M / BM; nN = N / BM; nwg = nM * nN; G = G_; c = c_; }
    DI bool next(int i, Unit& u) const {
        const long L = (long)i * G + c; if (L >= nwg) return false;
        int wgid = (int)L; { const int q = nwg / NXCD, r = nwg % NXCD, xcd = wgid % NXCD, off = wgid / NXCD; wgid = (xcd < r ? xcd * (q + 1) : r * (q + 1) + (xcd - r) * q) + off; }
        const int nig = WGM * nN, gid = wgid / nig, fm = gid * WGM, gsz = (nM - fm) < WGM ? (nM - fm) : WGM;
        u.i0 = fm + ((wgid % nig) % gsz); u.i1 = (wgid % nig) / gsz; u.i2 = 0; u.i3 = 0;
        u.a = A + (size_t)u.i0 * BM * lda * 2; u.b = Bt + (size_t)u.i1 * BM * ldb * 2; return true;
    }
    DI void aoff(const Unit&, unsigned (&vo)[2][2]) const {
#pragma unroll
        for (int i = 0; i < 2; ++i) { int R, C; stage_rc((int)threadIdx.x * 16 + i * 8192, R, C);
#pragma unroll
            for (int h = 0; h < 2; ++h) vo[h][i] = (unsigned)((h * HALF + R) * lda + C) * 2u; }
    }
};

template <class Epi, class Sched, bool ALIGN_EPI>
DI void gemm_phase(LAS unsigned char* lds, const int ldb, const int nt, const Sched& S, const Epi& E) {
    const int tid = threadIdx.x, wid = __builtin_amdgcn_readfirstlane(tid >> 6), lane = tid & 63, wr = wid >> 2, wc = wid & 3, fr = lane & 15, fq = lane >> 4;
    unsigned voffB[2];
#pragma unroll
    for (int i = 0; i < 2; ++i) { int R, C; stage_rc(tid * 16 + i * 8192, R, C); const int Rb = (R & ~31) + perm32(R & 31); voffB[i] = (unsigned)(Rb * ldb + C) * 2u; }
    const size_t kstep = (size_t)(BK * 2);
    const size_t hstep = (size_t)HALF * ldb * 2;
    const unsigned ldsw = (unsigned)wid * 1024u;
    const int aoff = lds_byte(wr * 64 + fr, fq * 8), boff = lds_byte(wc * 32 + fr, fq * 8);
#define PG8_SA(b, h) (((b) * 2 + (h)) * HTB)
#define PG8_SB(b, h) ((4 + (b) * 2 + (h)) * HTB)
#define PG8_STAGE(bufoff, gbase, voff) do { _Pragma("unroll") for (int _i = 0; _i < 2; ++_i) \
        __builtin_amdgcn_global_load_lds((const unsigned*)((const char*)(gbase) + (voff)[_i]), (LAS unsigned*)(lds + (bufoff) + ldsw + _i * 8192), 16, 0, 0); } while (0)
#define PG8_LDA(dst, b, h) do { _Pragma("unroll") for (int m = 0; m < 4; ++m) _Pragma("unroll") for (int k = 0; k < 2; ++k) dst[m][k] = *(const LAS h8*)(lds + PG8_SA(b, h) + aoff + m * 2048 + k * 1024); } while (0)
#define PG8_LDB(dst, b, h) do { _Pragma("unroll") for (int n = 0; n < 2; ++n) _Pragma("unroll") for (int k = 0; k < 2; ++k) dst[n][k] = *(const LAS h8*)(lds + PG8_SB(b, h) + boff + n * 2048 + k * 1024); } while (0)
#define PG8_MMA(ai, bj, At, Bt) do { __builtin_amdgcn_s_setprio(1); _Pragma("unroll") for (int m = 0; m < 4; ++m) _Pragma("unroll") for (int n = 0; n < 2; ++n) _Pragma("unroll") for (int k = 0; k < 2; ++k) \
        acc[ai][bj][m][n] = __builtin_amdgcn_mfma_f32_16x16x32_f16(Bt[n][k], At[m][k], acc[ai][bj][m][n], 0, 0, 0); __builtin_amdgcn_s_setprio(0); } while (0)
#define PG8_WAIT_V(n) asm volatile("s_waitcnt vmcnt(" #n ")" ::: "memory")
#define PG8_WAIT_L(n) asm volatile("s_waitcnt lgkmcnt(" #n ")" ::: "memory")
#define PG8_BAR __builtin_amdgcn_s_barrier()
#define PG8_SCHED __builtin_amdgcn_sched_barrier(0)
    Unit cur, nxt; int ui = 0;
    if (!S.next(0, cur)) return;
    f32x4 acc[2][2][4][2];
#pragma unroll
    for (int a = 0; a < 2; ++a)
#pragma unroll
        for (int b = 0; b < 2; ++b)
#pragma unroll
            for (int m = 0; m < 4; ++m)
#pragma unroll
                for (int n = 0; n < 2; ++n) acc[a][b][m][n] = (f32x4){0.f, 0.f, 0.f, 0.f};
    h8 At[4][2], B0[2][2], B1[2][2];
    unsigned voc[2][2], von[2][2];
    S.aoff(cur, voc);
    const char* cA = cur.a; const char* cB = cur.b;
    PG8_STAGE(PG8_SB(0, 0), cB, voffB); PG8_STAGE(PG8_SB(0, 1), cB + hstep, voffB); PG8_STAGE(PG8_SA(0, 0), cA, voc[0]); PG8_STAGE(PG8_SA(0, 1), cA, voc[1]);
    if (wr == 1) PG8_BAR;
    PG8_WAIT_V(2); PG8_BAR;
    PG8_STAGE(PG8_SB(1, 0), cB + kstep, voffB); PG8_STAGE(PG8_SA(1, 0), cA + kstep, voc[0]); PG8_STAGE(PG8_SB(1, 1), cB + hstep + kstep, voffB);
    PG8_WAIT_V(6); PG8_BAR;
    for (;;) {
        const bool has_next = S.next(ui + 1, nxt);
        const char* nA = has_next ? nxt.a : cA; const char* nB = has_next ? nxt.b : cB;
        if (has_next) S.aoff(nxt, von);
        else {
#pragma unroll
            for (int h = 0; h < 2; ++h)
#pragma unroll
                for (int i = 0; i < 2; ++i) von[h][i] = voc[h][i]; }
        for (int t = 0; t < nt; t += 2) {
            if constexpr (Epi::MIDK > 0) { if (t == Epi::MIDK) E.midk(acc, cur, wr, wc, fr, fq); }
            const bool last = (t == nt - 2);
            const char* a1 = cA + (size_t)(t + 1) * kstep;
            const char* a2 = last ? nA : cA + (size_t)(t + 2) * kstep; const char* b2 = last ? nB : cB + (size_t)(t + 2) * kstep;
            const char* a3 = a2 + kstep; const char* b3 = b2 + kstep;
            unsigned v2[2][2];
#pragma unroll
            for (int h = 0; h < 2; ++h)
#pragma unroll
                for (int i = 0; i < 2; ++i) v2[h][i] = last ? von[h][i] : voc[h][i];
            PG8_LDB(B0, 0, 0); PG8_LDB(B1, 0, 1); PG8_SCHED; PG8_LDA(At, 0, 0); PG8_STAGE(PG8_SA(1, 1), a1, voc[1]);
            PG8_WAIT_V(8); PG8_WAIT_L(0); PG8_BAR; PG8_MMA(0, 0, At, B0); PG8_MMA(0, 1, At, B1); PG8_BAR; PG8_SCHED;
            PG8_LDA(At, 0, 1); PG8_STAGE(PG8_SB(0, 0), b2, voffB); PG8_STAGE(PG8_SB(0, 1), b2 + hstep, voffB); PG8_STAGE(PG8_SA(0, 0), a2, v2[0]);
            PG8_WAIT_V(8); PG8_WAIT_L(0); PG8_BAR; PG8_MMA(1, 0, At, B0); PG8_MMA(1, 1, At, B1); PG8_BAR; PG8_SCHED;
            PG8_LDB(B0, 1, 0); PG8_LDB(B1, 1, 1); PG8_SCHED; PG8_LDA(At, 1, 0); PG8_STAGE(PG8_SA(0, 1), a2, v2[1]);
            PG8_WAIT_V(8); PG8_WAIT_L(0); PG8_BAR; PG8_MMA(0, 0, At, B0); PG8_MMA(0, 1, At, B1); PG8_BAR; PG8_SCHED;
            PG8_LDA(At, 1, 1); PG8_STAGE(PG8_SB(1, 0), b3, voffB); PG8_STAGE(PG8_SB(1, 1), b3 + hstep, voffB); PG8_STAGE(PG8_SA(1, 0), a3, v2[0]);
            PG8_WAIT_V(8); PG8_WAIT_L(0); PG8_BAR; PG8_MMA(1, 0, At, B0); PG8_MMA(1, 1, At, B1); PG8_BAR; PG8_SCHED;
        }
        if constexpr (ALIGN_EPI) { if (wr == 0) PG8_BAR; }
        E(acc, cur, wr, wc, fr, fq);
        if (!has_next) break;
#pragma unroll
        for (int a = 0; a < 2; ++a)
#pragma unroll
            for (int b = 0; b < 2; ++b)
#pragma unroll
                for (int m = 0; m < 4; ++m)
#pragma unroll
                    for (int n = 0; n < 2; ++n) acc[a][b][m][n] = (f32x4){0.f, 0.f, 0.f, 0.f};
        cur = nxt; cA = nA; cB = nB; ++ui;
#pragma unroll
        for (int h = 0; h < 2; ++h)
#pragma unroll
            for (int i = 0; i < 2; ++i) voc[h][i] = von[h][i];
        if constexpr (ALIGN_EPI) { if (wr == 1) PG8_BAR; }
    }
    PG8_WAIT_V(0);
    if constexpr (!ALIGN_EPI) { if (wr == 0) PG8_BAR; }
    PG8_BAR;
#undef PG8_SA
#undef PG8_SB
#undef PG8_STAGE
#undef PG8_LDA
#undef PG8_LDB
#undef PG8_MMA
#undef PG8_WAIT_V
#undef PG8_WAIT_L
#undef PG8_BAR
#undef PG8_SCHED
}
}

struct EpiProj {
    static constexpr int MIDK = 0;
    f16* PJ; const float* cosT; const float* sinT;
    DI void midk(f32x4 (&)[2][2][4][2], const pg8::Unit&, int, int, int, int) const {}
    DI void operator()(const f32x4 (&acc)[2][2][4][2], const pg8::Unit& u, int wr, int wc, int fr, int fq) const {
        const int pn = u.i1, row0 = u.i0 * 256 + wr * 64 + fr;
        if (pn < 6 || pn > 9) {
            const int col0 = pn * 256 + wc * 32 + 8 * fq;
#pragma unroll
            for (int ai = 0; ai < 2; ++ai)
#pragma unroll
                for (int m = 0; m < 4; ++m) { f16* rowp = PJ + (size_t)(row0 + ai * 128 + m * 16) * NPJ + col0;
#pragma unroll
                    for (int bj = 0; bj < 2; ++bj) *(h8*)(rowp + bj * 128) = cvt8(acc[ai][bj][m][0], acc[ai][bj][m][1]); }
        } else {
            const float sc = (pn >= 8) ? 0.08838834764831845f : 1.0f;
            const int i0 = 32 * (wc & 1) + 8 * fq;
            const int lcol = pn * 256 + (wc >> 1) * 128 + i0;
#pragma unroll
            for (int ai = 0; ai < 2; ++ai)
#pragma unroll
                for (int m = 0; m < 4; ++m) { const int row = row0 + ai * 128 + m * 16; const int pos = row & (SEQ - 1);
                    const f32x4 c0 = *(const f32x4*)(cosT + pos * 64 + i0) * sc, c1 = *(const f32x4*)(cosT + pos * 64 + i0 + 4) * sc;
                    const f32x4 s0 = *(const f32x4*)(sinT + pos * 64 + i0) * sc, s1 = *(const f32x4*)(sinT + pos * 64 + i0 + 4) * sc;
                    const f32x4 x10 = acc[ai][0][m][0], x11 = acc[ai][0][m][1], x20 = acc[ai][1][m][0], x21 = acc[ai][1][m][1];
                    f16* rowp = PJ + (size_t)row * NPJ + lcol;
                    *(h8*)(rowp) = cvt8(x10 * c0 - x20 * s0, x11 * c1 - x21 * s1);
                    *(h8*)(rowp + 64) = cvt8(x10 * s0 + x20 * c0, x11 * s1 + x21 * c1); }
        }
    }
};
struct EpiZ {
    static constexpr int MIDK = 8;
    const float* x; f16* z; const float* sumsq;
    DI void midk(f32x4 (&acc)[2][2][4][2], const pg8::Unit& u, int wr, int wc, int fr, int fq) const {
#pragma unroll
        for (int ai = 0; ai < 2; ++ai)
#pragma unroll
            for (int m = 0; m < 4; ++m) { const int row = u.i0 * 256 + ai * 128 + wr * 64 + m * 16 + fr;
                const f32x4 s0 = *(const f32x4*)(sumsq + (size_t)row * 8), s1 = *(const f32x4*)(sumsq + (size_t)row * 8 + 4);
                const float ss = ((s0[0] + s0[1]) + (s0[2] + s0[3])) + ((s1[0] + s1[1]) + (s1[2] + s1[3]));
                const float rinv = 1.0f / sqrtf(ss * (1.0f / 512.0f) + LN_EPS);
#pragma unroll
                for (int bj = 0; bj < 2; ++bj)
#pragma unroll
                    for (int n = 0; n < 2; ++n) acc[ai][bj][m][n] *= rinv; }
    }
    DI void operator()(const f32x4 (&acc)[2][2][4][2], const pg8::Unit& u, int wr, int wc, int fr, int fq) const {
        const int row0 = u.i0 * 256 + wr * 64 + fr, col0 = u.i1 * 256 + wc * 32 + 8 * fq;
#pragma unroll
        for (int ai = 0; ai < 2; ++ai)
#pragma unroll
            for (int m = 0; m < 4; ++m) { const size_t off = (size_t)(row0 + ai * 128 + m * 16) * DM + col0;
#pragma unroll
                for (int bj = 0; bj < 2; ++bj) {
                    const f32x4 x0 = *(const f32x4*)(x + off + bj * 128), x1 = *(const f32x4*)(x + off + bj * 128 + 4);
                    *(h8*)(z + off + bj * 128) = cvt8(x0 * ALPHA + acc[ai][bj][m][0], x1 * ALPHA + acc[ai][bj][m][1]); } }
    }
};
struct MoeSched {
    LAS const int* tab; const int* elist; const char* A; const char* Bt; size_t b_expert_bytes; int lda, ldb, G, c; bool gather;
    DI bool next(int i, pg8::Unit& u) const {
        const int MT = tab[64]; const int wpx = G >> 3, xcd = c & 7, w = c >> 3;
        const int q = w + wpx * i, g = (q >> 2) * 8 + xcd, nt = q & 3;
        if (g >= MT) return false;
        int e = 0;
#pragma unroll 1
        for (int k = 1; k < 32; ++k) e += (tab[32 + k] <= g) ? 1 : 0;
        u.i0 = g; u.i1 = nt; u.i2 = e; u.i3 = g - tab[32 + e];
        u.a = gather ? A : A + (size_t)g * 256 * lda * 2;
        u.b = Bt + (size_t)e * b_expert_bytes + (size_t)nt * 256 * ldb * 2; return true;
    }
    DI void aoff(const pg8::Unit& u, unsigned (&vo)[2][2]) const {
        const int cnt = tab[u.i2];
#pragma unroll
        for (int i = 0; i < 2; ++i) { int R, C; pg8::stage_rc((int)threadIdx.x * 16 + i * 8192, R, C);
#pragma unroll
            for (int h = 0; h < 2; ++h) {
                if (gather) { int idx = u.i3 * 256 + h * 128 + R; idx = idx < cnt ? idx : 0; const int tok = elist[u.i2 * NTOK + idx] >> 1; vo[h][i] = (unsigned)(tok * lda + C) * 2u; }
                else vo[h][i] = (unsigned)((h * 128 + R) * lda + C) * 2u; } }
    }
};
struct EpiGU {
    static constexpr int MIDK = 0;
    f16* hid;
    DI void midk(f32x4 (&)[2][2][4][2], const pg8::Unit&, int, int, int, int) const {}
    DI void operator()(const f32x4 (&acc)[2][2][4][2], const pg8::Unit& u, int wr, int wc, int fr, int fq) const {
        const int row0 = u.i0 * 256 + wr * 64 + fr, col0 = u.i1 * 128 + wc * 32 + 8 * fq;
#pragma unroll
        for (int ai = 0; ai < 2; ++ai)
#pragma unroll
            for (int m = 0; m < 4; ++m) { f32x4 o[2];
#pragma unroll
                for (int n = 0; n < 2; ++n) { const f32x4 g = acc[ai][0][m][n], up = acc[ai][1][m][n];
#pragma unroll
                    for (int e = 0; e < 4; ++e) o[n][e] = g[e] * up[e] / (1.0f + fexp2(-g[e] * LOG2E)); }
                *(h8*)(hid + (size_t)(row0 + ai * 128 + m * 16) * DE + col0) = cvt8(o[0], o[1]); }
    }
};
struct EpiDown {
    static constexpr int MIDK = 0;
    f16* y; const int* elist; const float* wts; LAS const int* tab;
    DI void midk(f32x4 (&)[2][2][4][2], const pg8::Unit&, int, int, int, int) const {}
    DI void operator()(const f32x4 (&acc)[2][2][4][2], const pg8::Unit& u, int wr, int wc, int fr, int fq) const {
        const int cnt = tab[u.i2], col0 = u.i1 * 256 + wc * 32 + 8 * fq;
#pragma unroll
        for (int ai = 0; ai < 2; ++ai)
#pragma unroll
            for (int m = 0; m < 4; ++m) { const int idx = u.i3 * 256 + ai * 128 + wr * 64 + m * 16 + fr;
                if (idx < cnt) { const int ent = elist[u.i2 * NTOK + idx]; const float w = wts[ent]; f16* rowp = y + (size_t)ent * DM + col0;
#pragma unroll
                    for (int bj = 0; bj < 2; ++bj) *(h8*)(rowp + bj * 128) = cvt8(acc[ai][bj][m][0] * w, acc[ai][bj][m][1] * w); } }
    }
};

DI void tr_item(const float* W, int ldw, int k0, int nsrc0, f16* WT, int ldt, int prow0, const float* ks, LAS float* scr, int lane) {
#pragma unroll 8
    for (int i = 0; i < 32; ++i) { const int kk = 2 * i + (lane >> 5); float v = W[(size_t)(k0 + kk) * ldw + nsrc0 + (lane & 31)]; if (ks) v *= ks[k0 + kk]; scr[kk * 33 + (lane & 31)] = v; }
    LDS_WAIT(); asm volatile("" ::: "memory");
    const int c = lane & 7;
#pragma unroll
    for (int j = 0; j < 4; ++j) { const int n = (lane >> 3) + 8 * j; const LAS float* s = scr + (8 * c) * 33 + n;
        h8 o; o[0] = (f16)s[0]; o[1] = (f16)s[33]; o[2] = (f16)s[66]; o[3] = (f16)s[99]; o[4] = (f16)s[132]; o[5] = (f16)s[165]; o[6] = (f16)s[198]; o[7] = (f16)s[231];
        *(h8*)(WT + (size_t)(prow0 + n) * ldt + k0 + 8 * c) = o; }
    LDS_WAIT(); asm volatile("" ::: "memory");
}

constexpr int KP64 = 144, VP64 = 192;
template <bool OWN>
DI void attn_tile(LAS const unsigned char* Kl, LAS const unsigned char* Vl, LAS const float* biasd, const h8 (&qf)[4], int rel, int w, int lane, float& m2, float& lsum, f32x16 (&o)[2]) {
    const int r = lane & 31, hp = lane >> 5;
    f32x16 st[8];
    const float b31 = biasd[31 + 160];
    float mx = -3.0e38f;
#pragma unroll
    for (int kt = 0; kt < 8; ++kt) {
        if (!OWN || kt <= w) {
            f32x16 a;
#pragma unroll
            for (int i = 0; i < 16; ++i) a[i] = 0.f;
#pragma unroll
            for (int ks = 0; ks < 4; ++ks) { const h8 kf = *(const LAS h8*)(Kl + (32 * kt + r) * KP64 + 32 * ks + 16 * hp); a = MFMA32(kf, qf[ks], a); }
            const bool far = __all(rel - (32 * kt + 31) >= 128) != 0;
            if (far) {
#pragma unroll
                for (int i = 0; i < 16; ++i) a[i] = a[i] * (0.125f * LOG2E) + b31;
            } else {
                int base = rel - 32 * kt - 4 * hp; base = base > 187 ? 187 : base;
                LAS const float* tp = biasd + (base + 4);
#pragma unroll
                for (int i = 0; i < 16; ++i) a[i] = a[i] * (0.125f * LOG2E) + tp[27 - ((i & 3) + 8 * (i >> 2))];
            }
#pragma unroll
            for (int i = 0; i < 16; ++i) mx = fmaxf(mx, a[i]);
            st[kt] = a;
        }
    }
    mx = fmaxf(mx, __shfl_xor(mx, 32));
    float ls = 0.f;
#pragma unroll
    for (int dt = 0; dt < 2; ++dt)
#pragma unroll
        for (int i = 0; i < 16; ++i) o[dt][i] = 0.f;
    const int i16 = lane & 15, q4 = i16 >> 2, p4 = i16 & 3, cb = (lane >> 4) & 1;
    LAS const unsigned char* vbase = Vl + (4 * hp + q4) * VP64 + 2 * (16 * cb + 4 * p4);
#pragma unroll
    for (int kt = 0; kt < 8; ++kt) {
        if (!OWN || kt <= w) {
            f32x16 p = st[kt];
#pragma unroll
            for (int i = 0; i < 16; ++i) { p[i] = fexp2(p[i] - mx); ls += p[i]; }
#pragma unroll
            for (int s = 0; s < 2; ++s) {
                const f32x8 pv = {p[8 * s], p[8 * s + 1], p[8 * s + 2], p[8 * s + 3], p[8 * s + 4], p[8 * s + 5], p[8 * s + 6], p[8 * s + 7]};
                const h8 pf = __builtin_convertvector(pv, h8);
#pragma unroll
                for (int dt = 0; dt < 2; ++dt) {
                    LAS const unsigned char* vp = vbase + (32 * kt + 16 * s) * VP64 + 64 * dt;
                    const h8 vf = cat44(tr_read(vp), tr_read(vp + 8 * VP64));
                    o[dt] = MFMA32(vf, pf, o[dt]);
                }
            }
        }
    }
    ls += __shfl_xor(ls, 32);
    m2 = mx; lsum = ls;
}
template <int P>
DI void stage64(LAS unsigned char* dst, const f16* src, int src_ld, int tid) {
#pragma unroll
    for (int i = 0; i < 4; ++i) { const int q = tid + 512 * i, row = q >> 3, ch = q & 7; *(LAS h8*)(dst + row * P + 16 * ch) = *(const h8*)(src + (size_t)row * src_ld + 8 * ch); }
}

DI void own_scores(LAS const unsigned char* Kl, LAS const float* biasd, const h8 (&qf)[4], int ql, int kt, int w, int r, int hp, f32x16& a) {
#pragma unroll
    for (int i = 0; i < 16; ++i) a[i] = 0.f;
#pragma unroll
    for (int ks = 0; ks < 4; ++ks) { const h8 kf = *(const LAS h8*)(Kl + (32 * kt + r) * KP64 + 32 * ks + 16 * hp); a = MFMA32(kf, qf[ks], a); }
    const int delta = w - kt;
    if (delta >= 5) {
        const float b31 = biasd[31 + 160];
#pragma unroll
        for (int i = 0; i < 16; ++i) a[i] = a[i] * (0.125f * LOG2E) + b31;
    } else {
        const int base = ql - 32 * kt - 4 * hp;
        LAS const float* tp = biasd + (base + 4);
        if (delta == 0) {
#pragma unroll
            for (int i = 0; i < 16; ++i) { const int ci = (i & 3) + 8 * (i >> 2); const float v = a[i] * (0.125f * LOG2E) + tp[27 - ci]; a[i] = (base - ci < 0) ? -3.0e38f : v; }
        } else {
#pragma unroll
            for (int i = 0; i < 16; ++i) a[i] = a[i] * (0.125f * LOG2E) + tp[27 - ((i & 3) + 8 * (i >> 2))];
        }
    }
}
DI void attn_own(LAS const unsigned char* Kl, LAS const unsigned char* Vl, LAS const float* biasd, const h8 (&qf)[4], int ql, int w, int lane, float& m2, float& lsum, f32x16 (&o)[2]) {
    const int r = lane & 31, hp = lane >> 5;
    float mx = -3.0e38f;
#pragma unroll 1
    for (int kt = 0; kt <= w; ++kt) { f32x16 a; own_scores(Kl, biasd, qf, ql, kt, w, r, hp, a);
#pragma unroll
        for (int i = 0; i < 16; ++i) mx = fmaxf(mx, a[i]); }
    mx = fmaxf(mx, __shfl_xor(mx, 32));
    float ls = 0.f;
#pragma unroll
    for (int dt = 0; dt < 2; ++dt)
#pragma unroll
        for (int i = 0; i < 16; ++i) o[dt][i] = 0.f;
    const int i16 = lane & 15, q4 = i16 >> 2, p4 = i16 & 3, cb = (lane >> 4) & 1;
    LAS const unsigned char* vbase = Vl + (4 * hp + q4) * VP64 + 2 * (16 * cb + 4 * p4);
#pragma unroll 1
    for (int kt = 0; kt <= w; ++kt) {
        f32x16 p; own_scores(Kl, biasd, qf, ql, kt, w, r, hp, p);
#pragma unroll
        for (int i = 0; i < 16; ++i) { p[i] = fexp2(p[i] - mx); ls += p[i]; }
#pragma unroll
        for (int s = 0; s < 2; ++s) {
            const f32x8 pv = {p[8 * s], p[8 * s + 1], p[8 * s + 2], p[8 * s + 3], p[8 * s + 4], p[8 * s + 5], p[8 * s + 6], p[8 * s + 7]};
            const h8 pf = __builtin_convertvector(pv, h8);
#pragma unroll
            for (int dt = 0; dt < 2; ++dt) {
                LAS const unsigned char* vp = vbase + (32 * kt + 16 * s) * VP64 + 64 * dt;
                const h8 vf = cat44(tr_read(vp), tr_read(vp + 8 * VP64));
                o[dt] = MFMA32(vf, pf, o[dt]);
            }
        }
    }
    ls += __shfl_xor(ls, 32);
    m2 = mx; lsum = ls;
}
__global__ void __launch_bounds__(512, 2) fwd(Args a) {
    extern __shared__ __attribute__((aligned(16))) unsigned char smem[];
    LAS unsigned char* lds = (LAS unsigned char*)smem;
    volatile LAS unsigned* MISC = (volatile LAS unsigned*)(lds + MISC_OFF);
    LAS float* biasl = (LAS float*)(lds + BIAS_OFF);
    const int tid = threadIdx.x, lane = tid & 63, wave = __builtin_amdgcn_readfirstlane(tid >> 6);
    const int G = gridDim.x, bid = blockIdx.x;
    unsigned char* ws = a.ws;
    unsigned* ctl = (unsigned*)(ws + WS_CTL);
    float* ropeC = (float*)(ws + WS_ROPEC); float* ropeS = (float*)(ws + WS_ROPES); float* xsum = (float*)(ws + WS_XSUM);
    f16* kmean = (f16*)(ws + WS_KMEAN); f16* WrT = (f16*)(ws + WS_WRT); float* sumsq = (float*)(ws + WS_SUMSQ); float* wts = (float*)(ws + WS_WTS);
    int* elist = (int*)(ws + WS_ELIST); unsigned short* mlist = (unsigned short*)(ws + WS_MLIST); f32x2* pml = (f32x2*)(ws + WS_PML);
    f16* WinT = (f16*)(ws + WS_WINT); f16* WoT = (f16*)(ws + WS_WOT); f16* WguT = (f16*)(ws + WS_WGUT); f16* WdnT = (f16*)(ws + WS_WDNT);
    f16* PJ = (f16*)(ws + WS_PJ); f16* xh = (f16*)(ws + WS_XH); f16* cat = (f16*)(ws + WS_CAT); float* kvbuf = (float*)(ws + WS_KV); f16* Rbuf = (f16*)(ws + WS_R);
    f16* hh = (f16*)(ws + WS_HH); f16* hid = (f16*)(ws + WS_HID); f16* ybuf = (f16*)(ws + WS_Y);
    f16* pO = (f16*)a.out;
    f16* zbuf = (f16*)a.out;
    unsigned* lcnt = ctl + CW_LCNT; unsigned* ecnt = ctl + CW_ECNT;

    if (tid < 64) MISC[tid] = 0u;
    for (int idx = tid; idx < 8 * BTP; idx += 512) { const int h = idx / BTP, d = idx % BTP - 31, dd = d > 128 ? 128 : d; biasl[idx] = d < 0 ? 0.f : a.rel[(int)T5_BUCKET[dd] * 8 + h] * LOG2E; }
    __syncthreads();
    const int lo = a.ph_lo, hi = a.ph_hi;
    XcdBarrier bar; bar.bar = ctl + CW_BAR; bar.x = 0; bar.st = MISC + 8;
    if (hi - lo > 1) bar = xcd_barrier_post(ctl + CW_BAR, MISC + 8);
#ifndef PH_MASK
#define PH_MASK 0x3ff
#endif
#define IN(k) ((((PH_MASK) >> (k)) & 1) && lo <= (k) && (k) < hi)
#ifndef DUP_PHASE
#define DUP_PHASE -1
#endif
#define REP(k) for (int rep_ = 0; rep_ < ((DUP_PHASE) == (k) ? 2 : 1); ++rep_)
#ifdef DIAG_PHASE
#ifndef DIAG_MODE
#define DIAG_MODE 0
#endif
    unsigned long long tdiag0 = 0ull;
#define DIAG_T0(k) do { if ((k) == DIAG_PHASE) tdiag0 = __builtin_amdgcn_s_memrealtime(); } while (0)
#define DIAG_T1(k, mode) do { if ((k) == DIAG_PHASE && (mode) == DIAG_MODE && bid == 0 && tid == 0) __hip_atomic_store(ctl + 24576, (unsigned)(__builtin_amdgcn_s_memrealtime() - tdiag0), __ATOMIC_RELAXED, __HIP_MEMORY_SCOPE_AGENT); } while (0)
#else
#define DIAG_T0(k) do { } while (0)
#define DIAG_T1(k, mode) do { } while (0)
#endif
#define SEAM(k) do { DIAG_T1(k, 1); if (IN(k) && IN((k) + 1)) xcd_barrier(bar); DIAG_T1(k, 0); DIAG_T0((k) + 1); } while (0)

    DIAG_T0(0);
    if (IN(0)) REP(0) {
        for (int hb = bid; hb < 256; hb += G) {
            const int c4 = tid & 255, rp = tid >> 8;
            const float* src = a.x + (size_t)hb * 128 * DM + c4 * 4; f16* dst = xh + (size_t)hb * 128 * DM + c4 * 4;
            f32x4 s = {0.f, 0.f, 0.f, 0.f};
#pragma unroll 8
            for (int r = rp; r < 128; r += 2) { const f32x4 v = *(const f32x4*)(src + (size_t)r * DM); s += v; *(h4*)(dst + (size_t)r * DM) = __builtin_convertvector(v, h4); }
            LAS f32x4* red = (LAS f32x4*)lds;
            if (rp == 1) red[c4] = s;
            __syncthreads();
            if (rp == 0) { s += red[c4]; *(f32x4*)(xsum + (size_t)hb * DM + c4 * 4) = s; }
            __syncthreads();
        }
        for (int idx = bid * 512 + tid; idx < SEQ * 64; idx += G * 512) {
            const int pos = idx >> 6, i = idx & 63;
            const float ang = (float)pos * ROPE_INV[i];
            const double xd = (double)ang, kd = __builtin_rint(xd * 0.6366197723675814);
            double rr = __builtin_fma(-kd, 1.5707963267948966, xd); rr = __builtin_fma(-kd, 6.123233995736766e-17, rr);
            const double r2 = rr * rr;
            const double sp = rr * (1.0 + r2 * (-1.0 / 6 + r2 * (1.0 / 120 + r2 * (-1.0 / 5040 + r2 * (1.0 / 362880 + r2 * (-1.0 / 39916800 + r2 * (1.0 / 6227020800.0)))))));
            const double cp = 1.0 + r2 * (-0.5 + r2 * (1.0 / 24 + r2 * (-1.0 / 720 + r2 * (1.0 / 40320 + r2 * (-1.0 / 3628800 + r2 * (1.0 / 479001600.0 + r2 * (-1.0 / 87178291200.0)))))));
            const int q = (int)kd & 3;
            const double sv = (q == 0) ? sp : (q == 1) ? cp : (q == 2) ? -sp : -cp;
            const double cv = (q == 0) ? cp : (q == 1) ? -sp : (q == 2) ? -cp : sp;
            ropeC[idx] = (float)cv; ropeS[idx] = (float)sv;
        }
        for (int idx = bid * 512 + tid; idx < 48 * DM; idx += G * 512) {
            const int n = idx >> 10, k = idx & 1023;
            const float v = (n < 4) ? a.wrg[k * 4 + n] : (n < 36) ? a.wre[k * 32 + (n - 4)] : 0.f;
            WrT[idx] = (f16)v;
        }
        {
            LAS float* scr = (LAS float*)(lds + wave * 16384);
            constexpr int I_IN = 16 * 112, I_O = 16 * 32, I_GU = 32 * 512, I_DN = 32 * 256, NIT = I_IN + I_O + I_GU + I_DN;
            for (int it = bid * 8 + wave; it < NIT; it += G * 8) {
                int r = it;
                if (r < I_IN) { const int kb = r / 112, nb = r % 112, pn = nb >> 3, g = nb & 7;
                    const int nsrc = (pn >= 6 && pn <= 9) ? pn * 256 + 128 * ((g >> 1) & 1) + 64 * (g >> 2) + 32 * (g & 1) : 32 * nb;
                    tr_item(a.w_in, NPJ, 64 * kb, nsrc, WinT, DM, 32 * nb, nullptr, scr, lane); continue; } r -= I_IN;
                if (r < I_O) { const int kb = r / 32, nb = r % 32; tr_item(a.w_out, DM, 64 * kb, 32 * nb, WoT, DM, 32 * nb, kb < 8 ? a.gain : nullptr, scr, lane); continue; } r -= I_O;
                if (r < I_GU) { const int e = r >> 9, rr = r & 511, kb = rr >> 5, nb = rr & 31, pn = nb >> 3, g = nb & 7;
                    const int nsrc = (g >> 2) * 512 + 128 * pn + 32 * (g & 3);
                    tr_item(a.wgu + (size_t)e * DM * DM, DM, 64 * kb, nsrc, WguT + (size_t)e * DM * DM, DM, 32 * nb, nullptr, scr, lane); continue; } r -= I_GU;
                { const int e = r >> 8, rr = r & 255, kb = rr >> 5, nb = rr & 31;
                    tr_item(a.wdn + (size_t)e * DE * DM, DM, 64 * kb, 32 * nb, WdnT + (size_t)e * DM * DE, DE, 32 * nb, nullptr, scr, lane); }
            }
        }
        __syncthreads();
    }
    SEAM(0);

    if (IN(1)) {
        REP(11) for (int job = bid; job < 256; job += G) {
            const int blk = job >> 1, ch = job & 1;
            LAS float* xm = (LAS float*)lds;
            for (int k = tid; k < DM; k += 512) xm[k] = (xsum[(size_t)(2 * blk) * DM + k] + xsum[(size_t)(2 * blk + 1) * DM + k]) * (1.0f / 256.0f);
            __syncthreads();
            const int col = tid & 255, kh = tid >> 8;
            const float* wp = a.w_in + (size_t)(kh * 512) * NPJ + C_AK + ch * 256 + col;
            float acc = 0.f;
#pragma unroll 8
            for (int k = 0; k < 512; ++k) acc += xm[kh * 512 + k] * wp[(size_t)k * NPJ];
            LAS float* red = xm + 1024;
            if (kh) red[col] = acc;
            __syncthreads();
            if (!kh) { acc += red[col]; const int c = ch * 256 + col, h = c >> 6, d = c & 63, b = blk >> 6, j = blk & 63; kmean[((size_t)(b * 8 + h) * 64 + j) * 64 + d] = (f16)acc; }
            __syncthreads();
        }
        pg8::StaticOrder S; S.init(xh, WinT, DM, DM, NTOK, NPJ, G, bid);
        EpiProj E{PJ, ropeC, ropeS};
        pg8::gemm_phase<EpiProj, pg8::StaticOrder, true>(lds, DM, DM / 64, S, E);
        if (DUP_PHASE == 1) pg8::gemm_phase<EpiProj, pg8::StaticOrder, true>(lds, DM, DM / 64, S, E);
    }
    SEAM(1);

    if (IN(2)) REP(2) {
        constexpr int NU_G = 16 * 63, NU_KV = 8 * 64;
        unsigned* lcnt_w = (rep_ | a.alt) ? ctl + 16384 : lcnt; unsigned short* mlist_w = (rep_ | a.alt) ? (unsigned short*)(ws + 480 * MiB) : mlist;
        for (int u = bid; u < NU_G + NU_KV; u += G) {
            if (u < NU_KV) {
                const int bh = u >> 6, ci = u & 63, b = bh >> 2, h = bh & 3;
                const float lg = gamma_log2(h);
                const f16* kp = PJ + (size_t)(b * SEQ + ci * 256) * NPJ + C_RK + h * 128;
                const f16* vp = PJ + (size_t)(b * SEQ + ci * 256) * NPJ + C_RV + h * 128;
                LAS unsigned char* Kl = lds; LAS unsigned char* Vl = lds + 128 * 320;
                const int dvt = wave & 3, dk0 = 2 * (wave >> 2);
                f32x16 acc[2];
#pragma unroll
                for (int t = 0; t < 2; ++t)
#pragma unroll
                    for (int i = 0; i < 16; ++i) acc[t][i] = 0.f;
                const int r = lane & 31, hp = lane >> 5, i16 = lane & 15, q4 = i16 >> 2, p4 = i16 & 3, cb = (lane >> 4) & 1;
                for (int half = 0; half < 2; ++half) {
#pragma unroll
                    for (int i = 0; i < 4; ++i) { const int q = tid + 512 * i, row = q >> 4, ch = q & 15; const int key = half * 128 + row;
                        const h8 kv = *(const h8*)(kp + (size_t)key * NPJ + 8 * ch); const float sc = fexp2(lg * (float)(255 - key));
                        const f32x8 kf = __builtin_convertvector(kv, f32x8) * sc;
                        *(LAS h8*)(Kl + row * 320 + 16 * ch) = __builtin_convertvector(kf, h8);
                        *(LAS h8*)(Vl + row * 320 + 16 * ch) = *(const h8*)(vp + (size_t)key * NPJ + 8 * ch); }
                    __syncthreads();
#pragma unroll
                    for (int s = 0; s < 8; ++s) {
                        LAS const unsigned char* ap = Vl + (16 * s + 8 * hp + q4) * 320 + 2 * (32 * dvt + 16 * cb + 4 * p4);
                        const h8 af = cat44(tr_read(ap), tr_read(ap + 4 * 320));
#pragma unroll
                        for (int t = 0; t < 2; ++t) {
                            LAS const unsigned char* bp = Kl + (16 * s + 8 * hp + q4) * 320 + 2 * (32 * (dk0 + t) + 16 * cb + 4 * p4);
                            const h8 bf = cat44(tr_read(bp), tr_read(bp + 4 * 320));
                            acc[t] = MFMA32(af, bf, acc[t]);
                        }
                    }
                    __syncthreads();
                }
                float* dst = kvbuf + (size_t)u * 128 * 128;
#pragma unroll
                for (int t = 0; t < 2; ++t)
#pragma unroll
                    for (int i = 0; i < 16; ++i) dst[(32 * dvt + crow(i, hp)) * 128 + 32 * (dk0 + t) + r] = acc[t][i];
            } else {
                const int uu = u - NU_KV, bh = uu / 63, c = 1 + uu % 63, b = bh >> 3, h = bh & 7;
                const int r = lane & 31, hp = lane >> 5;
                const int s = 256 * c + 32 * wave + r;
                const f16* qrow = PJ + (size_t)(b * SEQ + s) * NPJ + C_AQ + h * 64;
                h8 qf[4];
#pragma unroll
                for (int ks = 0; ks < 4; ++ks) qf[ks] = *(const h8*)(qrow + 16 * ks + 8 * hp);
                const f16* km = kmean + (size_t)bh * 64 * 64;
                float v[2][16];
#pragma unroll
                for (int t = 0; t < 2; ++t) {
                    f32x16 g;
#pragma unroll
                    for (int i = 0; i < 16; ++i) g[i] = 0.f;
                    if (t == 0 || c > 32) {
#pragma unroll
                        for (int ks = 0; ks < 4; ++ks) { const h8 kf = *(const h8*)(km + (32 * t + r) * 64 + 16 * ks + 8 * hp); g = MFMA32(kf, qf[ks], g); }
                    }
#pragma unroll
                    for (int i = 0; i < 16; ++i) v[t][i] = (32 * t + crow(i, hp) < c) ? g[i] : -3.0e38f;
                }
                int sel[3]; bool sval[3];
#pragma unroll
                for (int rd = 0; rd < 3; ++rd) {
                    float mv = -3.0e38f; int mi = 1 << 20;
#pragma unroll
                    for (int t = 0; t < 2; ++t)
#pragma unroll
                        for (int i = 0; i < 16; ++i) { const int idx = 32 * t + crow(i, hp); const float val = v[t][i]; if (val > mv || (val == mv && idx < mi)) { mv = val; mi = idx; } }
                    const float ov = __shfl_xor(mv, 32); const int oi = __shfl_xor(mi, 32);
                    if (ov > mv || (ov == mv && oi < mi)) { mv = ov; mi = oi; }
                    sel[rd] = mi; sval[rd] = mv > -1.0e38f;
#pragma unroll
                    for (int t = 0; t < 2; ++t)
#pragma unroll
                        for (int i = 0; i < 16; ++i) if (32 * t + crow(i, hp) == mi) v[t][i] = -3.0e38f;
                }
                LAS unsigned* hist = (LAS unsigned*)(lds + 96 * 1024);
                if (tid < 64) hist[tid] = 0u;
                __syncthreads();
                unsigned rank[3];
#pragma unroll
                for (int rd = 0; rd < 3; ++rd) { rank[rd] = 0u; if (sval[rd] && hp == 0) rank[rd] = __hip_atomic_fetch_add(hist + sel[rd], 1u, __ATOMIC_RELAXED, __HIP_MEMORY_SCOPE_WORKGROUP); }
                __syncthreads();
                if (tid < 64) { const unsigned n = hist[tid]; unsigned base = 0u; if (n) base = atomicAdd(lcnt_w + bh * 64 + tid, n); hist[64 + tid] = base; }
                __syncthreads();
#pragma unroll
                for (int rd = 0; rd < 3; ++rd) if (sval[rd] && hp == 0) { const int lb = sel[rd]; const unsigned pos = hist[64 + lb] + rank[rd];
                    mlist_w[(size_t)bh * MLIST_PER_BH + (size_t)lb * SEQ - 128 * lb * (lb + 1) + pos] = (unsigned short)((s << 2) | rd); }
            }
        }
    }
    SEAM(2);

    if (IN(3)) REP(3) {
        for (int gid = bid * 512 + tid; gid < 8 * 16384; gid += G * 512) {
            const int bh = gid >> 14, e = gid & 16383, h = bh & 3;
            const float cd = fexp2(256.0f * gamma_log2(h));
            const float* src = kvbuf + (size_t)bh * 64 * 16384 + e; f16* dst = Rbuf + (size_t)bh * 64 * 16384 + e;
            float run = 0.f;
#pragma unroll 8
            for (int i = 0; i < 64; ++i) { dst[(size_t)i * 16384] = (f16)run; run = run * cd + src[(size_t)i * 16384]; }
        }
        LAS int* pre = (LAS int*)(lds + 100 * 1024);
        LAS int* wsum = pre + 1032;
        {
            const int c0 = (int)lcnt[2 * tid], c1 = (int)lcnt[2 * tid + 1];
            const int n0 = (c0 + 255) >> 8, n1 = (c1 + 255) >> 8;
            int v = n0 + n1, incl = v;
#pragma unroll
            for (int o = 1; o < 64; o <<= 1) { const int t = __shfl_up(incl, o); if (lane >= o) incl += t; }
            if (lane == 63) wsum[wave] = incl;
            __syncthreads();
            int woff = 0;
            for (int k = 0; k < wave; ++k) woff += wsum[k];
            const int ex = woff + incl - v;
            pre[2 * tid] = ex; pre[2 * tid + 1] = ex + n0;
            if (tid == 511) pre[1024] = ex + v;
            __syncthreads();
        }
        const int U = pre[1024];
        const int u_lo = (int)(((long)U * bid) / G), u_hi = (int)(((long)U * (bid + 1)) / G);
        LAS unsigned char* Kl = lds; LAS unsigned char* Vl = lds + 256 * KP64;
        constexpr int NUB = 32;
        LAS int* uinf = (LAS int*)(lds + 108 * 1024);
        LAS unsigned short* uent = (LAS unsigned short*)(lds + 112 * 1024);
        int staged = -1;
        const int r = lane & 31, hp = lane >> 5;
        for (int ub = u_lo; ub < u_hi; ub += NUB) {
            const int nu = (u_hi - ub) < NUB ? (u_hi - ub) : NUB;
            __syncthreads();
            if (tid < nu) { const int u = ub + tid; int l = 0;
#pragma unroll 1
                for (int step = 512; step > 0; step >>= 1) if (l + step <= 1023 && pre[l + step] <= u) l += step;
                const int chunk = u - pre[l]; int rows = (int)lcnt[l] - 256 * chunk; rows = rows > 256 ? 256 : rows;
                uinf[4 * tid] = l; uinf[4 * tid + 1] = chunk; uinf[4 * tid + 2] = rows; }
            __syncthreads();
            for (int i = tid >> 8; i < nu; i += 2) { const int l = uinf[4 * i], chunk = uinf[4 * i + 1], rows = uinf[4 * i + 2], ri = tid & 255, bh = l >> 6, j = l & 63;
                uent[i * 256 + ri] = mlist[(size_t)bh * MLIST_PER_BH + (size_t)j * SEQ - 128 * j * (j + 1) + 256 * chunk + (ri < rows ? ri : 0)]; }
            __syncthreads();
            h8 qn[4];
            { const int l = uinf[0], bh = l >> 6; const unsigned ent = uent[32 * wave + r]; const int s = (int)(ent >> 2);
              const f16* qrow = PJ + (size_t)((bh >> 3) * SEQ + s) * NPJ + C_AQ + (bh & 7) * 64;
#pragma unroll
              for (int ks = 0; ks < 4; ++ks) qn[ks] = *(const h8*)(qrow + 16 * ks + 8 * hp); }
            for (int i = 0; i < nu; ++i) {
                const int l = uinf[4 * i], rows = uinf[4 * i + 2], bh = l >> 6, j = l & 63, b = bh >> 3, h = bh & 7;
                const unsigned ent = uent[i * 256 + 32 * wave + r];
                h8 qf[4];
#pragma unroll
                for (int ks = 0; ks < 4; ++ks) qf[ks] = qn[ks];
                if (i + 1 < nu) { const int l2 = uinf[4 * (i + 1)], bh2 = l2 >> 6; const unsigned e2 = uent[(i + 1) * 256 + 32 * wave + r]; const int s2 = (int)(e2 >> 2);
                    const f16* qrow = PJ + (size_t)((bh2 >> 3) * SEQ + s2) * NPJ + C_AQ + (bh2 & 7) * 64;
#pragma unroll
                    for (int ks = 0; ks < 4; ++ks) qn[ks] = *(const h8*)(qrow + 16 * ks + 8 * hp); }
                if (l != staged) {
                    __syncthreads();
                    stage64<KP64>(Kl, PJ + (size_t)(b * SEQ + j * 256) * NPJ + C_AK + h * 64, NPJ, tid);
                    stage64<VP64>(Vl, PJ + (size_t)(b * SEQ + j * 256) * NPJ + C_AV + h * 64, NPJ, tid);
                    __syncthreads();
                    staged = l;
                }
                if (32 * wave < rows) {
                    const bool valid = 32 * wave + r < rows;
                    const int s = (int)(ent >> 2), slot = (int)(ent & 3u);
                    float m2, ls; f32x16 o[2];
                    attn_tile<false>(Kl, Vl, biasl + h * BTP, qf, s - 256 * j, 0, lane, m2, ls, o);
                    if (valid) {
                        const size_t pidx = ((size_t)bh * SEQ + s) * 3 + slot;
                        if (hp == 0) pml[pidx] = (f32x2){m2, ls};
                        const float inv = 1.0f / ls; f16* po = pO + pidx * 64;
#pragma unroll
                        for (int dt = 0; dt < 2; ++dt)
#pragma unroll
                            for (int g = 0; g < 4; ++g) { const f32x4 vv = {o[dt][4 * g] * inv, o[dt][4 * g + 1] * inv, o[dt][4 * g + 2] * inv, o[dt][4 * g + 3] * inv};
                                *(h4*)(po + 32 * dt + 8 * g + 4 * hp) = __builtin_convertvector(vv, h4); }
                    }
                }
            }
        }
        __syncthreads();
    }
    SEAM(3);

    if (IN(4)) REP(4) {
        constexpr int NU_A = 16 * 64, NU_R = 8 * 64;
        for (int u = bid; u < NU_R; u += G) {
            __syncthreads();
            {
                const int bh = u >> 6, ci = u & 63, b = bh >> 2, h = bh & 3;
                const float lg = gamma_log2(h);
                const size_t row0 = (size_t)b * SEQ + ci * 256;
                LAS unsigned char* Kl = lds; LAS unsigned char* Vl = lds + 256 * 272;
#pragma unroll
                for (int i = 0; i < 8; ++i) { const int q = tid + 512 * i, row = q >> 4, ch = q & 15;
                    *(LAS h8*)(Kl + row * 272 + 16 * ch) = *(const h8*)(PJ + (row0 + row) * NPJ + C_RK + h * 128 + 8 * ch);
                    *(LAS h8*)(Vl + row * 320 + 16 * ch) = *(const h8*)(PJ + (row0 + row) * NPJ + C_RV + h * 128 + 8 * ch); }
                __syncthreads();
                const int r = lane & 31, hp = lane >> 5, i16 = lane & 15, q4 = i16 >> 2, p4 = i16 & 3, cb = (lane >> 4) & 1;
                const int ql = 32 * wave + r;
                const f16* qrow = PJ + (row0 + ql) * NPJ + C_RQ + h * 128;
                h8 qf[8];
#pragma unroll
                for (int ks = 0; ks < 8; ++ks) qf[ks] = *(const h8*)(qrow + 16 * ks + 8 * hp);
                f32x16 o[4];
#pragma unroll
                for (int t = 0; t < 4; ++t)
#pragma unroll
                    for (int i = 0; i < 16; ++i) o[t][i] = 0.f;
                const f16* Rt = Rbuf + (size_t)u * 128 * 128;
#pragma unroll
                for (int t = 0; t < 4; ++t)
#pragma unroll
                    for (int ks = 0; ks < 8; ++ks) { const h8 rf = *(const h8*)(Rt + (32 * t + r) * 128 + 16 * ks + 8 * hp); o[t] = MFMA32(rf, qf[ks], o[t]); }
                const float qd = fexp2(lg * (float)(ql + 1));
#pragma unroll
                for (int t = 0; t < 4; ++t)
#pragma unroll
                    for (int i = 0; i < 16; ++i) o[t][i] *= qd;
                LAS const unsigned char* vbase = Vl + (4 * hp + q4) * 320 + 2 * (16 * cb + 4 * p4);
                for (int kt = 0; kt <= wave; ++kt) {
                    f32x16 st;
#pragma unroll
                    for (int i = 0; i < 16; ++i) st[i] = 0.f;
#pragma unroll
                    for (int ks = 0; ks < 8; ++ks) { const h8 kf = *(const LAS h8*)(Kl + (32 * kt + r) * 272 + 32 * ks + 16 * hp); st = MFMA32(kf, qf[ks], st); }
#pragma unroll
                    for (int i = 0; i < 16; ++i) { const int dist = ql - (32 * kt + crow(i, hp)); st[i] = dist >= 0 ? st[i] * fexp2(lg * (float)dist) : 0.f; }
#pragma unroll
                    for (int s = 0; s < 2; ++s) {
                        const f32x8 pv = {st[8 * s], st[8 * s + 1], st[8 * s + 2], st[8 * s + 3], st[8 * s + 4], st[8 * s + 5], st[8 * s + 6], st[8 * s + 7]};
                        const h8 pf = __builtin_convertvector(pv, h8);
#pragma unroll
                        for (int t = 0; t < 4; ++t) {
                            LAS const unsigned char* vp = vbase + (32 * kt + 16 * s) * 320 + 64 * t;
                            const h8 vf = cat44(tr_read(vp), tr_read(vp + 8 * 320));
                            o[t] = MFMA32(vf, pf, o[t]);
                        }
                    }
                }
                float sm = 0.f;
#pragma unroll
                for (int t = 0; t < 4; ++t)
#pragma unroll
                    for (int i = 0; i < 16; ++i) sm += o[t][i];
                sm += __shfl_xor(sm, 32);
                const float mu = sm * (1.0f / 128.0f);
                float sq = 0.f;
#pragma unroll
                for (int t = 0; t < 4; ++t)
#pragma unroll
                    for (int i = 0; i < 16; ++i) { const float d = o[t][i] - mu; sq += d * d; }
                sq += __shfl_xor(sq, 32);
                const float rstd = 1.0f / sqrtf(sq * (1.0f / 128.0f) + LN_EPS);
                const f16* grow = PJ + (row0 + ql) * NPJ + C_RG + h * 128;
                f16* crow_ = cat + (row0 + ql) * DM + 512 + h * 128;
#pragma unroll
                for (int t = 0; t < 4; ++t)
#pragma unroll
                    for (int g = 0; g < 4; ++g) { const int d0 = 32 * t + 8 * g + 4 * hp;
                        const h4 gv = *(const h4*)(grow + d0); f32x4 ov;
#pragma unroll
                        for (int e = 0; e < 4; ++e) { const float gg = (float)gv[e]; const float sl = gg / (1.0f + fexp2(-gg * LOG2E)); ov[e] = sl * (o[t][4 * g + e] - mu) * rstd; }
                        *(h4*)(crow_ + d0) = __builtin_convertvector(ov, h4); }
            }
        }
        {
            LAS unsigned char* Kl = lds; LAS unsigned char* Vl = lds + 256 * KP64;
            const int r = lane & 31, hp = lane >> 5;
            h8 kr[4], vr[4];
            int uu = bid;
            if (uu < NU_A) { const int bh = uu >> 6, c = uu & 63, b = bh >> 3, h = bh & 7; const f16* kp = PJ + (size_t)(b * SEQ + c * 256) * NPJ + C_AK + h * 64;
#pragma unroll
                for (int i = 0; i < 4; ++i) { const int q = tid + 512 * i, row = q >> 3, ch = q & 7; kr[i] = *(const h8*)(kp + (size_t)row * NPJ + 8 * ch); vr[i] = *(const h8*)(kp + (size_t)row * NPJ + 512 + 8 * ch); } }
            for (; uu < NU_A; uu += G) {
                const int bh = uu >> 6, c = uu & 63, b = bh >> 3, h = bh & 7;
                __syncthreads();
#pragma unroll
                for (int i = 0; i < 4; ++i) { const int q = tid + 512 * i, row = q >> 3, ch = q & 7; *(LAS h8*)(Kl + row * KP64 + 16 * ch) = kr[i]; *(LAS h8*)(Vl + row * VP64 + 16 * ch) = vr[i]; }
                __syncthreads();
                if (uu + G < NU_A) { const int u2 = uu + G, bh2 = u2 >> 6, c2 = u2 & 63; const f16* kp = PJ + (size_t)((bh2 >> 3) * SEQ + c2 * 256) * NPJ + C_AK + (bh2 & 7) * 64;
#pragma unroll
                    for (int i = 0; i < 4; ++i) { const int q = tid + 512 * i, row = q >> 3, ch = q & 7; kr[i] = *(const h8*)(kp + (size_t)row * NPJ + 8 * ch); vr[i] = *(const h8*)(kp + (size_t)row * NPJ + 512 + 8 * ch); } }
                const int ql = 32 * wave + r, s = 256 * c + ql;
                const f16* qrow = PJ + (size_t)(b * SEQ + s) * NPJ + C_AQ + h * 64;
                h8 qf[4];
#pragma unroll
                for (int ks = 0; ks < 4; ++ks) qf[ks] = *(const h8*)(qrow + 16 * ks + 8 * hp);
                const int nsel = c < 3 ? c : 3;
                const size_t pidx = ((size_t)bh * SEQ + s) * 3;
                float pm[3], pl[3]; h4 pv[3][8];
#pragma unroll
                for (int t = 0; t < 3; ++t) { pm[t] = -3.0e38f; pl[t] = 0.f;
#pragma unroll
                    for (int g = 0; g < 8; ++g) pv[t][g] = (h4){0, 0, 0, 0};
                    if (t < nsel) { const f32x2 v = pml[pidx + t]; pm[t] = v[0]; pl[t] = v[1]; const f16* po = pO + (pidx + t) * 64;
#pragma unroll
                        for (int g = 0; g < 8; ++g) pv[t][g] = *(const h4*)(po + 32 * (g >> 2) + 8 * (g & 3) + 4 * hp); } }
                float m2, ls; f32x16 o[2];
                attn_own(Kl, Vl, biasl + h * BTP, qf, ql, wave, lane, m2, ls, o);
                float M = m2;
#pragma unroll
                for (int t = 0; t < 3; ++t) M = fmaxf(M, pm[t]);
                const float e0 = fexp2(m2 - M); float L = ls * e0;
#pragma unroll
                for (int dt = 0; dt < 2; ++dt)
#pragma unroll
                    for (int i = 0; i < 16; ++i) o[dt][i] *= e0;
#pragma unroll
                for (int t = 0; t < 3; ++t) { const float wt = pl[t] * fexp2(pm[t] - M); L += wt;
#pragma unroll
                    for (int g = 0; g < 8; ++g)
#pragma unroll
                        for (int e = 0; e < 4; ++e) o[g >> 2][4 * (g & 3) + e] += wt * (float)pv[t][g][e]; }
                const float invL = 1.0f / L; float sq = 0.f;
                f16* crow_ = cat + (size_t)(b * SEQ + s) * DM + h * 64;
#pragma unroll
                for (int dt = 0; dt < 2; ++dt)
#pragma unroll
                    for (int g = 0; g < 4; ++g) { f32x4 ov;
#pragma unroll
                        for (int e = 0; e < 4; ++e) { ov[e] = o[dt][4 * g + e] * invL; sq += ov[e] * ov[e]; }
                        *(h4*)(crow_ + 32 * dt + 8 * g + 4 * hp) = __builtin_convertvector(ov, h4); }
                sq += __shfl_xor(sq, 32);
                if (hp == 0) sumsq[(size_t)(b * SEQ + s) * 8 + h] = sq;
            }
        }
        __syncthreads();
    }
    SEAM(4);

    if (IN(5)) {
        pg8::StaticOrder S; S.init(cat, WoT, DM, DM, NTOK, DM, G, bid);
        EpiZ E{a.x, zbuf, sumsq};
        pg8::gemm_phase<EpiZ, pg8::StaticOrder, true>(lds, DM, DM / 64, S, E);
    }
    SEAM(5);

    if (IN(6)) REP(6) {
        unsigned* ecnt_w = (rep_ | a.alt) ? ecnt + 32 : ecnt; int* elist_w = (rep_ | a.alt) ? (int*)(ws + 496 * MiB) : elist; float* wts_w = (rep_ | a.alt) ? (float*)(ws + 500 * MiB) : wts;
        LAS unsigned char* Ht = lds;
        LAS float* lg = (LAS float*)(lds + 32 * 2064);
        f32x8 gv[2], bv[2];
#pragma unroll
        for (int j = 0; j < 2; ++j) { gv[j] = *(const f32x8*)(a.ln1g + 8 * lane + 512 * j); bv[j] = *(const f32x8*)(a.ln1b + 8 * lane + 512 * j); }
        for (int u = bid; u < NTOK / 32; u += G) {
            __syncthreads();
            h8 zin[4][2];
#pragma unroll
            for (int rr = 0; rr < 4; ++rr)
#pragma unroll
                for (int j = 0; j < 2; ++j) zin[rr][j] = *(const h8*)(zbuf + ((size_t)u * 32 + 4 * wave + rr) * DM + 8 * lane + 512 * j);
#pragma unroll
            for (int rr = 0; rr < 4; ++rr) {
                const int rl = 4 * wave + rr; const size_t row = (size_t)u * 32 + rl;
                f32x8 v[2]; float s = 0.f;
#pragma unroll
                for (int j = 0; j < 2; ++j) { v[j] = __builtin_convertvector(zin[rr][j], f32x8);
#pragma unroll
                    for (int e = 0; e < 8; ++e) s += v[j][e]; }
                const float mean = wave_sum(s) * (1.0f / DM); float s2 = 0.f;
#pragma unroll
                for (int j = 0; j < 2; ++j) { v[j] = v[j] - mean;
#pragma unroll
                    for (int e = 0; e < 8; ++e) s2 += v[j][e] * v[j][e]; }
                const float rstd = 1.0f / sqrtf(wave_sum(s2) * (1.0f / DM) + LN_EPS);
#pragma unroll
                for (int j = 0; j < 2; ++j) { const h8 hv = __builtin_convertvector(v[j] * rstd * gv[j] + bv[j], h8);
                    *(h8*)(hh + row * DM + 8 * lane + 512 * j) = hv; *(LAS h8*)(Ht + rl * 2064 + 2 * (8 * lane + 512 * j)) = hv; }
            }
            __syncthreads();
            if (wave < 6) {
                const int rt = wave / 3, ct = wave % 3, fr = lane & 15, fq = lane >> 4;
                f32x4 acc = {0.f, 0.f, 0.f, 0.f};
#pragma unroll 8
                for (int ks = 0; ks < 32; ++ks) { const h8 af = *(const LAS h8*)(Ht + (16 * rt + fr) * 2064 + 2 * (32 * ks + 8 * fq));
                    const h8 bf = *(const h8*)(WrT + (size_t)(16 * ct + fr) * DM + 32 * ks + 8 * fq); acc = MFMA16(af, bf, acc); }
#pragma unroll
                for (int e = 0; e < 4; ++e) lg[(16 * rt + 4 * fq + e) * 48 + 16 * ct + fr] = acc[e];
            }
            __syncthreads();
            if (tid < 32) {
                LAS unsigned* eh = (LAS unsigned*)(lds + 80 * 1024);
                eh[tid] = 0u;
                const int tok = u * 32 + tid; LAS const float* L = lg + tid * 48;
                float g4[4]; int gi = 0; float gm = -3.0e38f;
#pragma unroll
                for (int k = 0; k < 4; ++k) { g4[k] = L[k] + a.brg[k]; if (g4[k] > gm) { gm = g4[k]; gi = k; } }
                float gs = 0.f;
#pragma unroll
                for (int k = 0; k < 4; ++k) gs += __expf(g4[k] - gm);
                const float gp = 1.0f / gs;
                float l1 = -3.0e38f, l2 = -3.0e38f; int i1 = 0, i2 = 0;
                for (int k = 0; k < 8; ++k) { const float v = L[4 + 8 * gi + k] + a.bre[8 * gi + k]; if (v > l1) { l2 = l1; i2 = i1; l1 = v; i1 = k; } else if (v > l2) { l2 = v; i2 = k; } }
                const float w1 = 1.0f / (1.0f + __expf(l2 - l1)), w2 = 1.0f - w1;
                const int e1 = 8 * gi + i1, e2 = 8 * gi + i2;
                LDS_WAIT();
                const unsigned r1 = __hip_atomic_fetch_add(eh + e1, 1u, __ATOMIC_RELAXED, __HIP_MEMORY_SCOPE_WORKGROUP);
                const unsigned r2 = __hip_atomic_fetch_add(eh + e2, 1u, __ATOMIC_RELAXED, __HIP_MEMORY_SCOPE_WORKGROUP);
                LDS_WAIT();
                { const unsigned n = eh[tid]; unsigned base = 0u; if (n) base = atomicAdd(ecnt_w + tid * 64, n); eh[32 + tid] = base; }
                LDS_WAIT();
                const unsigned p1 = eh[32 + e1] + r1, p2 = eh[32 + e2] + r2;
                elist_w[e1 * NTOK + (int)p1] = tok * 2; elist_w[e2 * NTOK + (int)p2] = tok * 2 + 1;
                wts_w[tok * 2] = gp * w1; wts_w[tok * 2 + 1] = gp * w2;
            }
        }
        __syncthreads();
    }
    SEAM(6);

    LAS int* mtab = (LAS int*)(lds + pg8::STAGE_BYTES + 1024);
    if (IN(7) || IN(8)) {
        if (tid == 0) { int acc = 0; for (int e = 0; e < 32; ++e) { const int c = (int)ecnt[e * 64]; mtab[e] = c; mtab[32 + e] = acc; acc += (c + 255) >> 8; } mtab[64] = acc; }
        __syncthreads();
    }
    if (IN(7)) {
        MoeSched S{mtab, elist, (const char*)hh, (const char*)WguT, (size_t)DM * DM * 2, DM, DM, G, bid, true};
        EpiGU E{hid};
        pg8::gemm_phase<EpiGU, MoeSched, true>(lds, DM, DM / 64, S, E);
        if (DUP_PHASE == 7) pg8::gemm_phase<EpiGU, MoeSched, true>(lds, DM, DM / 64, S, E);
    }
    SEAM(7);
    if (IN(8)) {
        MoeSched S{mtab, elist, (const char*)hid, (const char*)WdnT, (size_t)DM * DE * 2, DE, DE, G, bid, false};
        EpiDown E{ybuf, elist, wts, mtab};
        pg8::gemm_phase<EpiDown, MoeSched, true>(lds, DE, DE / 64, S, E);
        if (DUP_PHASE == 8) pg8::gemm_phase<EpiDown, MoeSched, true>(lds, DE, DE / 64, S, E);
    }
    SEAM(8);

#ifdef DIAG_PHASE
    if (IN(9)) { xcd_barrier(bar); const float cval = sqrtf((float)__hip_atomic_load(ctl + 24576, __ATOMIC_RELAXED, __HIP_MEMORY_SCOPE_AGENT) * 0.01f);
        for (size_t i = (size_t)bid * 512 + tid; i < (size_t)NTOK * DM / 4; i += (size_t)G * 512) ((f32x4*)a.out)[i] = (f32x4){cval, cval, cval, cval}; }
    if (false) {
#else
    if (IN(9)) REP(9) {
#endif
        f32x4 gv[4], bv[4];
#pragma unroll
        for (int j = 0; j < 4; ++j) { gv[j] = *(const f32x4*)(a.ln2g + 4 * lane + 256 * j); bv[j] = *(const f32x4*)(a.ln2b + 4 * lane + 256 * j); }
        for (int row = bid * 8 + wave; row < NTOK; row += G * 8) {
            f32x4 v[4]; float s = 0.f;
#pragma unroll
            for (int j = 0; j < 4; ++j) { const size_t c = 4 * lane + 256 * j;
                const f32x4 hv = __builtin_convertvector(*(const h4*)(hh + (size_t)row * DM + c), f32x4);
                const f32x4 y0 = __builtin_convertvector(*(const h4*)(ybuf + (size_t)(2 * row) * DM + c), f32x4);
                const f32x4 y1 = __builtin_convertvector(*(const h4*)(ybuf + (size_t)(2 * row + 1) * DM + c), f32x4);
                v[j] = hv * ALPHA + (y0 + y1); s += (v[j][0] + v[j][1]) + (v[j][2] + v[j][3]); }
            const float mean = wave_sum(s) * (1.0f / DM); float s2 = 0.f;
#pragma unroll
            for (int j = 0; j < 4; ++j) { v[j] = v[j] - mean; s2 += (v[j][0] * v[j][0] + v[j][1] * v[j][1]) + (v[j][2] * v[j][2] + v[j][3] * v[j][3]); }
            const float rstd = 1.0f / sqrtf(wave_sum(s2) * (1.0f / DM) + LN_EPS);
#pragma unroll
            for (int j = 0; j < 4; ++j) *(f32x4*)(a.out + (size_t)row * DM + 4 * lane + 256 * j) = v[j] * rstd * gv[j] + bv[j];
        }
    }
#undef IN
#undef SEAM
}

extern "C" void kernel_launch(void* const* d_in, const int* in_sizes, int n_in, void* d_out, int out_size, void* d_ws, size_t ws_size, hipStream_t stream) {
    static int grid = 0;
    if (grid == 0) {
        if (n_in != 15 || in_sizes[0] != NTOK * DM || out_size != NTOK * DM || ws_size < WS_END) { fprintf(stderr, "kernel_launch: unexpected problem (n_in %d, ws %zu)\n", n_in, ws_size); grid = -1; return; }
        int dev = 0, cus = 0, per_cu = 0;
        if (hipGetDevice(&dev) != hipSuccess || hipDeviceGetAttribute(&cus, hipDeviceAttributeMultiprocessorCount, dev) != hipSuccess) { grid = -1; return; }
        if (hipFuncSetAttribute((const void*)fwd, hipFuncAttributeMaxDynamicSharedMemorySize, LDS_BYTES) != hipSuccess) { fprintf(stderr, "kernel_launch: hipFuncSetAttribute failed\n"); grid = -1; return; }
        if (hipOccupancyMaxActiveBlocksPerMultiprocessor(&per_cu, (const void*)fwd, 512, LDS_BYTES) != hipSuccess || per_cu < 1) { fprintf(stderr, "kernel_launch: occupancy query says %d\n", per_cu); (void)hipGetLastError(); grid = -1; return; }
        grid = cus;
    }
    if (grid < 0) return;
    (void)hipMemsetAsync((char*)d_ws + WS_CTL, 0, CTL_ZERO_BYTES, stream);
    Args a{};
    a.x = (const float*)d_in[0]; a.w_in = (const float*)d_in[1]; a.gain = (const float*)d_in[2]; a.rel = (const float*)d_in[3]; a.w_out = (const float*)d_in[4];
    a.ln1g = (const float*)d_in[5]; a.ln1b = (const float*)d_in[6]; a.wrg = (const float*)d_in[7]; a.brg = (const float*)d_in[8]; a.wre = (const float*)d_in[9];
    a.bre = (const float*)d_in[10]; a.wgu = (const float*)d_in[11]; a.wdn = (const float*)d_in[12]; a.ln2g = (const float*)d_in[13]; a.ln2b = (const float*)d_in[14];
    a.out = (float*)d_out; a.ws = (unsigned char*)d_ws;
#if MK_LAUNCHES == 1
    a.ph_lo = 0; a.ph_hi = NPHASE;
    hipLaunchKernelGGL(fwd, dim3(grid), dim3(512), LDS_BYTES, stream, a);
#else
    for (int p = 0; p < NPHASE; ++p) { a.ph_lo = p; a.ph_hi = p + 1; a.alt = 0; hipLaunchKernelGGL(fwd, dim3(grid), dim3(512), LDS_BYTES, stream, a);
#ifdef HOST_DUP
        if (p == HOST_DUP) { a.alt = 1; hipLaunchKernelGGL(fwd, dim3(grid), dim3(512), LDS_BYTES, stream, a); }
#endif
    }
#endif
}
```

```cpp
#include <hip/hip_runtime.h>
#include <cstdint>
#include <cstdio>

#ifndef MK_LAUNCHES
#define MK_LAUNCHES 1
#endif

#define DI __device__ __forceinline__
#define LAS __attribute__((address_space(3)))
typedef _Float16 f16;
typedef _Float16 h8 __attribute__((ext_vector_type(8)));
typedef _Float16 h4 __attribute__((ext_vector_type(4)));
typedef short s4v __attribute__((ext_vector_type(4)));
typedef float f32x2 __attribute__((ext_vector_type(2)));
typedef float f32x4 __attribute__((ext_vector_type(4)));
typedef float f32x8 __attribute__((ext_vector_type(8)));
typedef float f32x16 __attribute__((ext_vector_type(16)));

constexpr int NB = 2, SEQ = 16384, DM = 1024, NTOK = NB * SEQ, NPJ = 3584;
constexpr int C_AQ = 0, C_AK = 512, C_AV = 1024, C_RQ = 1536, C_RK = 2048, C_RV = 2560, C_RG = 3072;
constexpr int NBLK = SEQ / 256;
constexpr int NE = 32, DE = 512;
constexpr float ALPHA = 1.189207115002721f, LN_EPS = 1e-5f, LOG2E = 1.4426950408889634f;
constexpr int NPHASE = 10;

constexpr size_t MiB = 1u << 20;
constexpr size_t WS_CTL = 0, CTL_ZERO_BYTES = 128 * 1024;
constexpr size_t WS_ROPEC = 1 * MiB, WS_ROPES = 5 * MiB, WS_XSUM = 9 * MiB, WS_KMEAN = 10 * MiB, WS_WRT = 10 * MiB + 512 * 1024;
constexpr size_t WS_SUMSQ = 11 * MiB, WS_WTS = 12 * MiB, WS_ELIST = 13 * MiB, WS_MLIST = 17 * MiB, WS_PML = 33 * MiB;
constexpr size_t WS_WINT = 39 * MiB, WS_WOT = 46 * MiB, WS_WGUT = 48 * MiB, WS_WDNT = 112 * MiB;
constexpr size_t WS_PJ = 144 * MiB, WS_XH = 368 * MiB, WS_CAT = 368 * MiB, WS_KV = 432 * MiB, WS_R = 464 * MiB;
constexpr size_t WS_HH = 144 * MiB, WS_HID = 208 * MiB, WS_Y = 280 * MiB, WS_END = 480 * MiB;
constexpr int MLIST_PER_BH = 516096;
constexpr int CW_BAR = 4096, CW_LCNT = 8192, CW_ECNT = 12288;

constexpr int SCR_BYTES = 155648;
constexpr int BIAS_OFF = SCR_BYTES;
constexpr int BTP = 224;
constexpr int MISC_OFF = BIAS_OFF + 8 * BTP * 4 + 128;
constexpr int LDS_BYTES = MISC_OFF + 256;
static_assert(LDS_BYTES <= 163840, "LDS");

__device__ const unsigned char T5_BUCKET[129] = {0,1,2,3,4,5,6,7,8,9,10,11,12,13,14,15,16,16,16,17,17,18,18,18,19,19,19,20,20,20,20,21,21,21,21,22,22,22,22,22,23,23,23,23,23,23,24,24,24,24,24,24,25,25,25,25,25,25,25,26,26,26,26,26,26,26,26,27,27,27,27,27,27,27,27,27,27,28,28,28,28,28,28,28,28,28,28,29,29,29,29,29,29,29,29,29,29,29,29,30,30,30,30,30,30,30,30,30,30,30,30,30,30,31,31,31,31,31,31,31,31,31,31,31,31,31,31,31,31};
__device__ const float ROPE_INV[64] = {1.0f,0.865964353f,0.749894202f,0.649381638f,0.562341332f,0.486967534f,0.421696514f,0.365174115f,0.316227764f,0.273841977f,0.237137377f,0.2053525f,0.177827939f,0.153992653f,0.133352146f,0.115478195f,0.100000001f,0.0865964293f,0.0749894232f,0.0649381652f,0.0562341325f,0.0486967526f,0.0421696492f,0.0365174115f,0.0316227749f,0.0273841955f,0.0237137377f,0.0205352511f,0.0177827943f,0.0153992651f,0.013335214f,0.0115478197f,0.00999999978f,0.00865964312f,0.00749894232f,0.00649381615f,0.00562341325f,0.00486967526f,0.00421696482f,0.00365174119f,0.00316227763f,0.00273841969f,0.00237137382f,0.00205352507f,0.00177827943f,0.00153992651f,0.00133352145f,0.00115478202f,0.00100000005f,0.000865964335f,0.000749894185f,0.000649381604f,0.000562341302f,0.000486967532f,0.000421696517f,0.000365174114f,0.000316227757f,0.000273841957f,0.00023713737f,0.00020535251f,0.00017782794f,0.00015399266f,0.00013335215f,0.0001154782f};

constexpr size_t PJ_SLICE = (size_t)NTOK * 512;
DI f16* att_ptr(f16* PJ, int sl, int bh, int s) { return PJ + (size_t)sl * PJ_SLICE + ((size_t)bh * SEQ + s) * 64; }
DI f16* ret_ptr(f16* PJ, int sl, int bh, int s) { return PJ + (size_t)sl * PJ_SLICE + ((size_t)bh * SEQ + s) * 128; }

struct Args {
    const float *x, *w_in, *gain, *rel, *w_out, *ln1g, *ln1b, *wrg, *brg, *wre, *bre, *wgu, *wdn, *ln2g, *ln2b;
    float* out; unsigned char* ws; int ph_lo, ph_hi, alt, pad;
};

#define LDS_WAIT() asm volatile("s_waitcnt lgkmcnt(0)" ::: "memory")
#define MFMA32(a, b, c) __builtin_amdgcn_mfma_f32_32x32x16_f16((a), (b), (c), 0, 0, 0)
#define MFMA16(a, b, c) __builtin_amdgcn_mfma_f32_16x16x32_f16((a), (b), (c), 0, 0, 0)
DI int crow(int reg, int hp) { return (reg & 3) + 8 * (reg >> 2) + 4 * hp; }
DI h8 cvt8(f32x4 a, f32x4 b) { const f32x8 v = {a[0], a[1], a[2], a[3], b[0], b[1], b[2], b[3]}; return __builtin_convertvector(v, h8); }
DI float wave_sum(float v) {
#pragma unroll
    for (int o = 1; o < 64; o <<= 1) v += __shfl_xor(v, o);
    return v;
}
DI h4 tr_read(LAS const unsigned char* p) {
    typedef LAS s4v lds_s4;
    const s4v v = __builtin_amdgcn_ds_read_tr16_b64_v4i16((lds_s4*)p);
    return __builtin_bit_cast(h4, v);
}
DI h8 cat44(h4 a, h4 b) { return __builtin_shufflevector(a, b, 0, 1, 2, 3, 4, 5, 6, 7); }
DI float fexp2(float x) { return __builtin_amdgcn_exp2f(x); }
DI float gamma_log2(int h) { return __builtin_log2f(1.0f - fexp2(-(5.0f + (4.0f / 3.0f) * (float)h))); }

#define XB_TMO      128
#define XB_XCNT(j)  (256  + 64 * (j))
#define XB_XSUB(j)  (1280 + 64 * (j))
#define XB_XGEN(j)  (2304 + 64 * (j))
#define XB_TOP      3328
#define XB_TOPGEN   3392
#define XCD_BAR_WORDS 3456
#define XB_SPIN_CAP (1u << 18)
__device__ __forceinline__ unsigned xb_ld(unsigned* p)              { return __hip_atomic_load(p, __ATOMIC_RELAXED, __HIP_MEMORY_SCOPE_AGENT); }
__device__ __forceinline__ unsigned xb_add(unsigned* p, unsigned v) { return __hip_atomic_fetch_add(p, v, __ATOMIC_RELAXED, __HIP_MEMORY_SCOPE_AGENT); }
__device__ __forceinline__ unsigned xb_xcc_id() { return (unsigned)__builtin_amdgcn_s_getreg((3 << 11) | 20) & 0xFu; }
#define XB_SPIN(cond, bar) do { unsigned _sp = 0; while (cond) { __builtin_amdgcn_s_sleep(1); \
    if ((++_sp & 255u) == 0u) { if (xb_ld(&(bar)[XB_TMO])) break; if (_sp > XB_SPIN_CAP) { atomicAdd(&(bar)[XB_TMO], 1u); break; } } } } while (0)
struct XcdBarrier { unsigned* bar; unsigned x; volatile LAS unsigned* st; };
__device__ __forceinline__ XcdBarrier xcd_barrier_post(unsigned* bar, volatile LAS unsigned* st) {
    XcdBarrier b; b.bar = bar; b.x = xb_xcc_id(); b.st = st;
    if (threadIdx.x == 0) (void)xb_add(&bar[XB_XCNT(b.x)], 1u);
    return b;
}
__device__ __forceinline__ void xcd_barrier_complete(unsigned* bar, unsigned x, unsigned& nloc, unsigned& nx) {
    const unsigned G = gridDim.x * gridDim.y * gridDim.z;
    unsigned sum, cnt, mine, sp = 0u;
    for (;;) {
        sum = 0u; cnt = 0u; mine = 0u;
#pragma unroll
        for (unsigned j = 0; j < 16; ++j) { const unsigned c = xb_ld(&bar[XB_XCNT(j)]); sum += c; cnt += (c > 0u) ? 1u : 0u; mine = (j == x) ? c : mine; }
        if (sum == G) break;
        __builtin_amdgcn_s_sleep(1);
        if ((++sp & 255u) == 0u) { if (xb_ld(&bar[XB_TMO])) break; if (sp > XB_SPIN_CAP) { atomicAdd(&bar[XB_TMO], 1u); break; } }
    }
    nloc = mine > 0u ? mine : 1u; nx = cnt > 0u ? cnt : 1u;
}
__device__ __forceinline__ void xcd_barrier(const XcdBarrier& b) {
    asm volatile("s_waitcnt vmcnt(0)" ::: "memory");
    __syncthreads();
    if (threadIdx.x == 0) {
        unsigned* bar = b.bar;
        __builtin_amdgcn_s_waitcnt(0);
        unsigned nloc = b.st[0], nx = b.st[1];
        if (nloc == 0u) { xcd_barrier_complete(bar, b.x, nloc, nx); b.st[0] = nloc; b.st[1] = nx; }
        const unsigned old = xb_add(&bar[XB_XSUB(b.x)], 1u);
        const unsigned gen = old / nloc;
        if (old + 1u == (gen + 1u) * nloc) {
            __builtin_amdgcn_fence(__ATOMIC_RELEASE, "agent");
            asm volatile("s_waitcnt vmcnt(0)" ::: "memory");
            const unsigned og = xb_add(&bar[XB_TOP], 1u);
            const unsigned tg = og / nx;
            if (og + 1u == (tg + 1u) * nx) xb_add(&bar[XB_TOPGEN], 1u);
            else XB_SPIN(xb_ld(&bar[XB_TOPGEN]) == tg, bar);
            __builtin_amdgcn_fence(__ATOMIC_ACQUIRE, "agent");
            xb_add(&bar[XB_XGEN(b.x)], 1u);
            asm volatile("s_waitcnt vmcnt(0)" ::: "memory");
        } else {
            XB_SPIN(xb_ld(&bar[XB_XGEN(b.x)]) == gen, bar);
            __builtin_amdgcn_fence(__ATOMIC_ACQUIRE, "agent");
            asm volatile("s_waitcnt vmcnt(0)" ::: "memory");
        }
    }
    __syncthreads();
}

namespace pg8 {
constexpr int BM = 256, BK = 64, HALF = 128, HTB = HALF * BK * 2, STAGE_BYTES = 8 * HTB, NXCD = 8, WGM = 8;
DI int lds_byte(int r, int c) { const int st = (r >> 4) * 2 + (c >> 5), rr = r & 15, cc = c & 31, ob = rr * 64 + cc * 2; return st * 1024 + (ob ^ (((ob >> 9) & 1) << 5)); }
DI void stage_rc(int b, int& R, int& C) { const int st = b / 1024, sb = b % 1024, swz = sb ^ (((sb >> 9) & 1) << 5); R = (st >> 1) * 16 + swz / 64; C = (st & 1) * 32 + (swz % 64) / 2; }
DI int perm32(int rho) { const int n = rho >> 4, i = rho & 15; return 8 * (i >> 2) + 4 * n + (i & 3); }

struct Unit { const char* a; const char* b; int i0, i1, i2, i3; };

struct StaticOrder {
    const char* A; const char* Bt; int lda, ldb, nM, nN, nwg, G, c;
    DI void init(const void* A_, const void* Bt_, int lda_, int ldb_, int M, int N, int G_, int c_) { A = (const char*)A_; Bt = (const char*)Bt_; lda = lda_; ldb = ldb_; nM = M / BM; nN = N / BM; nwg = nM * nN; G = G_; c = c_; }
    DI bool next(int i, Unit& u) const {
        const long L = (long)i * G + c; if (L >= nwg) return false;
        int wgid = (int)L; { const int q = nwg / NXCD, r = nwg % NXCD, xcd = wgid % NXCD, off = wgid / NXCD; wgid = (xcd < r ? xcd * (q + 1) : r * (q + 1) + (xcd - r) * q) + off; }
        const int nig = WGM * nN, gid = wgid / nig, fm = gid * WGM, gsz = (nM - fm) < WGM ? (nM - fm) : WGM;
        u.i0 = fm + ((wgid % nig) % gsz); u.i1 = (wgid % nig) / gsz; u.i2 = 0; u.i3 = 0;
        u.a = A + (size_t)u.i0 * BM * lda * 2; u.b = Bt + (size_t)u.i1 * BM * ldb * 2; return true;
    }
    DI void aoff(const Unit&, unsigned (&vo)[2][2]) const {
#pragma unroll
        for (int i = 0; i < 2; ++i) { int R, C; stage_rc((int)threadIdx.x * 16 + i * 8192, R, C);
#pragma unroll
            for (int h = 0; h < 2; ++h) vo[h][i] = (unsigned)((h * HALF + R) * lda + C) * 2u; }
    }
};

template <class Epi, class Sched, bool ALIGN_EPI>
DI void gemm_phase(LAS unsigned char* lds, const int ldb, const int nt, const Sched& S, const Epi& E) {
    const int tid = threadIdx.x, wid = __builtin_amdgcn_readfirstlane(tid >> 6), lane = tid & 63, wr = wid >> 2, wc = wid & 3, fr = lane & 15, fq = lane >> 4;
    unsigned voffB[2];
#pragma unroll
    for (int i = 0; i < 2; ++i) { int R, C; stage_rc(tid * 16 + i * 8192, R, C); const int Rb = (R & ~31) + perm32(R & 31); voffB[i] = (unsigned)(Rb * ldb + C) * 2u; }
    const size_t kstep = (size_t)(BK * 2);
    const size_t hstep = (size_t)HALF * ldb * 2;
    const unsigned ldsw = (unsigned)wid * 1024u;
    const int aoff = lds_byte(wr * 64 + fr, fq * 8), boff = lds_byte(wc * 32 + fr, fq * 8);
#define PG8_SA(b, h) (((b) * 2 + (h)) * HTB)
#define PG8_SB(b, h) ((4 + (b) * 2 + (h)) * HTB)
#define PG8_STAGE(bufoff, gbase, voff) do { _Pragma("unroll") for (int _i = 0; _i < 2; ++_i) \
        __builtin_amdgcn_global_load_lds((const unsigned*)((const char*)(gbase) + (voff)[_i]), (LAS unsigned*)(lds + (bufoff) + ldsw + _i * 8192), 16, 0, 0); } while (0)
#define PG8_LDA(dst, b, h) do { _Pragma("unroll") for (int m = 0; m < 4; ++m) _Pragma("unroll") for (int k = 0; k < 2; ++k) dst[m][k] = *(const LAS h8*)(lds + PG8_SA(b, h) + aoff + m * 2048 + k * 1024); } while (0)
#define PG8_LDB(dst, b, h) do { _Pragma("unroll") for (int n = 0; n < 2; ++n) _Pragma("unroll") for (int k = 0; k < 2; ++k) dst[n][k] = *(const LAS h8*)(lds + PG8_SB(b, h) + boff + n * 2048 + k * 1024); } while (0)
#define PG8_MMA(ai, bj, At, Bt) do { __builtin_amdgcn_s_setprio(1); _Pragma("unroll") for (int m = 0; m < 4; ++m) _Pragma("unroll") for (int n = 0; n < 2; ++n) _Pragma("unroll") for (int k = 0; k < 2; ++k) \
        acc[ai][bj][m][n] = __builtin_amdgcn_mfma_f32_16x16x32_f16(Bt[n][k], At[m][k], acc[ai][bj][m][n], 0, 0, 0); __builtin_amdgcn_s_setprio(0); } while (0)
#define PG8_WAIT_V(n) asm volatile("s_waitcnt vmcnt(" #n ")" ::: "memory")
#define PG8_WAIT_L(n) asm volatile("s_waitcnt lgkmcnt(" #n ")" ::: "memory")
#define PG8_BAR __builtin_amdgcn_s_barrier()
#define PG8_SCHED __builtin_amdgcn_sched_barrier(0)
    Unit cur, nxt; int ui = 0;
    if (!S.next(0, cur)) return;
    f32x4 acc[2][2][4][2];
#pragma unroll
    for (int a = 0; a < 2; ++a)
#pragma unroll
        for (int b = 0; b < 2; ++b)
#pragma unroll
            for (int m = 0; m < 4; ++m)
#pragma unroll
                for (int n = 0; n < 2; ++n) acc[a][b][m][n] = (f32x4){0.f, 0.f, 0.f, 0.f};
    h8 At[4][2], B0[2][2], B1[2][2];
    unsigned voc[2][2], von[2][2];
    S.aoff(cur, voc);
    const char* cA = cur.a; const char* cB = cur.b;
    PG8_STAGE(PG8_SB(0, 0), cB, voffB); PG8_STAGE(PG8_SB(0, 1), cB + hstep, voffB); PG8_STAGE(PG8_SA(0, 0), cA, voc[0]); PG8_STAGE(PG8_SA(0, 1), cA, voc[1]);
    if (wr == 1) PG8_BAR;
    PG8_WAIT_V(2); PG8_BAR;
    PG8_STAGE(PG8_SB(1, 0), cB + kstep, voffB); PG8_STAGE(PG8_SA(1, 0), cA + kstep, voc[0]); PG8_STAGE(PG8_SB(1, 1), cB + hstep + kstep, voffB);
    PG8_WAIT_V(6); PG8_BAR;
    for (;;) {
        const bool has_next = S.next(ui + 1, nxt);
        const char* nA = has_next ? nxt.a : cA; const char* nB = has_next ? nxt.b : cB;
        if (has_next) S.aoff(nxt, von);
        else {
#pragma unroll
            for (int h = 0; h < 2; ++h)
#pragma unroll
                for (int i = 0; i < 2; ++i) von[h][i] = voc[h][i]; }
        for (int t = 0; t < nt; t += 2) {
            if constexpr (Epi::MIDK > 0) { if (t == Epi::MIDK) E.midk(acc, cur, wr, wc, fr, fq); }
            const bool last = (t == nt - 2);
            const char* a1 = cA + (size_t)(t + 1) * kstep;
            const char* a2 = last ? nA : cA + (size_t)(t + 2) * kstep; const char* b2 = last ? nB : cB + (size_t)(t + 2) * kstep;
            const char* a3 = a2 + kstep; const char* b3 = b2 + kstep;
            unsigned v2[2][2];
#pragma unroll
            for (int h = 0; h < 2; ++h)
#pragma unroll
                for (int i = 0; i < 2; ++i) v2[h][i] = last ? von[h][i] : voc[h][i];
            PG8_LDB(B0, 0, 0); PG8_LDB(B1, 0, 1); PG8_SCHED; PG8_LDA(At, 0, 0); PG8_STAGE(PG8_SA(1, 1), a1, voc[1]);
            PG8_WAIT_V(8); PG8_WAIT_L(0); PG8_BAR; PG8_MMA(0, 0, At, B0); PG8_MMA(0, 1, At, B1); PG8_BAR; PG8_SCHED;
            PG8_LDA(At, 0, 1); PG8_STAGE(PG8_SB(0, 0), b2, voffB); PG8_STAGE(PG8_SB(0, 1), b2 + hstep, voffB); PG8_STAGE(PG8_SA(0, 0), a2, v2[0]);
            PG8_WAIT_V(8); PG8_WAIT_L(0); PG8_BAR; PG8_MMA(1, 0, At, B0); PG8_MMA(1, 1, At, B1); PG8_BAR; PG8_SCHED;
            PG8_LDB(B0, 1, 0); PG8_LDB(B1, 1, 1); PG8_SCHED; PG8_LDA(At, 1, 0); PG8_STAGE(PG8_SA(0, 1), a2, v2[1]);
            PG8_WAIT_V(8); PG8_WAIT_L(0); PG8_BAR; PG8_MMA(0, 0, At, B0); PG8_MMA(0, 1, At, B1); PG8_BAR; PG8_SCHED;
            PG8_LDA(At, 1, 1); PG8_STAGE(PG8_SB(1, 0), b3, voffB); PG8_STAGE(PG8_SB(1, 1), b3 + hstep, voffB); PG8_STAGE(PG8_SA(1, 0), a3, v2[0]);
            PG8_WAIT_V(8); PG8_WAIT_L(0); PG8_BAR; PG8_MMA(1, 0, At, B0); PG8_MMA(1, 1, At, B1); PG8_BAR; PG8_SCHED;
        }
        if constexpr (ALIGN_EPI) { if (wr == 0) PG8_BAR; }
        E(acc, cur, wr, wc, fr, fq);
        if (!has_next) break;
#pragma unroll
        for (int a = 0; a < 2; ++a)
#pragma unroll
            for (int b = 0; b < 2; ++b)
#pragma unroll
                for (int m = 0; m < 4; ++m)
#pragma unroll
                    for (int n = 0; n < 2; ++n) acc[a][b][m][n] = (f32x4){0.f, 0.f, 0.f, 0.f};
        cur = nxt; cA = nA; cB = nB; ++ui;
#pragma unroll
        for (int h = 0; h < 2; ++h)
#pragma unroll
            for (int i = 0; i < 2; ++i) voc[h][i] = von[h][i];
        if constexpr (ALIGN_EPI) { if (wr == 1) PG8_BAR; }
    }
    PG8_WAIT_V(0);
    if constexpr (!ALIGN_EPI) { if (wr == 0) PG8_BAR; }
    PG8_BAR;
#undef PG8_SA
#undef PG8_SB
#undef PG8_STAGE
#undef PG8_LDA
#undef PG8_LDB
#undef PG8_MMA
#undef PG8_WAIT_V
#undef PG8_WAIT_L
#undef PG8_BAR
#undef PG8_SCHED
}
}

struct EpiProj {
    static constexpr int MIDK = 0;
    f16* PJ; const float* cosT; const float* sinT;
    DI void midk(f32x4 (&)[2][2][4][2], const pg8::Unit&, int, int, int, int) const {}
    DI void operator()(const f32x4 (&acc)[2][2][4][2], const pg8::Unit& u, int wr, int wc, int fr, int fq) const {
        const int pn = u.i1, row0 = u.i0 * 256 + wr * 64 + fr, sl = pn >> 1;
        const int b = row0 >> 14, s0 = row0 & (SEQ - 1);
        if (pn < 6) {
#pragma unroll
            for (int bj = 0; bj < 2; ++bj) { f16* hp_ = att_ptr(PJ, sl, b * 8 + (pn & 1) * 4 + 2 * bj + (wc >> 1), s0) + 32 * (wc & 1) + 8 * fq;
#pragma unroll
                for (int ai = 0; ai < 2; ++ai)
#pragma unroll
                    for (int m = 0; m < 4; ++m) *(h8*)(hp_ + (size_t)(ai * 128 + m * 16) * 64) = cvt8(acc[ai][bj][m][0], acc[ai][bj][m][1]); }
        } else if (pn > 9) {
#pragma unroll
            for (int bj = 0; bj < 2; ++bj) { f16* hp_ = ret_ptr(PJ, sl, b * 4 + (pn & 1) * 2 + bj, s0) + 32 * wc + 8 * fq;
#pragma unroll
                for (int ai = 0; ai < 2; ++ai)
#pragma unroll
                    for (int m = 0; m < 4; ++m) *(h8*)(hp_ + (size_t)(ai * 128 + m * 16) * 128) = cvt8(acc[ai][bj][m][0], acc[ai][bj][m][1]); }
        } else {
            const float sc = (pn >= 8) ? 0.08838834764831845f : 1.0f;
            const int i0 = 32 * (wc & 1) + 8 * fq;
            f16* hp_ = ret_ptr(PJ, sl, b * 4 + (pn & 1) * 2 + (wc >> 1), s0) + i0;
#pragma unroll
            for (int ai = 0; ai < 2; ++ai)
#pragma unroll
                for (int m = 0; m < 4; ++m) { const int pos = s0 + ai * 128 + m * 16;
                    const f32x4 c0 = *(const f32x4*)(cosT + pos * 64 + i0) * sc, c1 = *(const f32x4*)(cosT + pos * 64 + i0 + 4) * sc;
                    const f32x4 s0v = *(const f32x4*)(sinT + pos * 64 + i0) * sc, s1v = *(const f32x4*)(sinT + pos * 64 + i0 + 4) * sc;
                    const f32x4 x10 = acc[ai][0][m][0], x11 = acc[ai][0][m][1], x20 = acc[ai][1][m][0], x21 = acc[ai][1][m][1];
                    f16* rowp = hp_ + (size_t)(ai * 128 + m * 16) * 128;
                    *(h8*)(rowp) = cvt8(x10 * c0 - x20 * s0v, x11 * c1 - x21 * s1v);
                    *(h8*)(rowp + 64) = cvt8(x10 * s0v + x20 * c0, x11 * s1v + x21 * c1); }
        }
    }
};
struct EpiZ {
    static constexpr int MIDK = 8;
    const float* x; f16* z; const float* sumsq;
    DI void midk(f32x4 (&acc)[2][2][4][2], const pg8::Unit& u, int wr, int wc, int fr, int fq) const {
#pragma unroll
        for (int ai = 0; ai < 2; ++ai)
#pragma unroll
            for (int m = 0; m < 4; ++m) { const int row = u.i0 * 256 + ai * 128 + wr * 64 + m * 16 + fr;
                const f32x4 s0 = *(const f32x4*)(sumsq + (size_t)row * 8), s1 = *(const f32x4*)(sumsq + (size_t)row * 8 + 4);
                const float ss = ((s0[0] + s0[1]) + (s0[2] + s0[3])) + ((s1[0] + s1[1]) + (s1[2] + s1[3]));
                const float rinv = 1.0f / sqrtf(ss * (1.0f / 512.0f) + LN_EPS);
#pragma unroll
                for (int bj = 0; bj < 2; ++bj)
#pragma unroll
                    for (int n = 0; n < 2; ++n) acc[ai][bj][m][n] *= rinv; }
    }
    DI void operator()(const f32x4 (&acc)[2][2][4][2], const pg8::Unit& u, int wr, int wc, int fr, int fq) const {
        const int row0 = u.i0 * 256 + wr * 64 + fr, col0 = u.i1 * 256 + wc * 32 + 8 * fq;
#pragma unroll
        for (int ai = 0; ai < 2; ++ai)
#pragma unroll
            for (int m = 0; m < 4; ++m) { const size_t off = (size_t)(row0 + ai * 128 + m * 16) * DM + col0;
#pragma unroll
                for (int bj = 0; bj < 2; ++bj) {
                    const f32x4 x0 = *(const f32x4*)(x + off + bj * 128), x1 = *(const f32x4*)(x + off + bj * 128 + 4);
                    *(h8*)(z + off + bj * 128) = cvt8(x0 * ALPHA + acc[ai][bj][m][0], x1 * ALPHA + acc[ai][bj][m][1]); } }
    }
};
struct MoeSched {
    LAS const int* tab; const int* elist; const char* A; const char* Bt; size_t b_expert_bytes; int lda, ldb, G, c; bool gather;
    DI bool next(int i, pg8::Unit& u) const {
        const int MT = tab[64]; const int wpx = G >> 3, xcd = c & 7, w = c >> 3;
        const int q = w + wpx * i, g = (q >> 2) * 8 + xcd, nt = q & 3;
        if (g >= MT) return false;
        int e = 0;
#pragma unroll 1
        for (int k = 1; k < 32; ++k) e += (tab[32 + k] <= g) ? 1 : 0;
        u.i0 = g; u.i1 = nt; u.i2 = e; u.i3 = g - tab[32 + e];
        u.a = gather ? A : A + (size_t)g * 256 * lda * 2;
        u.b = Bt + (size_t)e * b_expert_bytes + (size_t)nt * 256 * ldb * 2; return true;
    }
    DI void aoff(const pg8::Unit& u, unsigned (&vo)[2][2]) const {
        const int cnt = tab[u.i2];
#pragma unroll
        for (int i = 0; i < 2; ++i) { int R, C; pg8::stage_rc((int)threadIdx.x * 16 + i * 8192, R, C);
#pragma unroll
            for (int h = 0; h < 2; ++h) {
                if (gather) { int idx = u.i3 * 256 + h * 128 + R; idx = idx < cnt ? idx : 0; const int tok = elist[u.i2 * NTOK + idx] >> 1; vo[h][i] = (unsigned)(tok * lda + C) * 2u; }
                else vo[h][i] = (unsigned)((h * 128 + R) * lda + C) * 2u; } }
    }
};
struct EpiGU {
    static constexpr int MIDK = 0;
    f16* hid;
    DI void midk(f32x4 (&)[2][2][4][2], const pg8::Unit&, int, int, int, int) const {}
    DI void operator()(const f32x4 (&acc)[2][2][4][2], const pg8::Unit& u, int wr, int wc, int fr, int fq) const {
        const int row0 = u.i0 * 256 + wr * 64 + fr, col0 = u.i1 * 128 + wc * 32 + 8 * fq;
#pragma unroll
        for (int ai = 0; ai < 2; ++ai)
#pragma unroll
            for (int m = 0; m < 4; ++m) { f32x4 o[2];
#pragma unroll
                for (int n = 0; n < 2; ++n) { const f32x4 g = acc[ai][0][m][n], up = acc[ai][1][m][n];
#pragma unroll
                    for (int e = 0; e < 4; ++e) o[n][e] = g[e] * up[e] / (1.0f + fexp2(-g[e] * LOG2E)); }
                *(h8*)(hid + (size_t)(row0 + ai * 128 + m * 16) * DE + col0) = cvt8(o[0], o[1]); }
    }
};
struct EpiDown {
    static constexpr int MIDK = 0;
    f16* y; const int* elist; const float* wts; LAS const int* tab;
    DI void midk(f32x4 (&)[2][2][4][2], const pg8::Unit&, int, int, int, int) const {}
    DI void operator()(const f32x4 (&acc)[2][2][4][2], const pg8::Unit& u, int wr, int wc, int fr, int fq) const {
        const int cnt = tab[u.i2], col0 = u.i1 * 256 + wc * 32 + 8 * fq;
#pragma unroll
        for (int ai = 0; ai < 2; ++ai)
#pragma unroll
            for (int m = 0; m < 4; ++m) { const int idx = u.i3 * 256 + ai * 128 + wr * 64 + m * 16 + fr;
                if (idx < cnt) { const int ent = elist[u.i2 * NTOK + idx]; const float w = wts[ent]; f16* rowp = y + (size_t)ent * DM + col0;
#pragma unroll
                    for (int bj = 0; bj < 2; ++bj) *(h8*)(rowp + bj * 128) = cvt8(acc[ai][bj][m][0] * w, acc[ai][bj][m][1] * w); } }
    }
};

DI void tr_item(const float* W, int ldw, int k0, int nsrc0, f16* WT, int ldt, int prow0, const float* ks, LAS float* scr, int lane) {
#pragma unroll
    for (int i = 0; i < 32; ++i) { const int kk = 2 * i + (lane >> 5); float v = W[(size_t)(k0 + kk) * ldw + nsrc0 + (lane & 31)]; if (ks) v *= ks[k0 + kk]; scr[kk * 33 + (lane & 31)] = v; }
    LDS_WAIT(); asm volatile("" ::: "memory");
    const int c = lane & 7;
#pragma unroll
    for (int j = 0; j < 4; ++j) { const int n = (lane >> 3) + 8 * j; const LAS float* s = scr + (8 * c) * 33 + n;
        h8 o; o[0] = (f16)s[0]; o[1] = (f16)s[33]; o[2] = (f16)s[66]; o[3] = (f16)s[99]; o[4] = (f16)s[132]; o[5] = (f16)s[165]; o[6] = (f16)s[198]; o[7] = (f16)s[231];
        *(h8*)(WT + (size_t)(prow0 + n) * ldt + k0 + 8 * c) = o; }
    LDS_WAIT(); asm volatile("" ::: "memory");
}

constexpr int KP64 = 144, VP64 = 192;
template <bool OWN>
DI void attn_tile(LAS const unsigned char* Kl, LAS const unsigned char* Vl, LAS const float* biasd, const h8 (&qf)[4], int rel, int w, int lane, float& m2, float& lsum, f32x16 (&o)[2]) {
    const int r = lane & 31, hp = lane >> 5;
    f32x16 st[8];
    const float b31 = biasd[31 + 160];
    float mx = -3.0e38f;
#pragma unroll
    for (int kt = 0; kt < 8; ++kt) {
        if (!OWN || kt <= w) {
            f32x16 a;
#pragma unroll
            for (int i = 0; i < 16; ++i) a[i] = 0.f;
#pragma unroll
            for (int ks = 0; ks < 4; ++ks) { const h8 kf = *(const LAS h8*)(Kl + (32 * kt + r) * KP64 + 32 * ks + 16 * hp); a = MFMA32(kf, qf[ks], a); }
            const bool far = __all(rel - (32 * kt + 31) >= 128) != 0;
            if (far) {
#pragma unroll
                for (int i = 0; i < 16; ++i) a[i] = a[i] * (0.125f * LOG2E) + b31;
            } else {
                int base = rel - 32 * kt - 4 * hp; base = base > 187 ? 187 : base;
                LAS const float* tp = biasd + (base + 4);
#pragma unroll
                for (int i = 0; i < 16; ++i) a[i] = a[i] * (0.125f * LOG2E) + tp[27 - ((i & 3) + 8 * (i >> 2))];
            }
#pragma unroll
            for (int i = 0; i < 16; ++i) mx = fmaxf(mx, a[i]);
            st[kt] = a;
        }
    }
    mx = fmaxf(mx, __shfl_xor(mx, 32));
    float ls = 0.f;
#pragma unroll
    for (int dt = 0; dt < 2; ++dt)
#pragma unroll
        for (int i = 0; i < 16; ++i) o[dt][i] = 0.f;
    const int i16 = lane & 15, q4 = i16 >> 2, p4 = i16 & 3, cb = (lane >> 4) & 1;
    LAS const unsigned char* vbase = Vl + (4 * hp + q4) * VP64 + 2 * (16 * cb + 4 * p4);
#pragma unroll
    for (int kt = 0; kt < 8; ++kt) {
        if (!OWN || kt <= w) {
            f32x16 p = st[kt];
#pragma unroll
            for (int i = 0; i < 16; ++i) { p[i] = fexp2(p[i] - mx); ls += p[i]; }
#pragma unroll
            for (int s = 0; s < 2; ++s) {
                const f32x8 pv = {p[8 * s], p[8 * s + 1], p[8 * s + 2], p[8 * s + 3], p[8 * s + 4], p[8 * s + 5], p[8 * s + 6], p[8 * s + 7]};
                const h8 pf = __builtin_convertvector(pv, h8);
#pragma unroll
                for (int dt = 0; dt < 2; ++dt) {
                    LAS const unsigned char* vp = vbase + (32 * kt + 16 * s) * VP64 + 64 * dt;
                    const h8 vf = cat44(tr_read(vp), tr_read(vp + 8 * VP64));
                    o[dt] = MFMA32(vf, pf, o[dt]);
                }
            }
        }
    }
    ls += __shfl_xor(ls, 32);
    m2 = mx; lsum = ls;
}
template <int P>
DI void stage64(LAS unsigned char* dst, const f16* src, int src_ld, int tid) {
#pragma unroll
    for (int i = 0; i < 4; ++i) { const int q = tid + 512 * i, row = q >> 3, ch = q & 7; *(LAS h8*)(dst + row * P + 16 * ch) = *(const h8*)(src + (size_t)row * src_ld + 8 * ch); }
}

DI void own_scores(LAS const unsigned char* Kl, LAS const float* biasd, const h8 (&qf)[4], int ql, int kt, int w, int r, int hp, f32x16& a) {
#pragma unroll
    for (int i = 0; i < 16; ++i) a[i] = 0.f;
#pragma unroll
    for (int ks = 0; ks < 4; ++ks) { const h8 kf = *(const LAS h8*)(Kl + (32 * kt + r) * KP64 + 32 * ks + 16 * hp); a = MFMA32(kf, qf[ks], a); }
    const int delta = w - kt;
    if (delta >= 5) {
        const float b31 = biasd[31 + 160];
#pragma unroll
        for (int i = 0; i < 16; ++i) a[i] = a[i] * (0.125f * LOG2E) + b31;
    } else {
        const int base = ql - 32 * kt - 4 * hp;
        LAS const float* tp = biasd + (base + 4);
        if (delta == 0) {
#pragma unroll
            for (int i = 0; i < 16; ++i) { const int ci = (i & 3) + 8 * (i >> 2); const float v = a[i] * (0.125f * LOG2E) + tp[27 - ci]; a[i] = (base - ci < 0) ? -3.0e38f : v; }
        } else {
#pragma unroll
            for (int i = 0; i < 16; ++i) a[i] = a[i] * (0.125f * LOG2E) + tp[27 - ((i & 3) + 8 * (i >> 2))];
        }
    }
}
DI void attn_own(LAS const unsigned char* Kl, LAS const unsigned char* Vl, LAS const float* biasd, const h8 (&qf)[4], int ql, int w, int lane, float& m2, float& lsum, f32x16 (&o)[2]) {
    const int r = lane & 31, hp = lane >> 5;
    float mx = -3.0e38f;
#pragma unroll 2
    for (int kt = 0; kt <= w; ++kt) { f32x16 a; own_scores(Kl, biasd, qf, ql, kt, w, r, hp, a);
#pragma unroll
        for (int i = 0; i < 16; ++i) mx = fmaxf(mx, a[i]); }
    mx = fmaxf(mx, __shfl_xor(mx, 32));
    float ls = 0.f;
#pragma unroll
    for (int dt = 0; dt < 2; ++dt)
#pragma unroll
        for (int i = 0; i < 16; ++i) o[dt][i] = 0.f;
    const int i16 = lane & 15, q4 = i16 >> 2, p4 = i16 & 3, cb = (lane >> 4) & 1;
    LAS const unsigned char* vbase = Vl + (4 * hp + q4) * VP64 + 2 * (16 * cb + 4 * p4);
#pragma unroll 2
    for (int kt = 0; kt <= w; ++kt) {
        f32x16 p; own_scores(Kl, biasd, qf, ql, kt, w, r, hp, p);
#pragma unroll
        for (int i = 0; i < 16; ++i) { p[i] = fexp2(p[i] - mx); ls += p[i]; }
#pragma unroll
        for (int s = 0; s < 2; ++s) {
            const f32x8 pv = {p[8 * s], p[8 * s + 1], p[8 * s + 2], p[8 * s + 3], p[8 * s + 4], p[8 * s + 5], p[8 * s + 6], p[8 * s + 7]};
            const h8 pf = __builtin_convertvector(pv, h8);
#pragma unroll
            for (int dt = 0; dt < 2; ++dt) {
                LAS const unsigned char* vp = vbase + (32 * kt + 16 * s) * VP64 + 64 * dt;
                const h8 vf = cat44(tr_read(vp), tr_read(vp + 8 * VP64));
                o[dt] = MFMA32(vf, pf, o[dt]);
            }
        }
    }
    ls += __shfl_xor(ls, 32);
    m2 = mx; lsum = ls;
}
__global__ void __launch_bounds__(512, 2) fwd(Args a) {
    extern __shared__ __attribute__((aligned(16))) unsigned char smem[];
    LAS unsigned char* lds = (LAS unsigned char*)smem;
    volatile LAS unsigned* MISC = (volatile LAS unsigned*)(lds + MISC_OFF);
    LAS float* biasl = (LAS float*)(lds + BIAS_OFF);
    const int tid = threadIdx.x, lane = tid & 63, wave = __builtin_amdgcn_readfirstlane(tid >> 6);
    const int G = gridDim.x, bid = blockIdx.x;
    unsigned char* ws = a.ws;
    unsigned* ctl = (unsigned*)(ws + WS_CTL);
    float* ropeC = (float*)(ws + WS_ROPEC); float* ropeS = (float*)(ws + WS_ROPES); float* xsum = (float*)(ws + WS_XSUM);
    f16* kmean = (f16*)(ws + WS_KMEAN); f16* WrT = (f16*)(ws + WS_WRT); float* sumsq = (float*)(ws + WS_SUMSQ); float* wts = (float*)(ws + WS_WTS);
    int* elist = (int*)(ws + WS_ELIST); unsigned short* mlist = (unsigned short*)(ws + WS_MLIST); f32x2* pml = (f32x2*)(ws + WS_PML);
    f16* WinT = (f16*)(ws + WS_WINT); f16* WoT = (f16*)(ws + WS_WOT); f16* WguT = (f16*)(ws + WS_WGUT); f16* WdnT = (f16*)(ws + WS_WDNT);
    f16* PJ = (f16*)(ws + WS_PJ); f16* xh = (f16*)(ws + WS_XH); f16* cat = (f16*)(ws + WS_CAT); float* kvbuf = (float*)(ws + WS_KV); f16* Rbuf = (f16*)(ws + WS_R);
    f16* hh = (f16*)(ws + WS_HH); f16* hid = (f16*)(ws + WS_HID); f16* ybuf = (f16*)(ws + WS_Y);
    f16* pO = (f16*)a.out;
    f16* zbuf = (f16*)a.out;
    unsigned* lcnt = ctl + CW_LCNT; unsigned* ecnt = ctl + CW_ECNT;

    if (tid < 64) MISC[tid] = 0u;
    for (int idx = tid; idx < 8 * BTP; idx += 512) { const int h = idx / BTP, d = idx % BTP - 31, dd = d > 128 ? 128 : d; biasl[idx] = d < 0 ? 0.f : a.rel[(int)T5_BUCKET[dd] * 8 + h] * LOG2E; }
    __syncthreads();
    const int lo = a.ph_lo, hi = a.ph_hi;
    XcdBarrier bar; bar.bar = ctl + CW_BAR; bar.x = 0; bar.st = MISC + 8;
    if (hi - lo > 1) bar = xcd_barrier_post(ctl + CW_BAR, MISC + 8);
#ifndef PH_MASK
#define PH_MASK 0x3ff
#endif
#define IN(k) ((((PH_MASK) >> (k)) & 1) && lo <= (k) && (k) < hi)
#ifndef DUP_PHASE
#define DUP_PHASE -1
#endif
#define REP(k) for (int rep_ = 0; rep_ < ((DUP_PHASE) == (k) ? 2 : 1); ++rep_)
#ifdef PROF_SEG
#ifndef PROF_K
#define PROF_K 4
#endif
#ifndef PROF_WAVE
#define PROF_WAVE 0
#endif
    unsigned long long prof_acc = 0ull, prof_t0 = 0ull;
#ifndef PROF_BLOCK
#define PROF_BLOCK 0
#endif
    const bool prof_on = (bid == PROF_BLOCK && tid == 64 * PROF_WAVE);
#define PROF_B(seg) do { if ((seg) == PROF_SEG) { __builtin_amdgcn_sched_barrier(0); prof_t0 = __builtin_amdgcn_s_memrealtime(); __builtin_amdgcn_sched_barrier(0); } } while (0)
#define PROF_E(seg) do { if ((seg) == PROF_SEG) { __builtin_amdgcn_sched_barrier(0); prof_acc += __builtin_amdgcn_s_memrealtime() - prof_t0; __builtin_amdgcn_sched_barrier(0); } } while (0)
#else
#define PROF_B(seg) do { } while (0)
#define PROF_E(seg) do { } while (0)
#endif
#ifdef DIAG_PHASE
#ifndef DIAG_MODE
#define DIAG_MODE 0
#endif
    unsigned long long tdiag0 = 0ull;
#define DIAG_T0(k) do { if ((k) == DIAG_PHASE) tdiag0 = __builtin_amdgcn_s_memrealtime(); } while (0)
#define DIAG_T1(k, mode) do { if ((k) == DIAG_PHASE && (mode) == DIAG_MODE && bid == 0 && tid == 0) __hip_atomic_store(ctl + 24576, (unsigned)(__builtin_amdgcn_s_memrealtime() - tdiag0), __ATOMIC_RELAXED, __HIP_MEMORY_SCOPE_AGENT); } while (0)
#else
#define DIAG_T0(k) do { } while (0)
#define DIAG_T1(k, mode) do { } while (0)
#endif
#define SEAM(k) do { PROF_E(10 + (k)); PROF_B(20 + (k)); DIAG_T1(k, 1); if (IN(k) && IN((k) + 1)) xcd_barrier(bar); DIAG_T1(k, 0); DIAG_T0((k) + 1); PROF_E(20 + (k)); PROF_B(11 + (k)); } while (0)

    DIAG_T0(0); PROF_B(10);
    if (IN(0)) REP(0) {
        for (int hb = bid; hb < 256; hb += G) {
            const int c4 = tid & 255, rp = tid >> 8;
            const float* src = a.x + (size_t)hb * 128 * DM + c4 * 4; f16* dst = xh + (size_t)hb * 128 * DM + c4 * 4;
            f32x4 s = {0.f, 0.f, 0.f, 0.f};
#pragma unroll 8
            for (int r = rp; r < 128; r += 2) { const f32x4 v = *(const f32x4*)(src + (size_t)r * DM); s += v; *(h4*)(dst + (size_t)r * DM) = __builtin_convertvector(v, h4); }
            LAS f32x4* red = (LAS f32x4*)lds;
            if (rp == 1) red[c4] = s;
            __syncthreads();
            if (rp == 0) { s += red[c4]; *(f32x4*)(xsum + (size_t)hb * DM + c4 * 4) = s; }
            __syncthreads();
        }
        for (int idx = bid * 512 + tid; idx < SEQ * 64; idx += G * 512) {
            const int pos = idx >> 6, i = idx & 63;
            const float ang = (float)pos * ROPE_INV[i];
            const double xd = (double)ang, kd = __builtin_rint(xd * 0.6366197723675814);
            double rr = __builtin_fma(-kd, 1.5707963267948966, xd); rr = __builtin_fma(-kd, 6.123233995736766e-17, rr);
            const double r2 = rr * rr;
            const double sp = rr * (1.0 + r2 * (-1.0 / 6 + r2 * (1.0 / 120 + r2 * (-1.0 / 5040 + r2 * (1.0 / 362880 + r2 * (-1.0 / 39916800 + r2 * (1.0 / 6227020800.0)))))));
            const double cp = 1.0 + r2 * (-0.5 + r2 * (1.0 / 24 + r2 * (-1.0 / 720 + r2 * (1.0 / 40320 + r2 * (-1.0 / 3628800 + r2 * (1.0 / 479001600.0 + r2 * (-1.0 / 87178291200.0)))))));
            const int q = (int)kd & 3;
            const double sv = (q == 0) ? sp : (q == 1) ? cp : (q == 2) ? -sp : -cp;
            const double cv = (q == 0) ? cp : (q == 1) ? -sp : (q == 2) ? -cp : sp;
            ropeC[idx] = (float)cv; ropeS[idx] = (float)sv;
        }
        for (int idx = bid * 512 + tid; idx < 48 * DM; idx += G * 512) {
            const int n = idx >> 10, k = idx & 1023;
            const float v = (n < 4) ? a.wrg[k * 4 + n] : (n < 36) ? a.wre[k * 32 + (n - 4)] : 0.f;
            WrT[idx] = (f16)v;
        }
        {
            LAS float* scr = (LAS float*)(lds + wave * 16384);
            constexpr int I_IN = 16 * 112, I_O = 16 * 32, I_GU = 32 * 512, I_DN = 32 * 256, NIT = I_IN + I_O + I_GU + I_DN;
            for (int it = bid * 8 + wave; it < NIT; it += G * 8) {
                int r = it;
                if (r < I_IN) { const int kb = r / 112, nb = r % 112, pn = nb >> 3, g = nb & 7;
                    const int nsrc = (pn >= 6 && pn <= 9) ? pn * 256 + 128 * ((g >> 1) & 1) + 64 * (g >> 2) + 32 * (g & 1) : 32 * nb;
                    tr_item(a.w_in, NPJ, 64 * kb, nsrc, WinT, DM, 32 * nb, nullptr, scr, lane); continue; } r -= I_IN;
                if (r < I_O) { const int kb = r / 32, nb = r % 32; tr_item(a.w_out, DM, 64 * kb, 32 * nb, WoT, DM, 32 * nb, kb < 8 ? a.gain : nullptr, scr, lane); continue; } r -= I_O;
                if (r < I_GU) { const int e = r >> 9, rr = r & 511, kb = rr >> 5, nb = rr & 31, pn = nb >> 3, g = nb & 7;
                    const int nsrc = (g >> 2) * 512 + 128 * pn + 32 * (g & 3);
                    tr_item(a.wgu + (size_t)e * DM * DM, DM, 64 * kb, nsrc, WguT + (size_t)e * DM * DM, DM, 32 * nb, nullptr, scr, lane); continue; } r -= I_GU;
                { const int e = r >> 8, rr = r & 255, kb = rr >> 5, nb = rr & 31;
                    tr_item(a.wdn + (size_t)e * DE * DM, DM, 64 * kb, 32 * nb, WdnT + (size_t)e * DM * DE, DE, 32 * nb, nullptr, scr, lane); }
            }
        }
        __syncthreads();
    }
    SEAM(0);

    if (IN(1)) {
        REP(11) for (int job = bid; job < 256; job += G) {
            const int blk = job >> 1, ch = job & 1;
            LAS float* xm = (LAS float*)lds;
            for (int k = tid; k < DM; k += 512) xm[k] = (xsum[(size_t)(2 * blk) * DM + k] + xsum[(size_t)(2 * blk + 1) * DM + k]) * (1.0f / 256.0f);
            __syncthreads();
            const int col = tid & 255, kh = tid >> 8;
            const float* wp = a.w_in + (size_t)(kh * 512) * NPJ + C_AK + ch * 256 + col;
            float acc = 0.f;
#pragma unroll 8
            for (int k = 0; k < 512; ++k) acc += xm[kh * 512 + k] * wp[(size_t)k * NPJ];
            LAS float* red = xm + 1024;
            if (kh) red[col] = acc;
            __syncthreads();
            if (!kh) { acc += red[col]; const int c = ch * 256 + col, h = c >> 6, d = c & 63, b = blk >> 6, j = blk & 63; kmean[((size_t)(b * 8 + h) * 64 + j) * 64 + d] = (f16)acc; }
            __syncthreads();
        }
        pg8::StaticOrder S; S.init(xh, WinT, DM, DM, NTOK, NPJ, G, bid);
        EpiProj E{PJ, ropeC, ropeS};
        pg8::gemm_phase<EpiProj, pg8::StaticOrder, true>(lds, DM, DM / 64, S, E);
        if (DUP_PHASE == 1) pg8::gemm_phase<EpiProj, pg8::StaticOrder, true>(lds, DM, DM / 64, S, E);
    }
    SEAM(1);

    if (IN(2)) REP(2) {
        constexpr int NU_G = 16 * 63, NU_KV = 8 * 64;
        unsigned* lcnt_w = (rep_ | a.alt) ? ctl + 16384 : lcnt; unsigned short* mlist_w = (rep_ | a.alt) ? (unsigned short*)(ws + 480 * MiB) : mlist;
        for (int u = bid; u < NU_G + NU_KV; u += G) {
            if (u < NU_KV) {
                const int bh = u >> 6, ci = u & 63, b = bh >> 2, h = bh & 3;
                const float lg = gamma_log2(h);
                const f16* kp = ret_ptr(PJ, 4, bh, ci * 256);
                const f16* vp = ret_ptr(PJ, 5, bh, ci * 256);
                LAS unsigned char* Kl = lds; LAS unsigned char* Vl = lds + 128 * 320;
                const int dvt = wave & 3, dk0 = 2 * (wave >> 2);
                f32x16 acc[2];
#pragma unroll
                for (int t = 0; t < 2; ++t)
#pragma unroll
                    for (int i = 0; i < 16; ++i) acc[t][i] = 0.f;
                const int r = lane & 31, hp = lane >> 5, i16 = lane & 15, q4 = i16 >> 2, p4 = i16 & 3, cb = (lane >> 4) & 1;
                for (int half = 0; half < 2; ++half) {
#pragma unroll
                    for (int i = 0; i < 4; ++i) { const int q = tid + 512 * i, row = q >> 4, ch = q & 15; const int key = half * 128 + row;
                        const h8 kv = *(const h8*)(kp + (size_t)key * 128 + 8 * ch); const float sc = fexp2(lg * (float)(255 - key));
                        const f32x8 kf = __builtin_convertvector(kv, f32x8) * sc;
                        *(LAS h8*)(Kl + row * 320 + 16 * ch) = __builtin_convertvector(kf, h8);
                        *(LAS h8*)(Vl + row * 320 + 16 * ch) = *(const h8*)(vp + (size_t)key * 128 + 8 * ch); }
                    __syncthreads();
#pragma unroll
                    for (int s = 0; s < 8; ++s) {
                        LAS const unsigned char* ap = Vl + (16 * s + 8 * hp + q4) * 320 + 2 * (32 * dvt + 16 * cb + 4 * p4);
                        const h8 af = cat44(tr_read(ap), tr_read(ap + 4 * 320));
#pragma unroll
                        for (int t = 0; t < 2; ++t) {
                            LAS const unsigned char* bp = Kl + (16 * s + 8 * hp + q4) * 320 + 2 * (32 * (dk0 + t) + 16 * cb + 4 * p4);
                            const h8 bf = cat44(tr_read(bp), tr_read(bp + 4 * 320));
                            acc[t] = MFMA32(af, bf, acc[t]);
                        }
                    }
                    __syncthreads();
                }
                float* dst = kvbuf + (size_t)u * 128 * 128;
#pragma unroll
                for (int t = 0; t < 2; ++t)
#pragma unroll
                    for (int i = 0; i < 16; ++i) dst[(32 * dvt + crow(i, hp)) * 128 + 32 * (dk0 + t) + r] = acc[t][i];
            } else {
                const int uu = u - NU_KV, bh = uu / 63, c = 1 + uu % 63, b = bh >> 3, h = bh & 7;
                const int r = lane & 31, hp = lane >> 5;
                const int s = 256 * c + 32 * wave + r;
                const f16* qrow = att_ptr(PJ, 0, bh, s);
                h8 qf[4];
#pragma unroll
                for (int ks = 0; ks < 4; ++ks) qf[ks] = *(const h8*)(qrow + 16 * ks + 8 * hp);
                const f16* km = kmean + (size_t)bh * 64 * 64;
                float v[2][16];
#pragma unroll
                for (int t = 0; t < 2; ++t) {
                    f32x16 g;
#pragma unroll
                    for (int i = 0; i < 16; ++i) g[i] = 0.f;
                    if (t == 0 || c > 32) {
#pragma unroll
                        for (int ks = 0; ks < 4; ++ks) { const h8 kf = *(const h8*)(km + (32 * t + r) * 64 + 16 * ks + 8 * hp); g = MFMA32(kf, qf[ks], g); }
                    }
#pragma unroll
                    for (int i = 0; i < 16; ++i) v[t][i] = (32 * t + crow(i, hp) < c) ? g[i] : -3.0e38f;
                }
                int sel[3]; bool sval[3];
#pragma unroll
                for (int rd = 0; rd < 3; ++rd) {
                    float mv = -3.0e38f; int mi = 1 << 20;
#pragma unroll
                    for (int t = 0; t < 2; ++t)
#pragma unroll
                        for (int i = 0; i < 16; ++i) { const int idx = 32 * t + crow(i, hp); const float val = v[t][i]; if (val > mv || (val == mv && idx < mi)) { mv = val; mi = idx; } }
                    const float ov = __shfl_xor(mv, 32); const int oi = __shfl_xor(mi, 32);
                    if (ov > mv || (ov == mv && oi < mi)) { mv = ov; mi = oi; }
                    sel[rd] = mi; sval[rd] = mv > -1.0e38f;
#pragma unroll
                    for (int t = 0; t < 2; ++t)
#pragma unroll
                        for (int i = 0; i < 16; ++i) if (32 * t + crow(i, hp) == mi) v[t][i] = -3.0e38f;
                }
                LAS unsigned* hist = (LAS unsigned*)(lds + 96 * 1024);
                if (tid < 64) hist[tid] = 0u;
                __syncthreads();
                unsigned rank[3];
#pragma unroll
                for (int rd = 0; rd < 3; ++rd) { rank[rd] = 0u; if (sval[rd] && hp == 0) rank[rd] = __hip_atomic_fetch_add(hist + sel[rd], 1u, __ATOMIC_RELAXED, __HIP_MEMORY_SCOPE_WORKGROUP); }
                __syncthreads();
                if (tid < 64) { const unsigned n = hist[tid]; unsigned base = 0u; if (n) base = atomicAdd(lcnt_w + bh * 64 + tid, n); hist[64 + tid] = base; }
                __syncthreads();
#pragma unroll
                for (int rd = 0; rd < 3; ++rd) if (sval[rd] && hp == 0) { const int lb = sel[rd]; const unsigned pos = hist[64 + lb] + rank[rd];
                    mlist_w[(size_t)bh * MLIST_PER_BH + (size_t)lb * SEQ - 128 * lb * (lb + 1) + pos] = (unsigned short)((s << 2) | rd); }
            }
        }
    }
    SEAM(2);

    if (IN(3)) REP(3) {
        PROF_B(33);
        if (!(a.alt & 2)) for (int gid = bid * 512 + tid; gid < 8 * 16384; gid += G * 512) {
            const int bh = gid >> 14, e = gid & 16383, h = bh & 3;
            const float cd = fexp2(256.0f * gamma_log2(h));
            const float* src = kvbuf + (size_t)bh * 64 * 16384 + e; f16* dst = Rbuf + (size_t)bh * 64 * 16384 + e;
            float run = 0.f;
#pragma unroll 8
            for (int i = 0; i < 64; ++i) { dst[(size_t)i * 16384] = (f16)run; run = run * cd + src[(size_t)i * 16384]; }
        }
        PROF_E(33); PROF_B(32);
        LAS int* pre = (LAS int*)(lds + 96 * 1024);
        LAS int* cpre = pre + 1032;
        LAS int* wsum = cpre + 1032;
        {
            const int c0 = (int)lcnt[2 * tid], c1 = (int)lcnt[2 * tid + 1];
            const int n0 = (c0 + 255) >> 8, n1 = (c1 + 255) >> 8;
            const int k0 = n0 ? 5 * n0 + 3 : 0, k1 = n1 ? 5 * n1 + 3 : 0;
            int v = n0 + n1, incl = v, cv = k0 + k1, cincl = cv;
#pragma unroll
            for (int o = 1; o < 64; o <<= 1) { const int t = __shfl_up(incl, o), ct = __shfl_up(cincl, o); if (lane >= o) { incl += t; cincl += ct; } }
            if (lane == 63) { wsum[wave] = incl; wsum[8 + wave] = cincl; }
            __syncthreads();
            int woff = 0, cwoff = 0;
            for (int k = 0; k < wave; ++k) { woff += wsum[k]; cwoff += wsum[8 + k]; }
            const int ex = woff + incl - v, cex = cwoff + cincl - cv;
            pre[2 * tid] = ex; pre[2 * tid + 1] = ex + n0; cpre[2 * tid] = cex; cpre[2 * tid + 1] = cex + k0;
            if (tid == 511) { pre[1024] = ex + v; cpre[1024] = cex + cv; }
            __syncthreads();
        }
        PROF_E(32);
        const int U = pre[1024], CT = cpre[1024];
        int ubnd[2];
#pragma unroll
        for (int e = 0; e < 2; ++e) {
            const int x = (int)(((long)CT * (bid + e)) / G);
            int l = 0;
#pragma unroll 1
            for (int step = 512; step > 0; step >>= 1) if (l + step <= 1023 && cpre[l + step] <= x) l += step;
            const int rem = x - cpre[l], n = pre[l + 1] - pre[l];
            int ch = rem <= 0 ? 0 : (rem - 3 + 4) / 5; ch = (rem > 0 && ch < 1) ? 1 : ch; ch = ch > n ? n : ch;
            ubnd[e] = (x >= CT) ? U : pre[l] + ch;
        }
        const int u_lo = ubnd[0], u_hi = (a.alt & 4) ? u_lo : ubnd[1];
        LAS unsigned char* Kl = lds; LAS unsigned char* Vl = lds + 256 * KP64;
        constexpr int NUB = 32;
        LAS int* uinf = (LAS int*)(lds + 108 * 1024);
        LAS unsigned short* uent = (LAS unsigned short*)(lds + 112 * 1024);
        int staged = -1;
        const int r = lane & 31, hp = lane >> 5;
        for (int ub = u_lo; ub < u_hi; ub += NUB) {
            const int nu = (u_hi - ub) < NUB ? (u_hi - ub) : NUB;
            __syncthreads();
            if (tid < nu) { const int u = ub + tid; int l = 0;
#pragma unroll 1
                for (int step = 512; step > 0; step >>= 1) if (l + step <= 1023 && pre[l + step] <= u) l += step;
                const int chunk = u - pre[l]; int rows = (int)lcnt[l] - 256 * chunk; rows = rows > 256 ? 256 : rows;
                uinf[4 * tid] = l; uinf[4 * tid + 1] = chunk; uinf[4 * tid + 2] = rows; }
            __syncthreads();
            for (int i = tid >> 8; i < nu; i += 2) { const int l = uinf[4 * i], chunk = uinf[4 * i + 1], rows = uinf[4 * i + 2], ri = tid & 255, bh = l >> 6, j = l & 63;
                uent[i * 256 + ri] = mlist[(size_t)bh * MLIST_PER_BH + (size_t)j * SEQ - 128 * j * (j + 1) + 256 * chunk + (ri < rows ? ri : 0)]; }
            __syncthreads();
            h8 qn[4];
            { const int l = uinf[0], bh = l >> 6; const unsigned ent = uent[32 * wave + r]; const int s = (int)(ent >> 2);
              const f16* qrow = att_ptr(PJ, 0, bh, s);
#pragma unroll
              for (int ks = 0; ks < 4; ++ks) qn[ks] = *(const h8*)(qrow + 16 * ks + 8 * hp); }
            for (int i = 0; i < nu; ++i) {
                const int l = uinf[4 * i], rows = uinf[4 * i + 2], bh = l >> 6, j = l & 63, b = bh >> 3, h = bh & 7;
                const unsigned ent = uent[i * 256 + 32 * wave + r];
                h8 qf[4];
#pragma unroll
                for (int ks = 0; ks < 4; ++ks) qf[ks] = qn[ks];
                if (i + 1 < nu) { const int l2 = uinf[4 * (i + 1)], bh2 = l2 >> 6; const unsigned e2 = uent[(i + 1) * 256 + 32 * wave + r]; const int s2 = (int)(e2 >> 2);
                    const f16* qrow = att_ptr(PJ, 0, bh2, s2);
#pragma unroll
                    for (int ks = 0; ks < 4; ++ks) qn[ks] = *(const h8*)(qrow + 16 * ks + 8 * hp); }
                PROF_B(30);
                if (l != staged) {
                    __syncthreads();
                    stage64<KP64>(Kl, att_ptr(PJ, 1, bh, j * 256), 64, tid);
                    stage64<VP64>(Vl, att_ptr(PJ, 2, bh, j * 256), 64, tid);
                    __syncthreads();
                    staged = l;
                }
                PROF_E(30); PROF_B(31);
                if (32 * wave < rows) {
                    const bool valid = 32 * wave + r < rows;
                    const int s = (int)(ent >> 2), slot = (int)(ent & 3u);
                    float m2, ls; f32x16 o[2];
                    attn_tile<false>(Kl, Vl, biasl + h * BTP, qf, s - 256 * j, 0, lane, m2, ls, o);
                    if (valid) {
                        const size_t pidx = ((size_t)bh * SEQ + s) * 3 + slot;
                        if (hp == 0) pml[pidx] = (f32x2){m2, ls};
                        const float inv = 1.0f / ls; f16* po = pO + pidx * 64 + 32 * hp;
#pragma unroll
                        for (int dt = 0; dt < 2; ++dt)
#pragma unroll
                            for (int g2 = 0; g2 < 2; ++g2) { const f32x8 vv = {o[dt][8 * g2] * inv, o[dt][8 * g2 + 1] * inv, o[dt][8 * g2 + 2] * inv, o[dt][8 * g2 + 3] * inv, o[dt][8 * g2 + 4] * inv, o[dt][8 * g2 + 5] * inv, o[dt][8 * g2 + 6] * inv, o[dt][8 * g2 + 7] * inv};
                                *(h8*)(po + 16 * dt + 8 * g2) = __builtin_convertvector(vv, h8); }
                    }
                }
                PROF_E(31);
            }
        }
        __syncthreads();
    }
    SEAM(3);

    if (IN(4)) REP(4) {
        constexpr int NU_A = 16 * 64, NU_R = 8 * 64;
        for (int u = (a.alt & 2) ? NU_R : bid; u < NU_R; u += G) {
            __syncthreads();
            {
                const int bh = u >> 6, ci = u & 63, b = bh >> 2, h = bh & 3;
                const float lg = gamma_log2(h);
                const size_t row0 = (size_t)b * SEQ + ci * 256;
                LAS unsigned char* Kl = lds; LAS unsigned char* Vl = lds + 256 * 272;
                PROF_B(40);
                const int r = lane & 31, hp = lane >> 5, i16 = lane & 15, q4 = i16 >> 2, p4 = i16 & 3, cb = (lane >> 4) & 1;
                const int qt = wave < 4 ? wave : 11 - wave;
                const int ql = 32 * qt + r;
#pragma unroll
                for (int i = 0; i < 8; ++i) { const int q = tid + 512 * i, row = q >> 4, ch = q & 15;
                    *(LAS h8*)(Kl + row * 272 + 16 * ch) = *(const h8*)(ret_ptr(PJ, 4, bh, ci * 256 + row) + 8 * ch);
                    *(LAS h8*)(Vl + row * 320 + 16 * ch) = *(const h8*)(ret_ptr(PJ, 5, bh, ci * 256 + row) + 8 * ch); }
                __syncthreads();
                PROF_E(40); PROF_B(41);
                const f16* qrow = ret_ptr(PJ, 3, bh, ci * 256 + ql);
                h8 qf[8];
#pragma unroll
                for (int ks = 0; ks < 8; ++ks) qf[ks] = *(const h8*)(qrow + 16 * ks + 8 * hp);
                f32x16 o[4];
#pragma unroll
                for (int t = 0; t < 4; ++t)
#pragma unroll
                    for (int i = 0; i < 16; ++i) o[t][i] = 0.f;
                const f16* Rt = Rbuf + (size_t)u * 128 * 128;
#pragma unroll
                for (int t = 0; t < 4; ++t)
#pragma unroll
                    for (int ks = 0; ks < 8; ++ks) { const h8 rf = *(const h8*)(Rt + (32 * t + r) * 128 + 16 * ks + 8 * hp); o[t] = MFMA32(rf, qf[ks], o[t]); }
                const f16* grow = ret_ptr(PJ, 6, bh, ci * 256 + ql);
                h4 rgv[16];
#pragma unroll
                for (int g = 0; g < 16; ++g) rgv[g] = *(const h4*)(grow + 8 * g + 4 * hp);
                const float qd = fexp2(lg * (float)(ql + 1));
#pragma unroll
                for (int t = 0; t < 4; ++t)
#pragma unroll
                    for (int i = 0; i < 16; ++i) o[t][i] *= qd;
                PROF_E(41); PROF_B(42);
                LAS const unsigned char* vbase = Vl + (4 * hp + q4) * 320 + 2 * (16 * cb + 4 * p4);
                for (int kt = 0; kt <= qt; ++kt) {
                    f32x16 st;
#pragma unroll
                    for (int i = 0; i < 16; ++i) st[i] = 0.f;
#pragma unroll
                    for (int ks = 0; ks < 8; ++ks) { const h8 kf = *(const LAS h8*)(Kl + (32 * kt + r) * 272 + 32 * ks + 16 * hp); st = MFMA32(kf, qf[ks], st); }
#pragma unroll
                    for (int i = 0; i < 16; ++i) { const int dist = ql - (32 * kt + crow(i, hp)); st[i] = dist >= 0 ? st[i] * fexp2(lg * (float)dist) : 0.f; }
#pragma unroll
                    for (int s = 0; s < 2; ++s) {
                        const f32x8 pv = {st[8 * s], st[8 * s + 1], st[8 * s + 2], st[8 * s + 3], st[8 * s + 4], st[8 * s + 5], st[8 * s + 6], st[8 * s + 7]};
                        const h8 pf = __builtin_convertvector(pv, h8);
#pragma unroll
                        for (int t = 0; t < 4; ++t) {
                            LAS const unsigned char* vp = vbase + (32 * kt + 16 * s) * 320 + 64 * t;
                            const h8 vf = cat44(tr_read(vp), tr_read(vp + 8 * 320));
                            o[t] = MFMA32(vf, pf, o[t]);
                        }
                    }
                }
                PROF_E(42); PROF_B(43);
                float sm = 0.f;
#pragma unroll
                for (int t = 0; t < 4; ++t)
#pragma unroll
                    for (int i = 0; i < 16; ++i) sm += o[t][i];
                sm += __shfl_xor(sm, 32);
                const float mu = sm * (1.0f / 128.0f);
                float sq = 0.f;
#pragma unroll
                for (int t = 0; t < 4; ++t)
#pragma unroll
                    for (int i = 0; i < 16; ++i) { const float d = o[t][i] - mu; sq += d * d; }
                sq += __shfl_xor(sq, 32);
                const float rstd = 1.0f / sqrtf(sq * (1.0f / 128.0f) + LN_EPS);
                f16* crow_ = cat + (row0 + ql) * DM + 512 + h * 128;
#pragma unroll
                for (int t = 0; t < 4; ++t)
#pragma unroll
                    for (int g = 0; g < 4; ++g) { const int d0 = 32 * t + 8 * g + 4 * hp;
                        const h4 gv = rgv[4 * t + g]; f32x4 ov;
#pragma unroll
                        for (int e = 0; e < 4; ++e) { const float gg = (float)gv[e]; const float sl = gg / (1.0f + fexp2(-gg * LOG2E)); ov[e] = sl * (o[t][4 * g + e] - mu) * rstd; }
                        *(h4*)(crow_ + d0) = __builtin_convertvector(ov, h4); }
                PROF_E(43);
            }
        }
        {
            LAS unsigned char* Kl = lds; LAS unsigned char* Vl = lds + 256 * KP64;
            const int r = lane & 31, hp = lane >> 5;
            h8 kr[4], vr[4], qn[4];
            const int qt = wave < 4 ? wave : 11 - wave;
            int uu = (a.alt & 4) ? NU_A : bid;
            if (uu < NU_A) { const int bh = uu >> 6, c = uu & 63; const f16* kp = att_ptr(PJ, 1, bh, c * 256);
                { const f16* qrow = att_ptr(PJ, 0, bh, 256 * c + 32 * qt + r);
#pragma unroll
                  for (int ks = 0; ks < 4; ++ks) qn[ks] = *(const h8*)(qrow + 16 * ks + 8 * hp); }
#pragma unroll
                for (int i = 0; i < 4; ++i) { const int q = tid + 512 * i, row = q >> 3, ch = q & 7; kr[i] = *(const h8*)(kp + (size_t)row * 64 + 8 * ch); vr[i] = *(const h8*)(kp + PJ_SLICE + (size_t)row * 64 + 8 * ch); } }
            for (; uu < NU_A; uu += G) {
                const int bh = uu >> 6, c = uu & 63, b = bh >> 3, h = bh & 7;
                PROF_B(44);
                __syncthreads();
#pragma unroll
                for (int i = 0; i < 4; ++i) { const int q = tid + 512 * i, row = q >> 3, ch = q & 7; *(LAS h8*)(Kl + row * KP64 + 16 * ch) = kr[i]; *(LAS h8*)(Vl + row * VP64 + 16 * ch) = vr[i]; }
                __syncthreads();
                h8 qf[4];
#pragma unroll
                for (int ks = 0; ks < 4; ++ks) qf[ks] = qn[ks];
                if (uu + G < NU_A) { const int u2 = uu + G, bh2 = u2 >> 6, c2 = u2 & 63; const f16* kp = att_ptr(PJ, 1, bh2, c2 * 256);
                    { const f16* qrow = att_ptr(PJ, 0, bh2, 256 * c2 + 32 * qt + r);
#pragma unroll
                      for (int ks = 0; ks < 4; ++ks) qn[ks] = *(const h8*)(qrow + 16 * ks + 8 * hp); }
#pragma unroll
                    for (int i = 0; i < 4; ++i) { const int q = tid + 512 * i, row = q >> 3, ch = q & 7; kr[i] = *(const h8*)(kp + (size_t)row * 64 + 8 * ch); vr[i] = *(const h8*)(kp + PJ_SLICE + (size_t)row * 64 + 8 * ch); } }
                const int ql = 32 * qt + r, s = 256 * c + ql;
                const int nsel = c < 3 ? c : 3;
                const size_t pidx = ((size_t)bh * SEQ + s) * 3;
                float pm[3], pl[3]; h8 pv[3][4];
#pragma unroll
                for (int t = 0; t < 3; ++t) { const f32x2 v = pml[pidx + t]; pm[t] = v[0]; pl[t] = v[1]; const f16* po = pO + (pidx + t) * 64 + 32 * hp;
#pragma unroll
                    for (int k = 0; k < 4; ++k) pv[t][k] = *(const h8*)(po + 8 * k); }
                PROF_E(44); PROF_B(45);
                float m2, ls; f32x16 o[2];
                attn_own(Kl, Vl, biasl + h * BTP, qf, ql, qt, lane, m2, ls, o);
                PROF_E(45); PROF_B(46);
#pragma unroll
                for (int t = 0; t < 3; ++t) { const bool ok = t < nsel; pm[t] = ok ? pm[t] : -3.0e38f; pl[t] = ok ? pl[t] : 0.f;
#pragma unroll
                    for (int k = 0; k < 4; ++k) pv[t][k] = ok ? pv[t][k] : (h8){0, 0, 0, 0, 0, 0, 0, 0}; }
                float M = m2;
#pragma unroll
                for (int t = 0; t < 3; ++t) M = fmaxf(M, pm[t]);
                const float e0 = fexp2(m2 - M); float L = ls * e0;
#pragma unroll
                for (int dt = 0; dt < 2; ++dt)
#pragma unroll
                    for (int i = 0; i < 16; ++i) o[dt][i] *= e0;
#pragma unroll
                for (int t = 0; t < 3; ++t) { const float wt = pl[t] * fexp2(pm[t] - M); L += wt;
#pragma unroll
                    for (int k = 0; k < 4; ++k)
#pragma unroll
                        for (int e = 0; e < 8; ++e) o[k >> 1][8 * (k & 1) + e] += wt * (float)pv[t][k][e]; }
                const float invL = 1.0f / L; float sq = 0.f;
                f16* crow_ = cat + (size_t)(b * SEQ + s) * DM + h * 64;
#pragma unroll
                for (int dt = 0; dt < 2; ++dt)
#pragma unroll
                    for (int g = 0; g < 4; ++g) { f32x4 ov;
#pragma unroll
                        for (int e = 0; e < 4; ++e) { ov[e] = o[dt][4 * g + e] * invL; sq += ov[e] * ov[e]; }
                        *(h4*)(crow_ + 32 * dt + 8 * g + 4 * hp) = __builtin_convertvector(ov, h4); }
                sq += __shfl_xor(sq, 32);
                if (hp == 0) sumsq[(size_t)(b * SEQ + s) * 8 + h] = sq;
                PROF_E(46);
            }
        }
        __syncthreads();
    }
    SEAM(4);

    if (IN(5)) {
        pg8::StaticOrder S; S.init(cat, WoT, DM, DM, NTOK, DM, G, bid);
        EpiZ E{a.x, zbuf, sumsq};
        pg8::gemm_phase<EpiZ, pg8::StaticOrder, true>(lds, DM, DM / 64, S, E);
    }
    SEAM(5);

    if (IN(6)) REP(6) {
        unsigned* ecnt_w = (rep_ | a.alt) ? ecnt + 32 : ecnt; int* elist_w = (rep_ | a.alt) ? (int*)(ws + 496 * MiB) : elist; float* wts_w = (rep_ | a.alt) ? (float*)(ws + 500 * MiB) : wts;
        LAS unsigned char* Ht = lds;
        LAS float* lg = (LAS float*)(lds + 32 * 2064);
        f32x8 gv[2], bv[2];
#pragma unroll
        for (int j = 0; j < 2; ++j) { gv[j] = *(const f32x8*)(a.ln1g + 8 * lane + 512 * j); bv[j] = *(const f32x8*)(a.ln1b + 8 * lane + 512 * j); }
        for (int u = bid; u < NTOK / 32; u += G) {
            __syncthreads();
            h8 zin[4][2];
#pragma unroll
            for (int rr = 0; rr < 4; ++rr)
#pragma unroll
                for (int j = 0; j < 2; ++j) zin[rr][j] = *(const h8*)(zbuf + ((size_t)u * 32 + 4 * wave + rr) * DM + 8 * lane + 512 * j);
#pragma unroll
            for (int rr = 0; rr < 4; ++rr) {
                const int rl = 4 * wave + rr; const size_t row = (size_t)u * 32 + rl;
                f32x8 v[2]; float s = 0.f;
#pragma unroll
                for (int j = 0; j < 2; ++j) { v[j] = __builtin_convertvector(zin[rr][j], f32x8);
#pragma unroll
                    for (int e = 0; e < 8; ++e) s += v[j][e]; }
                const float mean = wave_sum(s) * (1.0f / DM); float s2 = 0.f;
#pragma unroll
                for (int j = 0; j < 2; ++j) { v[j] = v[j] - mean;
#pragma unroll
                    for (int e = 0; e < 8; ++e) s2 += v[j][e] * v[j][e]; }
                const float rstd = 1.0f / sqrtf(wave_sum(s2) * (1.0f / DM) + LN_EPS);
#pragma unroll
                for (int j = 0; j < 2; ++j) { const h8 hv = __builtin_convertvector(v[j] * rstd * gv[j] + bv[j], h8);
                    *(h8*)(hh + row * DM + 8 * lane + 512 * j) = hv; *(LAS h8*)(Ht + rl * 2064 + 2 * (8 * lane + 512 * j)) = hv; }
            }
            __syncthreads();
            if (wave < 6) {
                const int rt = wave / 3, ct = wave % 3, fr = lane & 15, fq = lane >> 4;
                f32x4 acc = {0.f, 0.f, 0.f, 0.f};
#pragma unroll 8
                for (int ks = 0; ks < 32; ++ks) { const h8 af = *(const LAS h8*)(Ht + (16 * rt + fr) * 2064 + 2 * (32 * ks + 8 * fq));
                    const h8 bf = *(const h8*)(WrT + (size_t)(16 * ct + fr) * DM + 32 * ks + 8 * fq); acc = MFMA16(af, bf, acc); }
#pragma unroll
                for (int e = 0; e < 4; ++e) lg[(16 * rt + 4 * fq + e) * 48 + 16 * ct + fr] = acc[e];
            }
            __syncthreads();
            if (tid < 32) {
                LAS unsigned* eh = (LAS unsigned*)(lds + 80 * 1024);
                eh[tid] = 0u;
                const int tok = u * 32 + tid; LAS const float* L = lg + tid * 48;
                float g4[4]; int gi = 0; float gm = -3.0e38f;
#pragma unroll
                for (int k = 0; k < 4; ++k) { g4[k] = L[k] + a.brg[k]; if (g4[k] > gm) { gm = g4[k]; gi = k; } }
                float gs = 0.f;
#pragma unroll
                for (int k = 0; k < 4; ++k) gs += __expf(g4[k] - gm);
                const float gp = 1.0f / gs;
                float l1 = -3.0e38f, l2 = -3.0e38f; int i1 = 0, i2 = 0;
                for (int k = 0; k < 8; ++k) { const float v = L[4 + 8 * gi + k] + a.bre[8 * gi + k]; if (v > l1) { l2 = l1; i2 = i1; l1 = v; i1 = k; } else if (v > l2) { l2 = v; i2 = k; } }
                const float w1 = 1.0f / (1.0f + __expf(l2 - l1)), w2 = 1.0f - w1;
                const int e1 = 8 * gi + i1, e2 = 8 * gi + i2;
                LDS_WAIT();
                const unsigned r1 = __hip_atomic_fetch_add(eh + e1, 1u, __ATOMIC_RELAXED, __HIP_MEMORY_SCOPE_WORKGROUP);
                const unsigned r2 = __hip_atomic_fetch_add(eh + e2, 1u, __ATOMIC_RELAXED, __HIP_MEMORY_SCOPE_WORKGROUP);
                LDS_WAIT();
                { const unsigned n = eh[tid]; unsigned base = 0u; if (n) base = atomicAdd(ecnt_w + tid * 64, n); eh[32 + tid] = base; }
                LDS_WAIT();
                const unsigned p1 = eh[32 + e1] + r1, p2 = eh[32 + e2] + r2;
                elist_w[e1 * NTOK + (int)p1] = tok * 2; elist_w[e2 * NTOK + (int)p2] = tok * 2 + 1;
                wts_w[tok * 2] = gp * w1; wts_w[tok * 2 + 1] = gp * w2;
            }
        }
        __syncthreads();
    }
    SEAM(6);

    LAS int* mtab = (LAS int*)(lds + pg8::STAGE_BYTES + 1024);
    if (IN(7) || IN(8)) {
        if (tid == 0) { int acc = 0; for (int e = 0; e < 32; ++e) { const int c = (int)ecnt[e * 64]; mtab[e] = c; mtab[32 + e] = acc; acc += (c + 255) >> 8; } mtab[64] = acc; }
        __syncthreads();
    }
    if (IN(7)) {
        MoeSched S{mtab, elist, (const char*)hh, (const char*)WguT, (size_t)DM * DM * 2, DM, DM, G, bid, true};
        EpiGU E{hid};
        pg8::gemm_phase<EpiGU, MoeSched, true>(lds, DM, DM / 64, S, E);
        if (DUP_PHASE == 7) pg8::gemm_phase<EpiGU, MoeSched, true>(lds, DM, DM / 64, S, E);
    }
    SEAM(7);
    if (IN(8)) {
        MoeSched S{mtab, elist, (const char*)hid, (const char*)WdnT, (size_t)DM * DE * 2, DE, DE, G, bid, false};
        EpiDown E{ybuf, elist, wts, mtab};
        pg8::gemm_phase<EpiDown, MoeSched, true>(lds, DE, DE / 64, S, E);
        if (DUP_PHASE == 8) pg8::gemm_phase<EpiDown, MoeSched, true>(lds, DE, DE / 64, S, E);
    }
    SEAM(8);

#ifdef DIAG_PHASE
    if (IN(9)) { xcd_barrier(bar); const float cval = sqrtf((float)__hip_atomic_load(ctl + 24576, __ATOMIC_RELAXED, __HIP_MEMORY_SCOPE_AGENT) * 0.01f);
        for (size_t i = (size_t)bid * 512 + tid; i < (size_t)NTOK * DM / 4; i += (size_t)G * 512) ((f32x4*)a.out)[i] = (f32x4){cval, cval, cval, cval}; }
    if (false) {
#else
    if (IN(9)) REP(9) {
#endif
        f32x4 gv[4], bv[4];
#pragma unroll
        for (int j = 0; j < 4; ++j) { gv[j] = *(const f32x4*)(a.ln2g + 4 * lane + 256 * j); bv[j] = *(const f32x4*)(a.ln2b + 4 * lane + 256 * j); }
        for (int row = bid * 8 + wave; row < NTOK; row += G * 8) {
            f32x4 v[4]; float s = 0.f;
#pragma unroll
            for (int j = 0; j < 4; ++j) { const size_t c = 4 * lane + 256 * j;
                const f32x4 hv = __builtin_convertvector(*(const h4*)(hh + (size_t)row * DM + c), f32x4);
                const f32x4 y0 = __builtin_convertvector(*(const h4*)(ybuf + (size_t)(2 * row) * DM + c), f32x4);
                const f32x4 y1 = __builtin_convertvector(*(const h4*)(ybuf + (size_t)(2 * row + 1) * DM + c), f32x4);
                v[j] = hv * ALPHA + (y0 + y1); s += (v[j][0] + v[j][1]) + (v[j][2] + v[j][3]); }
            const float mean = wave_sum(s) * (1.0f / DM); float s2 = 0.f;
#pragma unroll
            for (int j = 0; j < 4; ++j) { v[j] = v[j] - mean; s2 += (v[j][0] * v[j][0] + v[j][1] * v[j][1]) + (v[j][2] * v[j][2] + v[j][3] * v[j][3]); }
            const float rstd = 1.0f / sqrtf(wave_sum(s2) * (1.0f / DM) + LN_EPS);
#pragma unroll
            for (int j = 0; j < 4; ++j) *(f32x4*)(a.out + (size_t)row * DM + 4 * lane + 256 * j) = v[j] * rstd * gv[j] + bv[j];
        }
    }
#ifdef PROF_SEG
    PROF_E(19);
    if (prof_on) { const unsigned long long t0 = __builtin_amdgcn_s_memrealtime(), dt = (unsigned long long)PROF_K * prof_acc; while (__builtin_amdgcn_s_memrealtime() - t0 < dt) __builtin_amdgcn_s_sleep(8); }
#endif
#undef IN
#undef SEAM
}

extern "C" void kernel_launch(void* const* d_in, const int* in_sizes, int n_in, void* d_out, int out_size, void* d_ws, size_t ws_size, hipStream_t stream) {
    static int grid = 0;
    if (grid == 0) {
        if (n_in != 15 || in_sizes[0] != NTOK * DM || out_size != NTOK * DM || ws_size < WS_END) { fprintf(stderr, "kernel_launch: unexpected problem (n_in %d, ws %zu)\n", n_in, ws_size); grid = -1; return; }
        int dev = 0, cus = 0, per_cu = 0;
        if (hipGetDevice(&dev) != hipSuccess || hipDeviceGetAttribute(&cus, hipDeviceAttributeMultiprocessorCount, dev) != hipSuccess) { grid = -1; return; }
        if (hipFuncSetAttribute((const void*)fwd, hipFuncAttributeMaxDynamicSharedMemorySize, LDS_BYTES) != hipSuccess) { fprintf(stderr, "kernel_launch: hipFuncSetAttribute failed\n"); grid = -1; return; }
        if (hipOccupancyMaxActiveBlocksPerMultiprocessor(&per_cu, (const void*)fwd, 512, LDS_BYTES) != hipSuccess || per_cu < 1) { fprintf(stderr, "kernel_launch: occupancy query says %d\n", per_cu); (void)hipGetLastError(); grid = -1; return; }
        grid = cus;
    }
    if (grid < 0) return;
    (void)hipMemsetAsync((char*)d_ws + WS_CTL, 0, CTL_ZERO_BYTES, stream);
    Args a{};
    a.x = (const float*)d_in[0]; a.w_in = (const float*)d_in[1]; a.gain = (const float*)d_in[2]; a.rel = (const float*)d_in[3]; a.w_out = (const float*)d_in[4];
    a.ln1g = (const float*)d_in[5]; a.ln1b = (const float*)d_in[6]; a.wrg = (const float*)d_in[7]; a.brg = (const float*)d_in[8]; a.wre = (const float*)d_in[9];
    a.bre = (const float*)d_in[10]; a.wgu = (const float*)d_in[11]; a.wdn = (const float*)d_in[12]; a.ln2g = (const float*)d_in[13]; a.ln2b = (const float*)d_in[14];
    a.out = (float*)d_out; a.ws = (unsigned char*)d_ws;
#if MK_LAUNCHES == 1
    a.ph_lo = 0; a.ph_hi = NPHASE;
    hipLaunchKernelGGL(fwd, dim3(grid), dim3(512), LDS_BYTES, stream, a);
#else
    for (int p = 0; p < NPHASE; ++p) { a.ph_lo = p; a.ph_hi = p + 1; a.alt = 0; hipLaunchKernelGGL(fwd, dim3(grid), dim3(512), LDS_BYTES, stream, a);
#ifdef HOST_DUP
#ifndef HOST_ALT
#define HOST_ALT 1
#endif
        if (p == HOST_DUP) { a.alt = HOST_ALT; hipLaunchKernelGGL(fwd, dim3(grid), dim3(512), LDS_BYTES, stream, a); }
#endif
    }
#endif
}
```

```cpp
#include <hip/hip_runtime.h>
#include <cstdint>
#include <cstdio>

#ifndef MK_LAUNCHES
#define MK_LAUNCHES 1
#endif

#define DI __device__ __forceinline__
#define LAS __attribute__((address_space(3)))
typedef _Float16 f16;
typedef _Float16 h8 __attribute__((ext_vector_type(8)));
typedef _Float16 h4 __attribute__((ext_vector_type(4)));
typedef short s4v __attribute__((ext_vector_type(4)));
typedef float f32x2 __attribute__((ext_vector_type(2)));
typedef float f32x4 __attribute__((ext_vector_type(4)));
typedef float f32x8 __attribute__((ext_vector_type(8)));
typedef float f32x16 __attribute__((ext_vector_type(16)));
typedef int i32x8 __attribute__((ext_vector_type(8)));
typedef unsigned u32x2 __attribute__((ext_vector_type(2)));

constexpr int NB = 2, SEQ = 16384, DM = 1024, NTOK = NB * SEQ, NPJ = 3584;
constexpr int C_AQ = 0, C_AK = 512, C_AV = 1024, C_RQ = 1536, C_RK = 2048, C_RV = 2560, C_RG = 3072;
constexpr int NBLK = SEQ / 256;
constexpr int NE = 32, DE = 512;
constexpr float ALPHA = 1.189207115002721f, LN_EPS = 1e-5f, LOG2E = 1.4426950408889634f;
constexpr int NPHASE = 10;

constexpr size_t MiB = 1u << 20;
constexpr size_t WS_CTL = 0, CTL_ZERO_BYTES = 128 * 1024;
constexpr size_t WS_ROPEC = 1 * MiB, WS_ROPES = 5 * MiB, WS_XSUM = 9 * MiB, WS_KMEAN = 10 * MiB, WS_WRT = 10 * MiB + 512 * 1024;
constexpr size_t WS_SUMSQ = 11 * MiB, WS_WTS = 12 * MiB, WS_ELIST = 13 * MiB, WS_MLIST = 17 * MiB, WS_PML = 33 * MiB;
constexpr size_t WS_WINT = 39 * MiB, WS_WOT = 46 * MiB, WS_WGUT = 48 * MiB, WS_WDNT = 80 * MiB, WS_HH8 = 96 * MiB;
constexpr size_t WS_PJ = 144 * MiB, WS_XH = 368 * MiB, WS_CAT = 368 * MiB, WS_KV = 432 * MiB, WS_R = 464 * MiB;
constexpr size_t WS_HH = 144 * MiB, WS_HID = 208 * MiB, WS_Y = 280 * MiB, WS_END = 480 * MiB;
constexpr int MLIST_PER_BH = 516096;
constexpr int CW_BAR = 4096, CW_LCNT = 8192, CW_ECNT = 12288;

constexpr int SCR_BYTES = 155648;
constexpr int BIAS_OFF = SCR_BYTES;
constexpr int BTP = 224;
constexpr int MISC_OFF = BIAS_OFF + 8 * BTP * 4 + 128;
constexpr int LDS_BYTES = MISC_OFF + 256;
static_assert(LDS_BYTES <= 163840, "LDS");

__device__ const unsigned char T5_BUCKET[129] = {0,1,2,3,4,5,6,7,8,9,10,11,12,13,14,15,16,16,16,17,17,18,18,18,19,19,19,20,20,20,20,21,21,21,21,22,22,22,22,22,23,23,23,23,23,23,24,24,24,24,24,24,25,25,25,25,25,25,25,26,26,26,26,26,26,26,26,27,27,27,27,27,27,27,27,27,27,28,28,28,28,28,28,28,28,28,28,29,29,29,29,29,29,29,29,29,29,29,29,30,30,30,30,30,30,30,30,30,30,30,30,30,30,31,31,31,31,31,31,31,31,31,31,31,31,31,31,31,31};
__device__ const float ROPE_INV[64] = {1.0f,0.865964353f,0.749894202f,0.649381638f,0.562341332f,0.486967534f,0.421696514f,0.365174115f,0.316227764f,0.273841977f,0.237137377f,0.2053525f,0.177827939f,0.153992653f,0.133352146f,0.115478195f,0.100000001f,0.0865964293f,0.0749894232f,0.0649381652f,0.0562341325f,0.0486967526f,0.0421696492f,0.0365174115f,0.0316227749f,0.0273841955f,0.0237137377f,0.0205352511f,0.0177827943f,0.0153992651f,0.013335214f,0.0115478197f,0.00999999978f,0.00865964312f,0.00749894232f,0.00649381615f,0.00562341325f,0.00486967526f,0.00421696482f,0.00365174119f,0.00316227763f,0.00273841969f,0.00237137382f,0.00205352507f,0.00177827943f,0.00153992651f,0.00133352145f,0.00115478202f,0.00100000005f,0.000865964335f,0.000749894185f,0.000649381604f,0.000562341302f,0.000486967532f,0.000421696517f,0.000365174114f,0.000316227757f,0.000273841957f,0.00023713737f,0.00020535251f,0.00017782794f,0.00015399266f,0.00013335215f,0.0001154782f};

constexpr size_t PJ_SLICE = (size_t)NTOK * 512;
DI f16* att_ptr(f16* PJ, int sl, int bh, int s) { return PJ + (size_t)sl * PJ_SLICE + ((size_t)bh * SEQ + s) * 64; }
DI f16* ret_ptr(f16* PJ, int sl, int bh, int s) { return PJ + (size_t)sl * PJ_SLICE + ((size_t)bh * SEQ + s) * 128; }

struct Args {
    const float *x, *w_in, *gain, *rel, *w_out, *ln1g, *ln1b, *wrg, *brg, *wre, *bre, *wgu, *wdn, *ln2g, *ln2b;
    float* out; unsigned char* ws; int ph_lo, ph_hi, alt, pad;
};

#define LDS_WAIT() asm volatile("s_waitcnt lgkmcnt(0)" ::: "memory")
#define MFMA32(a, b, c) __builtin_amdgcn_mfma_f32_32x32x16_f16((a), (b), (c), 0, 0, 0)
#define MFMA16(a, b, c) __builtin_amdgcn_mfma_f32_16x16x32_f16((a), (b), (c), 0, 0, 0)
DI int crow(int reg, int hp) { return (reg & 3) + 8 * (reg >> 2) + 4 * hp; }
DI h8 cvt8(f32x4 a, f32x4 b) { const f32x8 v = {a[0], a[1], a[2], a[3], b[0], b[1], b[2], b[3]}; return __builtin_convertvector(v, h8); }
DI float wave_sum(float v) {
#pragma unroll
    for (int o = 1; o < 64; o <<= 1) v += __shfl_xor(v, o);
    return v;
}
DI h4 tr_read(LAS const unsigned char* p) {
    typedef LAS s4v lds_s4;
    const s4v v = __builtin_amdgcn_ds_read_tr16_b64_v4i16((lds_s4*)p);
    return __builtin_bit_cast(h4, v);
}
DI h8 cat44(h4 a, h4 b) { return __builtin_shufflevector(a, b, 0, 1, 2, 3, 4, 5, 6, 7); }
DI float fexp2(float x) { return __builtin_amdgcn_exp2f(x); }
DI u32x2 cvt8_fp8(f32x4 a, f32x4 b) {
    int w0 = 0, w1 = 0;
    w0 = __builtin_amdgcn_cvt_pk_fp8_f32(a[0], a[1], w0, false); w0 = __builtin_amdgcn_cvt_pk_fp8_f32(a[2], a[3], w0, true);
    w1 = __builtin_amdgcn_cvt_pk_fp8_f32(b[0], b[1], w1, false); w1 = __builtin_amdgcn_cvt_pk_fp8_f32(b[2], b[3], w1, true);
    return (u32x2){(unsigned)w0, (unsigned)w1};
}
DI float gamma_log2(int h) { return __builtin_log2f(1.0f - fexp2(-(5.0f + (4.0f / 3.0f) * (float)h))); }

#define XB_TMO      128
#define XB_XCNT(j)  (256  + 64 * (j))
#define XB_XSUB(j)  (1280 + 64 * (j))
#define XB_XGEN(j)  (2304 + 64 * (j))
#define XB_TOP      3328
#define XB_TOPGEN   3392
#define XCD_BAR_WORDS 3456
#define XB_SPIN_CAP (1u << 18)
__device__ __forceinline__ unsigned xb_ld(unsigned* p)              { return __hip_atomic_load(p, __ATOMIC_RELAXED, __HIP_MEMORY_SCOPE_AGENT); }
__device__ __forceinline__ unsigned xb_add(unsigned* p, unsigned v) { return __hip_atomic_fetch_add(p, v, __ATOMIC_RELAXED, __HIP_MEMORY_SCOPE_AGENT); }
__device__ __forceinline__ unsigned xb_xcc_id() { return (unsigned)__builtin_amdgcn_s_getreg((3 << 11) | 20) & 0xFu; }
#define XB_SPIN(cond, bar) do { unsigned _sp = 0; while (cond) { __builtin_amdgcn_s_sleep(1); \
    if ((++_sp & 255u) == 0u) { if (xb_ld(&(bar)[XB_TMO])) break; if (_sp > XB_SPIN_CAP) { atomicAdd(&(bar)[XB_TMO], 1u); break; } } } } while (0)
struct XcdBarrier { unsigned* bar; unsigned x; volatile LAS unsigned* st; };
__device__ __forceinline__ XcdBarrier xcd_barrier_post(unsigned* bar, volatile LAS unsigned* st) {
    XcdBarrier b; b.bar = bar; b.x = xb_xcc_id(); b.st = st;
    if (threadIdx.x == 0) (void)xb_add(&bar[XB_XCNT(b.x)], 1u);
    return b;
}
__device__ __forceinline__ void xcd_barrier_complete(unsigned* bar, unsigned x, unsigned& nloc, unsigned& nx) {
    const unsigned G = gridDim.x * gridDim.y * gridDim.z;
    unsigned sum, cnt, mine, sp = 0u;
    for (;;) {
        sum = 0u; cnt = 0u; mine = 0u;
#pragma unroll
        for (unsigned j = 0; j < 16; ++j) { const unsigned c = xb_ld(&bar[XB_XCNT(j)]); sum += c; cnt += (c > 0u) ? 1u : 0u; mine = (j == x) ? c : mine; }
        if (sum == G) break;
        __builtin_amdgcn_s_sleep(1);
        if ((++sp & 255u) == 0u) { if (xb_ld(&bar[XB_TMO])) break; if (sp > XB_SPIN_CAP) { atomicAdd(&bar[XB_TMO], 1u); break; } }
    }
    nloc = mine > 0u ? mine : 1u; nx = cnt > 0u ? cnt : 1u;
}
__device__ __forceinline__ void xcd_barrier(const XcdBarrier& b) {
    asm volatile("s_waitcnt vmcnt(0)" ::: "memory");
    __syncthreads();
    if (threadIdx.x == 0) {
        unsigned* bar = b.bar;
        __builtin_amdgcn_s_waitcnt(0);
        unsigned nloc = b.st[0], nx = b.st[1];
        if (nloc == 0u) { xcd_barrier_complete(bar, b.x, nloc, nx); b.st[0] = nloc; b.st[1] = nx; }
        const unsigned old = xb_add(&bar[XB_XSUB(b.x)], 1u);
        const unsigned gen = old / nloc;
        if (old + 1u == (gen + 1u) * nloc) {
            __builtin_amdgcn_fence(__ATOMIC_RELEASE, "agent");
            asm volatile("s_waitcnt vmcnt(0)" ::: "memory");
            const unsigned og = xb_add(&bar[XB_TOP], 1u);
            const unsigned tg = og / nx;
            if (og + 1u == (tg + 1u) * nx) xb_add(&bar[XB_TOPGEN], 1u);
            else XB_SPIN(xb_ld(&bar[XB_TOPGEN]) == tg, bar);
            __builtin_amdgcn_fence(__ATOMIC_ACQUIRE, "agent");
            xb_add(&bar[XB_XGEN(b.x)], 1u);
            asm volatile("s_waitcnt vmcnt(0)" ::: "memory");
        } else {
            XB_SPIN(xb_ld(&bar[XB_XGEN(b.x)]) == gen, bar);
            __builtin_amdgcn_fence(__ATOMIC_ACQUIRE, "agent");
            asm volatile("s_waitcnt vmcnt(0)" ::: "memory");
        }
    }
    __syncthreads();
}

namespace pg8 {
constexpr int BM = 256, BK = 64, HALF = 128, HTB = HALF * BK * 2, STAGE_BYTES = 8 * HTB, NXCD = 8, WGM = 8;
DI int lds_byte(int r, int c) { const int st = (r >> 4) * 2 + (c >> 5), rr = r & 15, cc = c & 31, ob = rr * 64 + cc * 2; return st * 1024 + (ob ^ (((ob >> 9) & 1) << 5)); }
DI void stage_rc(int b, int& R, int& C) { const int st = b / 1024, sb = b % 1024, swz = sb ^ (((sb >> 9) & 1) << 5); R = (st >> 1) * 16 + swz / 64; C = (st & 1) * 32 + (swz % 64) / 2; }
DI int perm32(int rho) { const int n = rho >> 4, i = rho & 15; return 8 * (i >> 2) + 4 * n + (i & 3); }

struct Unit { const char* a; const char* b; int i0, i1, i2, i3; };

struct StaticOrder {
    static constexpr bool VARY_A = false;
    const char* A; const char* Bt; int lda, ldb, nM, nN, nwg, G, c;
    DI void init(const void* A_, const void* Bt_, int lda_, int ldb_, int M, int N, int G_, int c_) { A = (const char*)A_; Bt = (const char*)Bt_; lda = lda_; ldb = ldb_; nM = M / BM; nN = N / BM; nwg = nM * nN; G = G_; c = c_; }
    DI bool next(int i, Unit& u) const {
        const long L = (long)i * G + c; if (L >= nwg) return false;
        int wgid = (int)L; { const int q = nwg / NXCD, r = nwg % NXCD, xcd = wgid % NXCD, off = wgid / NXCD; wgid = (xcd < r ? xcd * (q + 1) : r * (q + 1) + (xcd - r) * q) + off; }
        const int nig = WGM * nN, gid = wgid / nig, fm = gid * WGM, gsz = (nM - fm) < WGM ? (nM - fm) : WGM;
        u.i0 = fm + ((wgid % nig) % gsz); u.i1 = (wgid % nig) / gsz; u.i2 = 0; u.i3 = 0;
        u.a = A + (size_t)u.i0 * BM * lda * 2; u.b = Bt + (size_t)u.i1 * BM * ldb * 2; return true;
    }
    DI void aoff(const Unit&, unsigned (&vo)[2][2]) const {
#pragma unroll
        for (int i = 0; i < 2; ++i) { int R, C; stage_rc((int)threadIdx.x * 16 + i * 8192, R, C);
#pragma unroll
            for (int h = 0; h < 2; ++h) vo[h][i] = (unsigned)((h * HALF + R) * lda + C) * 2u; }
    }
};

template <class Epi, class Sched, bool ALIGN_EPI>
DI void gemm_phase(LAS unsigned char* lds, const int ldb, const int nt, const Sched& S, const Epi& E) {
    const int tid = threadIdx.x, wid = __builtin_amdgcn_readfirstlane(tid >> 6), lane = tid & 63, wr = wid >> 2, wc = wid & 3, fr = lane & 15, fq = lane >> 4;
    unsigned voffB[2];
#pragma unroll
    for (int i = 0; i < 2; ++i) { int R, C; stage_rc(tid * 16 + i * 8192, R, C); const int Rb = (R & ~31) + perm32(R & 31); voffB[i] = (unsigned)(Rb * ldb + C) * 2u; }
    const size_t kstep = (size_t)(BK * 2);
    const size_t hstep = (size_t)HALF * ldb * 2;
    const unsigned ldsw = (unsigned)wid * 1024u;
    const int aoff = lds_byte(wr * 64 + fr, fq * 8), boff = lds_byte(wc * 32 + fr, fq * 8);
#define PG8_SA(b, h) (((b) * 2 + (h)) * HTB)
#define PG8_SB(b, h) ((4 + (b) * 2 + (h)) * HTB)
#define PG8_STAGE(bufoff, gbase, voff) do { _Pragma("unroll") for (int _i = 0; _i < 2; ++_i) \
        __builtin_amdgcn_global_load_lds((const unsigned*)((const char*)(gbase) + (voff)[_i]), (LAS unsigned*)(lds + (bufoff) + ldsw + _i * 8192), 16, 0, 0); } while (0)
#define PG8_LDA(dst, b, h) do { _Pragma("unroll") for (int m = 0; m < 4; ++m) _Pragma("unroll") for (int k = 0; k < 2; ++k) dst[m][k] = *(const LAS h8*)(lds + PG8_SA(b, h) + aoff + m * 2048 + k * 1024); } while (0)
#define PG8_LDB(dst, b, h) do { _Pragma("unroll") for (int n = 0; n < 2; ++n) _Pragma("unroll") for (int k = 0; k < 2; ++k) dst[n][k] = *(const LAS h8*)(lds + PG8_SB(b, h) + boff + n * 2048 + k * 1024); } while (0)
#define PG8_MMA(ai, bj, At, Bt) do { __builtin_amdgcn_s_setprio(1); _Pragma("unroll") for (int m = 0; m < 4; ++m) _Pragma("unroll") for (int n = 0; n < 2; ++n) _Pragma("unroll") for (int k = 0; k < 2; ++k) \
        acc[ai][bj][m][n] = __builtin_amdgcn_mfma_f32_16x16x32_f16(Bt[n][k], At[m][k], acc[ai][bj][m][n], 0, 0, 0); __builtin_amdgcn_s_setprio(0); } while (0)
#define PG8_WAIT_V(n) asm volatile("s_waitcnt vmcnt(" #n ")" ::: "memory")
#define PG8_WAIT_L(n) asm volatile("s_waitcnt lgkmcnt(" #n ")" ::: "memory")
#define PG8_BAR __builtin_amdgcn_s_barrier()
#define PG8_SCHED __builtin_amdgcn_sched_barrier(0)
    Unit cur, nxt; int ui = 0;
    if (!S.next(0, cur)) return;
    f32x4 acc[2][2][4][2];
#pragma unroll
    for (int a = 0; a < 2; ++a)
#pragma unroll
        for (int b = 0; b < 2; ++b)
#pragma unroll
            for (int m = 0; m < 4; ++m)
#pragma unroll
                for (int n = 0; n < 2; ++n) acc[a][b][m][n] = (f32x4){0.f, 0.f, 0.f, 0.f};
    h8 At[4][2], B0[2][2], B1[2][2];
    unsigned voc[2][2], von[2][2];
    S.aoff(cur, voc);
    const char* cA = cur.a; const char* cB = cur.b;
    PG8_STAGE(PG8_SB(0, 0), cB, voffB); PG8_STAGE(PG8_SB(0, 1), cB + hstep, voffB); PG8_STAGE(PG8_SA(0, 0), cA, voc[0]); PG8_STAGE(PG8_SA(0, 1), cA, voc[1]);
    if (wr == 1) PG8_BAR;
    PG8_WAIT_V(2); PG8_BAR;
    PG8_STAGE(PG8_SB(1, 0), cB + kstep, voffB); PG8_STAGE(PG8_SA(1, 0), cA + kstep, voc[0]); PG8_STAGE(PG8_SB(1, 1), cB + hstep + kstep, voffB);
    PG8_WAIT_V(6); PG8_BAR;
    for (;;) {
        const bool has_next = S.next(ui + 1, nxt);
        const char* nA = has_next ? nxt.a : cA; const char* nB = has_next ? nxt.b : cB;
        if (has_next) S.aoff(nxt, von);
        else {
#pragma unroll
            for (int h = 0; h < 2; ++h)
#pragma unroll
                for (int i = 0; i < 2; ++i) von[h][i] = voc[h][i]; }
#pragma unroll 1
        for (int t = 0; t < nt; t += 2) {
            if constexpr (Epi::MIDK > 0) { if (t == Epi::MIDK) E.midk(acc, cur, wr, wc, fr, fq); }
            const bool last = (t == nt - 2);
            const char* a1 = cA + (size_t)(t + 1) * kstep;
            const char* a2 = last ? nA : cA + (size_t)(t + 2) * kstep; const char* b2 = last ? nB : cB + (size_t)(t + 2) * kstep;
            const char* a3 = a2 + kstep; const char* b3 = b2 + kstep;
            unsigned v2[2][2];
#pragma unroll
            for (int h = 0; h < 2; ++h)
#pragma unroll
                for (int i = 0; i < 2; ++i) v2[h][i] = last ? von[h][i] : voc[h][i];
            PG8_LDB(B0, 0, 0); PG8_LDB(B1, 0, 1); PG8_SCHED; PG8_LDA(At, 0, 0); PG8_STAGE(PG8_SA(1, 1), a1, voc[1]);
            PG8_WAIT_V(8); PG8_WAIT_L(0); PG8_BAR; PG8_MMA(0, 0, At, B0); PG8_MMA(0, 1, At, B1); PG8_BAR; PG8_SCHED;
            PG8_LDA(At, 0, 1); PG8_STAGE(PG8_SB(0, 0), b2, voffB); PG8_STAGE(PG8_SB(0, 1), b2 + hstep, voffB); PG8_STAGE(PG8_SA(0, 0), a2, v2[0]);
            PG8_WAIT_V(8); PG8_WAIT_L(0); PG8_BAR; PG8_MMA(1, 0, At, B0); PG8_MMA(1, 1, At, B1); PG8_BAR; PG8_SCHED;
            PG8_LDB(B0, 1, 0); PG8_LDB(B1, 1, 1); PG8_SCHED; PG8_LDA(At, 1, 0); PG8_STAGE(PG8_SA(0, 1), a2, v2[1]);
            PG8_WAIT_V(8); PG8_WAIT_L(0); PG8_BAR; PG8_MMA(0, 0, At, B0); PG8_MMA(0, 1, At, B1); PG8_BAR; PG8_SCHED;
            PG8_LDA(At, 1, 1); PG8_STAGE(PG8_SB(1, 0), b3, voffB); PG8_STAGE(PG8_SB(1, 1), b3 + hstep, voffB); PG8_STAGE(PG8_SA(1, 0), a3, v2[0]);
            PG8_WAIT_V(8); PG8_WAIT_L(0); PG8_BAR; PG8_MMA(1, 0, At, B0); PG8_MMA(1, 1, At, B1); PG8_BAR; PG8_SCHED;
        }
        if constexpr (ALIGN_EPI) { if (wr == 0) PG8_BAR; }
        E(acc, cur, wr, wc, fr, fq);
        if (!has_next) break;
#pragma unroll
        for (int a = 0; a < 2; ++a)
#pragma unroll
            for (int b = 0; b < 2; ++b)
#pragma unroll
                for (int m = 0; m < 4; ++m)
#pragma unroll
                    for (int n = 0; n < 2; ++n) acc[a][b][m][n] = (f32x4){0.f, 0.f, 0.f, 0.f};
        cur = nxt; cA = nA; cB = nB; ++ui;
#pragma unroll
        for (int h = 0; h < 2; ++h)
#pragma unroll
            for (int i = 0; i < 2; ++i) voc[h][i] = von[h][i];
        if constexpr (ALIGN_EPI) { if (wr == 1) PG8_BAR; }
    }
    PG8_WAIT_V(0);
    if constexpr (!ALIGN_EPI) { if (wr == 0) PG8_BAR; }
    PG8_BAR;
#undef PG8_SA
#undef PG8_SB
#undef PG8_STAGE
#undef PG8_LDA
#undef PG8_LDB
#undef PG8_MMA
#undef PG8_WAIT_V
#undef PG8_WAIT_L
#undef PG8_BAR
#undef PG8_SCHED
}
template <class Epi, class Sched, bool ALIGN_EPI>
DI void gemm_phase8(LAS unsigned char* lds, const int ldb  , const int nt  , const Sched& S, const Epi& E) {
    const int tid = threadIdx.x, wid = __builtin_amdgcn_readfirstlane(tid >> 6), lane = tid & 63, wr = wid >> 2, wc = wid & 3, fr = lane & 15, fq = lane >> 4;
    unsigned voffB[2];
#pragma unroll
    for (int i = 0; i < 2; ++i) { int R, C; stage_rc(tid * 16 + i * 8192, R, C); const int Rb = (R & ~31) + perm32(R & 31); voffB[i] = (unsigned)(Rb * ldb + 2 * C); }
    const size_t kstep = (size_t)(BK * 2);
    const size_t hstep = (size_t)HALF * ldb;
    const unsigned ldsw = (unsigned)wid * 1024u;
    const int aoff = lds_byte(wr * 64 + fr, fq * 16), boff = lds_byte(wc * 32 + fr, fq * 16);
#define PG8_SA(b, h) (((b) * 2 + (h)) * HTB)
#define PG8_SB(b, h) ((4 + (b) * 2 + (h)) * HTB)
#define PG8_STAGE(bufoff, gbase, voff) do { _Pragma("unroll") for (int _i = 0; _i < 2; ++_i) \
        __builtin_amdgcn_global_load_lds((const unsigned*)((const char*)(gbase) + (voff)[_i]), (LAS unsigned*)(lds + (bufoff) + ldsw + _i * 8192), 16, 0, 0); } while (0)
#define PG8_LDA(dst, b, h) do { _Pragma("unroll") for (int m = 0; m < 4; ++m) dst[m] = *(const LAS i32x8*)(lds + PG8_SA(b, h) + aoff + m * 2048); } while (0)
#define PG8_LDB(dst, b, h) do { _Pragma("unroll") for (int n = 0; n < 2; ++n) dst[n] = *(const LAS i32x8*)(lds + PG8_SB(b, h) + boff + n * 2048); } while (0)
#define PG8_MMA(ai, bj, At, Bt) do { __builtin_amdgcn_s_setprio(1); _Pragma("unroll") for (int m = 0; m < 4; ++m) _Pragma("unroll") for (int n = 0; n < 2; ++n) \
        asm volatile("v_mfma_scale_f32_16x16x128_f8f6f4 %0, %1, %2, %0, %3, %3 op_sel_hi:[0,0,0]" : "+v"(acc[ai][bj][m][n]) : "v"(Bt[n]), "v"(At[m]), "v"(scl)); __builtin_amdgcn_s_setprio(0); } while (0)
#define PG8_WAIT_V(n) asm volatile("s_waitcnt vmcnt(" #n ")" ::: "memory")
#define PG8_WAIT_L(n) asm volatile("s_waitcnt lgkmcnt(" #n ")" ::: "memory")
#define PG8_BAR __builtin_amdgcn_s_barrier()
#define PG8_SCHED __builtin_amdgcn_sched_barrier(0)
    Unit cur, nxt; int ui = 0;
    if (!S.next(0, cur)) return;
    f32x4 acc[2][2][4][2];
#pragma unroll
    for (int a = 0; a < 2; ++a)
#pragma unroll
        for (int b = 0; b < 2; ++b)
#pragma unroll
            for (int m = 0; m < 4; ++m)
#pragma unroll
                for (int n = 0; n < 2; ++n) acc[a][b][m][n] = (f32x4){0.f, 0.f, 0.f, 0.f};
    i32x8 At[4], B0[2], B1[2];
    const int scl = 0x7F7F7F7F;
    unsigned voc[2][2];
    LAS unsigned* vsave = (LAS unsigned*)(lds + STAGE_BYTES + 4096) + 4 * tid;
    S.aoff(cur, voc);
    const char* cA = cur.a; const char* cB = cur.b;
    PG8_STAGE(PG8_SB(0, 0), cB, voffB); PG8_STAGE(PG8_SB(0, 1), cB + hstep, voffB); PG8_STAGE(PG8_SA(0, 0), cA, voc[0]); PG8_STAGE(PG8_SA(0, 1), cA, voc[1]);
    if (wr == 1) PG8_BAR;
    PG8_WAIT_V(2); PG8_BAR;
    PG8_STAGE(PG8_SB(1, 0), cB + kstep, voffB); PG8_STAGE(PG8_SA(1, 0), cA + kstep, voc[0]); PG8_STAGE(PG8_SB(1, 1), cB + hstep + kstep, voffB);
    PG8_WAIT_V(6); PG8_BAR;
    for (;;) {
        const bool has_next = S.next(ui + 1, nxt);
        const char* nA = has_next ? nxt.a : cA; const char* nB = has_next ? nxt.b : cB;
        if constexpr (Sched::VARY_A) { if (has_next) { unsigned tmp[2][2]; S.aoff(nxt, tmp); vsave[0] = tmp[0][0]; vsave[1] = tmp[0][1]; vsave[2] = tmp[1][0]; vsave[3] = tmp[1][1]; } }
#pragma unroll 1
        for (int t = 0; t < nt; t += 2) {
            if constexpr (Epi::MIDK > 0) { if (t == Epi::MIDK) E.midk(acc, cur, wr, wc, fr, fq); }
            const bool last = (t == nt - 2);
            const char* a1 = cA + (size_t)(t + 1) * kstep;
            const char* a2 = last ? nA : cA + (size_t)(t + 2) * kstep; const char* b2 = last ? nB : cB + (size_t)(t + 2) * kstep;
            const char* a3 = a2 + kstep; const char* b3 = b2 + kstep;
            PG8_LDB(B0, 0, 0); PG8_LDB(B1, 0, 1); PG8_SCHED; PG8_LDA(At, 0, 0); PG8_STAGE(PG8_SA(1, 1), a1, voc[1]);
            PG8_WAIT_V(8); PG8_WAIT_L(0); PG8_BAR; PG8_MMA(0, 0, At, B0); PG8_MMA(0, 1, At, B1); PG8_BAR; PG8_SCHED;
            if constexpr (Sched::VARY_A) { if (last && has_next) { voc[0][0] = vsave[0]; voc[0][1] = vsave[1]; voc[1][0] = vsave[2]; voc[1][1] = vsave[3]; } }
            PG8_LDA(At, 0, 1); PG8_STAGE(PG8_SB(0, 0), b2, voffB); PG8_STAGE(PG8_SB(0, 1), b2 + hstep, voffB); PG8_STAGE(PG8_SA(0, 0), a2, voc[0]);
            PG8_WAIT_V(8); PG8_WAIT_L(0); PG8_BAR; PG8_MMA(1, 0, At, B0); PG8_MMA(1, 1, At, B1); PG8_BAR; PG8_SCHED;
            PG8_LDB(B0, 1, 0); PG8_LDB(B1, 1, 1); PG8_SCHED; PG8_LDA(At, 1, 0); PG8_STAGE(PG8_SA(0, 1), a2, voc[1]);
            PG8_WAIT_V(8); PG8_WAIT_L(0); PG8_BAR; PG8_MMA(0, 0, At, B0); PG8_MMA(0, 1, At, B1); PG8_BAR; PG8_SCHED;
            PG8_LDA(At, 1, 1); PG8_STAGE(PG8_SB(1, 0), b3, voffB); PG8_STAGE(PG8_SB(1, 1), b3 + hstep, voffB); PG8_STAGE(PG8_SA(1, 0), a3, voc[0]);
            PG8_WAIT_V(8); PG8_WAIT_L(0); PG8_BAR; PG8_MMA(1, 0, At, B0); PG8_MMA(1, 1, At, B1); PG8_BAR; PG8_SCHED;
        }
        asm volatile("s_nop 15\n\ts_nop 15" ::: "memory");
        if constexpr (ALIGN_EPI) { if (wr == 0) PG8_BAR; }
        { int tz = threadIdx.x; asm volatile("" : "+v"(tz)); const int l2 = tz & 63;
          E(acc, cur, wr, wc, l2 & 15, l2 >> 4); }
        if (!has_next) break;
#pragma unroll
        for (int a = 0; a < 2; ++a)
#pragma unroll
            for (int b = 0; b < 2; ++b)
#pragma unroll
                for (int m = 0; m < 4; ++m)
#pragma unroll
                    for (int n = 0; n < 2; ++n) acc[a][b][m][n] = (f32x4){0.f, 0.f, 0.f, 0.f};
        cur = nxt; cA = nA; cB = nB; ++ui;
        if constexpr (ALIGN_EPI) { if (wr == 1) PG8_BAR; }
    }
    PG8_WAIT_V(0);
    if constexpr (!ALIGN_EPI) { if (wr == 0) PG8_BAR; }
    PG8_BAR;
#undef PG8_SA
#undef PG8_SB
#undef PG8_STAGE
#undef PG8_LDA
#undef PG8_LDB
#undef PG8_MMA
#undef PG8_WAIT_V
#undef PG8_WAIT_L
#undef PG8_BAR
#undef PG8_SCHED
}
}

struct EpiProj {
    static constexpr int MIDK = 0;
    f16* PJ; const float* cosT; const float* sinT;
    DI void midk(f32x4 (&)[2][2][4][2], const pg8::Unit&, int, int, int, int) const {}
    DI void operator()(const f32x4 (&acc)[2][2][4][2], const pg8::Unit& u, int wr, int wc, int fr, int fq) const {
        const int pn = u.i1, row0 = u.i0 * 256 + wr * 64 + fr, sl = pn >> 1;
        const int b = row0 >> 14, s0 = row0 & (SEQ - 1);
        if (pn < 6) {
#pragma unroll
            for (int bj = 0; bj < 2; ++bj) { f16* hp_ = att_ptr(PJ, sl, b * 8 + (pn & 1) * 4 + 2 * bj + (wc >> 1), s0) + 32 * (wc & 1) + 8 * fq;
#pragma unroll
                for (int ai = 0; ai < 2; ++ai)
#pragma unroll
                    for (int m = 0; m < 4; ++m) *(h8*)(hp_ + (size_t)(ai * 128 + m * 16) * 64) = cvt8(acc[ai][bj][m][0], acc[ai][bj][m][1]); }
        } else if (pn > 9) {
#pragma unroll
            for (int bj = 0; bj < 2; ++bj) { f16* hp_ = ret_ptr(PJ, sl, b * 4 + (pn & 1) * 2 + bj, s0) + 32 * wc + 8 * fq;
#pragma unroll
                for (int ai = 0; ai < 2; ++ai)
#pragma unroll
                    for (int m = 0; m < 4; ++m) *(h8*)(hp_ + (size_t)(ai * 128 + m * 16) * 128) = cvt8(acc[ai][bj][m][0], acc[ai][bj][m][1]); }
        } else {
            const float sc = (pn >= 8) ? 0.08838834764831845f : 1.0f;
            const int i0 = 32 * (wc & 1) + 8 * fq;
            f16* hp_ = ret_ptr(PJ, sl, b * 4 + (pn & 1) * 2 + (wc >> 1), s0) + i0;
#pragma unroll
            for (int ai = 0; ai < 2; ++ai)
#pragma unroll
                for (int m = 0; m < 4; ++m) { const int pos = s0 + ai * 128 + m * 16;
                    const f32x4 c0 = *(const f32x4*)(cosT + pos * 64 + i0) * sc, c1 = *(const f32x4*)(cosT + pos * 64 + i0 + 4) * sc;
                    const f32x4 s0v = *(const f32x4*)(sinT + pos * 64 + i0) * sc, s1v = *(const f32x4*)(sinT + pos * 64 + i0 + 4) * sc;
                    const f32x4 x10 = acc[ai][0][m][0], x11 = acc[ai][0][m][1], x20 = acc[ai][1][m][0], x21 = acc[ai][1][m][1];
                    f16* rowp = hp_ + (size_t)(ai * 128 + m * 16) * 128;
                    *(h8*)(rowp) = cvt8(x10 * c0 - x20 * s0v, x11 * c1 - x21 * s1v);
                    *(h8*)(rowp + 64) = cvt8(x10 * s0v + x20 * c0, x11 * s1v + x21 * c1); }
        }
    }
};
struct EpiZ {
    static constexpr int MIDK = 8;
    const float* x; f16* z; const float* sumsq;
    DI void midk(f32x4 (&acc)[2][2][4][2], const pg8::Unit& u, int wr, int wc, int fr, int fq) const {
#pragma unroll
        for (int ai = 0; ai < 2; ++ai)
#pragma unroll
            for (int m = 0; m < 4; ++m) { const int row = u.i0 * 256 + ai * 128 + wr * 64 + m * 16 + fr;
                const f32x4 s0 = *(const f32x4*)(sumsq + (size_t)row * 8), s1 = *(const f32x4*)(sumsq + (size_t)row * 8 + 4);
                const float ss = ((s0[0] + s0[1]) + (s0[2] + s0[3])) + ((s1[0] + s1[1]) + (s1[2] + s1[3]));
                const float rinv = 1.0f / sqrtf(ss * (1.0f / 512.0f) + LN_EPS);
#pragma unroll
                for (int bj = 0; bj < 2; ++bj)
#pragma unroll
                    for (int n = 0; n < 2; ++n) acc[ai][bj][m][n] *= rinv; }
    }
    DI void operator()(const f32x4 (&acc)[2][2][4][2], const pg8::Unit& u, int wr, int wc, int fr, int fq) const {
        const int row0 = u.i0 * 256 + wr * 64 + fr, col0 = u.i1 * 256 + wc * 32 + 8 * fq;
#pragma unroll
        for (int ai = 0; ai < 2; ++ai)
#pragma unroll
            for (int m = 0; m < 4; ++m) { const size_t off = (size_t)(row0 + ai * 128 + m * 16) * DM + col0;
#pragma unroll
                for (int bj = 0; bj < 2; ++bj) {
                    const f32x4 x0 = *(const f32x4*)(x + off + bj * 128), x1 = *(const f32x4*)(x + off + bj * 128 + 4);
                    *(h8*)(z + off + bj * 128) = cvt8(x0 * ALPHA + acc[ai][bj][m][0], x1 * ALPHA + acc[ai][bj][m][1]); } }
    }
};
template <bool GATHER>
struct MoeSched {
    static constexpr bool VARY_A = GATHER;
    LAS const int* tab; const int* elist; const char* A; const char* Bt; size_t b_expert_bytes; int lda, ldb, G, c;
    DI bool next(int i, pg8::Unit& u) const {
        const int MT = tab[64]; const int wpx = G >> 3, xcd = c & 7, w = c >> 3;
        const int q = w + wpx * i, g = (q >> 2) * 8 + xcd, nt = q & 3;
        if (g >= MT) return false;
        int e = 0;
#pragma unroll 1
        for (int k = 1; k < 32; ++k) e += (tab[32 + k] <= g) ? 1 : 0;
        u.i0 = g; u.i1 = nt; u.i2 = e; u.i3 = g - tab[32 + e];
        u.a = GATHER ? A : A + (size_t)g * 256 * lda;
        u.b = Bt + (size_t)e * b_expert_bytes + (size_t)nt * 256 * ldb; return true;
    }
    DI void aoff(const pg8::Unit& u, unsigned (&vo)[2][2]) const {
        const int cnt = tab[u.i2];
#pragma unroll
        for (int i = 0; i < 2; ++i) { int R, C; pg8::stage_rc((int)threadIdx.x * 16 + i * 8192, R, C);
#pragma unroll
            for (int h = 0; h < 2; ++h) {
                if (GATHER) { int idx = u.i3 * 256 + h * 128 + R; idx = idx < cnt ? idx : 0; const int tok = elist[u.i2 * NTOK + idx] >> 1; vo[h][i] = (unsigned)(tok * lda + 2 * C); }
                else vo[h][i] = (unsigned)((h * 128 + R) * lda + 2 * C); } }
    }
};
struct EpiGU {
    static constexpr int MIDK = 0;
    unsigned char* hid;
    DI void midk(f32x4 (&)[2][2][4][2], const pg8::Unit&, int, int, int, int) const {}
    DI void operator()(const f32x4 (&acc)[2][2][4][2], const pg8::Unit& u, int wr, int wc, int fr, int fq) const {
        const int row0 = u.i0 * 256 + wr * 64 + fr, col0 = u.i1 * 128 + wc * 32 + 8 * fq;
#pragma unroll
        for (int ai = 0; ai < 2; ++ai)
#pragma unroll
            for (int m = 0; m < 4; ++m) { f32x4 o[2];
#pragma unroll
                for (int n = 0; n < 2; ++n) { const f32x4 g = acc[ai][0][m][n], up = acc[ai][1][m][n];
#pragma unroll
                    for (int e = 0; e < 4; ++e) { const float gg = g[e] * (1.0f / 64.0f); o[n][e] = gg * up[e] * (8.0f / 64.0f) / (1.0f + fexp2(-gg * LOG2E)); } }
                *(u32x2*)(hid + (size_t)(row0 + ai * 128 + m * 16) * DE + col0) = cvt8_fp8(o[0], o[1]); }
    }
};
struct EpiDown {
    static constexpr int MIDK = 0;
    f16* y; const int* elist; const float* wts; LAS const int* tab;
    DI void midk(f32x4 (&)[2][2][4][2], const pg8::Unit&, int, int, int, int) const {}
    DI void operator()(const f32x4 (&acc)[2][2][4][2], const pg8::Unit& u, int wr, int wc, int fr, int fq) const {
        const int cnt = tab[u.i2], col0 = u.i1 * 256 + wc * 32 + 8 * fq;
#pragma unroll
        for (int ai = 0; ai < 2; ++ai)
#pragma unroll
            for (int m = 0; m < 4; ++m) { const int idx = u.i3 * 256 + ai * 128 + wr * 64 + m * 16 + fr;
                if (idx < cnt) { const int ent = elist[u.i2 * NTOK + idx]; const float w = wts[ent] * (1.0f / 256.0f); f16* rowp = y + (size_t)ent * DM + col0;
#pragma unroll
                    for (int bj = 0; bj < 2; ++bj) *(h8*)(rowp + bj * 128) = cvt8(acc[ai][bj][m][0] * w, acc[ai][bj][m][1] * w); } }
    }
};

DI void tr_item(const float* W, int ldw, int k0, int nsrc0, f16* WT, int ldt, int prow0, const float* ks, LAS float* scr, int lane) {
#pragma unroll
    for (int i = 0; i < 32; ++i) { const int kk = 2 * i + (lane >> 5); float v = W[(size_t)(k0 + kk) * ldw + nsrc0 + (lane & 31)]; if (ks) v *= ks[k0 + kk]; scr[kk * 33 + (lane & 31)] = v; }
    LDS_WAIT(); asm volatile("" ::: "memory");
    const int c = lane & 7;
#pragma unroll
    for (int j = 0; j < 4; ++j) { const int n = (lane >> 3) + 8 * j; const LAS float* s = scr + (8 * c) * 33 + n;
        h8 o; o[0] = (f16)s[0]; o[1] = (f16)s[33]; o[2] = (f16)s[66]; o[3] = (f16)s[99]; o[4] = (f16)s[132]; o[5] = (f16)s[165]; o[6] = (f16)s[198]; o[7] = (f16)s[231];
        *(h8*)(WT + (size_t)(prow0 + n) * ldt + k0 + 8 * c) = o; }
    LDS_WAIT(); asm volatile("" ::: "memory");
}

DI void tr_item8(const float* W, int ldw, int k0, int nsrc0, unsigned char* WT, int ldt, int prow0, float scale, LAS float* scr, int lane) {
#pragma unroll
    for (int i = 0; i < 32; ++i) { const int kk = 2 * i + (lane >> 5); scr[kk * 33 + (lane & 31)] = W[(size_t)(k0 + kk) * ldw + nsrc0 + (lane & 31)] * scale; }
    LDS_WAIT(); asm volatile("" ::: "memory");
    const int c = lane & 7;
#pragma unroll
    for (int j = 0; j < 4; ++j) { const int n = (lane >> 3) + 8 * j; const LAS float* sp = scr + (8 * c) * 33 + n;
        const f32x4 lo = {sp[0], sp[33], sp[66], sp[99]}, hi = {sp[132], sp[165], sp[198], sp[231]};
        *(u32x2*)(WT + (size_t)(prow0 + n) * ldt + k0 + 8 * c) = cvt8_fp8(lo, hi); }
    LDS_WAIT(); asm volatile("" ::: "memory");
}

constexpr int KP64 = 144, VP64 = 192;
template <bool OWN>
DI void attn_tile(LAS const unsigned char* Kl, LAS const unsigned char* Vl, LAS const float* biasd, const h8 (&qf)[4], int rel, int w, int lane, float& m2, float& lsum, f32x16 (&o)[2]) {
    const int r = lane & 31, hp = lane >> 5;
    f32x16 st[8];
    const float b31 = biasd[31 + 160];
    float mx = -3.0e38f;
#pragma unroll
    for (int kt = 0; kt < 8; ++kt) {
        if (!OWN || kt <= w) {
            f32x16 a;
#pragma unroll
            for (int i = 0; i < 16; ++i) a[i] = 0.f;
#pragma unroll
            for (int ks = 0; ks < 4; ++ks) { const h8 kf = *(const LAS h8*)(Kl + (32 * kt + r) * KP64 + 32 * ks + 16 * hp); a = MFMA32(kf, qf[ks], a); }
            const bool far = __all(rel - (32 * kt + 31) >= 128) != 0;
            if (far) {
#pragma unroll
                for (int i = 0; i < 16; ++i) a[i] = a[i] * (0.125f * LOG2E) + b31;
            } else {
                int base = rel - 32 * kt - 4 * hp; base = base > 187 ? 187 : base;
                LAS const float* tp = biasd + (base + 4);
#pragma unroll
                for (int i = 0; i < 16; ++i) a[i] = a[i] * (0.125f * LOG2E) + tp[27 - ((i & 3) + 8 * (i >> 2))];
            }
#pragma unroll
            for (int i = 0; i < 16; ++i) mx = fmaxf(mx, a[i]);
            st[kt] = a;
        }
    }
    mx = fmaxf(mx, __shfl_xor(mx, 32));
    float ls = 0.f;
#pragma unroll
    for (int dt = 0; dt < 2; ++dt)
#pragma unroll
        for (int i = 0; i < 16; ++i) o[dt][i] = 0.f;
    const int i16 = lane & 15, q4 = i16 >> 2, p4 = i16 & 3, cb = (lane >> 4) & 1;
    LAS const unsigned char* vbase = Vl + (4 * hp + q4) * VP64 + 2 * (16 * cb + 4 * p4);
#pragma unroll
    for (int kt = 0; kt < 8; ++kt) {
        if (!OWN || kt <= w) {
            f32x16 p = st[kt];
#pragma unroll
            for (int i = 0; i < 16; ++i) { p[i] = fexp2(p[i] - mx); ls += p[i]; }
#pragma unroll
            for (int s = 0; s < 2; ++s) {
                const f32x8 pv = {p[8 * s], p[8 * s + 1], p[8 * s + 2], p[8 * s + 3], p[8 * s + 4], p[8 * s + 5], p[8 * s + 6], p[8 * s + 7]};
                const h8 pf = __builtin_convertvector(pv, h8);
#pragma unroll
                for (int dt = 0; dt < 2; ++dt) {
                    LAS const unsigned char* vp = vbase + (32 * kt + 16 * s) * VP64 + 64 * dt;
                    const h8 vf = cat44(tr_read(vp), tr_read(vp + 8 * VP64));
                    o[dt] = MFMA32(vf, pf, o[dt]);
                }
            }
        }
    }
    ls += __shfl_xor(ls, 32);
    m2 = mx; lsum = ls;
}
template <int P>
DI void stage64(LAS unsigned char* dst, const f16* src, int src_ld, int tid) {
#pragma unroll
    for (int i = 0; i < 4; ++i) { const int q = tid + 512 * i, row = q >> 3, ch = q & 7; *(LAS h8*)(dst + row * P + 16 * ch) = *(const h8*)(src + (size_t)row * src_ld + 8 * ch); }
}

DI void own_scores(LAS const unsigned char* Kl, LAS const float* biasd, const h8 (&qf)[4], int ql, int kt, int w, int r, int hp, f32x16& a) {
#pragma unroll
    for (int i = 0; i < 16; ++i) a[i] = 0.f;
#pragma unroll
    for (int ks = 0; ks < 4; ++ks) { const h8 kf = *(const LAS h8*)(Kl + (32 * kt + r) * KP64 + 32 * ks + 16 * hp); a = MFMA32(kf, qf[ks], a); }
    const int delta = w - kt;
    if (delta >= 5) {
        const float b31 = biasd[31 + 160];
#pragma unroll
        for (int i = 0; i < 16; ++i) a[i] = a[i] * (0.125f * LOG2E) + b31;
    } else {
        const int base = ql - 32 * kt - 4 * hp;
        LAS const float* tp = biasd + (base + 4);
        if (delta == 0) {
#pragma unroll
            for (int i = 0; i < 16; ++i) { const int ci = (i & 3) + 8 * (i >> 2); const float v = a[i] * (0.125f * LOG2E) + tp[27 - ci]; a[i] = (base - ci < 0) ? -3.0e38f : v; }
        } else {
#pragma unroll
            for (int i = 0; i < 16; ++i) a[i] = a[i] * (0.125f * LOG2E) + tp[27 - ((i & 3) + 8 * (i >> 2))];
        }
    }
}
DI void attn_own(LAS const unsigned char* Kl, LAS const unsigned char* Vl, LAS const float* biasd, const h8 (&qf)[4], int ql, int w, int lane, float& m2, float& lsum, f32x16 (&o)[2]) {
    const int r = lane & 31, hp = lane >> 5;
    float mx = -3.0e38f;
#pragma unroll 2
    for (int kt = 0; kt <= w; ++kt) { f32x16 a; own_scores(Kl, biasd, qf, ql, kt, w, r, hp, a);
#pragma unroll
        for (int i = 0; i < 16; ++i) mx = fmaxf(mx, a[i]); }
    mx = fmaxf(mx, __shfl_xor(mx, 32));
    float ls = 0.f;
#pragma unroll
    for (int dt = 0; dt < 2; ++dt)
#pragma unroll
        for (int i = 0; i < 16; ++i) o[dt][i] = 0.f;
    const int i16 = lane & 15, q4 = i16 >> 2, p4 = i16 & 3, cb = (lane >> 4) & 1;
    LAS const unsigned char* vbase = Vl + (4 * hp + q4) * VP64 + 2 * (16 * cb + 4 * p4);
#pragma unroll 2
    for (int kt = 0; kt <= w; ++kt) {
        f32x16 p; own_scores(Kl, biasd, qf, ql, kt, w, r, hp, p);
#pragma unroll
        for (int i = 0; i < 16; ++i) { p[i] = fexp2(p[i] - mx); ls += p[i]; }
#pragma unroll
        for (int s = 0; s < 2; ++s) {
            const f32x8 pv = {p[8 * s], p[8 * s + 1], p[8 * s + 2], p[8 * s + 3], p[8 * s + 4], p[8 * s + 5], p[8 * s + 6], p[8 * s + 7]};
            const h8 pf = __builtin_convertvector(pv, h8);
#pragma unroll
            for (int dt = 0; dt < 2; ++dt) {
                LAS const unsigned char* vp = vbase + (32 * kt + 16 * s) * VP64 + 64 * dt;
                const h8 vf = cat44(tr_read(vp), tr_read(vp + 8 * VP64));
                o[dt] = MFMA32(vf, pf, o[dt]);
            }
        }
    }
    ls += __shfl_xor(ls, 32);
    m2 = mx; lsum = ls;
}
__global__ void __launch_bounds__(512, 2) fwd(Args a) {
    extern __shared__ __attribute__((aligned(16))) unsigned char smem[];
    LAS unsigned char* lds = (LAS unsigned char*)smem;
    volatile LAS unsigned* MISC = (volatile LAS unsigned*)(lds + MISC_OFF);
    LAS float* biasl = (LAS float*)(lds + BIAS_OFF);
    const int tid = threadIdx.x, lane = tid & 63, wave = __builtin_amdgcn_readfirstlane(tid >> 6);
    const int G = gridDim.x, bid = blockIdx.x;
    unsigned char* ws = a.ws;
    unsigned* ctl = (unsigned*)(ws + WS_CTL);
    float* ropeC = (float*)(ws + WS_ROPEC); float* ropeS = (float*)(ws + WS_ROPES); float* xsum = (float*)(ws + WS_XSUM);
    f16* kmean = (f16*)(ws + WS_KMEAN); f16* WrT = (f16*)(ws + WS_WRT); float* sumsq = (float*)(ws + WS_SUMSQ); float* wts = (float*)(ws + WS_WTS);
    int* elist = (int*)(ws + WS_ELIST); unsigned short* mlist = (unsigned short*)(ws + WS_MLIST); f32x2* pml = (f32x2*)(ws + WS_PML);
    f16* WinT = (f16*)(ws + WS_WINT); f16* WoT = (f16*)(ws + WS_WOT); unsigned char* WguT = ws + WS_WGUT; unsigned char* WdnT = ws + WS_WDNT; unsigned char* hh8 = ws + WS_HH8;
    f16* PJ = (f16*)(ws + WS_PJ); f16* xh = (f16*)(ws + WS_XH); f16* cat = (f16*)(ws + WS_CAT); float* kvbuf = (float*)(ws + WS_KV); f16* Rbuf = (f16*)(ws + WS_R);
    f16* hh = (f16*)(ws + WS_HH); unsigned char* hid = ws + WS_HID; f16* ybuf = (f16*)(ws + WS_Y);
    f16* pO = (f16*)a.out;
    f16* zbuf = (f16*)a.out;
    unsigned* lcnt = ctl + CW_LCNT; unsigned* ecnt = ctl + CW_ECNT;

    if (tid < 64) MISC[tid] = 0u;
    for (int idx = tid; idx < 8 * BTP; idx += 512) { const int h = idx / BTP, d = idx % BTP - 31, dd = d > 128 ? 128 : d; biasl[idx] = d < 0 ? 0.f : a.rel[(int)T5_BUCKET[dd] * 8 + h] * LOG2E; }
    __syncthreads();
    const int lo = a.ph_lo, hi = a.ph_hi;
    XcdBarrier bar; bar.bar = ctl + CW_BAR; bar.x = 0; bar.st = MISC + 8;
    if (hi - lo > 1) bar = xcd_barrier_post(ctl + CW_BAR, MISC + 8);
#ifndef PH_MASK
#define PH_MASK 0x3ff
#endif
#define IN(k) ((((PH_MASK) >> (k)) & 1) && lo <= (k) && (k) < hi)
#ifndef DUP_PHASE
#define DUP_PHASE -1
#endif
#define REP(k) for (int rep_ = 0; rep_ < ((DUP_PHASE) == (k) ? 2 : 1); ++rep_)
#ifdef PROF_SEG
#ifndef PROF_K
#define PROF_K 4
#endif
#ifndef PROF_WAVE
#define PROF_WAVE 0
#endif
    unsigned long long prof_acc = 0ull, prof_t0 = 0ull;
#ifndef PROF_BLOCK
#define PROF_BLOCK 0
#endif
    const bool prof_on = (bid == PROF_BLOCK && tid == 64 * PROF_WAVE);
#define PROF_B(seg) do { if ((seg) == PROF_SEG) { __builtin_amdgcn_sched_barrier(0); prof_t0 = __builtin_amdgcn_s_memrealtime(); __builtin_amdgcn_sched_barrier(0); } } while (0)
#define PROF_E(seg) do { if ((seg) == PROF_SEG) { __builtin_amdgcn_sched_barrier(0); prof_acc += __builtin_amdgcn_s_memrealtime() - prof_t0; __builtin_amdgcn_sched_barrier(0); } } while (0)
#else
#define PROF_B(seg) do { } while (0)
#define PROF_E(seg) do { } while (0)
#endif
#ifdef DIAG_PHASE
#ifndef DIAG_MODE
#define DIAG_MODE 0
#endif
    unsigned long long tdiag0 = 0ull;
#define DIAG_T0(k) do { if ((k) == DIAG_PHASE) tdiag0 = __builtin_amdgcn_s_memrealtime(); } while (0)
#define DIAG_T1(k, mode) do { if ((k) == DIAG_PHASE && (mode) == DIAG_MODE && bid == 0 && tid == 0) __hip_atomic_store(ctl + 24576, (unsigned)(__builtin_amdgcn_s_memrealtime() - tdiag0), __ATOMIC_RELAXED, __HIP_MEMORY_SCOPE_AGENT); } while (0)
#else
#define DIAG_T0(k) do { } while (0)
#define DIAG_T1(k, mode) do { } while (0)
#endif
#define SEAM(k) do { PROF_E(10 + (k)); PROF_B(20 + (k)); DIAG_T1(k, 1); if (IN(k) && IN((k) + 1)) xcd_barrier(bar); DIAG_T1(k, 0); DIAG_T0((k) + 1); PROF_E(20 + (k)); PROF_B(11 + (k)); } while (0)

    DIAG_T0(0); PROF_B(10);
    if (IN(0)) REP(0) {
        for (int hb = bid; hb < 256; hb += G) {
            const int c4 = tid & 255, rp = tid >> 8;
            const float* src = a.x + (size_t)hb * 128 * DM + c4 * 4; f16* dst = xh + (size_t)hb * 128 * DM + c4 * 4;
            f32x4 s = {0.f, 0.f, 0.f, 0.f};
#pragma unroll 8
            for (int r = rp; r < 128; r += 2) { const f32x4 v = *(const f32x4*)(src + (size_t)r * DM); s += v; *(h4*)(dst + (size_t)r * DM) = __builtin_convertvector(v, h4); }
            LAS f32x4* red = (LAS f32x4*)lds;
            if (rp == 1) red[c4] = s;
            __syncthreads();
            if (rp == 0) { s += red[c4]; *(f32x4*)(xsum + (size_t)hb * DM + c4 * 4) = s; }
            __syncthreads();
        }
        for (int idx = bid * 512 + tid; idx < SEQ * 64; idx += G * 512) {
            const int pos = idx >> 6, i = idx & 63;
            const float ang = (float)pos * ROPE_INV[i];
            const double xd = (double)ang, kd = __builtin_rint(xd * 0.6366197723675814);
            double rr = __builtin_fma(-kd, 1.5707963267948966, xd); rr = __builtin_fma(-kd, 6.123233995736766e-17, rr);
            const double r2 = rr * rr;
            const double sp = rr * (1.0 + r2 * (-1.0 / 6 + r2 * (1.0 / 120 + r2 * (-1.0 / 5040 + r2 * (1.0 / 362880 + r2 * (-1.0 / 39916800 + r2 * (1.0 / 6227020800.0)))))));
            const double cp = 1.0 + r2 * (-0.5 + r2 * (1.0 / 24 + r2 * (-1.0 / 720 + r2 * (1.0 / 40320 + r2 * (-1.0 / 3628800 + r2 * (1.0 / 479001600.0 + r2 * (-1.0 / 87178291200.0)))))));
            const int q = (int)kd & 3;
            const double sv = (q == 0) ? sp : (q == 1) ? cp : (q == 2) ? -sp : -cp;
            const double cv = (q == 0) ? cp : (q == 1) ? -sp : (q == 2) ? -cp : sp;
            ropeC[idx] = (float)cv; ropeS[idx] = (float)sv;
        }
        for (int idx = bid * 512 + tid; idx < 48 * DM; idx += G * 512) {
            const int n = idx >> 10, k = idx & 1023;
            const float v = (n < 4) ? a.wrg[k * 4 + n] : (n < 36) ? a.wre[k * 32 + (n - 4)] : 0.f;
            WrT[idx] = (f16)v;
        }
        {
            LAS float* scr = (LAS float*)(lds + wave * 16384);
            constexpr int I_IN = 16 * 112, I_O = 16 * 32, I_GU = 32 * 512, I_DN = 32 * 256, NIT = I_IN + I_O + I_GU + I_DN;
            for (int it = bid * 8 + wave; it < NIT; it += G * 8) {
                int r = it;
                if (r < I_IN) { const int kb = r / 112, nb = r % 112, pn = nb >> 3, g = nb & 7;
                    const int nsrc = (pn >= 6 && pn <= 9) ? pn * 256 + 128 * ((g >> 1) & 1) + 64 * (g >> 2) + 32 * (g & 1) : 32 * nb;
                    tr_item(a.w_in, NPJ, 64 * kb, nsrc, WinT, DM, 32 * nb, nullptr, scr, lane); continue; } r -= I_IN;
                if (r < I_O) { const int kb = r / 32, nb = r % 32; tr_item(a.w_out, DM, 64 * kb, 32 * nb, WoT, DM, 32 * nb, kb < 8 ? a.gain : nullptr, scr, lane); continue; } r -= I_O;
                if (r < I_GU) { const int e = r >> 9, rr = r & 511, kb = rr >> 5, nb = rr & 31, pn = nb >> 3, g = nb & 7;
                    const int nsrc = (g >> 2) * 512 + 128 * pn + 32 * (g & 3);
                    tr_item8(a.wgu + (size_t)e * DM * DM, DM, 64 * kb, nsrc, WguT + (size_t)e * DM * DM, DM, 32 * nb, 64.0f, scr, lane); continue; } r -= I_GU;
                { const int e = r >> 8, rr = r & 255, kb = rr >> 5, nb = rr & 31;
                    tr_item8(a.wdn + (size_t)e * DE * DM, DM, 64 * kb, 32 * nb, WdnT + (size_t)e * DM * DE, DE, 32 * nb, 32.0f, scr, lane); }
            }
        }
        __syncthreads();
    }
    SEAM(0);

    if (IN(1)) {
        REP(11) for (int job = bid; job < 256; job += G) {
            const int blk = job >> 1, ch = job & 1;
            LAS float* xm = (LAS float*)lds;
            for (int k = tid; k < DM; k += 512) xm[k] = (xsum[(size_t)(2 * blk) * DM + k] + xsum[(size_t)(2 * blk + 1) * DM + k]) * (1.0f / 256.0f);
            __syncthreads();
            const int col = tid & 255, kh = tid >> 8;
            const float* wp = a.w_in + (size_t)(kh * 512) * NPJ + C_AK + ch * 256 + col;
            float acc = 0.f;
#pragma unroll 8
            for (int k = 0; k < 512; ++k) acc += xm[kh * 512 + k] * wp[(size_t)k * NPJ];
            LAS float* red = xm + 1024;
            if (kh) red[col] = acc;
            __syncthreads();
            if (!kh) { acc += red[col]; const int c = ch * 256 + col, h = c >> 6, d = c & 63, b = blk >> 6, j = blk & 63; kmean[((size_t)(b * 8 + h) * 64 + j) * 64 + d] = (f16)acc; }
            __syncthreads();
        }
        pg8::StaticOrder S; S.init(xh, WinT, DM, DM, NTOK, NPJ, G, bid);
        EpiProj E{PJ, ropeC, ropeS};
        pg8::gemm_phase<EpiProj, pg8::StaticOrder, true>(lds, DM, DM / 64, S, E);
        if (DUP_PHASE == 1) pg8::gemm_phase<EpiProj, pg8::StaticOrder, true>(lds, DM, DM / 64, S, E);
    }
    SEAM(1);

    if (IN(2)) REP(2) {
        constexpr int NU_G = 16 * 63, NU_KV = 8 * 64;
        unsigned* lcnt_w = (rep_ | a.alt) ? ctl + 16384 : lcnt; unsigned short* mlist_w = (rep_ | a.alt) ? (unsigned short*)(ws + 480 * MiB) : mlist;
        for (int u = bid; u < NU_G + NU_KV; u += G) {
            if (u < NU_KV) {
                const int bh = u >> 6, ci = u & 63, b = bh >> 2, h = bh & 3;
                const float lg = gamma_log2(h);
                const f16* kp = ret_ptr(PJ, 4, bh, ci * 256);
                const f16* vp = ret_ptr(PJ, 5, bh, ci * 256);
                LAS unsigned char* Kl = lds; LAS unsigned char* Vl = lds + 128 * 320;
                const int dvt = wave & 3, dk0 = 2 * (wave >> 2);
                f32x16 acc[2];
#pragma unroll
                for (int t = 0; t < 2; ++t)
#pragma unroll
                    for (int i = 0; i < 16; ++i) acc[t][i] = 0.f;
                const int r = lane & 31, hp = lane >> 5, i16 = lane & 15, q4 = i16 >> 2, p4 = i16 & 3, cb = (lane >> 4) & 1;
                for (int half = 0; half < 2; ++half) {
#pragma unroll
                    for (int i = 0; i < 4; ++i) { const int q = tid + 512 * i, row = q >> 4, ch = q & 15; const int key = half * 128 + row;
                        const h8 kv = *(const h8*)(kp + (size_t)key * 128 + 8 * ch); const float sc = fexp2(lg * (float)(255 - key));
                        const f32x8 kf = __builtin_convertvector(kv, f32x8) * sc;
                        *(LAS h8*)(Kl + row * 320 + 16 * ch) = __builtin_convertvector(kf, h8);
                        *(LAS h8*)(Vl + row * 320 + 16 * ch) = *(const h8*)(vp + (size_t)key * 128 + 8 * ch); }
                    __syncthreads();
#pragma unroll
                    for (int s = 0; s < 8; ++s) {
                        LAS const unsigned char* ap = Vl + (16 * s + 8 * hp + q4) * 320 + 2 * (32 * dvt + 16 * cb + 4 * p4);
                        const h8 af = cat44(tr_read(ap), tr_read(ap + 4 * 320));
#pragma unroll
                        for (int t = 0; t < 2; ++t) {
                            LAS const unsigned char* bp = Kl + (16 * s + 8 * hp + q4) * 320 + 2 * (32 * (dk0 + t) + 16 * cb + 4 * p4);
                            const h8 bf = cat44(tr_read(bp), tr_read(bp + 4 * 320));
                            acc[t] = MFMA32(af, bf, acc[t]);
                        }
                    }
                    __syncthreads();
                }
                float* dst = kvbuf + (size_t)u * 128 * 128;
#pragma unroll
                for (int t = 0; t < 2; ++t)
#pragma unroll
                    for (int i = 0; i < 16; ++i) dst[(32 * dvt + crow(i, hp)) * 128 + 32 * (dk0 + t) + r] = acc[t][i];
            } else {
                const int uu = u - NU_KV, bh = uu / 63, c = 1 + uu % 63, b = bh >> 3, h = bh & 7;
                const int r = lane & 31, hp = lane >> 5;
                const int s = 256 * c + 32 * wave + r;
                const f16* qrow = att_ptr(PJ, 0, bh, s);
                h8 qf[4];
#pragma unroll
                for (int ks = 0; ks < 4; ++ks) qf[ks] = *(const h8*)(qrow + 16 * ks + 8 * hp);
                const f16* km = kmean + (size_t)bh * 64 * 64;
                float v[2][16];
#pragma unroll
                for (int t = 0; t < 2; ++t) {
                    f32x16 g;
#pragma unroll
                    for (int i = 0; i < 16; ++i) g[i] = 0.f;
                    if (t == 0 || c > 32) {
#pragma unroll
                        for (int ks = 0; ks < 4; ++ks) { const h8 kf = *(const h8*)(km + (32 * t + r) * 64 + 16 * ks + 8 * hp); g = MFMA32(kf, qf[ks], g); }
                    }
#pragma unroll
                    for (int i = 0; i < 16; ++i) v[t][i] = (32 * t + crow(i, hp) < c) ? g[i] : -3.0e38f;
                }
                int sel[3]; bool sval[3];
#pragma unroll
                for (int rd = 0; rd < 3; ++rd) {
                    float mv = -3.0e38f; int mi = 1 << 20;
#pragma unroll
                    for (int t = 0; t < 2; ++t)
#pragma unroll
                        for (int i = 0; i < 16; ++i) { const int idx = 32 * t + crow(i, hp); const float val = v[t][i]; if (val > mv || (val == mv && idx < mi)) { mv = val; mi = idx; } }
                    const float ov = __shfl_xor(mv, 32); const int oi = __shfl_xor(mi, 32);
                    if (ov > mv || (ov == mv && oi < mi)) { mv = ov; mi = oi; }
                    sel[rd] = mi; sval[rd] = mv > -1.0e38f;
#pragma unroll
                    for (int t = 0; t < 2; ++t)
#pragma unroll
                        for (int i = 0; i < 16; ++i) if (32 * t + crow(i, hp) == mi) v[t][i] = -3.0e38f;
                }
                LAS unsigned* hist = (LAS unsigned*)(lds + 96 * 1024);
                if (tid < 64) hist[tid] = 0u;
                __syncthreads();
                unsigned rank[3];
#pragma unroll
                for (int rd = 0; rd < 3; ++rd) { rank[rd] = 0u; if (sval[rd] && hp == 0) rank[rd] = __hip_atomic_fetch_add(hist + sel[rd], 1u, __ATOMIC_RELAXED, __HIP_MEMORY_SCOPE_WORKGROUP); }
                __syncthreads();
                if (tid < 64) { const unsigned n = hist[tid]; unsigned base = 0u; if (n) base = atomicAdd(lcnt_w + bh * 64 + tid, n); hist[64 + tid] = base; }
                __syncthreads();
#pragma unroll
                for (int rd = 0; rd < 3; ++rd) if (sval[rd] && hp == 0) { const int lb = sel[rd]; const unsigned pos = hist[64 + lb] + rank[rd];
                    mlist_w[(size_t)bh * MLIST_PER_BH + (size_t)lb * SEQ - 128 * lb * (lb + 1) + pos] = (unsigned short)((s << 2) | rd); }
            }
        }
    }
    SEAM(2);

    if (IN(3)) REP(3) {
        PROF_B(33);
        if (!(a.alt & 2)) for (int gid = bid * 512 + tid; gid < 8 * 16384; gid += G * 512) {
            const int bh = gid >> 14, e = gid & 16383, h = bh & 3;
            const float cd = fexp2(256.0f * gamma_log2(h));
            const float* src = kvbuf + (size_t)bh * 64 * 16384 + e; f16* dst = Rbuf + (size_t)bh * 64 * 16384 + e;
            float run = 0.f;
#pragma unroll 8
            for (int i = 0; i < 64; ++i) { dst[(size_t)i * 16384] = (f16)run; run = run * cd + src[(size_t)i * 16384]; }
        }
        PROF_E(33); PROF_B(32);
        LAS int* pre = (LAS int*)(lds + 96 * 1024);
        LAS int* cpre = pre + 1032;
        LAS int* wsum = cpre + 1032;
        {
            const int c0 = (int)lcnt[2 * tid], c1 = (int)lcnt[2 * tid + 1];
            const int n0 = (c0 + 255) >> 8, n1 = (c1 + 255) >> 8;
            const int k0 = n0 ? 5 * n0 + 3 : 0, k1 = n1 ? 5 * n1 + 3 : 0;
            int v = n0 + n1, incl = v, cv = k0 + k1, cincl = cv;
#pragma unroll
            for (int o = 1; o < 64; o <<= 1) { const int t = __shfl_up(incl, o), ct = __shfl_up(cincl, o); if (lane >= o) { incl += t; cincl += ct; } }
            if (lane == 63) { wsum[wave] = incl; wsum[8 + wave] = cincl; }
            __syncthreads();
            int woff = 0, cwoff = 0;
            for (int k = 0; k < wave; ++k) { woff += wsum[k]; cwoff += wsum[8 + k]; }
            const int ex = woff + incl - v, cex = cwoff + cincl - cv;
            pre[2 * tid] = ex; pre[2 * tid + 1] = ex + n0; cpre[2 * tid] = cex; cpre[2 * tid + 1] = cex + k0;
            if (tid == 511) { pre[1024] = ex + v; cpre[1024] = cex + cv; }
            __syncthreads();
        }
        PROF_E(32);
        const int U = pre[1024], CT = cpre[1024];
        int ubnd[2];
#pragma unroll
        for (int e = 0; e < 2; ++e) {
            const int x = (int)(((long)CT * (bid + e)) / G);
            int l = 0;
#pragma unroll 1
            for (int step = 512; step > 0; step >>= 1) if (l + step <= 1023 && cpre[l + step] <= x) l += step;
            const int rem = x - cpre[l], n = pre[l + 1] - pre[l];
            int ch = rem <= 0 ? 0 : (rem - 3 + 4) / 5; ch = (rem > 0 && ch < 1) ? 1 : ch; ch = ch > n ? n : ch;
            ubnd[e] = (x >= CT) ? U : pre[l] + ch;
        }
        const int u_lo = ubnd[0], u_hi = (a.alt & 4) ? u_lo : ubnd[1];
        LAS unsigned char* Kl = lds; LAS unsigned char* Vl = lds + 256 * KP64;
        constexpr int NUB = 32;
        LAS int* uinf = (LAS int*)(lds + 108 * 1024);
        LAS unsigned short* uent = (LAS unsigned short*)(lds + 112 * 1024);
        int staged = -1;
        const int r = lane & 31, hp = lane >> 5;
        for (int ub = u_lo; ub < u_hi; ub += NUB) {
            const int nu = (u_hi - ub) < NUB ? (u_hi - ub) : NUB;
            __syncthreads();
            if (tid < nu) { const int u = ub + tid; int l = 0;
#pragma unroll 1
                for (int step = 512; step > 0; step >>= 1) if (l + step <= 1023 && pre[l + step] <= u) l += step;
                const int chunk = u - pre[l]; int rows = (int)lcnt[l] - 256 * chunk; rows = rows > 256 ? 256 : rows;
                uinf[4 * tid] = l; uinf[4 * tid + 1] = chunk; uinf[4 * tid + 2] = rows; }
            __syncthreads();
            for (int i = tid >> 8; i < nu; i += 2) { const int l = uinf[4 * i], chunk = uinf[4 * i + 1], rows = uinf[4 * i + 2], ri = tid & 255, bh = l >> 6, j = l & 63;
                uent[i * 256 + ri] = mlist[(size_t)bh * MLIST_PER_BH + (size_t)j * SEQ - 128 * j * (j + 1) + 256 * chunk + (ri < rows ? ri : 0)]; }
            __syncthreads();
            h8 qn[4];
            { const int l = uinf[0], bh = l >> 6; const unsigned ent = uent[32 * wave + r]; const int s = (int)(ent >> 2);
              const f16* qrow = att_ptr(PJ, 0, bh, s);
#pragma unroll
              for (int ks = 0; ks < 4; ++ks) qn[ks] = *(const h8*)(qrow + 16 * ks + 8 * hp); }
            for (int i = 0; i < nu; ++i) {
                const int l = uinf[4 * i], rows = uinf[4 * i + 2], bh = l >> 6, j = l & 63, b = bh >> 3, h = bh & 7;
                const unsigned ent = uent[i * 256 + 32 * wave + r];
                h8 qf[4];
#pragma unroll
                for (int ks = 0; ks < 4; ++ks) qf[ks] = qn[ks];
                if (i + 1 < nu) { const int l2 = uinf[4 * (i + 1)], bh2 = l2 >> 6; const unsigned e2 = uent[(i + 1) * 256 + 32 * wave + r]; const int s2 = (int)(e2 >> 2);
                    const f16* qrow = att_ptr(PJ, 0, bh2, s2);
#pragma unroll
                    for (int ks = 0; ks < 4; ++ks) qn[ks] = *(const h8*)(qrow + 16 * ks + 8 * hp); }
                PROF_B(30);
                if (l != staged) {
                    __syncthreads();
                    stage64<KP64>(Kl, att_ptr(PJ, 1, bh, j * 256), 64, tid);
                    stage64<VP64>(Vl, att_ptr(PJ, 2, bh, j * 256), 64, tid);
                    __syncthreads();
                    staged = l;
                }
                PROF_E(30); PROF_B(31);
                if (32 * wave < rows) {
                    const bool valid = 32 * wave + r < rows;
                    const int s = (int)(ent >> 2), slot = (int)(ent & 3u);
                    float m2, ls; f32x16 o[2];
                    attn_tile<false>(Kl, Vl, biasl + h * BTP, qf, s - 256 * j, 0, lane, m2, ls, o);
                    if (valid) {
                        const size_t pidx = ((size_t)bh * SEQ + s) * 3 + slot;
                        if (hp == 0) pml[pidx] = (f32x2){m2, ls};
                        const float inv = 1.0f / ls; f16* po = pO + pidx * 64 + 32 * hp;
#pragma unroll
                        for (int dt = 0; dt < 2; ++dt)
#pragma unroll
                            for (int g2 = 0; g2 < 2; ++g2) { const f32x8 vv = {o[dt][8 * g2] * inv, o[dt][8 * g2 + 1] * inv, o[dt][8 * g2 + 2] * inv, o[dt][8 * g2 + 3] * inv, o[dt][8 * g2 + 4] * inv, o[dt][8 * g2 + 5] * inv, o[dt][8 * g2 + 6] * inv, o[dt][8 * g2 + 7] * inv};
                                *(h8*)(po + 16 * dt + 8 * g2) = __builtin_convertvector(vv, h8); }
                    }
                }
                PROF_E(31);
            }
        }
        __syncthreads();
    }
    SEAM(3);

    if (IN(4)) REP(4) {
        constexpr int NU_A = 16 * 64, NU_R = 8 * 64;
        for (int u = (a.alt & 2) ? NU_R : bid; u < NU_R; u += G) {
            __syncthreads();
            {
                const int bh = u >> 6, ci = u & 63, b = bh >> 2, h = bh & 3;
                const float lg = gamma_log2(h);
                const size_t row0 = (size_t)b * SEQ + ci * 256;
                LAS unsigned char* Kl = lds; LAS unsigned char* Vl = lds + 256 * 272;
                PROF_B(40);
                const int r = lane & 31, hp = lane >> 5, i16 = lane & 15, q4 = i16 >> 2, p4 = i16 & 3, cb = (lane >> 4) & 1;
                const int qt = wave < 4 ? wave : 11 - wave;
                const int ql = 32 * qt + r;
#pragma unroll
                for (int i = 0; i < 8; ++i) { const int q = tid + 512 * i, row = q >> 4, ch = q & 15;
                    *(LAS h8*)(Kl + row * 272 + 16 * ch) = *(const h8*)(ret_ptr(PJ, 4, bh, ci * 256 + row) + 8 * ch);
                    *(LAS h8*)(Vl + row * 320 + 16 * ch) = *(const h8*)(ret_ptr(PJ, 5, bh, ci * 256 + row) + 8 * ch); }
                __syncthreads();
                PROF_E(40); PROF_B(41);
                const f16* qrow = ret_ptr(PJ, 3, bh, ci * 256 + ql);
                h8 qf[8];
#pragma unroll
                for (int ks = 0; ks < 8; ++ks) qf[ks] = *(const h8*)(qrow + 16 * ks + 8 * hp);
                f32x16 o[4];
#pragma unroll
                for (int t = 0; t < 4; ++t)
#pragma unroll
                    for (int i = 0; i < 16; ++i) o[t][i] = 0.f;
                const f16* Rt = Rbuf + (size_t)u * 128 * 128;
#pragma unroll
                for (int t = 0; t < 4; ++t)
#pragma unroll
                    for (int ks = 0; ks < 8; ++ks) { const h8 rf = *(const h8*)(Rt + (32 * t + r) * 128 + 16 * ks + 8 * hp); o[t] = MFMA32(rf, qf[ks], o[t]); }
                const f16* grow = ret_ptr(PJ, 6, bh, ci * 256 + ql);
                h4 rgv[16];
#pragma unroll
                for (int g = 0; g < 16; ++g) rgv[g] = *(const h4*)(grow + 8 * g + 4 * hp);
                const float qd = fexp2(lg * (float)(ql + 1));
#pragma unroll
                for (int t = 0; t < 4; ++t)
#pragma unroll
                    for (int i = 0; i < 16; ++i) o[t][i] *= qd;
                PROF_E(41); PROF_B(42);
                LAS const unsigned char* vbase = Vl + (4 * hp + q4) * 320 + 2 * (16 * cb + 4 * p4);
                for (int kt = 0; kt <= qt; ++kt) {
                    f32x16 st;
#pragma unroll
                    for (int i = 0; i < 16; ++i) st[i] = 0.f;
#pragma unroll
                    for (int ks = 0; ks < 8; ++ks) { const h8 kf = *(const LAS h8*)(Kl + (32 * kt + r) * 272 + 32 * ks + 16 * hp); st = MFMA32(kf, qf[ks], st); }
#pragma unroll
                    for (int i = 0; i < 16; ++i) { const int dist = ql - (32 * kt + crow(i, hp)); st[i] = dist >= 0 ? st[i] * fexp2(lg * (float)dist) : 0.f; }
#pragma unroll
                    for (int s = 0; s < 2; ++s) {
                        const f32x8 pv = {st[8 * s], st[8 * s + 1], st[8 * s + 2], st[8 * s + 3], st[8 * s + 4], st[8 * s + 5], st[8 * s + 6], st[8 * s + 7]};
                        const h8 pf = __builtin_convertvector(pv, h8);
#pragma unroll
                        for (int t = 0; t < 4; ++t) {
                            LAS const unsigned char* vp = vbase + (32 * kt + 16 * s) * 320 + 64 * t;
                            const h8 vf = cat44(tr_read(vp), tr_read(vp + 8 * 320));
                            o[t] = MFMA32(vf, pf, o[t]);
                        }
                    }
                }
                PROF_E(42); PROF_B(43);
                float sm = 0.f;
#pragma unroll
                for (int t = 0; t < 4; ++t)
#pragma unroll
                    for (int i = 0; i < 16; ++i) sm += o[t][i];
                sm += __shfl_xor(sm, 32);
                const float mu = sm * (1.0f / 128.0f);
                float sq = 0.f;
#pragma unroll
                for (int t = 0; t < 4; ++t)
#pragma unroll
                    for (int i = 0; i < 16; ++i) { const float d = o[t][i] - mu; sq += d * d; }
                sq += __shfl_xor(sq, 32);
                const float rstd = 1.0f / sqrtf(sq * (1.0f / 128.0f) + LN_EPS);
                f16* crow_ = cat + (row0 + ql) * DM + 512 + h * 128;
#pragma unroll
                for (int t = 0; t < 4; ++t)
#pragma unroll
                    for (int g = 0; g < 4; ++g) { const int d0 = 32 * t + 8 * g + 4 * hp;
                        const h4 gv = rgv[4 * t + g]; f32x4 ov;
#pragma unroll
                        for (int e = 0; e < 4; ++e) { const float gg = (float)gv[e]; const float sl = gg / (1.0f + fexp2(-gg * LOG2E)); ov[e] = sl * (o[t][4 * g + e] - mu) * rstd; }
                        *(h4*)(crow_ + d0) = __builtin_convertvector(ov, h4); }
                PROF_E(43);
            }
        }
        {
            LAS unsigned char* Kl = lds; LAS unsigned char* Vl = lds + 256 * KP64;
            const int r = lane & 31, hp = lane >> 5;
            h8 kr[4], vr[4], qn[4];
            const int qt = wave < 4 ? wave : 11 - wave;
            int uu = (a.alt & 4) ? NU_A : bid;
            if (uu < NU_A) { const int bh = uu >> 6, c = uu & 63; const f16* kp = att_ptr(PJ, 1, bh, c * 256);
                { const f16* qrow = att_ptr(PJ, 0, bh, 256 * c + 32 * qt + r);
#pragma unroll
                  for (int ks = 0; ks < 4; ++ks) qn[ks] = *(const h8*)(qrow + 16 * ks + 8 * hp); }
#pragma unroll
                for (int i = 0; i < 4; ++i) { const int q = tid + 512 * i, row = q >> 3, ch = q & 7; kr[i] = *(const h8*)(kp + (size_t)row * 64 + 8 * ch); vr[i] = *(const h8*)(kp + PJ_SLICE + (size_t)row * 64 + 8 * ch); } }
            for (; uu < NU_A; uu += G) {
                const int bh = uu >> 6, c = uu & 63, b = bh >> 3, h = bh & 7;
                PROF_B(44);
                __syncthreads();
#pragma unroll
                for (int i = 0; i < 4; ++i) { const int q = tid + 512 * i, row = q >> 3, ch = q & 7; *(LAS h8*)(Kl + row * KP64 + 16 * ch) = kr[i]; *(LAS h8*)(Vl + row * VP64 + 16 * ch) = vr[i]; }
                __syncthreads();
                h8 qf[4];
#pragma unroll
                for (int ks = 0; ks < 4; ++ks) qf[ks] = qn[ks];
                if (uu + G < NU_A) { const int u2 = uu + G, bh2 = u2 >> 6, c2 = u2 & 63; const f16* kp = att_ptr(PJ, 1, bh2, c2 * 256);
                    { const f16* qrow = att_ptr(PJ, 0, bh2, 256 * c2 + 32 * qt + r);
#pragma unroll
                      for (int ks = 0; ks < 4; ++ks) qn[ks] = *(const h8*)(qrow + 16 * ks + 8 * hp); }
#pragma unroll
                    for (int i = 0; i < 4; ++i) { const int q = tid + 512 * i, row = q >> 3, ch = q & 7; kr[i] = *(const h8*)(kp + (size_t)row * 64 + 8 * ch); vr[i] = *(const h8*)(kp + PJ_SLICE + (size_t)row * 64 + 8 * ch); } }
                const int ql = 32 * qt + r, s = 256 * c + ql;
                const int nsel = c < 3 ? c : 3;
                const size_t pidx = ((size_t)bh * SEQ + s) * 3;
                float pm[3], pl[3]; h8 pv[3][4];
#pragma unroll
                for (int t = 0; t < 3; ++t) { const f32x2 v = pml[pidx + t]; pm[t] = v[0]; pl[t] = v[1]; const f16* po = pO + (pidx + t) * 64 + 32 * hp;
#pragma unroll
                    for (int k = 0; k < 4; ++k) pv[t][k] = *(const h8*)(po + 8 * k); }
                PROF_E(44); PROF_B(45);
                float m2, ls; f32x16 o[2];
                attn_own(Kl, Vl, biasl + h * BTP, qf, ql, qt, lane, m2, ls, o);
                PROF_E(45); PROF_B(46);
#pragma unroll
                for (int t = 0; t < 3; ++t) { const bool ok = t < nsel; pm[t] = ok ? pm[t] : -3.0e38f; pl[t] = ok ? pl[t] : 0.f;
#pragma unroll
                    for (int k = 0; k < 4; ++k) pv[t][k] = ok ? pv[t][k] : (h8){0, 0, 0, 0, 0, 0, 0, 0}; }
                float M = m2;
#pragma unroll
                for (int t = 0; t < 3; ++t) M = fmaxf(M, pm[t]);
                const float e0 = fexp2(m2 - M); float L = ls * e0;
#pragma unroll
                for (int dt = 0; dt < 2; ++dt)
#pragma unroll
                    for (int i = 0; i < 16; ++i) o[dt][i] *= e0;
#pragma unroll
                for (int t = 0; t < 3; ++t) { const float wt = pl[t] * fexp2(pm[t] - M); L += wt;
#pragma unroll
                    for (int k = 0; k < 4; ++k)
#pragma unroll
                        for (int e = 0; e < 8; ++e) o[k >> 1][8 * (k & 1) + e] += wt * (float)pv[t][k][e]; }
                const float invL = 1.0f / L; float sq = 0.f;
                f16* crow_ = cat + (size_t)(b * SEQ + s) * DM + h * 64;
#pragma unroll
                for (int dt = 0; dt < 2; ++dt)
#pragma unroll
                    for (int g = 0; g < 4; ++g) { f32x4 ov;
#pragma unroll
                        for (int e = 0; e < 4; ++e) { ov[e] = o[dt][4 * g + e] * invL; sq += ov[e] * ov[e]; }
                        *(h4*)(crow_ + 32 * dt + 8 * g + 4 * hp) = __builtin_convertvector(ov, h4); }
                sq += __shfl_xor(sq, 32);
                if (hp == 0) sumsq[(size_t)(b * SEQ + s) * 8 + h] = sq;
                PROF_E(46);
            }
        }
        __syncthreads();
    }
    SEAM(4);

    if (IN(5)) {
        pg8::StaticOrder S; S.init(cat, WoT, DM, DM, NTOK, DM, G, bid);
        EpiZ E{a.x, zbuf, sumsq};
        pg8::gemm_phase<EpiZ, pg8::StaticOrder, true>(lds, DM, DM / 64, S, E);
    }
    SEAM(5);

    if (IN(6)) REP(6) {
        unsigned* ecnt_w = (rep_ | a.alt) ? ecnt + 32 : ecnt; int* elist_w = (rep_ | a.alt) ? (int*)(ws + 496 * MiB) : elist; float* wts_w = (rep_ | a.alt) ? (float*)(ws + 500 * MiB) : wts;
        LAS unsigned char* Ht = lds;
        LAS float* lg = (LAS float*)(lds + 32 * 2064);
        f32x8 gv[2], bv[2];
#pragma unroll
        for (int j = 0; j < 2; ++j) { gv[j] = *(const f32x8*)(a.ln1g + 8 * lane + 512 * j); bv[j] = *(const f32x8*)(a.ln1b + 8 * lane + 512 * j); }
        for (int u = bid; u < NTOK / 32; u += G) {
            __syncthreads();
            h8 zin[4][2];
#pragma unroll
            for (int rr = 0; rr < 4; ++rr)
#pragma unroll
                for (int j = 0; j < 2; ++j) zin[rr][j] = *(const h8*)(zbuf + ((size_t)u * 32 + 4 * wave + rr) * DM + 8 * lane + 512 * j);
#pragma unroll
            for (int rr = 0; rr < 4; ++rr) {
                const int rl = 4 * wave + rr; const size_t row = (size_t)u * 32 + rl;
                f32x8 v[2]; float s = 0.f;
#pragma unroll
                for (int j = 0; j < 2; ++j) { v[j] = __builtin_convertvector(zin[rr][j], f32x8);
#pragma unroll
                    for (int e = 0; e < 8; ++e) s += v[j][e]; }
                const float mean = wave_sum(s) * (1.0f / DM); float s2 = 0.f;
#pragma unroll
                for (int j = 0; j < 2; ++j) { v[j] = v[j] - mean;
#pragma unroll
                    for (int e = 0; e < 8; ++e) s2 += v[j][e] * v[j][e]; }
                const float rstd = 1.0f / sqrtf(wave_sum(s2) * (1.0f / DM) + LN_EPS);
#pragma unroll
                for (int j = 0; j < 2; ++j) { const h8 hv = __builtin_convertvector(v[j] * rstd * gv[j] + bv[j], h8);
                    *(h8*)(hh + row * DM + 8 * lane + 512 * j) = hv; *(LAS h8*)(Ht + rl * 2064 + 2 * (8 * lane + 512 * j)) = hv;
                    const f32x8 hf = __builtin_convertvector(hv, f32x8);
                    *(u32x2*)(hh8 + row * DM + 8 * lane + 512 * j) = cvt8_fp8((f32x4){hf[0], hf[1], hf[2], hf[3]}, (f32x4){hf[4], hf[5], hf[6], hf[7]}); }
            }
            __syncthreads();
            if (wave < 6) {
                const int rt = wave / 3, ct = wave % 3, fr = lane & 15, fq = lane >> 4;
                f32x4 acc = {0.f, 0.f, 0.f, 0.f};
#pragma unroll 8
                for (int ks = 0; ks < 32; ++ks) { const h8 af = *(const LAS h8*)(Ht + (16 * rt + fr) * 2064 + 2 * (32 * ks + 8 * fq));
                    const h8 bf = *(const h8*)(WrT + (size_t)(16 * ct + fr) * DM + 32 * ks + 8 * fq); acc = MFMA16(af, bf, acc); }
#pragma unroll
                for (int e = 0; e < 4; ++e) lg[(16 * rt + 4 * fq + e) * 48 + 16 * ct + fr] = acc[e];
            }
            __syncthreads();
            if (tid < 32) {
                LAS unsigned* eh = (LAS unsigned*)(lds + 80 * 1024);
                eh[tid] = 0u;
                const int tok = u * 32 + tid; LAS const float* L = lg + tid * 48;
                float g4[4]; int gi = 0; float gm = -3.0e38f;
#pragma unroll
                for (int k = 0; k < 4; ++k) { g4[k] = L[k] + a.brg[k]; if (g4[k] > gm) { gm = g4[k]; gi = k; } }
                float gs = 0.f;
#pragma unroll
                for (int k = 0; k < 4; ++k) gs += __expf(g4[k] - gm);
                const float gp = 1.0f / gs;
                float l1 = -3.0e38f, l2 = -3.0e38f; int i1 = 0, i2 = 0;
                for (int k = 0; k < 8; ++k) { const float v = L[4 + 8 * gi + k] + a.bre[8 * gi + k]; if (v > l1) { l2 = l1; i2 = i1; l1 = v; i1 = k; } else if (v > l2) { l2 = v; i2 = k; } }
                const float w1 = 1.0f / (1.0f + __expf(l2 - l1)), w2 = 1.0f - w1;
                const int e1 = 8 * gi + i1, e2 = 8 * gi + i2;
                LDS_WAIT();
                const unsigned r1 = __hip_atomic_fetch_add(eh + e1, 1u, __ATOMIC_RELAXED, __HIP_MEMORY_SCOPE_WORKGROUP);
                const unsigned r2 = __hip_atomic_fetch_add(eh + e2, 1u, __ATOMIC_RELAXED, __HIP_MEMORY_SCOPE_WORKGROUP);
                LDS_WAIT();
                { const unsigned n = eh[tid]; unsigned base = 0u; if (n) base = atomicAdd(ecnt_w + tid * 64, n); eh[32 + tid] = base; }
                LDS_WAIT();
                const unsigned p1 = eh[32 + e1] + r1, p2 = eh[32 + e2] + r2;
                elist_w[e1 * NTOK + (int)p1] = tok * 2; elist_w[e2 * NTOK + (int)p2] = tok * 2 + 1;
                wts_w[tok * 2] = gp * w1; wts_w[tok * 2 + 1] = gp * w2;
            }
        }
        __syncthreads();
    }
    SEAM(6);

    LAS int* mtab = (LAS int*)(lds + pg8::STAGE_BYTES + 1024);
    if (IN(7) || IN(8)) {
        if (tid == 0) { int acc = 0; for (int e = 0; e < 32; ++e) { const int c = (int)ecnt[e * 64]; mtab[e] = c; mtab[32 + e] = acc; acc += (c + 255) >> 8; } mtab[64] = acc; }
        __syncthreads();
    }
    if (IN(7)) {
        MoeSched<true> S{mtab, elist, (const char*)hh8, (const char*)WguT, (size_t)DM * DM, DM, DM, G, bid};
        EpiGU E{hid};
        pg8::gemm_phase8<EpiGU, MoeSched<true>, true>(lds, DM, DM / 128, S, E);
    }
    SEAM(7);
    if (IN(8)) {
        MoeSched<false> S{mtab, elist, (const char*)hid, (const char*)WdnT, (size_t)DM * DE, DE, DE, G, bid};
        EpiDown E{ybuf, elist, wts, mtab};
        pg8::gemm_phase8<EpiDown, MoeSched<false>, true>(lds, DE, DE / 128, S, E);
    }
    SEAM(8);

#ifdef CHECK_MOE
    if (IN(9)) {
        if (bid < 64) {
            const int e = bid & 31, idx = bid >> 5;
            LAS float* hv = (LAS float*)lds; LAS float* hd = hv + 1024; LAS float* red = hd + 512; LAS int* ired = (LAS int*)(red + 16);
            { const int cnt = (int)ecnt[e * 64]; int best = idx ? -1 : 0x7fffffff;
              for (int k = tid; k < cnt; k += 512) { const int v = elist[e * NTOK + k]; best = idx ? (v > best ? v : best) : (v < best ? v : best); }
#pragma unroll
              for (int o = 1; o < 64; o <<= 1) { const int t = __shfl_xor(best, o); best = idx ? (t > best ? t : best) : (t < best ? t : best); }
              if (lane == 0) ired[wave] = best;
              __syncthreads();
              best = ired[0];
              for (int k = 1; k < 8; ++k) { const int t = ired[k]; best = idx ? (t > best ? t : best) : (t < best ? t : best); }
              ired[8] = best; }
            __syncthreads();
            const int ent = ired[8], tok = ent >> 1; const float w = wts[ent];
            for (int k = tid; k < DM; k += 512) hv[k] = (float)hh[(size_t)tok * DM + k];
            __syncthreads();
            { const float* wg = a.wgu + (size_t)e * DM * DM + tid; float g = 0.f, up = 0.f;
              for (int k = 0; k < DM; ++k) { g += hv[k] * wg[(size_t)k * DM]; up += hv[k] * wg[(size_t)k * DM + 512]; }
              hd[tid] = g / (1.0f + __expf(-g)) * up; }
            __syncthreads();
            float e2 = 0.f, r2 = 0.f;
            for (int n = tid; n < DM; n += 512) { const float* wd = a.wdn + (size_t)e * DE * DM + n; float y = 0.f;
                for (int j = 0; j < DE; ++j) y += hd[j] * wd[(size_t)j * DM];
                y *= w; const float d = (float)ybuf[(size_t)ent * DM + n] - y; e2 += d * d; r2 += y * y; }
            e2 = wave_sum(e2); r2 = wave_sum(r2);
            if (lane == 0) { red[wave] = e2; red[8 + wave] = r2; }
            __syncthreads();
            if (tid == 0) { float se = 0.f, sr = 0.f; for (int k = 0; k < 8; ++k) { se += red[k]; sr += red[8 + k]; }
                __hip_atomic_store(ctl + 24580 + 2 * bid, __float_as_uint(se), __ATOMIC_RELAXED, __HIP_MEMORY_SCOPE_AGENT); __hip_atomic_store(ctl + 24581 + 2 * bid, __float_as_uint(sr), __ATOMIC_RELAXED, __HIP_MEMORY_SCOPE_AGENT); }
        }
        xcd_barrier(bar);
        float se = 0.f, sr = 0.f;
        for (int k = 0; k < 64; ++k) { se += __uint_as_float(__hip_atomic_load(ctl + 24580 + 2 * k, __ATOMIC_RELAXED, __HIP_MEMORY_SCOPE_AGENT)); sr += __uint_as_float(__hip_atomic_load(ctl + 24581 + 2 * k, __ATOMIC_RELAXED, __HIP_MEMORY_SCOPE_AGENT)); }
        const float cval = sqrtf(1.0e6f * se / sr);
        for (size_t i = (size_t)bid * 512 + tid; i < (size_t)NTOK * DM / 4; i += (size_t)G * 512) ((f32x4*)a.out)[i] = (f32x4){cval, cval, cval, cval};
    }
    if (false) {
#elif defined(DIAG_PHASE)
    if (IN(9)) { xcd_barrier(bar); const float cval = sqrtf((float)__hip_atomic_load(ctl + 24576, __ATOMIC_RELAXED, __HIP_MEMORY_SCOPE_AGENT) * 0.01f);
        for (size_t i = (size_t)bid * 512 + tid; i < (size_t)NTOK * DM / 4; i += (size_t)G * 512) ((f32x4*)a.out)[i] = (f32x4){cval, cval, cval, cval}; }
    if (false) {
#else
    if (IN(9)) REP(9) {
#endif
        f32x4 gv[4], bv[4];
#pragma unroll
        for (int j = 0; j < 4; ++j) { gv[j] = *(const f32x4*)(a.ln2g + 4 * lane + 256 * j); bv[j] = *(const f32x4*)(a.ln2b + 4 * lane + 256 * j); }
        for (int row = bid * 8 + wave; row < NTOK; row += G * 8) {
            f32x4 v[4]; float s = 0.f;
#pragma unroll
            for (int j = 0; j < 4; ++j) { const size_t c = 4 * lane + 256 * j;
                const f32x4 hv = __builtin_convertvector(*(const h4*)(hh + (size_t)row * DM + c), f32x4);
                const f32x4 y0 = __builtin_convertvector(*(const h4*)(ybuf + (size_t)(2 * row) * DM + c), f32x4);
                const f32x4 y1 = __builtin_convertvector(*(const h4*)(ybuf + (size_t)(2 * row + 1) * DM + c), f32x4);
                v[j] = hv * ALPHA + (y0 + y1); s += (v[j][0] + v[j][1]) + (v[j][2] + v[j][3]); }
            const float mean = wave_sum(s) * (1.0f / DM); float s2 = 0.f;
#pragma unroll
            for (int j = 0; j < 4; ++j) { v[j] = v[j] - mean; s2 += (v[j][0] * v[j][0] + v[j][1] * v[j][1]) + (v[j][2] * v[j][2] + v[j][3] * v[j][3]); }
            const float rstd = 1.0f / sqrtf(wave_sum(s2) * (1.0f / DM) + LN_EPS);
#pragma unroll
            for (int j = 0; j < 4; ++j) *(f32x4*)(a.out + (size_t)row * DM + 4 * lane + 256 * j) = v[j] * rstd * gv[j] + bv[j];
        }
    }
#ifdef PROF_SEG
    PROF_E(19);
    if (prof_on) { const unsigned long long t0 = __builtin_amdgcn_s_memrealtime(), dt = (unsigned long long)PROF_K * prof_acc; while (__builtin_amdgcn_s_memrealtime() - t0 < dt) __builtin_amdgcn_s_sleep(8); }
#endif
#undef IN
#undef SEAM
}

extern "C" void kernel_launch(void* const* d_in, const int* in_sizes, int n_in, void* d_out, int out_size, void* d_ws, size_t ws_size, hipStream_t stream) {
    static int grid = 0;
    if (grid == 0) {
        if (n_in != 15 || in_sizes[0] != NTOK * DM || out_size != NTOK * DM || ws_size < WS_END) { fprintf(stderr, "kernel_launch: unexpected problem (n_in %d, ws %zu)\n", n_in, ws_size); grid = -1; return; }
        int dev = 0, cus = 0, per_cu = 0;
        if (hipGetDevice(&dev) != hipSuccess || hipDeviceGetAttribute(&cus, hipDeviceAttributeMultiprocessorCount, dev) != hipSuccess) { grid = -1; return; }
        if (hipFuncSetAttribute((const void*)fwd, hipFuncAttributeMaxDynamicSharedMemorySize, LDS_BYTES) != hipSuccess) { fprintf(stderr, "kernel_launch: hipFuncSetAttribute failed\n"); grid = -1; return; }
        if (hipOccupancyMaxActiveBlocksPerMultiprocessor(&per_cu, (const void*)fwd, 512, LDS_BYTES) != hipSuccess || per_cu < 1) { fprintf(stderr, "kernel_launch: occupancy query says %d\n", per_cu); (void)hipGetLastError(); grid = -1; return; }
        grid = cus;
    }
    if (grid < 0) return;
    (void)hipMemsetAsync((char*)d_ws + WS_CTL, 0, CTL_ZERO_BYTES, stream);
    Args a{};
    a.x = (const float*)d_in[0]; a.w_in = (const float*)d_in[1]; a.gain = (const float*)d_in[2]; a.rel = (const float*)d_in[3]; a.w_out = (const float*)d_in[4];
    a.ln1g = (const float*)d_in[5]; a.ln1b = (const float*)d_in[6]; a.wrg = (const float*)d_in[7]; a.brg = (const float*)d_in[8]; a.wre = (const float*)d_in[9];
    a.bre = (const float*)d_in[10]; a.wgu = (const float*)d_in[11]; a.wdn = (const float*)d_in[12]; a.ln2g = (const float*)d_in[13]; a.ln2b = (const float*)d_in[14];
    a.out = (float*)d_out; a.ws = (unsigned char*)d_ws;
#if MK_LAUNCHES == 1
    a.ph_lo = 0; a.ph_hi = NPHASE;
    hipLaunchKernelGGL(fwd, dim3(grid), dim3(512), LDS_BYTES, stream, a);
#else
    for (int p = 0; p < NPHASE; ++p) { a.ph_lo = p; a.ph_hi = p + 1; a.alt = 0; hipLaunchKernelGGL(fwd, dim3(grid), dim3(512), LDS_BYTES, stream, a);
#ifdef HOST_DUP
#ifndef HOST_ALT
#define HOST_ALT 1
#endif
        if (p == HOST_DUP) { a.alt = HOST_ALT; hipLaunchKernelGGL(fwd, dim3(grid), dim3(512), LDS_BYTES, stream, a); }
#endif
    }
#endif
}
```

```cpp
#include <hip/hip_runtime.h>
#include <cstdint>
#include <cstdio>

#ifndef MK_LAUNCHES
#define MK_LAUNCHES 1
#endif

#define DI __device__ __forceinline__
#define OPAQUE_TID int tid_o_ = threadIdx.x; asm volatile("" : "+v"(tid_o_)); const int tid = tid_o_, lane = tid & 63; (void)lane
#define LAS __attribute__((address_space(3)))
typedef _Float16 f16;
typedef _Float16 h8 __attribute__((ext_vector_type(8)));
typedef _Float16 h4 __attribute__((ext_vector_type(4)));
typedef short s4v __attribute__((ext_vector_type(4)));
typedef float f32x2 __attribute__((ext_vector_type(2)));
typedef float f32x4 __attribute__((ext_vector_type(4)));
typedef float f32x8 __attribute__((ext_vector_type(8)));
typedef float f32x16 __attribute__((ext_vector_type(16)));
typedef int i32x8 __attribute__((ext_vector_type(8)));
typedef unsigned u32x2 __attribute__((ext_vector_type(2)));

constexpr int NB = 2, SEQ = 16384, DM = 1024, NTOK = NB * SEQ, NPJ = 3584;
constexpr int C_AQ = 0, C_AK = 512, C_AV = 1024, C_RQ = 1536, C_RK = 2048, C_RV = 2560, C_RG = 3072;
constexpr int NBLK = SEQ / 256;
constexpr int NE = 32, DE = 512;
constexpr float ALPHA = 1.189207115002721f, LN_EPS = 1e-5f, LOG2E = 1.4426950408889634f;
constexpr int NPHASE = 10;

constexpr size_t MiB = 1u << 20;
constexpr size_t WS_CTL = 0, CTL_ZERO_BYTES = 128 * 1024;
constexpr size_t WS_ROPEC = 1 * MiB, WS_ROPES = 5 * MiB, WS_XSUM = 9 * MiB, WS_KMEAN = 10 * MiB, WS_WRT = 10 * MiB + 512 * 1024;
constexpr size_t WS_SUMSQ = 11 * MiB, WS_WTS = 12 * MiB, WS_ELIST = 13 * MiB, WS_MLIST = 17 * MiB, WS_PML = 33 * MiB;
constexpr size_t WS_WINT = 39 * MiB, WS_WOT = 46 * MiB, WS_WGUT = 48 * MiB, WS_WDNT = 80 * MiB, WS_HH8 = 96 * MiB;
constexpr size_t WS_PJ = 144 * MiB, WS_XH = 368 * MiB, WS_CAT = 368 * MiB, WS_KV = 432 * MiB, WS_R = 464 * MiB;
constexpr size_t WS_X8 = 432 * MiB;
constexpr size_t WS_WINT8 = 41 * MiB;
constexpr size_t WS_HH = 144 * MiB, WS_HID = 208 * MiB, WS_Y = 280 * MiB, WS_END = 480 * MiB;
constexpr int MLIST_PER_BH = 516096;
constexpr int CW_BAR = 4096, CW_LCNT = 8192, CW_ECNT = 12288;

constexpr int SCR_BYTES = 155648;
constexpr int BIAS_OFF = SCR_BYTES;
constexpr int BTP = 224;
constexpr int MISC_OFF = BIAS_OFF + 8 * BTP * 4 + 128;
constexpr int LDS_BYTES = MISC_OFF + 256;
static_assert(LDS_BYTES <= 163840, "LDS");

__device__ const unsigned char T5_BUCKET[129] = {0,1,2,3,4,5,6,7,8,9,10,11,12,13,14,15,16,16,16,17,17,18,18,18,19,19,19,20,20,20,20,21,21,21,21,22,22,22,22,22,23,23,23,23,23,23,24,24,24,24,24,24,25,25,25,25,25,25,25,26,26,26,26,26,26,26,26,27,27,27,27,27,27,27,27,27,27,28,28,28,28,28,28,28,28,28,28,29,29,29,29,29,29,29,29,29,29,29,29,30,30,30,30,30,30,30,30,30,30,30,30,30,30,31,31,31,31,31,31,31,31,31,31,31,31,31,31,31,31};
__device__ const float ROPE_INV[64] = {1.0f,0.865964353f,0.749894202f,0.649381638f,0.562341332f,0.486967534f,0.421696514f,0.365174115f,0.316227764f,0.273841977f,0.237137377f,0.2053525f,0.177827939f,0.153992653f,0.133352146f,0.115478195f,0.100000001f,0.0865964293f,0.0749894232f,0.0649381652f,0.0562341325f,0.0486967526f,0.0421696492f,0.0365174115f,0.0316227749f,0.0273841955f,0.0237137377f,0.0205352511f,0.0177827943f,0.0153992651f,0.013335214f,0.0115478197f,0.00999999978f,0.00865964312f,0.00749894232f,0.00649381615f,0.00562341325f,0.00486967526f,0.00421696482f,0.00365174119f,0.00316227763f,0.00273841969f,0.00237137382f,0.00205352507f,0.00177827943f,0.00153992651f,0.00133352145f,0.00115478202f,0.00100000005f,0.000865964335f,0.000749894185f,0.000649381604f,0.000562341302f,0.000486967532f,0.000421696517f,0.000365174114f,0.000316227757f,0.000273841957f,0.00023713737f,0.00020535251f,0.00017782794f,0.00015399266f,0.00013335215f,0.0001154782f};

constexpr size_t PJ_SLICE = (size_t)NTOK * 512;
DI f16* att_ptr(f16* PJ, int sl, int bh, int s) { return PJ + (size_t)sl * PJ_SLICE + ((size_t)bh * SEQ + s) * 64; }
DI f16* ret_ptr(f16* PJ, int sl, int bh, int s) { return PJ + (size_t)sl * PJ_SLICE + ((size_t)bh * SEQ + s) * 128; }

struct Args {
    const float *x, *w_in, *gain, *rel, *w_out, *ln1g, *ln1b, *wrg, *brg, *wre, *bre, *wgu, *wdn, *ln2g, *ln2b;
    float* out; unsigned char* ws; int ph_lo, ph_hi, alt, pad;
};

#define LDS_WAIT() asm volatile("s_waitcnt lgkmcnt(0)" ::: "memory")
#define MFMA32(a, b, c) __builtin_amdgcn_mfma_f32_32x32x16_f16((a), (b), (c), 0, 0, 0)
#define MFMA16(a, b, c) __builtin_amdgcn_mfma_f32_16x16x32_f16((a), (b), (c), 0, 0, 0)
DI int crow(int reg, int hp) { return (reg & 3) + 8 * (reg >> 2) + 4 * hp; }
DI h8 cvt8(f32x4 a, f32x4 b) { const f32x8 v = {a[0], a[1], a[2], a[3], b[0], b[1], b[2], b[3]}; return __builtin_convertvector(v, h8); }
DI float wave_sum(float v) {
#pragma unroll
    for (int o = 1; o < 64; o <<= 1) v += __shfl_xor(v, o);
    return v;
}
DI h4 tr_read(LAS const unsigned char* p) {
    typedef LAS s4v lds_s4;
    const s4v v = __builtin_amdgcn_ds_read_tr16_b64_v4i16((lds_s4*)p);
    return __builtin_bit_cast(h4, v);
}
DI h8 cat44(h4 a, h4 b) { return __builtin_shufflevector(a, b, 0, 1, 2, 3, 4, 5, 6, 7); }
DI float fexp2(float x) { return __builtin_amdgcn_exp2f(x); }
DI int cvt4_fp8(f32x4 a) { int w = 0; w = __builtin_amdgcn_cvt_pk_fp8_f32(a[0], a[1], w, false); w = __builtin_amdgcn_cvt_pk_fp8_f32(a[2], a[3], w, true); return w; }
DI u32x2 cvt8_fp8(f32x4 a, f32x4 b) {
    int w0 = 0, w1 = 0;
    w0 = __builtin_amdgcn_cvt_pk_fp8_f32(a[0], a[1], w0, false); w0 = __builtin_amdgcn_cvt_pk_fp8_f32(a[2], a[3], w0, true);
    w1 = __builtin_amdgcn_cvt_pk_fp8_f32(b[0], b[1], w1, false); w1 = __builtin_amdgcn_cvt_pk_fp8_f32(b[2], b[3], w1, true);
    return (u32x2){(unsigned)w0, (unsigned)w1};
}
DI float gamma_log2(int h) { return __builtin_log2f(1.0f - fexp2(-(5.0f + (4.0f / 3.0f) * (float)h))); }

#define XB_TMO      128
#define XB_XCNT(j)  (256  + 64 * (j))
#define XB_XSUB(j)  (1280 + 64 * (j))
#define XB_XGEN(j)  (2304 + 64 * (j))
#define XB_TOP      3328
#define XB_TOPGEN   3392
#define XCD_BAR_WORDS 3456
#define XB_SPIN_CAP (1u << 18)
__device__ __forceinline__ unsigned xb_ld(unsigned* p)              { return __hip_atomic_load(p, __ATOMIC_RELAXED, __HIP_MEMORY_SCOPE_AGENT); }
__device__ __forceinline__ unsigned xb_add(unsigned* p, unsigned v) { return __hip_atomic_fetch_add(p, v, __ATOMIC_RELAXED, __HIP_MEMORY_SCOPE_AGENT); }
__device__ __forceinline__ unsigned xb_xcc_id() { return (unsigned)__builtin_amdgcn_s_getreg((3 << 11) | 20) & 0xFu; }
#define XB_SPIN(cond, bar) do { unsigned _sp = 0; while (cond) { __builtin_amdgcn_s_sleep(1); \
    if ((++_sp & 255u) == 0u) { if (xb_ld(&(bar)[XB_TMO])) break; if (_sp > XB_SPIN_CAP) { atomicAdd(&(bar)[XB_TMO], 1u); break; } } } } while (0)
struct XcdBarrier { unsigned* bar; unsigned x; volatile LAS unsigned* st; };
__device__ __forceinline__ XcdBarrier xcd_barrier_post(unsigned* bar, volatile LAS unsigned* st) {
    XcdBarrier b; b.bar = bar; b.x = xb_xcc_id(); b.st = st;
    if (threadIdx.x == 0) (void)xb_add(&bar[XB_XCNT(b.x)], 1u);
    return b;
}
__device__ __forceinline__ void xcd_barrier_complete(unsigned* bar, unsigned x, unsigned& nloc, unsigned& nx) {
    const unsigned G = gridDim.x * gridDim.y * gridDim.z;
    unsigned sum, cnt, mine, sp = 0u;
    for (;;) {
        sum = 0u; cnt = 0u; mine = 0u;
#pragma unroll
        for (unsigned j = 0; j < 16; ++j) { const unsigned c = xb_ld(&bar[XB_XCNT(j)]); sum += c; cnt += (c > 0u) ? 1u : 0u; mine = (j == x) ? c : mine; }
        if (sum == G) break;
        __builtin_amdgcn_s_sleep(1);
        if ((++sp & 255u) == 0u) { if (xb_ld(&bar[XB_TMO])) break; if (sp > XB_SPIN_CAP) { atomicAdd(&bar[XB_TMO], 1u); break; } }
    }
    nloc = mine > 0u ? mine : 1u; nx = cnt > 0u ? cnt : 1u;
}
__device__ __forceinline__ void xcd_barrier(const XcdBarrier& b) {
    asm volatile("s_waitcnt vmcnt(0)" ::: "memory");
    __syncthreads();
    if (threadIdx.x == 0) {
        unsigned* bar = b.bar;
        __builtin_amdgcn_s_waitcnt(0);
        unsigned nloc = b.st[0], nx = b.st[1];
        if (nloc == 0u) { xcd_barrier_complete(bar, b.x, nloc, nx); b.st[0] = nloc; b.st[1] = nx; }
        const unsigned old = xb_add(&bar[XB_XSUB(b.x)], 1u);
        const unsigned gen = old / nloc;
        if (old + 1u == (gen + 1u) * nloc) {
            __builtin_amdgcn_fence(__ATOMIC_RELEASE, "agent");
            asm volatile("s_waitcnt vmcnt(0)" ::: "memory");
            const unsigned og = xb_add(&bar[XB_TOP], 1u);
            const unsigned tg = og / nx;
            if (og + 1u == (tg + 1u) * nx) xb_add(&bar[XB_TOPGEN], 1u);
            else XB_SPIN(xb_ld(&bar[XB_TOPGEN]) == tg, bar);
            __builtin_amdgcn_fence(__ATOMIC_ACQUIRE, "agent");
            xb_add(&bar[XB_XGEN(b.x)], 1u);
            asm volatile("s_waitcnt vmcnt(0)" ::: "memory");
        } else {
            XB_SPIN(xb_ld(&bar[XB_XGEN(b.x)]) == gen, bar);
            __builtin_amdgcn_fence(__ATOMIC_ACQUIRE, "agent");
            asm volatile("s_waitcnt vmcnt(0)" ::: "memory");
        }
    }
    __syncthreads();
}

namespace pg8 {
constexpr int BM = 256, BK = 64, HALF = 128, HTB = HALF * BK * 2, STAGE_BYTES = 8 * HTB, NXCD = 8, WGM = 8;
DI int lds_byte(int r, int c) { const int st = (r >> 4) * 2 + (c >> 5), rr = r & 15, cc = c & 31, ob = rr * 64 + cc * 2; return st * 1024 + (ob ^ (((ob >> 9) & 1) << 5)); }
DI void stage_rc(int b, int& R, int& C) { const int st = b / 1024, sb = b % 1024, swz = sb ^ (((sb >> 9) & 1) << 5); R = (st >> 1) * 16 + swz / 64; C = (st & 1) * 32 + (swz % 64) / 2; }
DI int perm32(int rho) { const int n = rho >> 4, i = rho & 15; return 8 * (i >> 2) + 4 * n + (i & 3); }

struct Unit { const char* a; const char* b; int i0, i1, i2, i3; };

struct StaticOrder {
    static constexpr bool VARY_A = false;
    const char* A; const char* Bt; int lda, ldb, nM, nN, nwg, G, c, esz;
    DI void init(const void* A_, const void* Bt_, int lda_, int ldb_, int M, int N, int G_, int c_, int esz_ = 2) { A = (const char*)A_; Bt = (const char*)Bt_; lda = lda_; ldb = ldb_; nM = M / BM; nN = N / BM; nwg = nM * nN; G = G_; c = c_; esz = esz_; }
    DI bool next(int i, Unit& u) const {
        const long L = (long)i * G + c; if (L >= nwg) return false;
        int wgid = (int)L; { const int q = nwg / NXCD, r = nwg % NXCD, xcd = wgid % NXCD, off = wgid / NXCD; wgid = (xcd < r ? xcd * (q + 1) : r * (q + 1) + (xcd - r) * q) + off; }
        const int nig = WGM * nN, gid = wgid / nig, fm = gid * WGM, gsz = (nM - fm) < WGM ? (nM - fm) : WGM;
        u.i0 = fm + ((wgid % nig) % gsz); u.i1 = (wgid % nig) / gsz; u.i2 = 0; u.i3 = 0;
        u.a = A + (size_t)u.i0 * BM * lda * esz; u.b = Bt + (size_t)u.i1 * BM * ldb * esz; return true;
    }
    DI void aoff(const Unit&, unsigned (&vo)[2][2]) const {
#pragma unroll
        for (int i = 0; i < 2; ++i) { int R, C; stage_rc((int)threadIdx.x * 16 + i * 8192, R, C);
#pragma unroll
            for (int h = 0; h < 2; ++h) vo[h][i] = (unsigned)((h * HALF + R) * lda * esz + 2 * C); }
    }
};

template <class Epi, class Sched, bool ALIGN_EPI>
DI void gemm_phase(LAS unsigned char* lds, const int ldb, const int nt, const Sched& S, const Epi& E) {
    int tid_o_ = threadIdx.x; asm volatile("" : "+v"(tid_o_));
    const int tid = tid_o_, wid = __builtin_amdgcn_readfirstlane(tid >> 6), lane = tid & 63, wr = wid >> 2, wc = wid & 3, fr = lane & 15, fq = lane >> 4;
    unsigned voffB[2];
#pragma unroll
    for (int i = 0; i < 2; ++i) { int R, C; stage_rc(tid * 16 + i * 8192, R, C); const int Rb = (R & ~31) + perm32(R & 31); voffB[i] = (unsigned)(Rb * ldb + C) * 2u; }
    const size_t kstep = (size_t)(BK * 2);
    const size_t hstep = (size_t)HALF * ldb * 2;
    const unsigned ldsw = (unsigned)wid * 1024u;
    const int aoff = lds_byte(wr * 64 + fr, fq * 8), boff = lds_byte(wc * 32 + fr, fq * 8);
#define PG8_SA(b, h) (((b) * 2 + (h)) * HTB)
#define PG8_SB(b, h) ((4 + (b) * 2 + (h)) * HTB)
#define PG8_STAGE(bufoff, gbase, voff) do { _Pragma("unroll") for (int _i = 0; _i < 2; ++_i) \
        __builtin_amdgcn_global_load_lds((const unsigned*)((const char*)(gbase) + (voff)[_i]), (LAS unsigned*)(lds + (bufoff) + ldsw + _i * 8192), 16, 0, 0); } while (0)
#define PG8_LDA(dst, b, h) do { _Pragma("unroll") for (int m = 0; m < 4; ++m) _Pragma("unroll") for (int k = 0; k < 2; ++k) dst[m][k] = *(const LAS h8*)(lds + PG8_SA(b, h) + aoff + m * 2048 + k * 1024); } while (0)
#define PG8_LDB(dst, b, h) do { _Pragma("unroll") for (int n = 0; n < 2; ++n) _Pragma("unroll") for (int k = 0; k < 2; ++k) dst[n][k] = *(const LAS h8*)(lds + PG8_SB(b, h) + boff + n * 2048 + k * 1024); } while (0)
#define PG8_MMA(ai, bj, At, Bt) do { __builtin_amdgcn_s_setprio(1); _Pragma("unroll") for (int m = 0; m < 4; ++m) _Pragma("unroll") for (int n = 0; n < 2; ++n) _Pragma("unroll") for (int k = 0; k < 2; ++k) \
        acc[ai][bj][m][n] = __builtin_amdgcn_mfma_f32_16x16x32_f16(Bt[n][k], At[m][k], acc[ai][bj][m][n], 0, 0, 0); __builtin_amdgcn_s_setprio(0); } while (0)
#define PG8_WAIT_V(n) asm volatile("s_waitcnt vmcnt(" #n ")" ::: "memory")
#define PG8_WAIT_L(n) asm volatile("s_waitcnt lgkmcnt(" #n ")" ::: "memory")
#define PG8_BAR __builtin_amdgcn_s_barrier()
#define PG8_SCHED __builtin_amdgcn_sched_barrier(0)
    Unit cur, nxt; int ui = 0;
    if (!S.next(0, cur)) return;
    f32x4 acc[2][2][4][2];
#pragma unroll
    for (int a = 0; a < 2; ++a)
#pragma unroll
        for (int b = 0; b < 2; ++b)
#pragma unroll
            for (int m = 0; m < 4; ++m)
#pragma unroll
                for (int n = 0; n < 2; ++n) acc[a][b][m][n] = (f32x4){0.f, 0.f, 0.f, 0.f};
    h8 At[4][2], B0[2][2], B1[2][2];
    unsigned voc[2][2], von[2][2];
    S.aoff(cur, voc);
    const char* cA = cur.a; const char* cB = cur.b;
    PG8_STAGE(PG8_SB(0, 0), cB, voffB); PG8_STAGE(PG8_SB(0, 1), cB + hstep, voffB); PG8_STAGE(PG8_SA(0, 0), cA, voc[0]); PG8_STAGE(PG8_SA(0, 1), cA, voc[1]);
    if (wr == 1) PG8_BAR;
    PG8_WAIT_V(2); PG8_BAR;
    PG8_STAGE(PG8_SB(1, 0), cB + kstep, voffB); PG8_STAGE(PG8_SA(1, 0), cA + kstep, voc[0]); PG8_STAGE(PG8_SB(1, 1), cB + hstep + kstep, voffB);
    PG8_WAIT_V(6); PG8_BAR;
    for (;;) {
        const bool has_next = S.next(ui + 1, nxt);
        const char* nA = has_next ? nxt.a : cA; const char* nB = has_next ? nxt.b : cB;
        if (has_next) S.aoff(nxt, von);
        else {
#pragma unroll
            for (int h = 0; h < 2; ++h)
#pragma unroll
                for (int i = 0; i < 2; ++i) von[h][i] = voc[h][i]; }
#pragma unroll 1
        for (int t = 0; t < nt; t += 2) {
            if constexpr (Epi::MIDK > 0) { if (t == Epi::MIDK) E.midk(acc, cur, wr, wc, fr, fq); }
            const bool last = (t == nt - 2);
            const char* a1 = cA + (size_t)(t + 1) * kstep;
            const char* a2 = last ? nA : cA + (size_t)(t + 2) * kstep; const char* b2 = last ? nB : cB + (size_t)(t + 2) * kstep;
            const char* a3 = a2 + kstep; const char* b3 = b2 + kstep;
            unsigned v2[2][2];
#pragma unroll
            for (int h = 0; h < 2; ++h)
#pragma unroll
                for (int i = 0; i < 2; ++i) v2[h][i] = last ? von[h][i] : voc[h][i];
            PG8_LDB(B0, 0, 0); PG8_LDB(B1, 0, 1); PG8_SCHED; PG8_LDA(At, 0, 0); PG8_STAGE(PG8_SA(1, 1), a1, voc[1]);
            PG8_WAIT_V(8); PG8_WAIT_L(0); PG8_BAR; PG8_MMA(0, 0, At, B0); PG8_MMA(0, 1, At, B1); PG8_BAR; PG8_SCHED;
            PG8_LDA(At, 0, 1); PG8_STAGE(PG8_SB(0, 0), b2, voffB); PG8_STAGE(PG8_SB(0, 1), b2 + hstep, voffB); PG8_STAGE(PG8_SA(0, 0), a2, v2[0]);
            PG8_WAIT_V(8); PG8_WAIT_L(0); PG8_BAR; PG8_MMA(1, 0, At, B0); PG8_MMA(1, 1, At, B1); PG8_BAR; PG8_SCHED;
            PG8_LDB(B0, 1, 0); PG8_LDB(B1, 1, 1); PG8_SCHED; PG8_LDA(At, 1, 0); PG8_STAGE(PG8_SA(0, 1), a2, v2[1]);
            PG8_WAIT_V(8); PG8_WAIT_L(0); PG8_BAR; PG8_MMA(0, 0, At, B0); PG8_MMA(0, 1, At, B1); PG8_BAR; PG8_SCHED;
            PG8_LDA(At, 1, 1); PG8_STAGE(PG8_SB(1, 0), b3, voffB); PG8_STAGE(PG8_SB(1, 1), b3 + hstep, voffB); PG8_STAGE(PG8_SA(1, 0), a3, v2[0]);
            PG8_WAIT_V(8); PG8_WAIT_L(0); PG8_BAR; PG8_MMA(1, 0, At, B0); PG8_MMA(1, 1, At, B1); PG8_BAR; PG8_SCHED;
        }
        if constexpr (ALIGN_EPI) { if (wr == 0) PG8_BAR; }
        E(acc, cur, wr, wc, fr, fq);
        if (!has_next) break;
#pragma unroll
        for (int a = 0; a < 2; ++a)
#pragma unroll
            for (int b = 0; b < 2; ++b)
#pragma unroll
                for (int m = 0; m < 4; ++m)
#pragma unroll
                    for (int n = 0; n < 2; ++n) acc[a][b][m][n] = (f32x4){0.f, 0.f, 0.f, 0.f};
        cur = nxt; cA = nA; cB = nB; ++ui;
#pragma unroll
        for (int h = 0; h < 2; ++h)
#pragma unroll
            for (int i = 0; i < 2; ++i) voc[h][i] = von[h][i];
        if constexpr (ALIGN_EPI) { if (wr == 1) PG8_BAR; }
    }
    PG8_WAIT_V(0);
    if constexpr (!ALIGN_EPI) { if (wr == 0) PG8_BAR; }
    PG8_BAR;
#undef PG8_SA
#undef PG8_SB
#undef PG8_STAGE
#undef PG8_LDA
#undef PG8_LDB
#undef PG8_MMA
#undef PG8_WAIT_V
#undef PG8_WAIT_L
#undef PG8_BAR
#undef PG8_SCHED
}
template <class Epi, class Sched, bool ALIGN_EPI>
DI void gemm_phase8(LAS unsigned char* lds, const int ldb  , const int nt  , const Sched& S, const Epi& E) {
    int tid_o_ = threadIdx.x; asm volatile("" : "+v"(tid_o_));
    const int tid = tid_o_, wid = __builtin_amdgcn_readfirstlane(tid >> 6), lane = tid & 63, wr = wid >> 2, wc = wid & 3, fr = lane & 15, fq = lane >> 4;
    unsigned voffB[2];
#pragma unroll
    for (int i = 0; i < 2; ++i) { int R, C; stage_rc(tid * 16 + i * 8192, R, C); const int Rb = (R & ~31) + perm32(R & 31); voffB[i] = (unsigned)(Rb * ldb + 2 * C); }
    const size_t kstep = (size_t)(BK * 2);
    const size_t hstep = (size_t)HALF * ldb;
    const unsigned ldsw = (unsigned)wid * 1024u;
    const int aoff = lds_byte(wr * 64 + fr, fq * 16), boff = lds_byte(wc * 32 + fr, fq * 16);
#define PG8_SA(b, h) (((b) * 2 + (h)) * HTB)
#define PG8_SB(b, h) ((4 + (b) * 2 + (h)) * HTB)
#define PG8_STAGE(bufoff, gbase, voff) do { _Pragma("unroll") for (int _i = 0; _i < 2; ++_i) \
        __builtin_amdgcn_global_load_lds((const unsigned*)((const char*)(gbase) + (voff)[_i]), (LAS unsigned*)(lds + (bufoff) + ldsw + _i * 8192), 16, 0, 0); } while (0)
#define PG8_LDA(dst, b, h) do { _Pragma("unroll") for (int m = 0; m < 4; ++m) dst[m] = *(const LAS i32x8*)(lds + PG8_SA(b, h) + aoff + m * 2048); } while (0)
#define PG8_LDB(dst, b, h) do { _Pragma("unroll") for (int n = 0; n < 2; ++n) dst[n] = *(const LAS i32x8*)(lds + PG8_SB(b, h) + boff + n * 2048); } while (0)
#define PG8_MMA(ai, bj, At, Bt) do { __builtin_amdgcn_s_setprio(1); _Pragma("unroll") for (int m = 0; m < 4; ++m) _Pragma("unroll") for (int n = 0; n < 2; ++n) \
        asm volatile("v_mfma_scale_f32_16x16x128_f8f6f4 %0, %1, %2, %0, %3, %3 op_sel_hi:[0,0,0]" : "+v"(acc[ai][bj][m][n]) : "v"(Bt[n]), "v"(At[m]), "v"(scl)); __builtin_amdgcn_s_setprio(0); } while (0)
#define PG8_WAIT_V(n) asm volatile("s_waitcnt vmcnt(" #n ")" ::: "memory")
#define PG8_WAIT_L(n) asm volatile("s_waitcnt lgkmcnt(" #n ")" ::: "memory")
#define PG8_BAR __builtin_amdgcn_s_barrier()
#define PG8_SCHED __builtin_amdgcn_sched_barrier(0)
    Unit cur, nxt; int ui = 0;
    if (!S.next(0, cur)) return;
    f32x4 acc[2][2][4][2];
#pragma unroll
    for (int a = 0; a < 2; ++a)
#pragma unroll
        for (int b = 0; b < 2; ++b)
#pragma unroll
            for (int m = 0; m < 4; ++m)
#pragma unroll
                for (int n = 0; n < 2; ++n) acc[a][b][m][n] = (f32x4){0.f, 0.f, 0.f, 0.f};
    i32x8 At[4], B0[2], B1[2];
    const int scl = 0x7F7F7F7F;
    unsigned voc[2][2];
    LAS unsigned* vsave = (LAS unsigned*)(lds + STAGE_BYTES + 4096) + 4 * tid;
    S.aoff(cur, voc);
    const char* cA = cur.a; const char* cB = cur.b;
    PG8_STAGE(PG8_SB(0, 0), cB, voffB); PG8_STAGE(PG8_SB(0, 1), cB + hstep, voffB); PG8_STAGE(PG8_SA(0, 0), cA, voc[0]); PG8_STAGE(PG8_SA(0, 1), cA, voc[1]);
    if (wr == 1) PG8_BAR;
    PG8_WAIT_V(2); PG8_BAR;
    PG8_STAGE(PG8_SB(1, 0), cB + kstep, voffB); PG8_STAGE(PG8_SA(1, 0), cA + kstep, voc[0]); PG8_STAGE(PG8_SB(1, 1), cB + hstep + kstep, voffB);
    PG8_WAIT_V(6); PG8_BAR;
    for (;;) {
        const bool has_next = S.next(ui + 1, nxt);
        const char* nA = has_next ? nxt.a : cA; const char* nB = has_next ? nxt.b : cB;
        if constexpr (Sched::VARY_A) { if (has_next) { unsigned tmp[2][2]; S.aoff(nxt, tmp); vsave[0] = tmp[0][0]; vsave[1] = tmp[0][1]; vsave[2] = tmp[1][0]; vsave[3] = tmp[1][1]; } }
#pragma unroll 1
        for (int t = 0; t < nt; t += 2) {
            if constexpr (Epi::MIDK > 0) { if (t == Epi::MIDK) { asm volatile("s_nop 15\n\ts_nop 15" ::: "memory"); E.midk(acc, cur, wr, wc, fr, fq);
#pragma unroll
                for (int a_ = 0; a_ < 2; ++a_)
#pragma unroll
                    for (int b_ = 0; b_ < 2; ++b_)
#pragma unroll
                        for (int m_ = 0; m_ < 4; ++m_)
#pragma unroll
                            for (int n_ = 0; n_ < 2; ++n_) asm volatile("" : "+v"(acc[a_][b_][m_][n_]));
                asm volatile("s_nop 7" ::: "memory"); } }
            const bool last = (t == nt - 2);
            const char* a1 = cA + (size_t)(t + 1) * kstep;
            const char* a2 = last ? nA : cA + (size_t)(t + 2) * kstep; const char* b2 = last ? nB : cB + (size_t)(t + 2) * kstep;
            const char* a3 = a2 + kstep; const char* b3 = b2 + kstep;
            PG8_LDB(B0, 0, 0); PG8_LDB(B1, 0, 1); PG8_SCHED; PG8_LDA(At, 0, 0); PG8_STAGE(PG8_SA(1, 1), a1, voc[1]);
            PG8_WAIT_V(8); PG8_WAIT_L(0); PG8_BAR; PG8_MMA(0, 0, At, B0); PG8_MMA(0, 1, At, B1); PG8_BAR; PG8_SCHED;
            if constexpr (Sched::VARY_A) { if (last && has_next) { voc[0][0] = vsave[0]; voc[0][1] = vsave[1]; voc[1][0] = vsave[2]; voc[1][1] = vsave[3]; } }
            PG8_LDA(At, 0, 1); PG8_STAGE(PG8_SB(0, 0), b2, voffB); PG8_STAGE(PG8_SB(0, 1), b2 + hstep, voffB); PG8_STAGE(PG8_SA(0, 0), a2, voc[0]);
            PG8_WAIT_V(8); PG8_WAIT_L(0); PG8_BAR; PG8_MMA(1, 0, At, B0); PG8_MMA(1, 1, At, B1); PG8_BAR; PG8_SCHED;
            PG8_LDB(B0, 1, 0); PG8_LDB(B1, 1, 1); PG8_SCHED; PG8_LDA(At, 1, 0); PG8_STAGE(PG8_SA(0, 1), a2, voc[1]);
            PG8_WAIT_V(8); PG8_WAIT_L(0); PG8_BAR; PG8_MMA(0, 0, At, B0); PG8_MMA(0, 1, At, B1); PG8_BAR; PG8_SCHED;
            PG8_LDA(At, 1, 1); PG8_STAGE(PG8_SB(1, 0), b3, voffB); PG8_STAGE(PG8_SB(1, 1), b3 + hstep, voffB); PG8_STAGE(PG8_SA(1, 0), a3, voc[0]);
            PG8_WAIT_V(8); PG8_WAIT_L(0); PG8_BAR; PG8_MMA(1, 0, At, B0); PG8_MMA(1, 1, At, B1); PG8_BAR; PG8_SCHED;
        }
#if defined(PROF_SEG) && PROF_SEG == 51
        const unsigned long long tp0 = __builtin_amdgcn_s_memrealtime();
#endif
        asm volatile("s_nop 15\n\ts_nop 15" ::: "memory");
        if constexpr (ALIGN_EPI) { if (wr == 0) PG8_BAR; }
        { int tz = threadIdx.x; asm volatile("" : "+v"(tz)); const int l2 = tz & 63;
          E(acc, cur, wr, wc, l2 & 15, l2 >> 4); }
#if defined(PROF_SEG) && PROF_SEG == 51
        asm volatile("s_waitcnt vmcnt(0)" ::: "memory");
        if (tid == 0) { LAS unsigned* pw = (LAS unsigned*)(lds + 162944 + 64); pw[0] += (unsigned)(__builtin_amdgcn_s_memrealtime() - tp0); }
#endif
        if (!has_next) break;
#pragma unroll
        for (int a = 0; a < 2; ++a)
#pragma unroll
            for (int b = 0; b < 2; ++b)
#pragma unroll
                for (int m = 0; m < 4; ++m)
#pragma unroll
                    for (int n = 0; n < 2; ++n) acc[a][b][m][n] = (f32x4){0.f, 0.f, 0.f, 0.f};
        cur = nxt; cA = nA; cB = nB; ++ui;
        if constexpr (ALIGN_EPI) { if (wr == 1) PG8_BAR; }
    }
    PG8_WAIT_V(0);
    if constexpr (!ALIGN_EPI) { if (wr == 0) PG8_BAR; }
    PG8_BAR;
#undef PG8_SA
#undef PG8_SB
#undef PG8_STAGE
#undef PG8_LDA
#undef PG8_LDB
#undef PG8_MMA
#undef PG8_WAIT_V
#undef PG8_WAIT_L
#undef PG8_BAR
#undef PG8_SCHED
}
}

struct EpiProj {
    static constexpr int MIDK = 0;
    f16* PJ; const float* cosT; const float* sinT; int pn_off; float osc;
    DI void midk(f32x4 (&)[2][2][4][2], const pg8::Unit&, int, int, int, int) const {}
    DI void operator()(const f32x4 (&acc)[2][2][4][2], const pg8::Unit& u, int wr, int wc, int fr, int fq) const {
        const int pn = u.i1 + pn_off, row0 = u.i0 * 256 + wr * 64 + fr, sl = pn >> 1;
        const int b = row0 >> 14, s0 = row0 & (SEQ - 1);
        if (pn < 6) {
#pragma unroll
            for (int bj = 0; bj < 2; ++bj) { f16* hp_ = att_ptr(PJ, sl, b * 8 + (pn & 1) * 4 + 2 * bj + (wc >> 1), s0) + 32 * (wc & 1) + 8 * fq;
#pragma unroll
                for (int ai = 0; ai < 2; ++ai)
#pragma unroll
                    for (int m = 0; m < 4; ++m) *(h8*)(hp_ + (size_t)(ai * 128 + m * 16) * 64) = cvt8(acc[ai][bj][m][0] * osc, acc[ai][bj][m][1] * osc); }
        } else if (pn > 9) {
#pragma unroll
            for (int bj = 0; bj < 2; ++bj) { f16* hp_ = ret_ptr(PJ, sl, b * 4 + (pn & 1) * 2 + bj, s0) + 32 * wc + 8 * fq;
#pragma unroll
                for (int ai = 0; ai < 2; ++ai)
#pragma unroll
                    for (int m = 0; m < 4; ++m) *(h8*)(hp_ + (size_t)(ai * 128 + m * 16) * 128) = cvt8(acc[ai][bj][m][0] * osc, acc[ai][bj][m][1] * osc); }
        } else {
            const float sc = ((pn >= 8) ? 0.08838834764831845f : 1.0f) * osc;
            const int i0 = 32 * (wc & 1) + 8 * fq;
            f16* hp_ = ret_ptr(PJ, sl, b * 4 + (pn & 1) * 2 + (wc >> 1), s0) + i0;
#pragma unroll
            for (int ai = 0; ai < 2; ++ai)
#pragma unroll
                for (int m = 0; m < 4; ++m) { const int pos = s0 + ai * 128 + m * 16;
                    const f32x4 c0 = *(const f32x4*)(cosT + pos * 64 + i0) * sc, c1 = *(const f32x4*)(cosT + pos * 64 + i0 + 4) * sc;
                    const f32x4 s0v = *(const f32x4*)(sinT + pos * 64 + i0) * sc, s1v = *(const f32x4*)(sinT + pos * 64 + i0 + 4) * sc;
                    const f32x4 x10 = acc[ai][0][m][0], x11 = acc[ai][0][m][1], x20 = acc[ai][1][m][0], x21 = acc[ai][1][m][1];
                    f16* rowp = hp_ + (size_t)(ai * 128 + m * 16) * 128;
                    *(h8*)(rowp) = cvt8(x10 * c0 - x20 * s0v, x11 * c1 - x21 * s1v);
                    *(h8*)(rowp + 64) = cvt8(x10 * s0v + x20 * c0, x11 * s1v + x21 * c1); }
        }
    }
};
struct EpiZ {
    static constexpr int MIDK = 4;
    const float* x; f16* z; const f16* sumsq;
    DI void midk(f32x4 (&acc)[2][2][4][2], const pg8::Unit& u, int wr, int wc, int fr, int fq) const {
#pragma unroll
        for (int ai = 0; ai < 2; ++ai)
#pragma unroll
            for (int m = 0; m < 4; ++m) { const int row = u.i0 * 256 + ai * 128 + wr * 64 + m * 16 + fr;
                const f32x8 sv = __builtin_convertvector(*(const h8*)(sumsq + (size_t)row * 8), f32x8);
                const float ss = ((sv[0] + sv[1]) + (sv[2] + sv[3])) + ((sv[4] + sv[5]) + (sv[6] + sv[7]));
                const float rinv = (1.0f / 16.0f) / sqrtf(ss * (1.0f / 512.0f) + LN_EPS);
#pragma unroll
                for (int bj = 0; bj < 2; ++bj)
#pragma unroll
                    for (int n = 0; n < 2; ++n) acc[ai][bj][m][n] *= rinv; }
    }
    DI void operator()(const f32x4 (&acc)[2][2][4][2], const pg8::Unit& u, int wr, int wc, int fr, int fq) const {
        const int row0 = u.i0 * 256 + wr * 64 + fr, col0 = u.i1 * 256 + wc * 32 + 8 * fq;
#pragma unroll
        for (int ai = 0; ai < 2; ++ai)
#pragma unroll
            for (int m = 0; m < 4; ++m) { const size_t off = (size_t)(row0 + ai * 128 + m * 16) * DM + col0;
#pragma unroll
                for (int bj = 0; bj < 2; ++bj) {
                    const f32x4 x0 = *(const f32x4*)(x + off + bj * 128), x1 = *(const f32x4*)(x + off + bj * 128 + 4);
                    *(h8*)(z + off + bj * 128) = cvt8(x0 * ALPHA + acc[ai][bj][m][0] * (1.0f / 64.0f), x1 * ALPHA + acc[ai][bj][m][1] * (1.0f / 64.0f)); } }
    }
};
template <bool GATHER>
struct MoeSched {
    static constexpr bool VARY_A = GATHER;
    LAS const int* tab; const int* elist; const char* A; const char* Bt; size_t b_expert_bytes; int lda, ldb, G, c;
    DI bool next(int i, pg8::Unit& u) const {
        const int MT = tab[64]; const int wpx = G >> 3, xcd = c & 7, w = c >> 3;
        const int q = w + wpx * i, g = (q >> 2) * 8 + xcd, nt = q & 3;
        if (g >= MT) return false;
        int e = 0;
#pragma unroll 1
        for (int k = 1; k < 32; ++k) e += (tab[32 + k] <= g) ? 1 : 0;
        u.i0 = g; u.i1 = nt; u.i2 = e; u.i3 = g - tab[32 + e];
        u.a = GATHER ? A : A + (size_t)g * 256 * lda;
        u.b = Bt + (size_t)e * b_expert_bytes + (size_t)nt * 256 * ldb; return true;
    }
    DI void aoff(const pg8::Unit& u, unsigned (&vo)[2][2]) const {
        const int cnt = tab[u.i2];
#pragma unroll
        for (int i = 0; i < 2; ++i) { int R, C; pg8::stage_rc((int)threadIdx.x * 16 + i * 8192, R, C);
#pragma unroll
            for (int h = 0; h < 2; ++h) {
                if (GATHER) { int idx = u.i3 * 256 + h * 128 + R; idx = idx < cnt ? idx : 0; const int tok = elist[u.i2 * NTOK + idx] >> 1; vo[h][i] = (unsigned)(tok * lda + 2 * C); }
                else vo[h][i] = (unsigned)((h * 128 + R) * lda + 2 * C); } }
    }
};
struct EpiGU {
    static constexpr int MIDK = 0;
    unsigned char* hid;
    DI void midk(f32x4 (&)[2][2][4][2], const pg8::Unit&, int, int, int, int) const {}
    DI void operator()(const f32x4 (&acc)[2][2][4][2], const pg8::Unit& u, int wr, int wc, int fr, int fq) const {
        const int row0 = u.i0 * 256 + wr * 64 + fr, col0 = u.i1 * 128 + wc * 32 + 8 * fq;
#pragma unroll
        for (int ai = 0; ai < 2; ++ai)
#pragma unroll
            for (int m = 0; m < 4; ++m) { f32x4 o[2];
#pragma unroll
                for (int n = 0; n < 2; ++n) { const f32x4 g = acc[ai][0][m][n], up = acc[ai][1][m][n];
#pragma unroll
                    for (int e = 0; e < 4; ++e) { const float gg = g[e] * (1.0f / 64.0f); o[n][e] = gg * up[e] * (8.0f / 64.0f) / (1.0f + fexp2(-gg * LOG2E)); } }
                *(u32x2*)(hid + (size_t)(row0 + ai * 128 + m * 16) * DE + col0) = cvt8_fp8(o[0], o[1]); }
    }
};
struct EpiDown {
    static constexpr int MIDK = 0;
    f16* y; const int* elist; const float* wts; LAS const int* tab;
    DI void midk(f32x4 (&)[2][2][4][2], const pg8::Unit&, int, int, int, int) const {}
    DI void operator()(const f32x4 (&acc)[2][2][4][2], const pg8::Unit& u, int wr, int wc, int fr, int fq) const {
        const int cnt = tab[u.i2], col0 = u.i1 * 256 + wc * 32 + 8 * fq;
#pragma unroll
        for (int ai = 0; ai < 2; ++ai)
#pragma unroll
            for (int m = 0; m < 4; ++m) { const int idx = u.i3 * 256 + ai * 128 + wr * 64 + m * 16 + fr;
                if (idx < cnt) { const int ent = elist[u.i2 * NTOK + idx]; const float w = wts[ent] * (1.0f / 256.0f); f16* rowp = y + (size_t)ent * DM + col0;
#pragma unroll
                    for (int bj = 0; bj < 2; ++bj) *(h8*)(rowp + bj * 128) = cvt8(acc[ai][bj][m][0] * w, acc[ai][bj][m][1] * w); } }
    }
};

DI void tr_item(const float* W, int ldw, int k0, int nsrc0, f16* WT, int ldt, int prow0, const float* ks, LAS float* scr, int lane) {
#pragma unroll
    for (int i = 0; i < 32; ++i) { const int kk = 2 * i + (lane >> 5); float v = W[(size_t)(k0 + kk) * ldw + nsrc0 + (lane & 31)]; if (ks) v *= ks[k0 + kk]; scr[kk * 33 + (lane & 31)] = v; }
    LDS_WAIT(); asm volatile("" ::: "memory");
    const int c = lane & 7;
#pragma unroll
    for (int j = 0; j < 4; ++j) { const int n = (lane >> 3) + 8 * j; const LAS float* s = scr + (8 * c) * 33 + n;
        h8 o; o[0] = (f16)s[0]; o[1] = (f16)s[33]; o[2] = (f16)s[66]; o[3] = (f16)s[99]; o[4] = (f16)s[132]; o[5] = (f16)s[165]; o[6] = (f16)s[198]; o[7] = (f16)s[231];
        *(h8*)(WT + (size_t)(prow0 + n) * ldt + k0 + 8 * c) = o; }
    LDS_WAIT(); asm volatile("" ::: "memory");
}

DI void tr_item8(const float* W, int ldw, int k0, int nsrc0, unsigned char* WT, int ldt, int prow0, float scale, const float* ks, LAS float* scr, int lane) {
#pragma unroll
    for (int i = 0; i < 32; ++i) { const int kk = 2 * i + (lane >> 5); float v = W[(size_t)(k0 + kk) * ldw + nsrc0 + (lane & 31)] * scale; if (ks) v *= ks[k0 + kk]; scr[kk * 33 + (lane & 31)] = v; }
    LDS_WAIT(); asm volatile("" ::: "memory");
    const int c = lane & 7;
#pragma unroll
    for (int j = 0; j < 4; ++j) { const int n = (lane >> 3) + 8 * j; const LAS float* sp = scr + (8 * c) * 33 + n;
        const f32x4 lo = {sp[0], sp[33], sp[66], sp[99]}, hi = {sp[132], sp[165], sp[198], sp[231]};
        *(u32x2*)(WT + (size_t)(prow0 + n) * ldt + k0 + 8 * c) = cvt8_fp8(lo, hi); }
    LDS_WAIT(); asm volatile("" ::: "memory");
}

constexpr int KP64 = 144, VP64 = 192;
template <bool OWN>
DI void attn_tile(LAS const unsigned char* Kl, LAS const unsigned char* Vl, LAS const float* biasd, const h8 (&qf)[4], int rel, int w, int lane, float& m2, float& lsum, f32x16 (&o)[2]) {
    const int r = lane & 31, hp = lane >> 5;
    f32x16 st[8];
    const float b31 = biasd[31 + 160];
    float mx = -3.0e38f;
#pragma unroll
    for (int kt = 0; kt < 8; ++kt) {
        if (!OWN || kt <= w) {
            f32x16 a;
#pragma unroll
            for (int i = 0; i < 16; ++i) a[i] = 0.f;
#pragma unroll
            for (int ks = 0; ks < 4; ++ks) { const h8 kf = *(const LAS h8*)(Kl + (32 * kt + r) * KP64 + 32 * ks + 16 * hp); a = MFMA32(kf, qf[ks], a); }
            const bool far = __all(rel - (32 * kt + 31) >= 128) != 0;
            if (far) {
#pragma unroll
                for (int i = 0; i < 16; ++i) a[i] = a[i] * (0.125f * LOG2E) + b31;
            } else {
                int base = rel - 32 * kt - 4 * hp; base = base > 187 ? 187 : base;
                LAS const float* tp = biasd + (base + 4);
#pragma unroll
                for (int i = 0; i < 16; ++i) a[i] = a[i] * (0.125f * LOG2E) + tp[27 - ((i & 3) + 8 * (i >> 2))];
            }
#pragma unroll
            for (int i = 0; i < 16; ++i) mx = fmaxf(mx, a[i]);
            st[kt] = a;
        }
    }
    mx = fmaxf(mx, __shfl_xor(mx, 32));
    float ls = 0.f;
#pragma unroll
    for (int dt = 0; dt < 2; ++dt)
#pragma unroll
        for (int i = 0; i < 16; ++i) o[dt][i] = 0.f;
    const int i16 = lane & 15, q4 = i16 >> 2, p4 = i16 & 3, cb = (lane >> 4) & 1;
    LAS const unsigned char* vbase = Vl + (4 * hp + q4) * VP64 + 2 * (16 * cb + 4 * p4);
#pragma unroll
    for (int kt = 0; kt < 8; ++kt) {
        if (!OWN || kt <= w) {
            f32x16 p = st[kt];
#pragma unroll
            for (int i = 0; i < 16; ++i) { p[i] = fexp2(p[i] - mx); ls += p[i]; }
#pragma unroll
            for (int s = 0; s < 2; ++s) {
                const f32x8 pv = {p[8 * s], p[8 * s + 1], p[8 * s + 2], p[8 * s + 3], p[8 * s + 4], p[8 * s + 5], p[8 * s + 6], p[8 * s + 7]};
                const h8 pf = __builtin_convertvector(pv, h8);
#pragma unroll
                for (int dt = 0; dt < 2; ++dt) {
                    LAS const unsigned char* vp = vbase + (32 * kt + 16 * s) * VP64 + 64 * dt;
                    const h8 vf = cat44(tr_read(vp), tr_read(vp + 8 * VP64));
                    o[dt] = MFMA32(vf, pf, o[dt]);
                }
            }
        }
    }
    ls += __shfl_xor(ls, 32);
    m2 = mx; lsum = ls;
}
template <int P>
DI void stage64(LAS unsigned char* dst, const f16* src, int src_ld, int tid) {
#pragma unroll
    for (int i = 0; i < 4; ++i) { const int q = tid + 512 * i, row = q >> 3, ch = q & 7; *(LAS h8*)(dst + row * P + 16 * ch) = *(const h8*)(src + (size_t)row * src_ld + 8 * ch); }
}

DI void own_scores(LAS const unsigned char* Kl, LAS const float* biasd, const h8 (&qf)[4], int ql, int kt, int w, int r, int hp, f32x16& a) {
#pragma unroll
    for (int i = 0; i < 16; ++i) a[i] = 0.f;
#pragma unroll
    for (int ks = 0; ks < 4; ++ks) { const h8 kf = *(const LAS h8*)(Kl + (32 * kt + r) * KP64 + 32 * ks + 16 * hp); a = MFMA32(kf, qf[ks], a); }
    const int delta = w - kt;
    if (delta >= 5) {
        const float b31 = biasd[31 + 160];
#pragma unroll
        for (int i = 0; i < 16; ++i) a[i] = a[i] * (0.125f * LOG2E) + b31;
    } else {
        const int base = ql - 32 * kt - 4 * hp;
        LAS const float* tp = biasd + (base + 4);
        if (delta == 0) {
#pragma unroll
            for (int i = 0; i < 16; ++i) { const int ci = (i & 3) + 8 * (i >> 2); const float v = a[i] * (0.125f * LOG2E) + tp[27 - ci]; a[i] = (base - ci < 0) ? -3.0e38f : v; }
        } else {
#pragma unroll
            for (int i = 0; i < 16; ++i) a[i] = a[i] * (0.125f * LOG2E) + tp[27 - ((i & 3) + 8 * (i >> 2))];
        }
    }
}
DI void attn_own(LAS const unsigned char* Kl, LAS const unsigned char* Vl, LAS const float* biasd, const h8 (&qf)[4], int ql, int w, int lane, float& m2, float& lsum, f32x16 (&o)[2]) {
    const int r = lane & 31, hp = lane >> 5;
    float mx = -3.0e38f;
#pragma unroll 2
    for (int kt = 0; kt <= w; ++kt) { f32x16 a; own_scores(Kl, biasd, qf, ql, kt, w, r, hp, a);
#pragma unroll
        for (int i = 0; i < 16; ++i) mx = fmaxf(mx, a[i]); }
    mx = fmaxf(mx, __shfl_xor(mx, 32));
    float ls = 0.f;
#pragma unroll
    for (int dt = 0; dt < 2; ++dt)
#pragma unroll
        for (int i = 0; i < 16; ++i) o[dt][i] = 0.f;
    const int i16 = lane & 15, q4 = i16 >> 2, p4 = i16 & 3, cb = (lane >> 4) & 1;
    LAS const unsigned char* vbase = Vl + (4 * hp + q4) * VP64 + 2 * (16 * cb + 4 * p4);
#pragma unroll 2
    for (int kt = 0; kt <= w; ++kt) {
        f32x16 p; own_scores(Kl, biasd, qf, ql, kt, w, r, hp, p);
#pragma unroll
        for (int i = 0; i < 16; ++i) { p[i] = fexp2(p[i] - mx); ls += p[i]; }
#pragma unroll
        for (int s = 0; s < 2; ++s) {
            const f32x8 pv = {p[8 * s], p[8 * s + 1], p[8 * s + 2], p[8 * s + 3], p[8 * s + 4], p[8 * s + 5], p[8 * s + 6], p[8 * s + 7]};
            const h8 pf = __builtin_convertvector(pv, h8);
#pragma unroll
            for (int dt = 0; dt < 2; ++dt) {
                LAS const unsigned char* vp = vbase + (32 * kt + 16 * s) * VP64 + 64 * dt;
                const h8 vf = cat44(tr_read(vp), tr_read(vp + 8 * VP64));
                o[dt] = MFMA32(vf, pf, o[dt]);
            }
        }
    }
    ls += __shfl_xor(ls, 32);
    m2 = mx; lsum = ls;
}
__global__ void __launch_bounds__(512, 2) fwd(Args a) {
    extern __shared__ __attribute__((aligned(16))) unsigned char smem[];
    LAS unsigned char* lds = (LAS unsigned char*)smem;
    volatile LAS unsigned* MISC = (volatile LAS unsigned*)(lds + MISC_OFF);
    LAS float* biasl = (LAS float*)(lds + BIAS_OFF);
    const int tid = threadIdx.x, lane = tid & 63, wave = __builtin_amdgcn_readfirstlane(tid >> 6);
    const int G = gridDim.x, bid = blockIdx.x;
    unsigned char* ws = a.ws;
    unsigned* ctl = (unsigned*)(ws + WS_CTL);
#define ropeC ((float*)(ws + WS_ROPEC))
#define ropeS ((float*)(ws + WS_ROPES))
#define xsum ((float*)(ws + WS_XSUM))
#define kmean ((f16*)(ws + WS_KMEAN))
#define WrT ((f16*)(ws + WS_WRT))
#define sumsq ((f16*)(ws + WS_SUMSQ))
#define wts ((float*)(ws + WS_WTS))
#define elist ((int*)(ws + WS_ELIST))
#define mlist ((unsigned short*)(ws + WS_MLIST))
#define pml ((f32x2*)(ws + WS_PML))
#define WinT ((f16*)(ws + WS_WINT))
#define WoT8 ((unsigned char*)(ws + WS_WOT))
#define x8 ((unsigned char*)(ws + WS_X8))
#define WinT8 ((unsigned char*)(ws + WS_WINT8))
#define WguT ((unsigned char*)(ws + WS_WGUT))
#define WdnT ((unsigned char*)(ws + WS_WDNT))
#define hh8 ((unsigned char*)(ws + WS_HH8))
#define PJ ((f16*)(ws + WS_PJ))
#define xh ((f16*)(ws + WS_XH))
#define cat8 ((unsigned char*)(ws + WS_CAT))
#define kvbuf ((float*)(ws + WS_KV))
#define Rbuf ((f16*)(ws + WS_R))
#define hh ((f16*)(ws + WS_HH))
#define hid ((unsigned char*)(ws + WS_HID))
#define ybuf ((f16*)(ws + WS_Y))
#define pO ((f16*)a.out)
#define zbuf ((f16*)a.out)
    unsigned* lcnt = ctl + CW_LCNT; unsigned* ecnt = ctl + CW_ECNT;

    if (tid < 64) MISC[tid] = 0u;
    for (int idx = tid; idx < 8 * BTP; idx += 512) { const int h = idx / BTP, d = idx % BTP - 31, dd = d > 128 ? 128 : d; biasl[idx] = d < 0 ? 0.f : a.rel[(int)T5_BUCKET[dd] * 8 + h] * LOG2E; }
    __syncthreads();
    const int lo = a.ph_lo, hi = a.ph_hi;
    XcdBarrier bar; bar.bar = ctl + CW_BAR; bar.x = 0; bar.st = MISC + 8;
    if (hi - lo > 1) bar = xcd_barrier_post(ctl + CW_BAR, MISC + 8);
#ifndef PH_MASK
#define PH_MASK 0x3ff
#endif
#define IN(k) ((((PH_MASK) >> (k)) & 1) && lo <= (k) && (k) < hi)
#ifndef DUP_PHASE
#define DUP_PHASE -1
#endif
#define REP(k) for (int rep_ = 0; rep_ < ((DUP_PHASE) == (k) ? 2 : 1); ++rep_)
#ifdef PROF_SEG
#ifndef PROF_K
#define PROF_K 4
#endif
#ifndef PROF_WAVE
#define PROF_WAVE 0
#endif
    unsigned long long prof_acc = 0ull, prof_t0 = 0ull;
#ifndef PROF_BLOCK
#define PROF_BLOCK 0
#endif
    const bool prof_on = (bid == PROF_BLOCK && tid == 64 * PROF_WAVE);
#define PROF_B(seg) do { if ((seg) == PROF_SEG) { __builtin_amdgcn_sched_barrier(0); prof_t0 = __builtin_amdgcn_s_memrealtime(); __builtin_amdgcn_sched_barrier(0); } } while (0)
#define PROF_E(seg) do { if ((seg) == PROF_SEG) { __builtin_amdgcn_sched_barrier(0); prof_acc += __builtin_amdgcn_s_memrealtime() - prof_t0; __builtin_amdgcn_sched_barrier(0); } } while (0)
#else
#define PROF_B(seg) do { } while (0)
#define PROF_E(seg) do { } while (0)
#endif
#ifdef DIAG_PHASE
#ifndef DIAG_MODE
#define DIAG_MODE 0
#endif
    unsigned long long tdiag0 = 0ull;
#define DIAG_T0(k) do { if ((k) == DIAG_PHASE) tdiag0 = __builtin_amdgcn_s_memrealtime(); } while (0)
#define DIAG_T1(k, mode) do { if ((k) == DIAG_PHASE && (mode) == DIAG_MODE && bid == 0 && tid == 0) __hip_atomic_store(ctl + 24576, (unsigned)(__builtin_amdgcn_s_memrealtime() - tdiag0), __ATOMIC_RELAXED, __HIP_MEMORY_SCOPE_AGENT); } while (0)
#else
#define DIAG_T0(k) do { } while (0)
#define DIAG_T1(k, mode) do { } while (0)
#endif
#define SEAM(k) do { PROF_E(10 + (k)); PROF_B(20 + (k)); DIAG_T1(k, 1); if (IN(k) && IN((k) + 1)) xcd_barrier(bar); DIAG_T1(k, 0); DIAG_T0((k) + 1); PROF_E(20 + (k)); PROF_B(11 + (k)); } while (0)

    DIAG_T0(0); PROF_B(10);
    if (IN(0)) REP(0) { OPAQUE_TID;
        for (int hb = bid; hb < 256; hb += G) {
            const int c4 = tid & 255, rp = tid >> 8;
            const float* src = a.x + (size_t)hb * 128 * DM + c4 * 4; f16* dst = xh + (size_t)hb * 128 * DM + c4 * 4;
            f32x4 s = {0.f, 0.f, 0.f, 0.f};
#pragma unroll 8
            for (int r = rp; r < 128; r += 2) { const f32x4 v = *(const f32x4*)(src + (size_t)r * DM); s += v; *(h4*)(dst + (size_t)r * DM) = __builtin_convertvector(v, h4);
                int w8 = 0; w8 = __builtin_amdgcn_cvt_pk_fp8_f32(v[0], v[1], w8, false); w8 = __builtin_amdgcn_cvt_pk_fp8_f32(v[2], v[3], w8, true);
                *(int*)(x8 + ((size_t)hb * 128 + r) * DM + c4 * 4) = w8; }
            LAS f32x4* red = (LAS f32x4*)lds;
            if (rp == 1) red[c4] = s;
            __syncthreads();
            if (rp == 0) { s += red[c4]; *(f32x4*)(xsum + (size_t)hb * DM + c4 * 4) = s; }
            __syncthreads();
        }
        for (int idx = bid * 512 + tid; idx < SEQ * 64; idx += G * 512) {
            const int pos = idx >> 6, i = idx & 63;
            const float ang = (float)pos * ROPE_INV[i];
            const double xd = (double)ang, kd = __builtin_rint(xd * 0.6366197723675814);
            double rr = __builtin_fma(-kd, 1.5707963267948966, xd); rr = __builtin_fma(-kd, 6.123233995736766e-17, rr);
            const double r2 = rr * rr;
            const double sp = rr * (1.0 + r2 * (-1.0 / 6 + r2 * (1.0 / 120 + r2 * (-1.0 / 5040 + r2 * (1.0 / 362880 + r2 * (-1.0 / 39916800 + r2 * (1.0 / 6227020800.0)))))));
            const double cp = 1.0 + r2 * (-0.5 + r2 * (1.0 / 24 + r2 * (-1.0 / 720 + r2 * (1.0 / 40320 + r2 * (-1.0 / 3628800 + r2 * (1.0 / 479001600.0 + r2 * (-1.0 / 87178291200.0)))))));
            const int q = (int)kd & 3;
            const double sv = (q == 0) ? sp : (q == 1) ? cp : (q == 2) ? -sp : -cp;
            const double cv = (q == 0) ? cp : (q == 1) ? -sp : (q == 2) ? -cp : sp;
            ropeC[idx] = (float)cv; ropeS[idx] = (float)sv;
        }
        for (int idx = bid * 512 + tid; idx < 48 * DM; idx += G * 512) {
            const int n = idx >> 10, k = idx & 1023;
            const float v = (n < 4) ? a.wrg[k * 4 + n] : (n < 36) ? a.wre[k * 32 + (n - 4)] : 0.f;
            WrT[idx] = (f16)v;
        }
        {
            LAS float* scr = (LAS float*)(lds + wave * 16384);
            constexpr int I_IN = 16 * 112, I_O = 16 * 32, I_GU = 32 * 512, I_DN = 32 * 256, NIT = I_IN + I_O + I_GU + I_DN;
            for (int it = bid * 8 + wave; it < NIT; it += G * 8) {
                int r = it;
                if (r < I_IN) { const int kb = r / 112, nb = r % 112, pn = nb >> 3, g = nb & 7;
                    const int nsrc = (pn >= 6 && pn <= 9) ? pn * 256 + 128 * ((g >> 1) & 1) + 64 * (g >> 2) + 32 * (g & 1) : 32 * nb;
                    if (nb < 32) tr_item(a.w_in, NPJ, 64 * kb, nsrc, WinT, DM, 32 * nb, nullptr, scr, lane);
                    else tr_item8(a.w_in, NPJ, 64 * kb, nsrc, WinT8, DM, 32 * nb - 1024, 32.0f, nullptr, scr, lane);
                    continue; } r -= I_IN;
                if (r < I_O) { const int kb = r / 32, nb = r % 32; tr_item8(a.w_out, DM, 64 * kb, 32 * nb, WoT8, DM, 32 * nb, 64.0f, kb < 8 ? a.gain : nullptr, scr, lane); continue; } r -= I_O;
                if (r < I_GU) { const int e = r >> 9, rr = r & 511, kb = rr >> 5, nb = rr & 31, pn = nb >> 3, g = nb & 7;
                    const int nsrc = (g >> 2) * 512 + 128 * pn + 32 * (g & 3);
                    tr_item8(a.wgu + (size_t)e * DM * DM, DM, 64 * kb, nsrc, WguT + (size_t)e * DM * DM, DM, 32 * nb, 64.0f, nullptr, scr, lane); continue; } r -= I_GU;
                { const int e = r >> 8, rr = r & 255, kb = rr >> 5, nb = rr & 31;
                    tr_item8(a.wdn + (size_t)e * DE * DM, DM, 64 * kb, 32 * nb, WdnT + (size_t)e * DM * DE, DE, 32 * nb, 32.0f, nullptr, scr, lane); }
            }
        }
        __syncthreads();
    }
    SEAM(0);

    if (IN(1)) { OPAQUE_TID;
        REP(11) for (int job = bid; job < 256; job += G) {
            const int blk = job >> 1, ch = job & 1;
            LAS float* xm = (LAS float*)lds;
            for (int k = tid; k < DM; k += 512) xm[k] = (xsum[(size_t)(2 * blk) * DM + k] + xsum[(size_t)(2 * blk + 1) * DM + k]) * (1.0f / 256.0f);
            __syncthreads();
            const int col = tid & 255, kh = tid >> 8;
            const float* wp = a.w_in + (size_t)(kh * 512) * NPJ + C_AK + ch * 256 + col;
            float acc = 0.f;
#pragma unroll 8
            for (int k = 0; k < 512; ++k) acc += xm[kh * 512 + k] * wp[(size_t)k * NPJ];
            LAS float* red = xm + 1024;
            if (kh) red[col] = acc;
            __syncthreads();
            if (!kh) { acc += red[col]; const int c = ch * 256 + col, h = c >> 6, d = c & 63, b = blk >> 6, j = blk & 63; kmean[((size_t)(b * 8 + h) * 64 + j) * 64 + d] = (f16)acc; }
            __syncthreads();
        }
        { pg8::StaticOrder S; S.init(xh, WinT, DM, DM, NTOK, 1024, G, bid);
          EpiProj E{PJ, ropeC, ropeS, 0, 1.0f};
          pg8::gemm_phase<EpiProj, pg8::StaticOrder, true>(lds, DM, DM / 64, S, E); }
        { pg8::StaticOrder S; S.init(x8, WinT8, DM, DM, NTOK, NPJ - 1024, G, bid, 1);
          EpiProj E{PJ, ropeC, ropeS, 4, 1.0f / 32.0f};
          pg8::gemm_phase8<EpiProj, pg8::StaticOrder, true>(lds, DM, DM / 128, S, E); }
    }
    SEAM(1);

    if (IN(2)) REP(2) { OPAQUE_TID;
        constexpr int NU_G = 16 * 63, NU_KV = 8 * 64;
        unsigned* lcnt_w = (rep_ | a.alt) ? ctl + 16384 : lcnt; unsigned short* mlist_w = (rep_ | a.alt) ? (unsigned short*)(ws + 480 * MiB) : mlist;
        for (int u = bid; u < NU_G + NU_KV; u += G) {
            if (u < NU_KV) {
                const int bh = u >> 6, ci = u & 63, b = bh >> 2, h = bh & 3;
                const float lg = gamma_log2(h);
                const f16* kp = ret_ptr(PJ, 4, bh, ci * 256);
                const f16* vp = ret_ptr(PJ, 5, bh, ci * 256);
                LAS unsigned char* Kl = lds; LAS unsigned char* Vl = lds + 128 * 320;
                const int dvt = wave & 3, dk0 = 2 * (wave >> 2);
                f32x16 acc[2];
#pragma unroll
                for (int t = 0; t < 2; ++t)
#pragma unroll
                    for (int i = 0; i < 16; ++i) acc[t][i] = 0.f;
                const int r = lane & 31, hp = lane >> 5, i16 = lane & 15, q4 = i16 >> 2, p4 = i16 & 3, cb = (lane >> 4) & 1;
                for (int half = 0; half < 2; ++half) {
#pragma unroll
                    for (int i = 0; i < 4; ++i) { const int q = tid + 512 * i, row = q >> 4, ch = q & 15; const int key = half * 128 + row;
                        const h8 kv = *(const h8*)(kp + (size_t)key * 128 + 8 * ch); const float sc = fexp2(lg * (float)(255 - key));
                        const f32x8 kf = __builtin_convertvector(kv, f32x8) * sc;
                        *(LAS h8*)(Kl + row * 320 + 16 * ch) = __builtin_convertvector(kf, h8);
                        *(LAS h8*)(Vl + row * 320 + 16 * ch) = *(const h8*)(vp + (size_t)key * 128 + 8 * ch); }
                    __syncthreads();
#pragma unroll
                    for (int s = 0; s < 8; ++s) {
                        LAS const unsigned char* ap = Vl + (16 * s + 8 * hp + q4) * 320 + 2 * (32 * dvt + 16 * cb + 4 * p4);
                        const h8 af = cat44(tr_read(ap), tr_read(ap + 4 * 320));
#pragma unroll
                        for (int t = 0; t < 2; ++t) {
                            LAS const unsigned char* bp = Kl + (16 * s + 8 * hp + q4) * 320 + 2 * (32 * (dk0 + t) + 16 * cb + 4 * p4);
                            const h8 bf = cat44(tr_read(bp), tr_read(bp + 4 * 320));
                            acc[t] = MFMA32(af, bf, acc[t]);
                        }
                    }
                    __syncthreads();
                }
                float* dst = kvbuf + (size_t)u * 128 * 128;
#pragma unroll
                for (int t = 0; t < 2; ++t)
#pragma unroll
                    for (int i = 0; i < 16; ++i) dst[(32 * dvt + crow(i, hp)) * 128 + 32 * (dk0 + t) + r] = acc[t][i];
            } else {
                const int uu = u - NU_KV, bh = uu / 63, c = 1 + uu % 63, b = bh >> 3, h = bh & 7;
                const int r = lane & 31, hp = lane >> 5;
                const int s = 256 * c + 32 * wave + r;
                const f16* qrow = att_ptr(PJ, 0, bh, s);
                h8 qf[4];
#pragma unroll
                for (int ks = 0; ks < 4; ++ks) qf[ks] = *(const h8*)(qrow + 16 * ks + 8 * hp);
                const f16* km = kmean + (size_t)bh * 64 * 64;
                float v[2][16];
#pragma unroll
                for (int t = 0; t < 2; ++t) {
                    f32x16 g;
#pragma unroll
                    for (int i = 0; i < 16; ++i) g[i] = 0.f;
                    if (t == 0 || c > 32) {
#pragma unroll
                        for (int ks = 0; ks < 4; ++ks) { const h8 kf = *(const h8*)(km + (32 * t + r) * 64 + 16 * ks + 8 * hp); g = MFMA32(kf, qf[ks], g); }
                    }
#pragma unroll
                    for (int i = 0; i < 16; ++i) v[t][i] = (32 * t + crow(i, hp) < c) ? g[i] : -3.0e38f;
                }
                int sel[3]; bool sval[3];
#pragma unroll
                for (int rd = 0; rd < 3; ++rd) {
                    float mv = -3.0e38f; int mi = 1 << 20;
#pragma unroll
                    for (int t = 0; t < 2; ++t)
#pragma unroll
                        for (int i = 0; i < 16; ++i) { const int idx = 32 * t + crow(i, hp); const float val = v[t][i]; if (val > mv || (val == mv && idx < mi)) { mv = val; mi = idx; } }
                    const float ov = __shfl_xor(mv, 32); const int oi = __shfl_xor(mi, 32);
                    if (ov > mv || (ov == mv && oi < mi)) { mv = ov; mi = oi; }
                    sel[rd] = mi; sval[rd] = mv > -1.0e38f;
#pragma unroll
                    for (int t = 0; t < 2; ++t)
#pragma unroll
                        for (int i = 0; i < 16; ++i) if (32 * t + crow(i, hp) == mi) v[t][i] = -3.0e38f;
                }
                LAS unsigned* hist = (LAS unsigned*)(lds + 96 * 1024);
                if (tid < 64) hist[tid] = 0u;
                __syncthreads();
                unsigned rank[3];
#pragma unroll
                for (int rd = 0; rd < 3; ++rd) { rank[rd] = 0u; if (sval[rd] && hp == 0) rank[rd] = __hip_atomic_fetch_add(hist + sel[rd], 1u, __ATOMIC_RELAXED, __HIP_MEMORY_SCOPE_WORKGROUP); }
                __syncthreads();
                if (tid < 64) { const unsigned n = hist[tid]; unsigned base = 0u; if (n) base = atomicAdd(lcnt_w + bh * 64 + tid, n); hist[64 + tid] = base; }
                __syncthreads();
#pragma unroll
                for (int rd = 0; rd < 3; ++rd) if (sval[rd] && hp == 0) { const int lb = sel[rd]; const unsigned pos = hist[64 + lb] + rank[rd];
                    mlist_w[(size_t)bh * MLIST_PER_BH + (size_t)lb * SEQ - 128 * lb * (lb + 1) + pos] = (unsigned short)((s << 2) | rd); }
            }
        }
    }
    SEAM(2);

    if (IN(3)) REP(3) { OPAQUE_TID;
        PROF_B(33);
        if (!(a.alt & 2)) for (int gid = bid * 512 + tid; gid < 8 * 16384; gid += G * 512) {
            const int bh = gid >> 14, e = gid & 16383, h = bh & 3;
            const float cd = fexp2(256.0f * gamma_log2(h));
            const float* src = kvbuf + (size_t)bh * 64 * 16384 + e; f16* dst = Rbuf + (size_t)bh * 64 * 16384 + e;
            float run = 0.f;
#pragma unroll 8
            for (int i = 0; i < 64; ++i) { dst[(size_t)i * 16384] = (f16)run; run = run * cd + src[(size_t)i * 16384]; }
        }
        PROF_E(33); PROF_B(32);
        LAS int* pre = (LAS int*)(lds + 96 * 1024);
        LAS int* cpre = pre + 1032;
        LAS int* wsum = cpre + 1032;
        {
            const int c0 = (int)lcnt[2 * tid], c1 = (int)lcnt[2 * tid + 1];
            const int n0 = (c0 + 255) >> 8, n1 = (c1 + 255) >> 8;
            const int k0 = n0 ? 5 * n0 + 3 : 0, k1 = n1 ? 5 * n1 + 3 : 0;
            int v = n0 + n1, incl = v, cv = k0 + k1, cincl = cv;
#pragma unroll
            for (int o = 1; o < 64; o <<= 1) { const int t = __shfl_up(incl, o), ct = __shfl_up(cincl, o); if (lane >= o) { incl += t; cincl += ct; } }
            if (lane == 63) { wsum[wave] = incl; wsum[8 + wave] = cincl; }
            __syncthreads();
            int woff = 0, cwoff = 0;
            for (int k = 0; k < wave; ++k) { woff += wsum[k]; cwoff += wsum[8 + k]; }
            const int ex = woff + incl - v, cex = cwoff + cincl - cv;
            pre[2 * tid] = ex; pre[2 * tid + 1] = ex + n0; cpre[2 * tid] = cex; cpre[2 * tid + 1] = cex + k0;
            if (tid == 511) { pre[1024] = ex + v; cpre[1024] = cex + cv; }
            __syncthreads();
        }
        PROF_E(32);
        const int U = pre[1024], CT = cpre[1024];
        int ubnd[2];
#pragma unroll
        for (int e = 0; e < 2; ++e) {
            const int x = (int)(((long)CT * (bid + e)) / G);
            int l = 0;
#pragma unroll 1
            for (int step = 512; step > 0; step >>= 1) if (l + step <= 1023 && cpre[l + step] <= x) l += step;
            const int rem = x - cpre[l], n = pre[l + 1] - pre[l];
            int ch = rem <= 0 ? 0 : (rem - 3 + 4) / 5; ch = (rem > 0 && ch < 1) ? 1 : ch; ch = ch > n ? n : ch;
            ubnd[e] = (x >= CT) ? U : pre[l] + ch;
        }
        const int u_lo = ubnd[0], u_hi = (a.alt & 4) ? u_lo : ubnd[1];
        LAS unsigned char* Kl = lds; LAS unsigned char* Vl = lds + 256 * KP64;
        constexpr int NUB = 32;
        LAS int* uinf = (LAS int*)(lds + 108 * 1024);
        LAS unsigned short* uent = (LAS unsigned short*)(lds + 112 * 1024);
        int staged = -1;
        const int r = lane & 31, hp = lane >> 5;
        for (int ub = u_lo; ub < u_hi; ub += NUB) {
            const int nu = (u_hi - ub) < NUB ? (u_hi - ub) : NUB;
            __syncthreads();
            if (tid < nu) { const int u = ub + tid; int l = 0;
#pragma unroll 1
                for (int step = 512; step > 0; step >>= 1) if (l + step <= 1023 && pre[l + step] <= u) l += step;
                const int chunk = u - pre[l]; int rows = (int)lcnt[l] - 256 * chunk; rows = rows > 256 ? 256 : rows;
                uinf[4 * tid] = l; uinf[4 * tid + 1] = chunk; uinf[4 * tid + 2] = rows; }
            __syncthreads();
            for (int i = tid >> 8; i < nu; i += 2) { const int l = uinf[4 * i], chunk = uinf[4 * i + 1], rows = uinf[4 * i + 2], ri = tid & 255, bh = l >> 6, j = l & 63;
                uent[i * 256 + ri] = mlist[(size_t)bh * MLIST_PER_BH + (size_t)j * SEQ - 128 * j * (j + 1) + 256 * chunk + (ri < rows ? ri : 0)]; }
            __syncthreads();
            h8 qn[4];
            { const int l = uinf[0], bh = l >> 6; const unsigned ent = uent[32 * wave + r]; const int s = (int)(ent >> 2);
              const f16* qrow = att_ptr(PJ, 0, bh, s);
#pragma unroll
              for (int ks = 0; ks < 4; ++ks) qn[ks] = *(const h8*)(qrow + 16 * ks + 8 * hp); }
            for (int i = 0; i < nu; ++i) {
                const int l = uinf[4 * i], rows = uinf[4 * i + 2], bh = l >> 6, j = l & 63, b = bh >> 3, h = bh & 7;
                const unsigned ent = uent[i * 256 + 32 * wave + r];
                h8 qf[4];
#pragma unroll
                for (int ks = 0; ks < 4; ++ks) qf[ks] = qn[ks];
                if (i + 1 < nu) { const int l2 = uinf[4 * (i + 1)], bh2 = l2 >> 6; const unsigned e2 = uent[(i + 1) * 256 + 32 * wave + r]; const int s2 = (int)(e2 >> 2);
                    const f16* qrow = att_ptr(PJ, 0, bh2, s2);
#pragma unroll
                    for (int ks = 0; ks < 4; ++ks) qn[ks] = *(const h8*)(qrow + 16 * ks + 8 * hp); }
                PROF_B(30);
                if (l != staged) {
                    __syncthreads();
                    stage64<KP64>(Kl, att_ptr(PJ, 1, bh, j * 256), 64, tid);
                    stage64<VP64>(Vl, att_ptr(PJ, 2, bh, j * 256), 64, tid);
                    __syncthreads();
                    staged = l;
                }
                PROF_E(30); PROF_B(31);
                if (32 * wave < rows) {
                    const bool valid = 32 * wave + r < rows;
                    const int s = (int)(ent >> 2), slot = (int)(ent & 3u);
                    float m2, ls; f32x16 o[2];
                    attn_tile<false>(Kl, Vl, biasl + h * BTP, qf, s - 256 * j, 0, lane, m2, ls, o);
                    if (valid) {
                        const size_t pidx = ((size_t)bh * SEQ + s) * 3 + slot;
                        if (hp == 0) pml[pidx] = (f32x2){m2, ls};
                        const float inv = 1.0f / ls; f16* po = pO + pidx * 64 + 32 * hp;
#pragma unroll
                        for (int dt = 0; dt < 2; ++dt)
#pragma unroll
                            for (int g2 = 0; g2 < 2; ++g2) { const f32x8 vv = {o[dt][8 * g2] * inv, o[dt][8 * g2 + 1] * inv, o[dt][8 * g2 + 2] * inv, o[dt][8 * g2 + 3] * inv, o[dt][8 * g2 + 4] * inv, o[dt][8 * g2 + 5] * inv, o[dt][8 * g2 + 6] * inv, o[dt][8 * g2 + 7] * inv};
                                *(h8*)(po + 16 * dt + 8 * g2) = __builtin_convertvector(vv, h8); }
                    }
                }
                PROF_E(31);
            }
        }
        __syncthreads();
    }
    SEAM(3);

    if (IN(4)) REP(4) { OPAQUE_TID;
        constexpr int NU_A = 16 * 64, NU_R = 8 * 64;
        for (int u = (a.alt & 2) ? NU_R : bid; u < NU_R; u += G) {
            __syncthreads();
            {
                const int bh = u >> 6, ci = u & 63, b = bh >> 2, h = bh & 3;
                const float lg = gamma_log2(h);
                const size_t row0 = (size_t)b * SEQ + ci * 256;
                LAS unsigned char* Kl = lds; LAS unsigned char* Vl = lds + 256 * 272;
                PROF_B(40);
                const int r = lane & 31, hp = lane >> 5, i16 = lane & 15, q4 = i16 >> 2, p4 = i16 & 3, cb = (lane >> 4) & 1;
                const int qt = wave < 4 ? wave : 11 - wave;
                const int ql = 32 * qt + r;
#pragma unroll
                for (int i = 0; i < 8; ++i) { const int q = tid + 512 * i, row = q >> 4, ch = q & 15;
                    *(LAS h8*)(Kl + row * 272 + 16 * ch) = *(const h8*)(ret_ptr(PJ, 4, bh, ci * 256 + row) + 8 * ch);
                    *(LAS h8*)(Vl + row * 320 + 16 * ch) = *(const h8*)(ret_ptr(PJ, 5, bh, ci * 256 + row) + 8 * ch); }
                __syncthreads();
                PROF_E(40); PROF_B(41);
                const f16* qrow = ret_ptr(PJ, 3, bh, ci * 256 + ql);
                h8 qf[8];
#pragma unroll
                for (int ks = 0; ks < 8; ++ks) qf[ks] = *(const h8*)(qrow + 16 * ks + 8 * hp);
                f32x16 o[4];
#pragma unroll
                for (int t = 0; t < 4; ++t)
#pragma unroll
                    for (int i = 0; i < 16; ++i) o[t][i] = 0.f;
                const f16* Rt = Rbuf + (size_t)u * 128 * 128;
#pragma unroll
                for (int t = 0; t < 4; ++t)
#pragma unroll
                    for (int ks = 0; ks < 8; ++ks) { const h8 rf = *(const h8*)(Rt + (32 * t + r) * 128 + 16 * ks + 8 * hp); o[t] = MFMA32(rf, qf[ks], o[t]); }
                const f16* grow = ret_ptr(PJ, 6, bh, ci * 256 + ql);
                h4 rgv[16];
#pragma unroll
                for (int g = 0; g < 16; ++g) rgv[g] = *(const h4*)(grow + 8 * g + 4 * hp);
                const float qd = fexp2(lg * (float)(ql + 1));
#pragma unroll
                for (int t = 0; t < 4; ++t)
#pragma unroll
                    for (int i = 0; i < 16; ++i) o[t][i] *= qd;
                PROF_E(41); PROF_B(42);
                LAS const unsigned char* vbase = Vl + (4 * hp + q4) * 320 + 2 * (16 * cb + 4 * p4);
                for (int kt = 0; kt <= qt; ++kt) {
                    f32x16 st;
#pragma unroll
                    for (int i = 0; i < 16; ++i) st[i] = 0.f;
#pragma unroll
                    for (int ks = 0; ks < 8; ++ks) { const h8 kf = *(const LAS h8*)(Kl + (32 * kt + r) * 272 + 32 * ks + 16 * hp); st = MFMA32(kf, qf[ks], st); }
#pragma unroll
                    for (int i = 0; i < 16; ++i) { const int dist = ql - (32 * kt + crow(i, hp)); st[i] = dist >= 0 ? st[i] * fexp2(lg * (float)dist) : 0.f; }
#pragma unroll
                    for (int s = 0; s < 2; ++s) {
                        const f32x8 pv = {st[8 * s], st[8 * s + 1], st[8 * s + 2], st[8 * s + 3], st[8 * s + 4], st[8 * s + 5], st[8 * s + 6], st[8 * s + 7]};
                        const h8 pf = __builtin_convertvector(pv, h8);
#pragma unroll
                        for (int t = 0; t < 4; ++t) {
                            LAS const unsigned char* vp = vbase + (32 * kt + 16 * s) * 320 + 64 * t;
                            const h8 vf = cat44(tr_read(vp), tr_read(vp + 8 * 320));
                            o[t] = MFMA32(vf, pf, o[t]);
                        }
                    }
                }
                PROF_E(42); PROF_B(43);
                float sm = 0.f;
#pragma unroll
                for (int t = 0; t < 4; ++t)
#pragma unroll
                    for (int i = 0; i < 16; ++i) sm += o[t][i];
                sm += __shfl_xor(sm, 32);
                const float mu = sm * (1.0f / 128.0f);
                float sq = 0.f;
#pragma unroll
                for (int t = 0; t < 4; ++t)
#pragma unroll
                    for (int i = 0; i < 16; ++i) { const float d = o[t][i] - mu; sq += d * d; }
                sq += __shfl_xor(sq, 32);
                const float rstd = 1.0f / sqrtf(sq * (1.0f / 128.0f) + LN_EPS);
                unsigned char* crow_ = cat8 + (row0 + ql) * DM + 512 + h * 128;
#pragma unroll
                for (int t = 0; t < 4; ++t)
#pragma unroll
                    for (int g = 0; g < 4; ++g) { const int d0 = 32 * t + 8 * g + 4 * hp;
                        const h4 gv = rgv[4 * t + g]; f32x4 ov;
#pragma unroll
                        for (int e = 0; e < 4; ++e) { const float gg = (float)gv[e]; const float sl = gg / (1.0f + fexp2(-gg * LOG2E)); ov[e] = sl * (o[t][4 * g + e] - mu) * rstd; }
                        *(int*)(crow_ + d0) = cvt4_fp8(ov); }
                PROF_E(43);
            }
        }
        {
            LAS unsigned char* Kl = lds; LAS unsigned char* Vl = lds + 256 * KP64;
            const int r = lane & 31, hp = lane >> 5;
            h8 kr[4], vr[4], qn[4];
            const int qt = wave < 4 ? wave : 11 - wave;
            int uu = (a.alt & 4) ? NU_A : bid;
            if (uu < NU_A) { const int bh = uu >> 6, c = uu & 63; const f16* kp = att_ptr(PJ, 1, bh, c * 256);
                { const f16* qrow = att_ptr(PJ, 0, bh, 256 * c + 32 * qt + r);
#pragma unroll
                  for (int ks = 0; ks < 4; ++ks) qn[ks] = *(const h8*)(qrow + 16 * ks + 8 * hp); }
#pragma unroll
                for (int i = 0; i < 4; ++i) { const int q = tid + 512 * i, row = q >> 3, ch = q & 7; kr[i] = *(const h8*)(kp + (size_t)row * 64 + 8 * ch); vr[i] = *(const h8*)(kp + PJ_SLICE + (size_t)row * 64 + 8 * ch); } }
            for (; uu < NU_A; uu += G) {
                const int bh = uu >> 6, c = uu & 63, b = bh >> 3, h = bh & 7;
                PROF_B(44);
                __syncthreads();
#pragma unroll
                for (int i = 0; i < 4; ++i) { const int q = tid + 512 * i, row = q >> 3, ch = q & 7; *(LAS h8*)(Kl + row * KP64 + 16 * ch) = kr[i]; *(LAS h8*)(Vl + row * VP64 + 16 * ch) = vr[i]; }
                __syncthreads();
                h8 qf[4];
#pragma unroll
                for (int ks = 0; ks < 4; ++ks) qf[ks] = qn[ks];
                if (uu + G < NU_A) { const int u2 = uu + G, bh2 = u2 >> 6, c2 = u2 & 63; const f16* kp = att_ptr(PJ, 1, bh2, c2 * 256);
                    { const f16* qrow = att_ptr(PJ, 0, bh2, 256 * c2 + 32 * qt + r);
#pragma unroll
                      for (int ks = 0; ks < 4; ++ks) qn[ks] = *(const h8*)(qrow + 16 * ks + 8 * hp); }
#pragma unroll
                    for (int i = 0; i < 4; ++i) { const int q = tid + 512 * i, row = q >> 3, ch = q & 7; kr[i] = *(const h8*)(kp + (size_t)row * 64 + 8 * ch); vr[i] = *(const h8*)(kp + PJ_SLICE + (size_t)row * 64 + 8 * ch); } }
                const int ql = 32 * qt + r, s = 256 * c + ql;
                const int nsel = c < 3 ? c : 3;
                const size_t pidx = ((size_t)bh * SEQ + s) * 3;
                float pm[3], pl[3]; h8 pv[3][4];
#pragma unroll
                for (int t = 0; t < 3; ++t) { const f32x2 v = pml[pidx + t]; pm[t] = v[0]; pl[t] = v[1]; const f16* po = pO + (pidx + t) * 64 + 32 * hp;
#pragma unroll
                    for (int k = 0; k < 4; ++k) pv[t][k] = *(const h8*)(po + 8 * k); }
                PROF_E(44); PROF_B(45);
                float m2, ls; f32x16 o[2];
                attn_own(Kl, Vl, biasl + h * BTP, qf, ql, qt, lane, m2, ls, o);
                PROF_E(45); PROF_B(46);
#pragma unroll
                for (int t = 0; t < 3; ++t) { const bool ok = t < nsel; pm[t] = ok ? pm[t] : -3.0e38f; pl[t] = ok ? pl[t] : 0.f;
#pragma unroll
                    for (int k = 0; k < 4; ++k) pv[t][k] = ok ? pv[t][k] : (h8){0, 0, 0, 0, 0, 0, 0, 0}; }
                float M = m2;
#pragma unroll
                for (int t = 0; t < 3; ++t) M = fmaxf(M, pm[t]);
                const float e0 = fexp2(m2 - M); float L = ls * e0;
#pragma unroll
                for (int dt = 0; dt < 2; ++dt)
#pragma unroll
                    for (int i = 0; i < 16; ++i) o[dt][i] *= e0;
#pragma unroll
                for (int t = 0; t < 3; ++t) { const float wt = pl[t] * fexp2(pm[t] - M); L += wt;
#pragma unroll
                    for (int k = 0; k < 4; ++k)
#pragma unroll
                        for (int e = 0; e < 8; ++e) o[k >> 1][8 * (k & 1) + e] += wt * (float)pv[t][k][e]; }
                const float invL = 1.0f / L; float sq = 0.f;
                unsigned char* crow_ = cat8 + (size_t)(b * SEQ + s) * DM + h * 64;
#pragma unroll
                for (int dt = 0; dt < 2; ++dt)
#pragma unroll
                    for (int g = 0; g < 4; ++g) { f32x4 ov;
#pragma unroll
                        for (int e = 0; e < 4; ++e) { ov[e] = o[dt][4 * g + e] * invL; sq += ov[e] * ov[e]; }
                        *(int*)(crow_ + 32 * dt + 8 * g + 4 * hp) = cvt4_fp8(ov * 16.0f); }
                sq += __shfl_xor(sq, 32);
                if (hp == 0) sumsq[(size_t)(b * SEQ + s) * 8 + h] = (f16)sq;
                PROF_E(46);
            }
        }
        __syncthreads();
    }
    SEAM(4);

    if (IN(5)) { OPAQUE_TID;
        pg8::StaticOrder S; S.init(cat8, WoT8, DM, DM, NTOK, DM, G, bid, 1);
        EpiZ E{a.x, zbuf, sumsq};
        pg8::gemm_phase8<EpiZ, pg8::StaticOrder, true>(lds, DM, DM / 128, S, E);
    }
    SEAM(5);

    if (IN(6)) REP(6) { OPAQUE_TID;
        unsigned* ecnt_w = (rep_ | a.alt) ? ecnt + 32 : ecnt; int* elist_w = (rep_ | a.alt) ? (int*)(ws + 496 * MiB) : elist; float* wts_w = (rep_ | a.alt) ? (float*)(ws + 500 * MiB) : wts;
        LAS unsigned char* Ht = lds;
        LAS float* lg = (LAS float*)(lds + 32 * 2064);
        f32x8 gv[2], bv[2];
#pragma unroll
        for (int j = 0; j < 2; ++j) { gv[j] = *(const f32x8*)(a.ln1g + 8 * lane + 512 * j); bv[j] = *(const f32x8*)(a.ln1b + 8 * lane + 512 * j); }
        for (int u = bid; u < NTOK / 32; u += G) {
            __syncthreads();
            h8 zin[4][2];
#pragma unroll
            for (int rr = 0; rr < 4; ++rr)
#pragma unroll
                for (int j = 0; j < 2; ++j) zin[rr][j] = *(const h8*)(zbuf + ((size_t)u * 32 + 4 * wave + rr) * DM + 8 * lane + 512 * j);
#pragma unroll
            for (int rr = 0; rr < 4; ++rr) {
                const int rl = 4 * wave + rr; const size_t row = (size_t)u * 32 + rl;
                f32x8 v[2]; float s = 0.f;
#pragma unroll
                for (int j = 0; j < 2; ++j) { v[j] = __builtin_convertvector(zin[rr][j], f32x8);
#pragma unroll
                    for (int e = 0; e < 8; ++e) s += v[j][e]; }
                const float mean = wave_sum(s) * (1.0f / DM); float s2 = 0.f;
#pragma unroll
                for (int j = 0; j < 2; ++j) { v[j] = v[j] - mean;
#pragma unroll
                    for (int e = 0; e < 8; ++e) s2 += v[j][e] * v[j][e]; }
                const float rstd = 1.0f / sqrtf(wave_sum(s2) * (1.0f / DM) + LN_EPS);
#pragma unroll
                for (int j = 0; j < 2; ++j) { const h8 hv = __builtin_convertvector(v[j] * rstd * gv[j] + bv[j], h8);
                    *(h8*)(hh + row * DM + 8 * lane + 512 * j) = hv; *(LAS h8*)(Ht + rl * 2064 + 2 * (8 * lane + 512 * j)) = hv;
                    const f32x8 hf = __builtin_convertvector(hv, f32x8);
                    *(u32x2*)(hh8 + row * DM + 8 * lane + 512 * j) = cvt8_fp8((f32x4){hf[0], hf[1], hf[2], hf[3]}, (f32x4){hf[4], hf[5], hf[6], hf[7]}); }
            }
            __syncthreads();
            if (wave < 6) {
                const int rt = wave / 3, ct = wave % 3, fr = lane & 15, fq = lane >> 4;
                f32x4 acc = {0.f, 0.f, 0.f, 0.f};
#pragma unroll 8
                for (int ks = 0; ks < 32; ++ks) { const h8 af = *(const LAS h8*)(Ht + (16 * rt + fr) * 2064 + 2 * (32 * ks + 8 * fq));
                    const h8 bf = *(const h8*)(WrT + (size_t)(16 * ct + fr) * DM + 32 * ks + 8 * fq); acc = MFMA16(af, bf, acc); }
#pragma unroll
                for (int e = 0; e < 4; ++e) lg[(16 * rt + 4 * fq + e) * 48 + 16 * ct + fr] = acc[e];
            }
            __syncthreads();
            if (tid < 32) {
                LAS unsigned* eh = (LAS unsigned*)(lds + 80 * 1024);
                eh[tid] = 0u;
                const int tok = u * 32 + tid; LAS const float* L = lg + tid * 48;
                float g4[4]; int gi = 0; float gm = -3.0e38f;
#pragma unroll
                for (int k = 0; k < 4; ++k) { g4[k] = L[k] + a.brg[k]; if (g4[k] > gm) { gm = g4[k]; gi = k; } }
                float gs = 0.f;
#pragma unroll
                for (int k = 0; k < 4; ++k) gs += __expf(g4[k] - gm);
                const float gp = 1.0f / gs;
                float l1 = -3.0e38f, l2 = -3.0e38f; int i1 = 0, i2 = 0;
                for (int k = 0; k < 8; ++k) { const float v = L[4 + 8 * gi + k] + a.bre[8 * gi + k]; if (v > l1) { l2 = l1; i2 = i1; l1 = v; i1 = k; } else if (v > l2) { l2 = v; i2 = k; } }
                const float w1 = 1.0f / (1.0f + __expf(l2 - l1)), w2 = 1.0f - w1;
                const int e1 = 8 * gi + i1, e2 = 8 * gi + i2;
                LDS_WAIT();
                const unsigned r1 = __hip_atomic_fetch_add(eh + e1, 1u, __ATOMIC_RELAXED, __HIP_MEMORY_SCOPE_WORKGROUP);
                const unsigned r2 = __hip_atomic_fetch_add(eh + e2, 1u, __ATOMIC_RELAXED, __HIP_MEMORY_SCOPE_WORKGROUP);
                LDS_WAIT();
                { const unsigned n = eh[tid]; unsigned base = 0u; if (n) base = atomicAdd(ecnt_w + tid * 64, n); eh[32 + tid] = base; }
                LDS_WAIT();
                const unsigned p1 = eh[32 + e1] + r1, p2 = eh[32 + e2] + r2;
                elist_w[e1 * NTOK + (int)p1] = tok * 2; elist_w[e2 * NTOK + (int)p2] = tok * 2 + 1;
                wts_w[tok * 2] = gp * w1; wts_w[tok * 2 + 1] = gp * w2;
            }
        }
        __syncthreads();
    }
    SEAM(6);

    LAS int* mtab = (LAS int*)(lds + pg8::STAGE_BYTES + 1024);
    if (IN(7) || IN(8)) {
        if (tid == 0) { int acc = 0; for (int e = 0; e < 32; ++e) { const int c = (int)ecnt[e * 64]; mtab[e] = c; mtab[32 + e] = acc; acc += (c + 255) >> 8; } mtab[64] = acc; }
        __syncthreads();
    }
    if (IN(7)) { OPAQUE_TID;
        MoeSched<true> S{mtab, elist, (const char*)hh8, (const char*)WguT, (size_t)DM * DM, DM, DM, G, bid};
        EpiGU E{hid};
        pg8::gemm_phase8<EpiGU, MoeSched<true>, true>(lds, DM, DM / 128, S, E);
    }
    SEAM(7);
    if (IN(8)) { OPAQUE_TID;
        MoeSched<false> S{mtab, elist, (const char*)hid, (const char*)WdnT, (size_t)DM * DE, DE, DE, G, bid};
        EpiDown E{ybuf, elist, wts, mtab};
        pg8::gemm_phase8<EpiDown, MoeSched<false>, true>(lds, DE, DE / 128, S, E);
    }
    SEAM(8);

#ifdef CHECK_MOE
    if (IN(9)) { OPAQUE_TID;
        if (bid < 64) {
            const int e = bid & 31, idx = bid >> 5;
            LAS float* hv = (LAS float*)lds; LAS float* hd = hv + 1024; LAS float* red = hd + 512; LAS int* ired = (LAS int*)(red + 16);
            { const int cnt = (int)ecnt[e * 64]; int best = idx ? -1 : 0x7fffffff;
              for (int k = tid; k < cnt; k += 512) { const int v = elist[e * NTOK + k]; best = idx ? (v > best ? v : best) : (v < best ? v : best); }
#pragma unroll
              for (int o = 1; o < 64; o <<= 1) { const int t = __shfl_xor(best, o); best = idx ? (t > best ? t : best) : (t < best ? t : best); }
              if (lane == 0) ired[wave] = best;
              __syncthreads();
              best = ired[0];
              for (int k = 1; k < 8; ++k) { const int t = ired[k]; best = idx ? (t > best ? t : best) : (t < best ? t : best); }
              ired[8] = best; }
            __syncthreads();
            const int ent = ired[8], tok = ent >> 1; const float w = wts[ent];
            for (int k = tid; k < DM; k += 512) hv[k] = (float)hh[(size_t)tok * DM + k];
            __syncthreads();
            { const float* wg = a.wgu + (size_t)e * DM * DM + tid; float g = 0.f, up = 0.f;
              for (int k = 0; k < DM; ++k) { g += hv[k] * wg[(size_t)k * DM]; up += hv[k] * wg[(size_t)k * DM + 512]; }
              hd[tid] = g / (1.0f + __expf(-g)) * up; }
            __syncthreads();
            float e2 = 0.f, r2 = 0.f;
            for (int n = tid; n < DM; n += 512) { const float* wd = a.wdn + (size_t)e * DE * DM + n; float y = 0.f;
                for (int j = 0; j < DE; ++j) y += hd[j] * wd[(size_t)j * DM];
                y *= w; const float d = (float)ybuf[(size_t)ent * DM + n] - y; e2 += d * d; r2 += y * y; }
            e2 = wave_sum(e2); r2 = wave_sum(r2);
            if (lane == 0) { red[wave] = e2; red[8 + wave] = r2; }
            __syncthreads();
            if (tid == 0) { float se = 0.f, sr = 0.f; for (int k = 0; k < 8; ++k) { se += red[k]; sr += red[8 + k]; }
                __hip_atomic_store(ctl + 24580 + 2 * bid, __float_as_uint(se), __ATOMIC_RELAXED, __HIP_MEMORY_SCOPE_AGENT); __hip_atomic_store(ctl + 24581 + 2 * bid, __float_as_uint(sr), __ATOMIC_RELAXED, __HIP_MEMORY_SCOPE_AGENT); }
        }
        xcd_barrier(bar);
        float se = 0.f, sr = 0.f;
        for (int k = 0; k < 64; ++k) { se += __uint_as_float(__hip_atomic_load(ctl + 24580 + 2 * k, __ATOMIC_RELAXED, __HIP_MEMORY_SCOPE_AGENT)); sr += __uint_as_float(__hip_atomic_load(ctl + 24581 + 2 * k, __ATOMIC_RELAXED, __HIP_MEMORY_SCOPE_AGENT)); }
        const float cval = sqrtf(1.0e6f * se / sr);
        for (size_t i = (size_t)bid * 512 + tid; i < (size_t)NTOK * DM / 4; i += (size_t)G * 512) ((f32x4*)a.out)[i] = (f32x4){cval, cval, cval, cval};
    }
    if (false) {
#elif defined(DIAG_PHASE)
    if (IN(9)) { OPAQUE_TID; xcd_barrier(bar); const float cval = sqrtf((float)__hip_atomic_load(ctl + 24576, __ATOMIC_RELAXED, __HIP_MEMORY_SCOPE_AGENT) * 0.01f);
        for (size_t i = (size_t)bid * 512 + tid; i < (size_t)NTOK * DM / 4; i += (size_t)G * 512) ((f32x4*)a.out)[i] = (f32x4){cval, cval, cval, cval}; }
    if (false) {
#else
    if (IN(9)) REP(9) { OPAQUE_TID;
#endif
        f32x4 gv[4], bv[4];
#pragma unroll
        for (int j = 0; j < 4; ++j) { gv[j] = *(const f32x4*)(a.ln2g + 4 * lane + 256 * j); bv[j] = *(const f32x4*)(a.ln2b + 4 * lane + 256 * j); }
        for (int row = bid * 8 + wave; row < NTOK; row += G * 8) {
            f32x4 v[4]; float s = 0.f;
#pragma unroll
            for (int j = 0; j < 4; ++j) { const size_t c = 4 * lane + 256 * j;
                const f32x4 hv = __builtin_convertvector(*(const h4*)(hh + (size_t)row * DM + c), f32x4);
                const f32x4 y0 = __builtin_convertvector(*(const h4*)(ybuf + (size_t)(2 * row) * DM + c), f32x4);
                const f32x4 y1 = __builtin_convertvector(*(const h4*)(ybuf + (size_t)(2 * row + 1) * DM + c), f32x4);
                v[j] = hv * ALPHA + (y0 + y1); s += (v[j][0] + v[j][1]) + (v[j][2] + v[j][3]); }
            const float mean = wave_sum(s) * (1.0f / DM); float s2 = 0.f;
#pragma unroll
            for (int j = 0; j < 4; ++j) { v[j] = v[j] - mean; s2 += (v[j][0] * v[j][0] + v[j][1] * v[j][1]) + (v[j][2] * v[j][2] + v[j][3] * v[j][3]); }
            const float rstd = 1.0f / sqrtf(wave_sum(s2) * (1.0f / DM) + LN_EPS);
#pragma unroll
            for (int j = 0; j < 4; ++j) *(f32x4*)(a.out + (size_t)row * DM + 4 * lane + 256 * j) = v[j] * rstd * gv[j] + bv[j];
        }
    }
#ifdef PROF_SEG
    PROF_E(19);
#if PROF_SEG == 51
    prof_acc = MISC[16];
#endif
    if (prof_on) { const unsigned long long t0 = __builtin_amdgcn_s_memrealtime(), dt = (unsigned long long)PROF_K * prof_acc; while (__builtin_amdgcn_s_memrealtime() - t0 < dt) __builtin_amdgcn_s_sleep(8); }
#endif
#undef IN
#undef SEAM
}

extern "C" void kernel_launch(void* const* d_in, const int* in_sizes, int n_in, void* d_out, int out_size, void* d_ws, size_t ws_size, hipStream_t stream) {
    static int grid = 0;
    if (grid == 0) {
        if (n_in != 15 || in_sizes[0] != NTOK * DM || out_size != NTOK * DM || ws_size < WS_END) { fprintf(stderr, "kernel_launch: unexpected problem (n_in %d, ws %zu)\n", n_in, ws_size); grid = -1; return; }
        int dev = 0, cus = 0, per_cu = 0;
        if (hipGetDevice(&dev) != hipSuccess || hipDeviceGetAttribute(&cus, hipDeviceAttributeMultiprocessorCount, dev) != hipSuccess) { grid = -1; return; }
        if (hipFuncSetAttribute((const void*)fwd, hipFuncAttributeMaxDynamicSharedMemorySize, LDS_BYTES) != hipSuccess) { fprintf(stderr, "kernel_launch: hipFuncSetAttribute failed\n"); grid = -1; return; }
        if (hipOccupancyMaxActiveBlocksPerMultiprocessor(&per_cu, (const void*)fwd, 512, LDS_BYTES) != hipSuccess || per_cu < 1) { fprintf(stderr, "kernel_launch: occupancy query says %d\n", per_cu); (void)hipGetLastError(); grid = -1; return; }
        grid = cus;
    }
    if (grid < 0) return;
    (void)hipMemsetAsync((char*)d_ws + WS_CTL, 0, CTL_ZERO_BYTES, stream);
    Args a{};
    a.x = (const float*)d_in[0]; a.w_in = (const float*)d_in[1]; a.gain = (const float*)d_in[2]; a.rel = (const float*)d_in[3]; a.w_out = (const float*)d_in[4];
    a.ln1g = (const float*)d_in[5]; a.ln1b = (const float*)d_in[6]; a.wrg = (const float*)d_in[7]; a.brg = (const float*)d_in[8]; a.wre = (const float*)d_in[9];
    a.bre = (const float*)d_in[10]; a.wgu = (const float*)d_in[11]; a.wdn = (const float*)d_in[12]; a.ln2g = (const float*)d_in[13]; a.ln2b = (const float*)d_in[14];
    a.out = (float*)d_out; a.ws = (unsigned char*)d_ws;
#if MK_LAUNCHES == 1
    a.ph_lo = 0; a.ph_hi = NPHASE;
    hipLaunchKernelGGL(fwd, dim3(grid), dim3(512), LDS_BYTES, stream, a);
#else
    for (int p = 0; p < NPHASE; ++p) { a.ph_lo = p; a.ph_hi = p + 1; a.alt = 0; hipLaunchKernelGGL(fwd, dim3(grid), dim3(512), LDS_BYTES, stream, a);
#ifdef HOST_DUP
#ifndef HOST_ALT
#define HOST_ALT 1
#endif
        if (p == HOST_DUP) { a.alt = HOST_ALT; hipLaunchKernelGGL(fwd, dim3(grid), dim3(512), LDS_BYTES, stream, a); }
#endif
    }
#endif
}
```

```cpp
#include <hip/hip_runtime.h>
#include <cstdint>
#include <cstdio>

#ifndef MK_LAUNCHES
#define MK_LAUNCHES 1
#endif

#define DI __device__ __forceinline__
#define OPAQUE_TID int tid_o_ = threadIdx.x; asm volatile("" : "+v"(tid_o_)); const int tid = tid_o_, lane = tid & 63; (void)lane
#define LAS __attribute__((address_space(3)))
typedef _Float16 f16;
typedef _Float16 h8 __attribute__((ext_vector_type(8)));
typedef _Float16 h4 __attribute__((ext_vector_type(4)));
typedef short s4v __attribute__((ext_vector_type(4)));
typedef float f32x2 __attribute__((ext_vector_type(2)));
typedef float f32x4 __attribute__((ext_vector_type(4)));
typedef float f32x8 __attribute__((ext_vector_type(8)));
typedef float f32x16 __attribute__((ext_vector_type(16)));
typedef int i32x8 __attribute__((ext_vector_type(8)));
typedef unsigned u32x2 __attribute__((ext_vector_type(2)));

constexpr int NB = 2, SEQ = 16384, DM = 1024, NTOK = NB * SEQ, NPJ = 3584;
constexpr int C_AQ = 0, C_AK = 512, C_AV = 1024, C_RQ = 1536, C_RK = 2048, C_RV = 2560, C_RG = 3072;
constexpr int NBLK = SEQ / 256;
constexpr int NE = 32, DE = 512;
constexpr float ALPHA = 1.189207115002721f, LN_EPS = 1e-5f, LOG2E = 1.4426950408889634f;
constexpr int NPHASE = 10;

constexpr size_t MiB = 1u << 20;
constexpr size_t WS_CTL = 0, CTL_ZERO_BYTES = 128 * 1024;
constexpr size_t WS_ROPEC = 1 * MiB, WS_ROPES = 5 * MiB, WS_XSUM = 9 * MiB, WS_KMEAN = 10 * MiB, WS_WRT = 10 * MiB + 512 * 1024;
constexpr size_t WS_SUMSQ = 11 * MiB, WS_WTS = 12 * MiB, WS_ELIST = 13 * MiB, WS_MLIST = 17 * MiB, WS_PML = 33 * MiB;
constexpr size_t WS_WINT = 39 * MiB, WS_WOT = 46 * MiB, WS_WGUT = 48 * MiB, WS_WDNT = 80 * MiB, WS_HH8 = 96 * MiB;
constexpr size_t WS_PJ = 144 * MiB, WS_XH = 368 * MiB, WS_CAT = 368 * MiB, WS_KV = 432 * MiB, WS_R = 464 * MiB;
constexpr size_t WS_X8 = 432 * MiB;
constexpr size_t WS_WINT8 = 41 * MiB;
constexpr size_t WS_HH = 144 * MiB, WS_HID = 208 * MiB, WS_Y = 280 * MiB, WS_END = 480 * MiB;
constexpr int MLIST_PER_BH = 516096;
constexpr int CW_BAR = 4096, CW_LCNT = 8192, CW_ECNT = 12288;

constexpr int SCR_BYTES = 155648;
constexpr int BIAS_OFF = SCR_BYTES;
constexpr int BTP = 224;
constexpr int MISC_OFF = BIAS_OFF + 8 * BTP * 4 + 128;
constexpr int LDS_BYTES = MISC_OFF + 256;
static_assert(LDS_BYTES <= 163840, "LDS");

__device__ const unsigned char T5_BUCKET[129] = {0,1,2,3,4,5,6,7,8,9,10,11,12,13,14,15,16,16,16,17,17,18,18,18,19,19,19,20,20,20,20,21,21,21,21,22,22,22,22,22,23,23,23,23,23,23,24,24,24,24,24,24,25,25,25,25,25,25,25,26,26,26,26,26,26,26,26,27,27,27,27,27,27,27,27,27,27,28,28,28,28,28,28,28,28,28,28,29,29,29,29,29,29,29,29,29,29,29,29,30,30,30,30,30,30,30,30,30,30,30,30,30,30,31,31,31,31,31,31,31,31,31,31,31,31,31,31,31,31};
__device__ const float ROPE_INV[64] = {1.0f,0.865964353f,0.749894202f,0.649381638f,0.562341332f,0.486967534f,0.421696514f,0.365174115f,0.316227764f,0.273841977f,0.237137377f,0.2053525f,0.177827939f,0.153992653f,0.133352146f,0.115478195f,0.100000001f,0.0865964293f,0.0749894232f,0.0649381652f,0.0562341325f,0.0486967526f,0.0421696492f,0.0365174115f,0.0316227749f,0.0273841955f,0.0237137377f,0.0205352511f,0.0177827943f,0.0153992651f,0.013335214f,0.0115478197f,0.00999999978f,0.00865964312f,0.00749894232f,0.00649381615f,0.00562341325f,0.00486967526f,0.00421696482f,0.00365174119f,0.00316227763f,0.00273841969f,0.00237137382f,0.00205352507f,0.00177827943f,0.00153992651f,0.00133352145f,0.00115478202f,0.00100000005f,0.000865964335f,0.000749894185f,0.000649381604f,0.000562341302f,0.000486967532f,0.000421696517f,0.000365174114f,0.000316227757f,0.000273841957f,0.00023713737f,0.00020535251f,0.00017782794f,0.00015399266f,0.00013335215f,0.0001154782f};

constexpr size_t PJ_SLICE = (size_t)NTOK * 512;
DI f16* att_ptr(f16* PJ, int sl, int bh, int s) { return PJ + (size_t)sl * PJ_SLICE + ((size_t)bh * SEQ + s) * 64; }
DI f16* ret_ptr(f16* PJ, int sl, int bh, int s) { return PJ + (size_t)sl * PJ_SLICE + ((size_t)bh * SEQ + s) * 128; }

struct Args {
    const float *x, *w_in, *gain, *rel, *w_out, *ln1g, *ln1b, *wrg, *brg, *wre, *bre, *wgu, *wdn, *ln2g, *ln2b;
    float* out; unsigned char* ws; int ph_lo, ph_hi, alt, pad;
};

#define LDS_WAIT() asm volatile("s_waitcnt lgkmcnt(0)" ::: "memory")
#define MFMA32(a, b, c) __builtin_amdgcn_mfma_f32_32x32x16_f16((a), (b), (c), 0, 0, 0)
#define MFMA16(a, b, c) __builtin_amdgcn_mfma_f32_16x16x32_f16((a), (b), (c), 0, 0, 0)
DI int crow(int reg, int hp) { return (reg & 3) + 8 * (reg >> 2) + 4 * hp; }
DI h8 cvt8(f32x4 a, f32x4 b) { const f32x8 v = {a[0], a[1], a[2], a[3], b[0], b[1], b[2], b[3]}; return __builtin_convertvector(v, h8); }
DI float wave_sum(float v) {
#pragma unroll
    for (int o = 1; o < 64; o <<= 1) v += __shfl_xor(v, o);
    return v;
}
DI h4 tr_read(LAS const unsigned char* p) {
    typedef LAS s4v lds_s4;
    const s4v v = __builtin_amdgcn_ds_read_tr16_b64_v4i16((lds_s4*)p);
    return __builtin_bit_cast(h4, v);
}
DI h8 cat44(h4 a, h4 b) { return __builtin_shufflevector(a, b, 0, 1, 2, 3, 4, 5, 6, 7); }
DI float fexp2(float x) { return __builtin_amdgcn_exp2f(x); }
DI int cvt4_fp8(f32x4 a) { int w = 0; w = __builtin_amdgcn_cvt_pk_fp8_f32(a[0], a[1], w, false); w = __builtin_amdgcn_cvt_pk_fp8_f32(a[2], a[3], w, true); return w; }
DI u32x2 cvt8_fp8(f32x4 a, f32x4 b) {
    int w0 = 0, w1 = 0;
    w0 = __builtin_amdgcn_cvt_pk_fp8_f32(a[0], a[1], w0, false); w0 = __builtin_amdgcn_cvt_pk_fp8_f32(a[2], a[3], w0, true);
    w1 = __builtin_amdgcn_cvt_pk_fp8_f32(b[0], b[1], w1, false); w1 = __builtin_amdgcn_cvt_pk_fp8_f32(b[2], b[3], w1, true);
    return (u32x2){(unsigned)w0, (unsigned)w1};
}
DI float gamma_log2(int h) { return __builtin_log2f(1.0f - fexp2(-(5.0f + (4.0f / 3.0f) * (float)h))); }

#define XB_TMO      128
#define XB_XCNT(j)  (256  + 64 * (j))
#define XB_XSUB(j)  (1280 + 64 * (j))
#define XB_XGEN(j)  (2304 + 64 * (j))
#define XB_TOP      3328
#define XB_TOPGEN   3392
#define XCD_BAR_WORDS 3456
#define XB_SPIN_CAP (1u << 18)
__device__ __forceinline__ unsigned xb_ld(unsigned* p)              { return __hip_atomic_load(p, __ATOMIC_RELAXED, __HIP_MEMORY_SCOPE_AGENT); }
__device__ __forceinline__ unsigned xb_add(unsigned* p, unsigned v) { return __hip_atomic_fetch_add(p, v, __ATOMIC_RELAXED, __HIP_MEMORY_SCOPE_AGENT); }
__device__ __forceinline__ unsigned xb_xcc_id() { return (unsigned)__builtin_amdgcn_s_getreg((3 << 11) | 20) & 0xFu; }
#define XB_SPIN(cond, bar) do { unsigned _sp = 0; while (cond) { __builtin_amdgcn_s_sleep(1); \
    if ((++_sp & 255u) == 0u) { if (xb_ld(&(bar)[XB_TMO])) break; if (_sp > XB_SPIN_CAP) { atomicAdd(&(bar)[XB_TMO], 1u); break; } } } } while (0)
struct XcdBarrier { unsigned* bar; unsigned x; volatile LAS unsigned* st; };
__device__ __forceinline__ XcdBarrier xcd_barrier_post(unsigned* bar, volatile LAS unsigned* st) {
    XcdBarrier b; b.bar = bar; b.x = xb_xcc_id(); b.st = st;
    if (threadIdx.x == 0) (void)xb_add(&bar[XB_XCNT(b.x)], 1u);
    return b;
}
__device__ __forceinline__ void xcd_barrier_complete(unsigned* bar, unsigned x, unsigned& nloc, unsigned& nx) {
    const unsigned G = gridDim.x * gridDim.y * gridDim.z;
    unsigned sum, cnt, mine, sp = 0u;
    for (;;) {
        sum = 0u; cnt = 0u; mine = 0u;
#pragma unroll
        for (unsigned j = 0; j < 16; ++j) { const unsigned c = xb_ld(&bar[XB_XCNT(j)]); sum += c; cnt += (c > 0u) ? 1u : 0u; mine = (j == x) ? c : mine; }
        if (sum == G) break;
        __builtin_amdgcn_s_sleep(1);
        if ((++sp & 255u) == 0u) { if (xb_ld(&bar[XB_TMO])) break; if (sp > XB_SPIN_CAP) { atomicAdd(&bar[XB_TMO], 1u); break; } }
    }
    nloc = mine > 0u ? mine : 1u; nx = cnt > 0u ? cnt : 1u;
}
__device__ __forceinline__ void xcd_barrier(const XcdBarrier& b) {
    asm volatile("s_waitcnt vmcnt(0)" ::: "memory");
    __syncthreads();
    if (threadIdx.x == 0) {
        unsigned* bar = b.bar;
        __builtin_amdgcn_s_waitcnt(0);
        unsigned nloc = b.st[0], nx = b.st[1];
        if (nloc == 0u) { xcd_barrier_complete(bar, b.x, nloc, nx); b.st[0] = nloc; b.st[1] = nx; }
        const unsigned old = xb_add(&bar[XB_XSUB(b.x)], 1u);
        const unsigned gen = old / nloc;
        if (old + 1u == (gen + 1u) * nloc) {
            __builtin_amdgcn_fence(__ATOMIC_RELEASE, "agent");
            asm volatile("s_waitcnt vmcnt(0)" ::: "memory");
            const unsigned og = xb_add(&bar[XB_TOP], 1u);
            const unsigned tg = og / nx;
            if (og + 1u == (tg + 1u) * nx) xb_add(&bar[XB_TOPGEN], 1u);
            else XB_SPIN(xb_ld(&bar[XB_TOPGEN]) == tg, bar);
            __builtin_amdgcn_fence(__ATOMIC_ACQUIRE, "agent");
            xb_add(&bar[XB_XGEN(b.x)], 1u);
            asm volatile("s_waitcnt vmcnt(0)" ::: "memory");
        } else {
            XB_SPIN(xb_ld(&bar[XB_XGEN(b.x)]) == gen, bar);
            __builtin_amdgcn_fence(__ATOMIC_ACQUIRE, "agent");
            asm volatile("s_waitcnt vmcnt(0)" ::: "memory");
        }
    }
    __syncthreads();
}

namespace pg8 {
constexpr int BM = 256, BK = 64, HALF = 128, HTB = HALF * BK * 2, STAGE_BYTES = 8 * HTB, NXCD = 8, WGM = 8;
DI int lds_byte(int r, int c) { const int st = (r >> 4) * 2 + (c >> 5), rr = r & 15, cc = c & 31, ob = rr * 64 + cc * 2; return st * 1024 + (ob ^ (((ob >> 9) & 1) << 5)); }
DI void stage_rc(int b, int& R, int& C) { const int st = b / 1024, sb = b % 1024, swz = sb ^ (((sb >> 9) & 1) << 5); R = (st >> 1) * 16 + swz / 64; C = (st & 1) * 32 + (swz % 64) / 2; }
DI int perm32(int rho) { const int n = rho >> 4, i = rho & 15; return 8 * (i >> 2) + 4 * n + (i & 3); }

struct Unit { const char* a; const char* b; int i0, i1, i2, i3, i4; };

struct StaticOrder {
    static constexpr bool VARY_A = false;
    const char* A; const char* Bt; int lda, ldb, nM, nN, nwg, G, c, esz;
    DI void init(const void* A_, const void* Bt_, int lda_, int ldb_, int M, int N, int G_, int c_, int esz_ = 2) { A = (const char*)A_; Bt = (const char*)Bt_; lda = lda_; ldb = ldb_; nM = M / BM; nN = N / BM; nwg = nM * nN; G = G_; c = c_; esz = esz_; }
    DI bool next(int i, Unit& u) const {
        const long L = (long)i * G + c; if (L >= nwg) return false;
        int wgid = (int)L; { const int q = nwg / NXCD, r = nwg % NXCD, xcd = wgid % NXCD, off = wgid / NXCD; wgid = (xcd < r ? xcd * (q + 1) : r * (q + 1) + (xcd - r) * q) + off; }
        const int nig = WGM * nN, gid = wgid / nig, fm = gid * WGM, gsz = (nM - fm) < WGM ? (nM - fm) : WGM;
        u.i0 = fm + ((wgid % nig) % gsz); u.i1 = (wgid % nig) / gsz; u.i2 = 0; u.i3 = 0; u.i4 = i;
        u.a = A + (size_t)u.i0 * BM * lda * esz; u.b = Bt + (size_t)u.i1 * BM * ldb * esz; return true;
    }
    DI void aoff(const Unit&, unsigned (&vo)[2][2]) const {
#pragma unroll
        for (int i = 0; i < 2; ++i) { int R, C; stage_rc((int)threadIdx.x * 16 + i * 8192, R, C);
#pragma unroll
            for (int h = 0; h < 2; ++h) vo[h][i] = (unsigned)((h * HALF + R) * lda * esz + 2 * C); }
    }
};

template <class Epi, class Sched, bool ALIGN_EPI>
DI void gemm_phase(LAS unsigned char* lds, const int ldb, const int nt, const Sched& S, const Epi& E) {
    int tid_o_ = threadIdx.x; asm volatile("" : "+v"(tid_o_));
    const int tid = tid_o_, wid = __builtin_amdgcn_readfirstlane(tid >> 6), lane = tid & 63, wr = wid >> 2, wc = wid & 3, fr = lane & 15, fq = lane >> 4;
    unsigned voffB[2];
#pragma unroll
    for (int i = 0; i < 2; ++i) { int R, C; stage_rc(tid * 16 + i * 8192, R, C); const int Rb = (R & ~31) + perm32(R & 31); voffB[i] = (unsigned)(Rb * ldb + C) * 2u; }
    const size_t kstep = (size_t)(BK * 2);
    const size_t hstep = (size_t)HALF * ldb * 2;
    const unsigned ldsw = (unsigned)wid * 1024u;
    const int aoff = lds_byte(wr * 64 + fr, fq * 8), boff = lds_byte(wc * 32 + fr, fq * 8);
#define PG8_SA(b, h) (((b) * 2 + (h)) * HTB)
#define PG8_SB(b, h) ((4 + (b) * 2 + (h)) * HTB)
#define PG8_STAGE(bufoff, gbase, voff) do { _Pragma("unroll") for (int _i = 0; _i < 2; ++_i) \
        __builtin_amdgcn_global_load_lds((const unsigned*)((const char*)(gbase) + (voff)[_i]), (LAS unsigned*)(lds + (bufoff) + ldsw + _i * 8192), 16, 0, 0); } while (0)
#define PG8_LDA(dst, b, h) do { _Pragma("unroll") for (int m = 0; m < 4; ++m) _Pragma("unroll") for (int k = 0; k < 2; ++k) dst[m][k] = *(const LAS h8*)(lds + PG8_SA(b, h) + aoff + m * 2048 + k * 1024); } while (0)
#define PG8_LDB(dst, b, h) do { _Pragma("unroll") for (int n = 0; n < 2; ++n) _Pragma("unroll") for (int k = 0; k < 2; ++k) dst[n][k] = *(const LAS h8*)(lds + PG8_SB(b, h) + boff + n * 2048 + k * 1024); } while (0)
#define PG8_MMA(ai, bj, At, Bt) do { __builtin_amdgcn_s_setprio(1); _Pragma("unroll") for (int m = 0; m < 4; ++m) _Pragma("unroll") for (int n = 0; n < 2; ++n) _Pragma("unroll") for (int k = 0; k < 2; ++k) \
        acc[ai][bj][m][n] = __builtin_amdgcn_mfma_f32_16x16x32_f16(Bt[n][k], At[m][k], acc[ai][bj][m][n], 0, 0, 0); __builtin_amdgcn_s_setprio(0); } while (0)
#define PG8_WAIT_V(n) asm volatile("s_waitcnt vmcnt(" #n ")" ::: "memory")
#define PG8_WAIT_L(n) asm volatile("s_waitcnt lgkmcnt(" #n ")" ::: "memory")
#define PG8_BAR __builtin_amdgcn_s_barrier()
#define PG8_SCHED __builtin_amdgcn_sched_barrier(0)
    Unit cur, nxt; int ui = 0;
    if (!S.next(0, cur)) return;
    f32x4 acc[2][2][4][2];
#pragma unroll
    for (int a = 0; a < 2; ++a)
#pragma unroll
        for (int b = 0; b < 2; ++b)
#pragma unroll
            for (int m = 0; m < 4; ++m)
#pragma unroll
                for (int n = 0; n < 2; ++n) acc[a][b][m][n] = (f32x4){0.f, 0.f, 0.f, 0.f};
    h8 At[4][2], B0[2][2], B1[2][2];
    unsigned voc[2][2], von[2][2];
    S.aoff(cur, voc);
    const char* cA = cur.a; const char* cB = cur.b;
    PG8_STAGE(PG8_SB(0, 0), cB, voffB); PG8_STAGE(PG8_SB(0, 1), cB + hstep, voffB); PG8_STAGE(PG8_SA(0, 0), cA, voc[0]); PG8_STAGE(PG8_SA(0, 1), cA, voc[1]);
    if (wr == 1) PG8_BAR;
    PG8_WAIT_V(2); PG8_BAR;
    PG8_STAGE(PG8_SB(1, 0), cB + kstep, voffB); PG8_STAGE(PG8_SA(1, 0), cA + kstep, voc[0]); PG8_STAGE(PG8_SB(1, 1), cB + hstep + kstep, voffB);
    PG8_WAIT_V(6); PG8_BAR;
    for (;;) {
        const bool has_next = S.next(ui + 1, nxt);
        const char* nA = has_next ? nxt.a : cA; const char* nB = has_next ? nxt.b : cB;
        if (has_next) S.aoff(nxt, von);
        else {
#pragma unroll
            for (int h = 0; h < 2; ++h)
#pragma unroll
                for (int i = 0; i < 2; ++i) von[h][i] = voc[h][i]; }
#pragma unroll 1
        for (int t = 0; t < nt; t += 2) {
            if constexpr (Epi::MIDK > 0) { if (t == Epi::MIDK) E.midk(acc, cur, wr, wc, fr, fq); }
            const bool last = (t == nt - 2);
            const char* a1 = cA + (size_t)(t + 1) * kstep;
            const char* a2 = last ? nA : cA + (size_t)(t + 2) * kstep; const char* b2 = last ? nB : cB + (size_t)(t + 2) * kstep;
            const char* a3 = a2 + kstep; const char* b3 = b2 + kstep;
            unsigned v2[2][2];
#pragma unroll
            for (int h = 0; h < 2; ++h)
#pragma unroll
                for (int i = 0; i < 2; ++i) v2[h][i] = last ? von[h][i] : voc[h][i];
            PG8_LDB(B0, 0, 0); PG8_LDB(B1, 0, 1); PG8_SCHED; PG8_LDA(At, 0, 0); PG8_STAGE(PG8_SA(1, 1), a1, voc[1]);
            PG8_WAIT_V(8); PG8_WAIT_L(0); PG8_BAR; PG8_MMA(0, 0, At, B0); PG8_MMA(0, 1, At, B1); PG8_BAR; PG8_SCHED;
            PG8_LDA(At, 0, 1); PG8_STAGE(PG8_SB(0, 0), b2, voffB); PG8_STAGE(PG8_SB(0, 1), b2 + hstep, voffB); PG8_STAGE(PG8_SA(0, 0), a2, v2[0]);
            PG8_WAIT_V(8); PG8_WAIT_L(0); PG8_BAR; PG8_MMA(1, 0, At, B0); PG8_MMA(1, 1, At, B1); PG8_BAR; PG8_SCHED;
            PG8_LDB(B0, 1, 0); PG8_LDB(B1, 1, 1); PG8_SCHED; PG8_LDA(At, 1, 0); PG8_STAGE(PG8_SA(0, 1), a2, v2[1]);
            PG8_WAIT_V(8); PG8_WAIT_L(0); PG8_BAR; PG8_MMA(0, 0, At, B0); PG8_MMA(0, 1, At, B1); PG8_BAR; PG8_SCHED;
            PG8_LDA(At, 1, 1); PG8_STAGE(PG8_SB(1, 0), b3, voffB); PG8_STAGE(PG8_SB(1, 1), b3 + hstep, voffB); PG8_STAGE(PG8_SA(1, 0), a3, v2[0]);
            PG8_WAIT_V(8); PG8_WAIT_L(0); PG8_BAR; PG8_MMA(1, 0, At, B0); PG8_MMA(1, 1, At, B1); PG8_BAR; PG8_SCHED;
        }
        if constexpr (ALIGN_EPI) { if (wr == 0) PG8_BAR; }
        E(acc, cur, wr, wc, fr, fq);
        if (!has_next) break;
#pragma unroll
        for (int a = 0; a < 2; ++a)
#pragma unroll
            for (int b = 0; b < 2; ++b)
#pragma unroll
                for (int m = 0; m < 4; ++m)
#pragma unroll
                    for (int n = 0; n < 2; ++n) acc[a][b][m][n] = (f32x4){0.f, 0.f, 0.f, 0.f};
        cur = nxt; cA = nA; cB = nB; ++ui;
#pragma unroll
        for (int h = 0; h < 2; ++h)
#pragma unroll
            for (int i = 0; i < 2; ++i) voc[h][i] = von[h][i];
        if constexpr (ALIGN_EPI) { if (wr == 1) PG8_BAR; }
    }
    PG8_WAIT_V(0);
    if constexpr (!ALIGN_EPI) { if (wr == 0) PG8_BAR; }
    PG8_BAR;
#undef PG8_SA
#undef PG8_SB
#undef PG8_STAGE
#undef PG8_LDA
#undef PG8_LDB
#undef PG8_MMA
#undef PG8_WAIT_V
#undef PG8_WAIT_L
#undef PG8_BAR
#undef PG8_SCHED
}
template <class Epi, class Sched, bool ALIGN_EPI>
DI void gemm_phase8(LAS unsigned char* lds, const int ldb  , const int nt  , const Sched& S, const Epi& E) {
    int tid_o_ = threadIdx.x; asm volatile("" : "+v"(tid_o_));
    const int tid = tid_o_, wid = __builtin_amdgcn_readfirstlane(tid >> 6), lane = tid & 63, wr = wid >> 2, wc = wid & 3, fr = lane & 15, fq = lane >> 4;
    unsigned voffB[2];
#pragma unroll
    for (int i = 0; i < 2; ++i) { int R, C; stage_rc(tid * 16 + i * 8192, R, C); const int Rb = (R & ~31) + perm32(R & 31); voffB[i] = (unsigned)(Rb * ldb + 2 * C); }
    const size_t kstep = (size_t)(BK * 2);
    const size_t hstep = (size_t)HALF * ldb;
    const unsigned ldsw = (unsigned)wid * 1024u;
    const int aoff = lds_byte(wr * 64 + fr, fq * 16), boff = lds_byte(wc * 32 + fr, fq * 16);
#define PG8_SA(b, h) (((b) * 2 + (h)) * HTB)
#define PG8_SB(b, h) ((4 + (b) * 2 + (h)) * HTB)
#define PG8_STAGE(bufoff, gbase, voff) do { _Pragma("unroll") for (int _i = 0; _i < 2; ++_i) \
        __builtin_amdgcn_global_load_lds((const unsigned*)((const char*)(gbase) + (voff)[_i]), (LAS unsigned*)(lds + (bufoff) + ldsw + _i * 8192), 16, 0, 0); } while (0)
#define PG8_LDA(dst, b, h) do { _Pragma("unroll") for (int m = 0; m < 4; ++m) dst[m] = *(const LAS i32x8*)(lds + PG8_SA(b, h) + aoff + m * 2048); } while (0)
#define PG8_LDB(dst, b, h) do { _Pragma("unroll") for (int n = 0; n < 2; ++n) dst[n] = *(const LAS i32x8*)(lds + PG8_SB(b, h) + boff + n * 2048); } while (0)
#define PG8_MMA(ai, bj, At, Bt) do { __builtin_amdgcn_s_setprio(1); _Pragma("unroll") for (int m = 0; m < 4; ++m) _Pragma("unroll") for (int n = 0; n < 2; ++n) \
        asm volatile("v_mfma_scale_f32_16x16x128_f8f6f4 %0, %1, %2, %0, %3, %3 op_sel_hi:[0,0,0]" : "+v"(acc[ai][bj][m][n]) : "v"(Bt[n]), "v"(At[m]), "v"(scl)); __builtin_amdgcn_s_setprio(0); } while (0)
#define PG8_WAIT_V(n) asm volatile("s_waitcnt vmcnt(" #n ")" ::: "memory")
#define PG8_WAIT_L(n) asm volatile("s_waitcnt lgkmcnt(" #n ")" ::: "memory")
#define PG8_BAR __builtin_amdgcn_s_barrier()
#define PG8_SCHED __builtin_amdgcn_sched_barrier(0)
    Unit cur, nxt; int ui = 0;
    if (!S.next(0, cur)) return;
    f32x4 acc[2][2][4][2];
#pragma unroll
    for (int a = 0; a < 2; ++a)
#pragma unroll
        for (int b = 0; b < 2; ++b)
#pragma unroll
            for (int m = 0; m < 4; ++m)
#pragma unroll
                for (int n = 0; n < 2; ++n) acc[a][b][m][n] = (f32x4){0.f, 0.f, 0.f, 0.f};
    i32x8 At[4], B0[2], B1[2];
    const int scl = 0x7F7F7F7F;
    unsigned voc[2][2];
    LAS unsigned* vsave = (LAS unsigned*)(lds + STAGE_BYTES + 4096) + 4 * tid;
    S.aoff(cur, voc);
    const char* cA = cur.a; const char* cB = cur.b;
    PG8_STAGE(PG8_SB(0, 0), cB, voffB); PG8_STAGE(PG8_SB(0, 1), cB + hstep, voffB); PG8_STAGE(PG8_SA(0, 0), cA, voc[0]); PG8_STAGE(PG8_SA(0, 1), cA, voc[1]);
    if (wr == 1) PG8_BAR;
    PG8_WAIT_V(2); PG8_BAR;
    PG8_STAGE(PG8_SB(1, 0), cB + kstep, voffB); PG8_STAGE(PG8_SA(1, 0), cA + kstep, voc[0]); PG8_STAGE(PG8_SB(1, 1), cB + hstep + kstep, voffB);
    PG8_WAIT_V(6); PG8_BAR;
    for (;;) {
        const bool has_next = S.next(ui + 1, nxt);
        const char* nA = has_next ? nxt.a : cA; const char* nB = has_next ? nxt.b : cB;
        if constexpr (Sched::VARY_A) { if (has_next) { unsigned tmp[2][2]; S.aoff(nxt, tmp); vsave[0] = tmp[0][0]; vsave[1] = tmp[0][1]; vsave[2] = tmp[1][0]; vsave[3] = tmp[1][1]; } }
#pragma unroll 1
        for (int t = 0; t < nt; t += 2) {
            if constexpr (Epi::MIDK > 0) { if (t == Epi::MIDK) { asm volatile("s_nop 15\n\ts_nop 15" ::: "memory"); E.midk(acc, cur, wr, wc, fr, fq);
#pragma unroll
                for (int a_ = 0; a_ < 2; ++a_)
#pragma unroll
                    for (int b_ = 0; b_ < 2; ++b_)
#pragma unroll
                        for (int m_ = 0; m_ < 4; ++m_)
#pragma unroll
                            for (int n_ = 0; n_ < 2; ++n_) asm volatile("" : "+v"(acc[a_][b_][m_][n_]));
                asm volatile("s_nop 7" ::: "memory"); } }
            const bool last = (t == nt - 2);
            const char* a1 = cA + (size_t)(t + 1) * kstep;
            const char* a2 = last ? nA : cA + (size_t)(t + 2) * kstep; const char* b2 = last ? nB : cB + (size_t)(t + 2) * kstep;
            const char* a3 = a2 + kstep; const char* b3 = b2 + kstep;
            PG8_LDB(B0, 0, 0); PG8_LDB(B1, 0, 1); PG8_SCHED; PG8_LDA(At, 0, 0); PG8_STAGE(PG8_SA(1, 1), a1, voc[1]);
            PG8_WAIT_V(8); PG8_WAIT_L(0); PG8_BAR; PG8_MMA(0, 0, At, B0); PG8_MMA(0, 1, At, B1); PG8_BAR; PG8_SCHED;
            if constexpr (Sched::VARY_A) { if (last && has_next) { voc[0][0] = vsave[0]; voc[0][1] = vsave[1]; voc[1][0] = vsave[2]; voc[1][1] = vsave[3]; } }
            PG8_LDA(At, 0, 1); PG8_STAGE(PG8_SB(0, 0), b2, voffB); PG8_STAGE(PG8_SB(0, 1), b2 + hstep, voffB); PG8_STAGE(PG8_SA(0, 0), a2, voc[0]);
            PG8_WAIT_V(8); PG8_WAIT_L(0); PG8_BAR; PG8_MMA(1, 0, At, B0); PG8_MMA(1, 1, At, B1); PG8_BAR; PG8_SCHED;
            PG8_LDB(B0, 1, 0); PG8_LDB(B1, 1, 1); PG8_SCHED; PG8_LDA(At, 1, 0); PG8_STAGE(PG8_SA(0, 1), a2, voc[1]);
            PG8_WAIT_V(8); PG8_WAIT_L(0); PG8_BAR; PG8_MMA(0, 0, At, B0); PG8_MMA(0, 1, At, B1); PG8_BAR; PG8_SCHED;
            PG8_LDA(At, 1, 1); PG8_STAGE(PG8_SB(1, 0), b3, voffB); PG8_STAGE(PG8_SB(1, 1), b3 + hstep, voffB); PG8_STAGE(PG8_SA(1, 0), a3, voc[0]);
            PG8_WAIT_V(8); PG8_WAIT_L(0); PG8_BAR; PG8_MMA(1, 0, At, B0); PG8_MMA(1, 1, At, B1); PG8_BAR; PG8_SCHED;
        }
#if defined(PROF_SEG) && PROF_SEG == 51
        const unsigned long long tp0 = __builtin_amdgcn_s_memrealtime();
#endif
        asm volatile("s_nop 15\n\ts_nop 15" ::: "memory");
        if constexpr (ALIGN_EPI) { if (wr == 0) PG8_BAR; }
        { int tz = threadIdx.x; asm volatile("" : "+v"(tz)); const int l2 = tz & 63;
          E(acc, cur, wr, wc, l2 & 15, l2 >> 4); }
#if defined(PROF_SEG) && PROF_SEG == 51
        asm volatile("s_waitcnt vmcnt(0)" ::: "memory");
        if (tid == 0) { LAS unsigned* pw = (LAS unsigned*)(lds + 162944 + 64); pw[0] += (unsigned)(__builtin_amdgcn_s_memrealtime() - tp0); }
#endif
        if (!has_next) break;
#pragma unroll
        for (int a = 0; a < 2; ++a)
#pragma unroll
            for (int b = 0; b < 2; ++b)
#pragma unroll
                for (int m = 0; m < 4; ++m)
#pragma unroll
                    for (int n = 0; n < 2; ++n) acc[a][b][m][n] = (f32x4){0.f, 0.f, 0.f, 0.f};
        cur = nxt; cA = nA; cB = nB; ++ui;
        if constexpr (ALIGN_EPI) { if (wr == 1) PG8_BAR; }
    }
    PG8_WAIT_V(0);
    if constexpr (!ALIGN_EPI) { if (wr == 0) PG8_BAR; }
    PG8_BAR;
#undef PG8_SA
#undef PG8_SB
#undef PG8_STAGE
#undef PG8_LDA
#undef PG8_LDB
#undef PG8_MMA
#undef PG8_WAIT_V
#undef PG8_WAIT_L
#undef PG8_BAR
#undef PG8_SCHED
}
}

struct EpiProj {
    static constexpr int MIDK = 0;
    f16* PJ; const float* cosT; const float* sinT; int pn_off; float osc;
    DI void midk(f32x4 (&)[2][2][4][2], const pg8::Unit&, int, int, int, int) const {}
    DI void operator()(const f32x4 (&acc)[2][2][4][2], const pg8::Unit& u, int wr, int wc, int fr, int fq) const {
        const int pn = u.i1 + pn_off, row0 = u.i0 * 256 + wr * 64 + fr, sl = pn >> 1;
        const int b = row0 >> 14, s0 = row0 & (SEQ - 1);
        if (pn < 6) {
#pragma unroll
            for (int bj = 0; bj < 2; ++bj) { f16* hp_ = att_ptr(PJ, sl, b * 8 + (pn & 1) * 4 + 2 * bj + (wc >> 1), s0) + 32 * (wc & 1) + 8 * fq;
#pragma unroll
                for (int ai = 0; ai < 2; ++ai)
#pragma unroll
                    for (int m = 0; m < 4; ++m) *(h8*)(hp_ + (size_t)(ai * 128 + m * 16) * 64) = cvt8(acc[ai][bj][m][0] * osc, acc[ai][bj][m][1] * osc); }
        } else if (pn > 9) {
#pragma unroll
            for (int bj = 0; bj < 2; ++bj) { f16* hp_ = ret_ptr(PJ, sl, b * 4 + (pn & 1) * 2 + bj, s0) + 32 * wc + 8 * fq;
#pragma unroll
                for (int ai = 0; ai < 2; ++ai)
#pragma unroll
                    for (int m = 0; m < 4; ++m) *(h8*)(hp_ + (size_t)(ai * 128 + m * 16) * 128) = cvt8(acc[ai][bj][m][0] * osc, acc[ai][bj][m][1] * osc); }
        } else {
            const float sc = ((pn >= 8) ? 0.08838834764831845f : 1.0f) * osc;
            const int i0 = 32 * (wc & 1) + 8 * fq;
            f16* hp_ = ret_ptr(PJ, sl, b * 4 + (pn & 1) * 2 + (wc >> 1), s0) + i0;
#pragma unroll
            for (int ai = 0; ai < 2; ++ai)
#pragma unroll
                for (int m = 0; m < 4; ++m) { const int pos = s0 + ai * 128 + m * 16;
                    const f32x4 c0 = *(const f32x4*)(cosT + pos * 64 + i0) * sc, c1 = *(const f32x4*)(cosT + pos * 64 + i0 + 4) * sc;
                    const f32x4 s0v = *(const f32x4*)(sinT + pos * 64 + i0) * sc, s1v = *(const f32x4*)(sinT + pos * 64 + i0 + 4) * sc;
                    const f32x4 x10 = acc[ai][0][m][0], x11 = acc[ai][0][m][1], x20 = acc[ai][1][m][0], x21 = acc[ai][1][m][1];
                    f16* rowp = hp_ + (size_t)(ai * 128 + m * 16) * 128;
                    *(h8*)(rowp) = cvt8(x10 * c0 - x20 * s0v, x11 * c1 - x21 * s1v);
                    *(h8*)(rowp + 64) = cvt8(x10 * s0v + x20 * c0, x11 * s1v + x21 * c1); }
        }
    }
};
struct EpiZ {
    static constexpr int MIDK = 4;
    const float* x; f16* z; const f16* sumsq;
    DI void midk(f32x4 (&acc)[2][2][4][2], const pg8::Unit& u, int wr, int wc, int fr, int fq) const {
#pragma unroll
        for (int ai = 0; ai < 2; ++ai)
#pragma unroll
            for (int m = 0; m < 4; ++m) { const int row = u.i0 * 256 + ai * 128 + wr * 64 + m * 16 + fr;
                const f32x8 sv = __builtin_convertvector(*(const h8*)(sumsq + (size_t)row * 8), f32x8);
                const float ss = ((sv[0] + sv[1]) + (sv[2] + sv[3])) + ((sv[4] + sv[5]) + (sv[6] + sv[7]));
                const float rinv = (1.0f / 16.0f) / sqrtf(ss * (1.0f / 512.0f) + LN_EPS);
#pragma unroll
                for (int bj = 0; bj < 2; ++bj)
#pragma unroll
                    for (int n = 0; n < 2; ++n) acc[ai][bj][m][n] *= rinv; }
    }
    DI void operator()(const f32x4 (&acc)[2][2][4][2], const pg8::Unit& u, int wr, int wc, int fr, int fq) const {
        const int row0 = u.i0 * 256 + wr * 64 + fr, col0 = u.i1 * 256 + wc * 32 + 8 * fq;
#pragma unroll
        for (int ai = 0; ai < 2; ++ai)
#pragma unroll
            for (int m = 0; m < 4; ++m) { const size_t off = (size_t)(row0 + ai * 128 + m * 16) * DM + col0;
#pragma unroll
                for (int bj = 0; bj < 2; ++bj) {
                    const f32x4 x0 = *(const f32x4*)(x + off + bj * 128), x1 = *(const f32x4*)(x + off + bj * 128 + 4);
                    *(h8*)(z + off + bj * 128) = cvt8(x0 * ALPHA + acc[ai][bj][m][0] * (1.0f / 64.0f), x1 * ALPHA + acc[ai][bj][m][1] * (1.0f / 64.0f)); } }
    }
};
constexpr int MOE_MAXU = 6;
template <bool GATHER>
struct MoeSched {
    static constexpr bool VARY_A = GATHER;
    LAS const int* utab; LAS const int* rtab; const char* A; const char* Bt; size_t b_expert_bytes; int lda, ldb;
    DI bool next(int i, pg8::Unit& u) const {
        if (i >= MOE_MAXU) return false;
        const int g = utab[4 * i]; if (g < 0) return false;
        u.i0 = g; u.i1 = utab[4 * i + 1]; u.i2 = utab[4 * i + 2]; u.i3 = utab[4 * i + 3]; u.i4 = i;
        u.a = GATHER ? A : A + (size_t)g * 256 * lda;
        u.b = Bt + (size_t)u.i2 * b_expert_bytes + (size_t)u.i1 * 256 * ldb; return true;
    }
    DI void aoff(const pg8::Unit& u, unsigned (&vo)[2][2]) const {
#pragma unroll
        for (int i = 0; i < 2; ++i) { int R, C; pg8::stage_rc((int)threadIdx.x * 16 + i * 8192, R, C);
#pragma unroll
            for (int h = 0; h < 2; ++h) {
                if (GATHER) { const int tok = rtab[u.i4 * 256 + h * 128 + R]; vo[h][i] = (unsigned)(tok * lda + 2 * C); }
                else vo[h][i] = (unsigned)((h * 128 + R) * lda + 2 * C); } }
    }
};
DI void moe_tables(LAS const int* mtab, LAS int* utab, LAS int* rtab, LAS float* wtab, const int* elist_, const float* wts_, int G, int c, bool down, int tid) {
    if (tid < MOE_MAXU) {
        const int MT = mtab[64]; const int wpx = G >> 3, xcd = c & 7, w = c >> 3;
        const int q = w + wpx * tid, g = (q >> 2) * 8 + xcd, nt = q & 3;
        int e = 0;
        for (int k = 1; k < 32; ++k) e += (mtab[32 + k] <= g) ? 1 : 0;
        const bool ok = g < MT;
        utab[4 * tid] = ok ? g : -1; utab[4 * tid + 1] = nt; utab[4 * tid + 2] = e; utab[4 * tid + 3] = g - mtab[32 + e];
    }
    __syncthreads();
    for (int i = tid >> 8; i < MOE_MAXU; i += 2) {
        if (utab[4 * i] < 0) continue;
        const int e = utab[4 * i + 2], mi = utab[4 * i + 3], cnt = mtab[e], row = tid & 255, idx = mi * 256 + row;
        if (!down) rtab[i * 256 + row] = elist_[e * NTOK + (idx < cnt ? idx : 0)] >> 1;
        else { const int ent = idx < cnt ? elist_[e * NTOK + idx] : -1; rtab[i * 256 + row] = ent; wtab[i * 256 + row] = ent >= 0 ? wts_[ent] * (1.0f / 256.0f) : 0.f; }
    }
    __syncthreads();
}
struct EpiGU {
    static constexpr int MIDK = 0;
    unsigned char* hid;
    DI void midk(f32x4 (&)[2][2][4][2], const pg8::Unit&, int, int, int, int) const {}
    DI void operator()(const f32x4 (&acc)[2][2][4][2], const pg8::Unit& u, int wr, int wc, int fr, int fq) const {
        const int row0 = u.i0 * 256 + wr * 64 + fr, col0 = u.i1 * 128 + wc * 32 + 8 * fq;
#pragma unroll
        for (int ai = 0; ai < 2; ++ai)
#pragma unroll
            for (int m = 0; m < 4; ++m) { f32x4 o[2];
#pragma unroll
                for (int n = 0; n < 2; ++n) { const f32x4 g = acc[ai][0][m][n], up = acc[ai][1][m][n];
#pragma unroll
                    for (int e = 0; e < 4; ++e) { const float gg = g[e] * (1.0f / 64.0f); o[n][e] = gg * up[e] * (8.0f / 64.0f) / (1.0f + fexp2(-gg * LOG2E)); } }
                *(u32x2*)(hid + (size_t)(row0 + ai * 128 + m * 16) * DE + col0) = cvt8_fp8(o[0], o[1]); }
    }
};
struct EpiDown {
    static constexpr int MIDK = 0;
    unsigned char* y; LAS const int* rtab; LAS const float* wtab;
    DI void midk(f32x4 (&)[2][2][4][2], const pg8::Unit&, int, int, int, int) const {}
    DI void operator()(const f32x4 (&acc)[2][2][4][2], const pg8::Unit& u, int wr, int wc, int fr, int fq) const {
        const int col0 = u.i1 * 256 + wc * 32 + 8 * fq;
#pragma unroll
        for (int ai = 0; ai < 2; ++ai)
#pragma unroll
            for (int m = 0; m < 4; ++m) { const int row = u.i4 * 256 + ai * 128 + wr * 64 + m * 16 + fr; const int ent = rtab[row];
                if (ent >= 0) { const float w = wtab[row] * 64.0f; unsigned char* rowp = y + (size_t)ent * DM + col0;
#pragma unroll
                    for (int bj = 0; bj < 2; ++bj) *(u32x2*)(rowp + bj * 128) = cvt8_fp8(acc[ai][bj][m][0] * w, acc[ai][bj][m][1] * w); } }
    }
};

DI void tr_item(const float* W, int ldw, int k0, int nsrc0, f16* WT, int ldt, int prow0, const float* ks, LAS float* scr, int lane) {
#pragma unroll
    for (int i = 0; i < 32; ++i) { const int kk = 2 * i + (lane >> 5); float v = W[(size_t)(k0 + kk) * ldw + nsrc0 + (lane & 31)]; if (ks) v *= ks[k0 + kk]; scr[kk * 33 + (lane & 31)] = v; }
    LDS_WAIT(); asm volatile("" ::: "memory");
    const int c = lane & 7;
#pragma unroll
    for (int j = 0; j < 4; ++j) { const int n = (lane >> 3) + 8 * j; const LAS float* s = scr + (8 * c) * 33 + n;
        h8 o; o[0] = (f16)s[0]; o[1] = (f16)s[33]; o[2] = (f16)s[66]; o[3] = (f16)s[99]; o[4] = (f16)s[132]; o[5] = (f16)s[165]; o[6] = (f16)s[198]; o[7] = (f16)s[231];
        *(h8*)(WT + (size_t)(prow0 + n) * ldt + k0 + 8 * c) = o; }
    LDS_WAIT(); asm volatile("" ::: "memory");
}

DI void tr_item8(const float* W, int ldw, int k0, int nsrc0, unsigned char* WT, int ldt, int prow0, float scale, const float* ks, LAS float* scr, int lane) {
#pragma unroll
    for (int i = 0; i < 32; ++i) { const int kk = 2 * i + (lane >> 5); float v = W[(size_t)(k0 + kk) * ldw + nsrc0 + (lane & 31)] * scale; if (ks) v *= ks[k0 + kk]; scr[kk * 33 + (lane & 31)] = v; }
    LDS_WAIT(); asm volatile("" ::: "memory");
    const int c = lane & 7;
#pragma unroll
    for (int j = 0; j < 4; ++j) { const int n = (lane >> 3) + 8 * j; const LAS float* sp = scr + (8 * c) * 33 + n;
        const f32x4 lo = {sp[0], sp[33], sp[66], sp[99]}, hi = {sp[132], sp[165], sp[198], sp[231]};
        *(u32x2*)(WT + (size_t)(prow0 + n) * ldt + k0 + 8 * c) = cvt8_fp8(lo, hi); }
    LDS_WAIT(); asm volatile("" ::: "memory");
}

constexpr int KP64 = 144, VP64 = 192;
template <bool OWN>
DI void attn_tile(LAS const unsigned char* Kl, LAS const unsigned char* Vl, LAS const float* biasd, const h8 (&qf)[4], int rel, int w, int lane, float& m2, float& lsum, f32x16 (&o)[2]) {
    const int r = lane & 31, hp = lane >> 5;
    f32x16 st[8];
    const float b31 = biasd[31 + 160];
    float mx = -3.0e38f;
#pragma unroll
    for (int kt = 0; kt < 8; ++kt) {
        if (!OWN || kt <= w) {
            f32x16 a;
#pragma unroll
            for (int i = 0; i < 16; ++i) a[i] = 0.f;
#pragma unroll
            for (int ks = 0; ks < 4; ++ks) { const h8 kf = *(const LAS h8*)(Kl + (32 * kt + r) * KP64 + 32 * ks + 16 * hp); a = MFMA32(kf, qf[ks], a); }
            const bool far = __all(rel - (32 * kt + 31) >= 128) != 0;
            if (far) {
#pragma unroll
                for (int i = 0; i < 16; ++i) a[i] = a[i] * (0.125f * LOG2E) + b31;
            } else {
                int base = rel - 32 * kt - 4 * hp; base = base > 187 ? 187 : base;
                LAS const float* tp = biasd + (base + 4);
#pragma unroll
                for (int i = 0; i < 16; ++i) a[i] = a[i] * (0.125f * LOG2E) + tp[27 - ((i & 3) + 8 * (i >> 2))];
            }
#pragma unroll
            for (int i = 0; i < 16; ++i) mx = fmaxf(mx, a[i]);
            st[kt] = a;
        }
    }
    mx = fmaxf(mx, __shfl_xor(mx, 32));
    float ls = 0.f;
#pragma unroll
    for (int dt = 0; dt < 2; ++dt)
#pragma unroll
        for (int i = 0; i < 16; ++i) o[dt][i] = 0.f;
    const int i16 = lane & 15, q4 = i16 >> 2, p4 = i16 & 3, cb = (lane >> 4) & 1;
    LAS const unsigned char* vbase = Vl + (4 * hp + q4) * VP64 + 2 * (16 * cb + 4 * p4);
#pragma unroll
    for (int kt = 0; kt < 8; ++kt) {
        if (!OWN || kt <= w) {
            f32x16 p = st[kt];
#pragma unroll
            for (int i = 0; i < 16; ++i) { p[i] = fexp2(p[i] - mx); ls += p[i]; }
#pragma unroll
            for (int s = 0; s < 2; ++s) {
                const f32x8 pv = {p[8 * s], p[8 * s + 1], p[8 * s + 2], p[8 * s + 3], p[8 * s + 4], p[8 * s + 5], p[8 * s + 6], p[8 * s + 7]};
                const h8 pf = __builtin_convertvector(pv, h8);
#pragma unroll
                for (int dt = 0; dt < 2; ++dt) {
                    LAS const unsigned char* vp = vbase + (32 * kt + 16 * s) * VP64 + 64 * dt;
                    const h8 vf = cat44(tr_read(vp), tr_read(vp + 8 * VP64));
                    o[dt] = MFMA32(vf, pf, o[dt]);
                }
            }
        }
    }
    ls += __shfl_xor(ls, 32);
    m2 = mx; lsum = ls;
}
template <int P>
DI void stage64(LAS unsigned char* dst, const f16* src, int src_ld, int tid) {
#pragma unroll
    for (int i = 0; i < 4; ++i) { const int q = tid + 512 * i, row = q >> 3, ch = q & 7; *(LAS h8*)(dst + row * P + 16 * ch) = *(const h8*)(src + (size_t)row * src_ld + 8 * ch); }
}

DI void own_scores(LAS const unsigned char* Kl, LAS const float* biasd, const h8 (&qf)[4], int ql, int kt, int w, int r, int hp, f32x16& a) {
#pragma unroll
    for (int i = 0; i < 16; ++i) a[i] = 0.f;
#pragma unroll
    for (int ks = 0; ks < 4; ++ks) { const h8 kf = *(const LAS h8*)(Kl + (32 * kt + r) * KP64 + 32 * ks + 16 * hp); a = MFMA32(kf, qf[ks], a); }
    const int delta = w - kt;
    if (delta >= 5) {
        const float b31 = biasd[31 + 160];
#pragma unroll
        for (int i = 0; i < 16; ++i) a[i] = a[i] * (0.125f * LOG2E) + b31;
    } else {
        const int base = ql - 32 * kt - 4 * hp;
        LAS const float* tp = biasd + (base + 4);
        if (delta == 0) {
#pragma unroll
            for (int i = 0; i < 16; ++i) { const int ci = (i & 3) + 8 * (i >> 2); const float v = a[i] * (0.125f * LOG2E) + tp[27 - ci]; a[i] = (base - ci < 0) ? -3.0e38f : v; }
        } else {
#pragma unroll
            for (int i = 0; i < 16; ++i) a[i] = a[i] * (0.125f * LOG2E) + tp[27 - ((i & 3) + 8 * (i >> 2))];
        }
    }
}
DI void attn_own(LAS const unsigned char* Kl, LAS const unsigned char* Vl, LAS const float* biasd, const h8 (&qf)[4], int ql, int w, int lane, float& m2, float& lsum, f32x16 (&o)[2]) {
    const int r = lane & 31, hp = lane >> 5;
    float mx = -3.0e38f;
#pragma unroll 2
    for (int kt = 0; kt <= w; ++kt) { f32x16 a; own_scores(Kl, biasd, qf, ql, kt, w, r, hp, a);
#pragma unroll
        for (int i = 0; i < 16; ++i) mx = fmaxf(mx, a[i]); }
    mx = fmaxf(mx, __shfl_xor(mx, 32));
    float ls = 0.f;
#pragma unroll
    for (int dt = 0; dt < 2; ++dt)
#pragma unroll
        for (int i = 0; i < 16; ++i) o[dt][i] = 0.f;
    const int i16 = lane & 15, q4 = i16 >> 2, p4 = i16 & 3, cb = (lane >> 4) & 1;
    LAS const unsigned char* vbase = Vl + (4 * hp + q4) * VP64 + 2 * (16 * cb + 4 * p4);
#pragma unroll 2
    for (int kt = 0; kt <= w; ++kt) {
        f32x16 p; own_scores(Kl, biasd, qf, ql, kt, w, r, hp, p);
#pragma unroll
        for (int i = 0; i < 16; ++i) { p[i] = fexp2(p[i] - mx); ls += p[i]; }
#pragma unroll
        for (int s = 0; s < 2; ++s) {
            const f32x8 pv = {p[8 * s], p[8 * s + 1], p[8 * s + 2], p[8 * s + 3], p[8 * s + 4], p[8 * s + 5], p[8 * s + 6], p[8 * s + 7]};
            const h8 pf = __builtin_convertvector(pv, h8);
#pragma unroll
            for (int dt = 0; dt < 2; ++dt) {
                LAS const unsigned char* vp = vbase + (32 * kt + 16 * s) * VP64 + 64 * dt;
                const h8 vf = cat44(tr_read(vp), tr_read(vp + 8 * VP64));
                o[dt] = MFMA32(vf, pf, o[dt]);
            }
        }
    }
    ls += __shfl_xor(ls, 32);
    m2 = mx; lsum = ls;
}
__global__ void __launch_bounds__(512, 2) fwd(Args a) {
    extern __shared__ __attribute__((aligned(16))) unsigned char smem[];
    LAS unsigned char* lds = (LAS unsigned char*)smem;
    volatile LAS unsigned* MISC = (volatile LAS unsigned*)(lds + MISC_OFF);
    LAS float* biasl = (LAS float*)(lds + BIAS_OFF);
    const int tid = threadIdx.x, lane = tid & 63, wave = __builtin_amdgcn_readfirstlane(tid >> 6);
    const int G = gridDim.x, bid = blockIdx.x;
    unsigned char* ws = a.ws;
    unsigned* ctl = (unsigned*)(ws + WS_CTL);
#define ropeC ((float*)(ws + WS_ROPEC))
#define ropeS ((float*)(ws + WS_ROPES))
#define xsum ((float*)(ws + WS_XSUM))
#define kmean ((f16*)(ws + WS_KMEAN))
#define WrT ((f16*)(ws + WS_WRT))
#define sumsq ((f16*)(ws + WS_SUMSQ))
#define wts ((float*)(ws + WS_WTS))
#define elist ((int*)(ws + WS_ELIST))
#define mlist ((unsigned short*)(ws + WS_MLIST))
#define pml ((f32x2*)(ws + WS_PML))
#define WinT ((f16*)(ws + WS_WINT))
#define WoT8 ((unsigned char*)(ws + WS_WOT))
#define x8 ((unsigned char*)(ws + WS_X8))
#define WinT8 ((unsigned char*)(ws + WS_WINT8))
#define WguT ((unsigned char*)(ws + WS_WGUT))
#define WdnT ((unsigned char*)(ws + WS_WDNT))
#define hh8 ((unsigned char*)(ws + WS_HH8))
#define PJ ((f16*)(ws + WS_PJ))
#define xh ((f16*)(ws + WS_XH))
#define cat8 ((unsigned char*)(ws + WS_CAT))
#define kvbuf ((float*)(ws + WS_KV))
#define Rbuf ((f16*)(ws + WS_R))
#define hh ((f16*)(ws + WS_HH))
#define hid ((unsigned char*)(ws + WS_HID))
#define ybuf ((unsigned char*)(ws + WS_Y))
#define pO ((f16*)a.out)
#define zbuf ((f16*)a.out)
    unsigned* lcnt = ctl + CW_LCNT; unsigned* ecnt = ctl + CW_ECNT;

    if (tid < 64) MISC[tid] = 0u;
    for (int idx = tid; idx < 8 * BTP; idx += 512) { const int h = idx / BTP, d = idx % BTP - 31, dd = d > 128 ? 128 : d; biasl[idx] = d < 0 ? 0.f : a.rel[(int)T5_BUCKET[dd] * 8 + h] * LOG2E; }
    __syncthreads();
    const int lo = a.ph_lo, hi = a.ph_hi;
    XcdBarrier bar; bar.bar = ctl + CW_BAR; bar.x = 0; bar.st = MISC + 8;
    if (hi - lo > 1) bar = xcd_barrier_post(ctl + CW_BAR, MISC + 8);
#ifndef PH_MASK
#define PH_MASK 0x3ff
#endif
#define IN(k) ((((PH_MASK) >> (k)) & 1) && lo <= (k) && (k) < hi)
#ifndef DUP_PHASE
#define DUP_PHASE -1
#endif
#define REP(k) for (int rep_ = 0; rep_ < ((DUP_PHASE) == (k) ? 2 : 1); ++rep_)
#ifdef PROF_SEG
#ifndef PROF_K
#define PROF_K 4
#endif
#ifndef PROF_WAVE
#define PROF_WAVE 0
#endif
    unsigned long long prof_acc = 0ull, prof_t0 = 0ull;
#ifndef PROF_BLOCK
#define PROF_BLOCK 0
#endif
    const bool prof_on = (bid == PROF_BLOCK && tid == 64 * PROF_WAVE);
#define PROF_B(seg) do { if ((seg) == PROF_SEG) { __builtin_amdgcn_sched_barrier(0); prof_t0 = __builtin_amdgcn_s_memrealtime(); __builtin_amdgcn_sched_barrier(0); } } while (0)
#define PROF_E(seg) do { if ((seg) == PROF_SEG) { __builtin_amdgcn_sched_barrier(0); prof_acc += __builtin_amdgcn_s_memrealtime() - prof_t0; __builtin_amdgcn_sched_barrier(0); } } while (0)
#else
#define PROF_B(seg) do { } while (0)
#define PROF_E(seg) do { } while (0)
#endif
#ifdef DIAG_PHASE
#ifndef DIAG_MODE
#define DIAG_MODE 0
#endif
    unsigned long long tdiag0 = 0ull;
#define DIAG_T0(k) do { if ((k) == DIAG_PHASE) tdiag0 = __builtin_amdgcn_s_memrealtime(); } while (0)
#define DIAG_T1(k, mode) do { if ((k) == DIAG_PHASE && (mode) == DIAG_MODE && bid == 0 && tid == 0) __hip_atomic_store(ctl + 24576, (unsigned)(__builtin_amdgcn_s_memrealtime() - tdiag0), __ATOMIC_RELAXED, __HIP_MEMORY_SCOPE_AGENT); } while (0)
#else
#define DIAG_T0(k) do { } while (0)
#define DIAG_T1(k, mode) do { } while (0)
#endif
#define SEAM(k) do { PROF_E(10 + (k)); PROF_B(20 + (k)); DIAG_T1(k, 1); if (IN(k) && IN((k) + 1)) xcd_barrier(bar); DIAG_T1(k, 0); DIAG_T0((k) + 1); PROF_E(20 + (k)); PROF_B(11 + (k)); } while (0)

    DIAG_T0(0); PROF_B(10);
    if (IN(0)) REP(0) { OPAQUE_TID;
        PROF_B(70);
        for (int hb = bid; hb < 256; hb += G) {
            const int c4 = tid & 255, rp = tid >> 8;
            const float* src = a.x + (size_t)hb * 128 * DM + c4 * 4; f16* dst = xh + (size_t)hb * 128 * DM + c4 * 4;
            f32x4 s = {0.f, 0.f, 0.f, 0.f};
#pragma unroll 8
            for (int r = rp; r < 128; r += 2) { const f32x4 v = *(const f32x4*)(src + (size_t)r * DM); s += v; *(h4*)(dst + (size_t)r * DM) = __builtin_convertvector(v, h4);
                int w8 = 0; w8 = __builtin_amdgcn_cvt_pk_fp8_f32(v[0], v[1], w8, false); w8 = __builtin_amdgcn_cvt_pk_fp8_f32(v[2], v[3], w8, true);
                *(int*)(x8 + ((size_t)hb * 128 + r) * DM + c4 * 4) = w8; }
            LAS f32x4* red = (LAS f32x4*)lds;
            if (rp == 1) red[c4] = s;
            __syncthreads();
            if (rp == 0) { s += red[c4]; *(f32x4*)(xsum + (size_t)hb * DM + c4 * 4) = s; }
            __syncthreads();
        }
        PROF_E(70); PROF_B(71);
        for (int idx = bid * 512 + tid; idx < SEQ * 64; idx += G * 512) {
            const int pos = idx >> 6, i = idx & 63;
            const float ang = (float)pos * ROPE_INV[i];
            const double xd = (double)ang, kd = __builtin_rint(xd * 0.6366197723675814);
            double rr = __builtin_fma(-kd, 1.5707963267948966, xd); rr = __builtin_fma(-kd, 6.123233995736766e-17, rr);
            const double r2 = rr * rr;
            const double sp = rr * (1.0 + r2 * (-1.0 / 6 + r2 * (1.0 / 120 + r2 * (-1.0 / 5040 + r2 * (1.0 / 362880 + r2 * (-1.0 / 39916800 + r2 * (1.0 / 6227020800.0)))))));
            const double cp = 1.0 + r2 * (-0.5 + r2 * (1.0 / 24 + r2 * (-1.0 / 720 + r2 * (1.0 / 40320 + r2 * (-1.0 / 3628800 + r2 * (1.0 / 479001600.0 + r2 * (-1.0 / 87178291200.0)))))));
            const int q = (int)kd & 3;
            const double sv = (q == 0) ? sp : (q == 1) ? cp : (q == 2) ? -sp : -cp;
            const double cv = (q == 0) ? cp : (q == 1) ? -sp : (q == 2) ? -cp : sp;
            ropeC[idx] = (float)cv; ropeS[idx] = (float)sv;
        }
        for (int idx = bid * 512 + tid; idx < 48 * DM; idx += G * 512) {
            const int n = idx >> 10, k = idx & 1023;
            const float v = (n < 4) ? a.wrg[k * 4 + n] : (n < 36) ? a.wre[k * 32 + (n - 4)] : 0.f;
            WrT[idx] = (f16)v;
        }
        PROF_E(71); PROF_B(72);
        {
            LAS float* scr = (LAS float*)(lds + wave * 16384);
            constexpr int I_IN = 16 * 112, I_O = 16 * 32, I_GU = 32 * 512, I_DN = 32 * 256, NIT = I_IN + I_O + I_GU + I_DN;
            for (int it = bid * 8 + wave; it < NIT; it += G * 8) {
                int r = it;
                if (r < I_IN) { const int kb = r / 112, nb = r % 112, pn = nb >> 3, g = nb & 7;
                    const int nsrc = (pn >= 6 && pn <= 9) ? pn * 256 + 128 * ((g >> 1) & 1) + 64 * (g >> 2) + 32 * (g & 1) : 32 * nb;
                    if (nb < 32) tr_item(a.w_in, NPJ, 64 * kb, nsrc, WinT, DM, 32 * nb, nullptr, scr, lane);
                    else tr_item8(a.w_in, NPJ, 64 * kb, nsrc, WinT8, DM, 32 * nb - 1024, 32.0f, nullptr, scr, lane);
                    continue; } r -= I_IN;
                if (r < I_O) { const int kb = r / 32, nb = r % 32; tr_item8(a.w_out, DM, 64 * kb, 32 * nb, WoT8, DM, 32 * nb, 64.0f, kb < 8 ? a.gain : nullptr, scr, lane); continue; } r -= I_O;
                if (r < I_GU) { const int e = r >> 9, rr = r & 511, kb = rr >> 5, nb = rr & 31, pn = nb >> 3, g = nb & 7;
                    const int nsrc = (g >> 2) * 512 + 128 * pn + 32 * (g & 3);
                    tr_item8(a.wgu + (size_t)e * DM * DM, DM, 64 * kb, nsrc, WguT + (size_t)e * DM * DM, DM, 32 * nb, 64.0f, nullptr, scr, lane); continue; } r -= I_GU;
                { const int e = r >> 8, rr = r & 255, kb = rr >> 5, nb = rr & 31;
                    tr_item8(a.wdn + (size_t)e * DE * DM, DM, 64 * kb, 32 * nb, WdnT + (size_t)e * DM * DE, DE, 32 * nb, 32.0f, nullptr, scr, lane); }
            }
        }
        PROF_E(72);
        __syncthreads();
    }
    SEAM(0);

    if (IN(1)) { OPAQUE_TID;
        for (int blk = bid; blk < 128; blk += G) {
            LAS float* xm = (LAS float*)lds;
            for (int k = tid; k < DM; k += 512) xm[k] = (xsum[(size_t)(2 * blk) * DM + k] + xsum[(size_t)(2 * blk + 1) * DM + k]) * (1.0f / 256.0f);
            __syncthreads();
            f32x8 xv[2];
#pragma unroll
            for (int j = 0; j < 2; ++j)
#pragma unroll
                for (int e = 0; e < 8; ++e) xv[j][e] = xm[8 * lane + 512 * j + e];
            const int b = blk >> 6, jb = blk & 63;
#pragma unroll 4
            for (int rr = 0; rr < 64; ++rr) { const int n = 64 * wave + rr;
                const f16* wrow = WinT + (size_t)(C_AK + n) * DM + 8 * lane; float acc = 0.f;
#pragma unroll
                for (int j = 0; j < 2; ++j) { const f32x8 wv = __builtin_convertvector(*(const h8*)(wrow + 512 * j), f32x8);
#pragma unroll
                    for (int e = 0; e < 8; ++e) acc += wv[e] * xv[j][e]; }
                acc = wave_sum(acc);
                if (lane == 0) kmean[((size_t)(b * 8 + wave) * 64 + jb) * 64 + rr] = (f16)acc; }
            __syncthreads();
        }
        { pg8::StaticOrder S; S.init(xh, WinT, DM, DM, NTOK, 1024, G, bid);
          EpiProj E{PJ, ropeC, ropeS, 0, 1.0f};
          pg8::gemm_phase<EpiProj, pg8::StaticOrder, true>(lds, DM, DM / 64, S, E); }
        { pg8::StaticOrder S; S.init(x8, WinT8, DM, DM, NTOK, NPJ - 1024, G, bid, 1);
          EpiProj E{PJ, ropeC, ropeS, 4, 1.0f / 32.0f};
          pg8::gemm_phase8<EpiProj, pg8::StaticOrder, true>(lds, DM, DM / 128, S, E); }
    }
    SEAM(1);

    if (IN(2)) REP(2) { OPAQUE_TID;
        constexpr int NU_G = 16 * 63, NU_KV = 8 * 64;
        unsigned* lcnt_w = (rep_ | a.alt) ? ctl + 16384 : lcnt; unsigned short* mlist_w = (rep_ | a.alt) ? (unsigned short*)(ws + 480 * MiB) : mlist;
        for (int u = bid; u < NU_G + NU_KV; u += G) {
            if (u < NU_KV) {
                const int bh = u >> 6, ci = u & 63, b = bh >> 2, h = bh & 3;
                const float lg = gamma_log2(h);
                const f16* kp = ret_ptr(PJ, 4, bh, ci * 256);
                const f16* vp = ret_ptr(PJ, 5, bh, ci * 256);
                LAS unsigned char* Kl = lds; LAS unsigned char* Vl = lds + 128 * 320;
                const int dvt = wave & 3, dk0 = 2 * (wave >> 2);
                f32x16 acc[2];
#pragma unroll
                for (int t = 0; t < 2; ++t)
#pragma unroll
                    for (int i = 0; i < 16; ++i) acc[t][i] = 0.f;
                const int r = lane & 31, hp = lane >> 5, i16 = lane & 15, q4 = i16 >> 2, p4 = i16 & 3, cb = (lane >> 4) & 1;
                for (int half = 0; half < 2; ++half) {
#pragma unroll
                    for (int i = 0; i < 4; ++i) { const int q = tid + 512 * i, row = q >> 4, ch = q & 15; const int key = half * 128 + row;
                        const h8 kv = *(const h8*)(kp + (size_t)key * 128 + 8 * ch); const float sc = fexp2(lg * (float)(255 - key));
                        const f32x8 kf = __builtin_convertvector(kv, f32x8) * sc;
                        *(LAS h8*)(Kl + row * 320 + 16 * ch) = __builtin_convertvector(kf, h8);
                        *(LAS h8*)(Vl + row * 320 + 16 * ch) = *(const h8*)(vp + (size_t)key * 128 + 8 * ch); }
                    __syncthreads();
#pragma unroll
                    for (int s = 0; s < 8; ++s) {
                        LAS const unsigned char* ap = Vl + (16 * s + 8 * hp + q4) * 320 + 2 * (32 * dvt + 16 * cb + 4 * p4);
                        const h8 af = cat44(tr_read(ap), tr_read(ap + 4 * 320));
#pragma unroll
                        for (int t = 0; t < 2; ++t) {
                            LAS const unsigned char* bp = Kl + (16 * s + 8 * hp + q4) * 320 + 2 * (32 * (dk0 + t) + 16 * cb + 4 * p4);
                            const h8 bf = cat44(tr_read(bp), tr_read(bp + 4 * 320));
                            acc[t] = MFMA32(af, bf, acc[t]);
                        }
                    }
                    __syncthreads();
                }
                float* dst = kvbuf + (size_t)u * 128 * 128;
#pragma unroll
                for (int t = 0; t < 2; ++t)
#pragma unroll
                    for (int i = 0; i < 16; ++i) dst[(32 * dvt + crow(i, hp)) * 128 + 32 * (dk0 + t) + r] = acc[t][i];
            } else {
                const int uu = u - NU_KV, bh = uu / 63, c = 1 + uu % 63, b = bh >> 3, h = bh & 7;
                const int r = lane & 31, hp = lane >> 5;
                const int s = 256 * c + 32 * wave + r;
                const f16* qrow = att_ptr(PJ, 0, bh, s);
                h8 qf[4];
#pragma unroll
                for (int ks = 0; ks < 4; ++ks) qf[ks] = *(const h8*)(qrow + 16 * ks + 8 * hp);
                const f16* km = kmean + (size_t)bh * 64 * 64;
                float v[2][16];
#pragma unroll
                for (int t = 0; t < 2; ++t) {
                    f32x16 g;
#pragma unroll
                    for (int i = 0; i < 16; ++i) g[i] = 0.f;
                    if (t == 0 || c > 32) {
#pragma unroll
                        for (int ks = 0; ks < 4; ++ks) { const h8 kf = *(const h8*)(km + (32 * t + r) * 64 + 16 * ks + 8 * hp); g = MFMA32(kf, qf[ks], g); }
                    }
#pragma unroll
                    for (int i = 0; i < 16; ++i) v[t][i] = (32 * t + crow(i, hp) < c) ? g[i] : -3.0e38f;
                }
                int sel[3]; bool sval[3];
#pragma unroll
                for (int rd = 0; rd < 3; ++rd) {
                    float mv = -3.0e38f; int mi = 1 << 20;
#pragma unroll
                    for (int t = 0; t < 2; ++t)
#pragma unroll
                        for (int i = 0; i < 16; ++i) { const int idx = 32 * t + crow(i, hp); const float val = v[t][i]; if (val > mv || (val == mv && idx < mi)) { mv = val; mi = idx; } }
                    const float ov = __shfl_xor(mv, 32); const int oi = __shfl_xor(mi, 32);
                    if (ov > mv || (ov == mv && oi < mi)) { mv = ov; mi = oi; }
                    sel[rd] = mi; sval[rd] = mv > -1.0e38f;
#pragma unroll
                    for (int t = 0; t < 2; ++t)
#pragma unroll
                        for (int i = 0; i < 16; ++i) if (32 * t + crow(i, hp) == mi) v[t][i] = -3.0e38f;
                }
                LAS unsigned* hist = (LAS unsigned*)(lds + 96 * 1024);
                if (tid < 64) hist[tid] = 0u;
                __syncthreads();
                unsigned rank[3];
#pragma unroll
                for (int rd = 0; rd < 3; ++rd) { rank[rd] = 0u; if (sval[rd] && hp == 0) rank[rd] = __hip_atomic_fetch_add(hist + sel[rd], 1u, __ATOMIC_RELAXED, __HIP_MEMORY_SCOPE_WORKGROUP); }
                __syncthreads();
                if (tid < 64) { const unsigned n = hist[tid]; unsigned base = 0u; if (n) base = atomicAdd(lcnt_w + bh * 64 + tid, n); hist[64 + tid] = base; }
                __syncthreads();
#pragma unroll
                for (int rd = 0; rd < 3; ++rd) if (sval[rd] && hp == 0) { const int lb = sel[rd]; const unsigned pos = hist[64 + lb] + rank[rd];
                    mlist_w[(size_t)bh * MLIST_PER_BH + (size_t)lb * SEQ - 128 * lb * (lb + 1) + pos] = (unsigned short)((s << 2) | rd); }
            }
        }
    }
    SEAM(2);

    if (IN(3)) REP(3) { OPAQUE_TID;
        PROF_B(33);
        if (!(a.alt & 2)) for (int gid = bid * 512 + tid; gid < 8 * 16384; gid += G * 512) {
            const int bh = gid >> 14, e = gid & 16383, h = bh & 3;
            const float cd = fexp2(256.0f * gamma_log2(h));
            const float* src = kvbuf + (size_t)bh * 64 * 16384 + e; f16* dst = Rbuf + (size_t)bh * 64 * 16384 + e;
            float run = 0.f;
#pragma unroll 8
            for (int i = 0; i < 64; ++i) { dst[(size_t)i * 16384] = (f16)run; run = run * cd + src[(size_t)i * 16384]; }
        }
        PROF_E(33); PROF_B(32);
        LAS int* pre = (LAS int*)(lds + 96 * 1024);
        LAS int* cpre = pre + 1032;
        LAS int* wsum = cpre + 1032;
        {
            const int c0 = (int)lcnt[2 * tid], c1 = (int)lcnt[2 * tid + 1];
            const int n0 = (c0 + 255) >> 8, n1 = (c1 + 255) >> 8;
            const int k0 = n0 ? 5 * n0 + 3 : 0, k1 = n1 ? 5 * n1 + 3 : 0;
            int v = n0 + n1, incl = v, cv = k0 + k1, cincl = cv;
#pragma unroll
            for (int o = 1; o < 64; o <<= 1) { const int t = __shfl_up(incl, o), ct = __shfl_up(cincl, o); if (lane >= o) { incl += t; cincl += ct; } }
            if (lane == 63) { wsum[wave] = incl; wsum[8 + wave] = cincl; }
            __syncthreads();
            int woff = 0, cwoff = 0;
            for (int k = 0; k < wave; ++k) { woff += wsum[k]; cwoff += wsum[8 + k]; }
            const int ex = woff + incl - v, cex = cwoff + cincl - cv;
            pre[2 * tid] = ex; pre[2 * tid + 1] = ex + n0; cpre[2 * tid] = cex; cpre[2 * tid + 1] = cex + k0;
            if (tid == 511) { pre[1024] = ex + v; cpre[1024] = cex + cv; }
            __syncthreads();
        }
        PROF_E(32);
        const int U = pre[1024], CT = cpre[1024];
        int ubnd[2];
#pragma unroll
        for (int e = 0; e < 2; ++e) {
            const int x = (int)(((long)CT * (bid + e)) / G);
            int l = 0;
#pragma unroll 1
            for (int step = 512; step > 0; step >>= 1) if (l + step <= 1023 && cpre[l + step] <= x) l += step;
            const int rem = x - cpre[l], n = pre[l + 1] - pre[l];
            int ch = rem <= 0 ? 0 : (rem - 3 + 4) / 5; ch = (rem > 0 && ch < 1) ? 1 : ch; ch = ch > n ? n : ch;
            ubnd[e] = (x >= CT) ? U : pre[l] + ch;
        }
        const int u_lo = ubnd[0], u_hi = (a.alt & 4) ? u_lo : ubnd[1];
        LAS unsigned char* Kl = lds; LAS unsigned char* Vl = lds + 256 * KP64;
        constexpr int NUB = 32;
        LAS int* uinf = (LAS int*)(lds + 108 * 1024);
        LAS unsigned short* uent = (LAS unsigned short*)(lds + 112 * 1024);
        int staged = -1;
        const int r = lane & 31, hp = lane >> 5;
        for (int ub = u_lo; ub < u_hi; ub += NUB) {
            const int nu = (u_hi - ub) < NUB ? (u_hi - ub) : NUB;
            __syncthreads();
            if (tid < nu) { const int u = ub + tid; int l = 0;
#pragma unroll 1
                for (int step = 512; step > 0; step >>= 1) if (l + step <= 1023 && pre[l + step] <= u) l += step;
                const int chunk = u - pre[l]; int rows = (int)lcnt[l] - 256 * chunk; rows = rows > 256 ? 256 : rows;
                uinf[4 * tid] = l; uinf[4 * tid + 1] = chunk; uinf[4 * tid + 2] = rows; }
            __syncthreads();
            for (int i = tid >> 8; i < nu; i += 2) { const int l = uinf[4 * i], chunk = uinf[4 * i + 1], rows = uinf[4 * i + 2], ri = tid & 255, bh = l >> 6, j = l & 63;
                uent[i * 256 + ri] = mlist[(size_t)bh * MLIST_PER_BH + (size_t)j * SEQ - 128 * j * (j + 1) + 256 * chunk + (ri < rows ? ri : 0)]; }
            __syncthreads();
            h8 qn[4];
            { const int l = uinf[0], bh = l >> 6; const unsigned ent = uent[32 * wave + r]; const int s = (int)(ent >> 2);
              const f16* qrow = att_ptr(PJ, 0, bh, s);
#pragma unroll
              for (int ks = 0; ks < 4; ++ks) qn[ks] = *(const h8*)(qrow + 16 * ks + 8 * hp); }
            for (int i = 0; i < nu; ++i) {
                const int l = uinf[4 * i], rows = uinf[4 * i + 2], bh = l >> 6, j = l & 63, b = bh >> 3, h = bh & 7;
                const unsigned ent = uent[i * 256 + 32 * wave + r];
                h8 qf[4];
#pragma unroll
                for (int ks = 0; ks < 4; ++ks) qf[ks] = qn[ks];
                if (i + 1 < nu) { const int l2 = uinf[4 * (i + 1)], bh2 = l2 >> 6; const unsigned e2 = uent[(i + 1) * 256 + 32 * wave + r]; const int s2 = (int)(e2 >> 2);
                    const f16* qrow = att_ptr(PJ, 0, bh2, s2);
#pragma unroll
                    for (int ks = 0; ks < 4; ++ks) qn[ks] = *(const h8*)(qrow + 16 * ks + 8 * hp); }
                PROF_B(30);
                if (l != staged) {
                    __syncthreads();
                    stage64<KP64>(Kl, att_ptr(PJ, 1, bh, j * 256), 64, tid);
                    stage64<VP64>(Vl, att_ptr(PJ, 2, bh, j * 256), 64, tid);
                    __syncthreads();
                    staged = l;
                }
                PROF_E(30); PROF_B(31);
                if (32 * wave < rows) {
                    const bool valid = 32 * wave + r < rows;
                    const int s = (int)(ent >> 2), slot = (int)(ent & 3u);
                    float m2, ls; f32x16 o[2];
                    attn_tile<false>(Kl, Vl, biasl + h * BTP, qf, s - 256 * j, 0, lane, m2, ls, o);
                    if (valid) {
                        const size_t pidx = ((size_t)bh * SEQ + s) * 3 + slot;
                        if (hp == 0) pml[pidx] = (f32x2){m2, ls};
                        const float inv = 1.0f / ls; f16* po = pO + pidx * 64 + 32 * hp;
#pragma unroll
                        for (int dt = 0; dt < 2; ++dt)
#pragma unroll
                            for (int g2 = 0; g2 < 2; ++g2) { const f32x8 vv = {o[dt][8 * g2] * inv, o[dt][8 * g2 + 1] * inv, o[dt][8 * g2 + 2] * inv, o[dt][8 * g2 + 3] * inv, o[dt][8 * g2 + 4] * inv, o[dt][8 * g2 + 5] * inv, o[dt][8 * g2 + 6] * inv, o[dt][8 * g2 + 7] * inv};
                                *(h8*)(po + 16 * dt + 8 * g2) = __builtin_convertvector(vv, h8); }
                    }
                }
                PROF_E(31);
            }
        }
        __syncthreads();
    }
    SEAM(3);

    if (IN(4)) REP(4) { OPAQUE_TID;
        constexpr int NU_A = 16 * 64, NU_R = 8 * 64;
        for (int u = (a.alt & 2) ? NU_R : bid; u < NU_R; u += G) {
            __syncthreads();
            {
                const int bh = u >> 6, ci = u & 63, b = bh >> 2, h = bh & 3;
                const float lg = gamma_log2(h);
                const size_t row0 = (size_t)b * SEQ + ci * 256;
                LAS unsigned char* Kl = lds; LAS unsigned char* Vl = lds + 256 * 272;
                PROF_B(40);
                const int r = lane & 31, hp = lane >> 5, i16 = lane & 15, q4 = i16 >> 2, p4 = i16 & 3, cb = (lane >> 4) & 1;
                const int qt = wave < 4 ? wave : 11 - wave;
                const int ql = 32 * qt + r;
#pragma unroll
                for (int i = 0; i < 8; ++i) { const int q = tid + 512 * i, row = q >> 4, ch = q & 15;
                    *(LAS h8*)(Kl + row * 272 + 16 * ch) = *(const h8*)(ret_ptr(PJ, 4, bh, ci * 256 + row) + 8 * ch);
                    *(LAS h8*)(Vl + row * 320 + 16 * ch) = *(const h8*)(ret_ptr(PJ, 5, bh, ci * 256 + row) + 8 * ch); }
                __syncthreads();
                PROF_E(40); PROF_B(41);
                const f16* qrow = ret_ptr(PJ, 3, bh, ci * 256 + ql);
                h8 qf[8];
#pragma unroll
                for (int ks = 0; ks < 8; ++ks) qf[ks] = *(const h8*)(qrow + 16 * ks + 8 * hp);
                f32x16 o[4];
#pragma unroll
                for (int t = 0; t < 4; ++t)
#pragma unroll
                    for (int i = 0; i < 16; ++i) o[t][i] = 0.f;
                const f16* Rt = Rbuf + (size_t)u * 128 * 128;
#pragma unroll
                for (int t = 0; t < 4; ++t)
#pragma unroll
                    for (int ks = 0; ks < 8; ++ks) { const h8 rf = *(const h8*)(Rt + (32 * t + r) * 128 + 16 * ks + 8 * hp); o[t] = MFMA32(rf, qf[ks], o[t]); }
                const f16* grow = ret_ptr(PJ, 6, bh, ci * 256 + ql);
                h4 rgv[16];
#pragma unroll
                for (int g = 0; g < 16; ++g) rgv[g] = *(const h4*)(grow + 8 * g + 4 * hp);
                const float qd = fexp2(lg * (float)(ql + 1));
#pragma unroll
                for (int t = 0; t < 4; ++t)
#pragma unroll
                    for (int i = 0; i < 16; ++i) o[t][i] *= qd;
                PROF_E(41); PROF_B(42);
                LAS const unsigned char* vbase = Vl + (4 * hp + q4) * 320 + 2 * (16 * cb + 4 * p4);
                for (int kt = 0; kt <= qt; ++kt) {
                    f32x16 st;
#pragma unroll
                    for (int i = 0; i < 16; ++i) st[i] = 0.f;
#pragma unroll
                    for (int ks = 0; ks < 8; ++ks) { const h8 kf = *(const LAS h8*)(Kl + (32 * kt + r) * 272 + 32 * ks + 16 * hp); st = MFMA32(kf, qf[ks], st); }
#pragma unroll
                    for (int i = 0; i < 16; ++i) { const int dist = ql - (32 * kt + crow(i, hp)); st[i] = dist >= 0 ? st[i] * fexp2(lg * (float)dist) : 0.f; }
#pragma unroll
                    for (int s = 0; s < 2; ++s) {
                        const f32x8 pv = {st[8 * s], st[8 * s + 1], st[8 * s + 2], st[8 * s + 3], st[8 * s + 4], st[8 * s + 5], st[8 * s + 6], st[8 * s + 7]};
                        const h8 pf = __builtin_convertvector(pv, h8);
#pragma unroll
                        for (int t = 0; t < 4; ++t) {
                            LAS const unsigned char* vp = vbase + (32 * kt + 16 * s) * 320 + 64 * t;
                            const h8 vf = cat44(tr_read(vp), tr_read(vp + 8 * 320));
                            o[t] = MFMA32(vf, pf, o[t]);
                        }
                    }
                }
                PROF_E(42); PROF_B(43);
                float sm = 0.f;
#pragma unroll
                for (int t = 0; t < 4; ++t)
#pragma unroll
                    for (int i = 0; i < 16; ++i) sm += o[t][i];
                sm += __shfl_xor(sm, 32);
                const float mu = sm * (1.0f / 128.0f);
                float sq = 0.f;
#pragma unroll
                for (int t = 0; t < 4; ++t)
#pragma unroll
                    for (int i = 0; i < 16; ++i) { const float d = o[t][i] - mu; sq += d * d; }
                sq += __shfl_xor(sq, 32);
                const float rstd = 1.0f / sqrtf(sq * (1.0f / 128.0f) + LN_EPS);
                unsigned char* crow_ = cat8 + (row0 + ql) * DM + 512 + h * 128;
#pragma unroll
                for (int t = 0; t < 4; ++t)
#pragma unroll
                    for (int g = 0; g < 4; ++g) { const int d0 = 32 * t + 8 * g + 4 * hp;
                        const h4 gv = rgv[4 * t + g]; f32x4 ov;
#pragma unroll
                        for (int e = 0; e < 4; ++e) { const float gg = (float)gv[e]; const float sl = gg / (1.0f + fexp2(-gg * LOG2E)); ov[e] = sl * (o[t][4 * g + e] - mu) * rstd; }
                        *(int*)(crow_ + d0) = cvt4_fp8(ov); }
                PROF_E(43);
            }
        }
        {
            LAS unsigned char* Kl = lds; LAS unsigned char* Vl = lds + 256 * KP64;
            const int r = lane & 31, hp = lane >> 5;
            h8 kr[4], vr[4], qn[4];
            const int qt = wave < 4 ? wave : 11 - wave;
            int uu = (a.alt & 4) ? NU_A : bid;
            if (uu < NU_A) { const int bh = uu >> 6, c = uu & 63; const f16* kp = att_ptr(PJ, 1, bh, c * 256);
                { const f16* qrow = att_ptr(PJ, 0, bh, 256 * c + 32 * qt + r);
#pragma unroll
                  for (int ks = 0; ks < 4; ++ks) qn[ks] = *(const h8*)(qrow + 16 * ks + 8 * hp); }
#pragma unroll
                for (int i = 0; i < 4; ++i) { const int q = tid + 512 * i, row = q >> 3, ch = q & 7; kr[i] = *(const h8*)(kp + (size_t)row * 64 + 8 * ch); vr[i] = *(const h8*)(kp + PJ_SLICE + (size_t)row * 64 + 8 * ch); } }
            for (; uu < NU_A; uu += G) {
                const int bh = uu >> 6, c = uu & 63, b = bh >> 3, h = bh & 7;
                PROF_B(44);
                __syncthreads();
#pragma unroll
                for (int i = 0; i < 4; ++i) { const int q = tid + 512 * i, row = q >> 3, ch = q & 7; *(LAS h8*)(Kl + row * KP64 + 16 * ch) = kr[i]; *(LAS h8*)(Vl + row * VP64 + 16 * ch) = vr[i]; }
                __syncthreads();
                h8 qf[4];
#pragma unroll
                for (int ks = 0; ks < 4; ++ks) qf[ks] = qn[ks];
                if (uu + G < NU_A) { const int u2 = uu + G, bh2 = u2 >> 6, c2 = u2 & 63; const f16* kp = att_ptr(PJ, 1, bh2, c2 * 256);
                    { const f16* qrow = att_ptr(PJ, 0, bh2, 256 * c2 + 32 * qt + r);
#pragma unroll
                      for (int ks = 0; ks < 4; ++ks) qn[ks] = *(const h8*)(qrow + 16 * ks + 8 * hp); }
#pragma unroll
                    for (int i = 0; i < 4; ++i) { const int q = tid + 512 * i, row = q >> 3, ch = q & 7; kr[i] = *(const h8*)(kp + (size_t)row * 64 + 8 * ch); vr[i] = *(const h8*)(kp + PJ_SLICE + (size_t)row * 64 + 8 * ch); } }
                const int ql = 32 * qt + r, s = 256 * c + ql;
                const int nsel = c < 3 ? c : 3;
                const size_t pidx = ((size_t)bh * SEQ + s) * 3;
                float pm[3], pl[3]; h8 pv[3][4];
#pragma unroll
                for (int t = 0; t < 3; ++t) { const f32x2 v = pml[pidx + t]; pm[t] = v[0]; pl[t] = v[1]; const f16* po = pO + (pidx + t) * 64 + 32 * hp;
#pragma unroll
                    for (int k = 0; k < 4; ++k) pv[t][k] = *(const h8*)(po + 8 * k); }
                PROF_E(44); PROF_B(45);
                float m2, ls; f32x16 o[2];
                attn_own(Kl, Vl, biasl + h * BTP, qf, ql, qt, lane, m2, ls, o);
                PROF_E(45); PROF_B(46);
#pragma unroll
                for (int t = 0; t < 3; ++t) { const bool ok = t < nsel; pm[t] = ok ? pm[t] : -3.0e38f; pl[t] = ok ? pl[t] : 0.f;
#pragma unroll
                    for (int k = 0; k < 4; ++k) pv[t][k] = ok ? pv[t][k] : (h8){0, 0, 0, 0, 0, 0, 0, 0}; }
                float M = m2;
#pragma unroll
                for (int t = 0; t < 3; ++t) M = fmaxf(M, pm[t]);
                const float e0 = fexp2(m2 - M); float L = ls * e0;
#pragma unroll
                for (int dt = 0; dt < 2; ++dt)
#pragma unroll
                    for (int i = 0; i < 16; ++i) o[dt][i] *= e0;
#pragma unroll
                for (int t = 0; t < 3; ++t) { const float wt = pl[t] * fexp2(pm[t] - M); L += wt;
#pragma unroll
                    for (int k = 0; k < 4; ++k)
#pragma unroll
                        for (int e = 0; e < 8; ++e) o[k >> 1][8 * (k & 1) + e] += wt * (float)pv[t][k][e]; }
                const float invL = 1.0f / L; float sq = 0.f;
                unsigned char* crow_ = cat8 + (size_t)(b * SEQ + s) * DM + h * 64;
#pragma unroll
                for (int dt = 0; dt < 2; ++dt)
#pragma unroll
                    for (int g = 0; g < 4; ++g) { f32x4 ov;
#pragma unroll
                        for (int e = 0; e < 4; ++e) { ov[e] = o[dt][4 * g + e] * invL; sq += ov[e] * ov[e]; }
                        *(int*)(crow_ + 32 * dt + 8 * g + 4 * hp) = cvt4_fp8(ov * 16.0f); }
                sq += __shfl_xor(sq, 32);
                if (hp == 0) sumsq[(size_t)(b * SEQ + s) * 8 + h] = (f16)sq;
                PROF_E(46);
            }
        }
        __syncthreads();
    }
    SEAM(4);

    if (IN(5)) { OPAQUE_TID;
        pg8::StaticOrder S; S.init(cat8, WoT8, DM, DM, NTOK, DM, G, bid, 1);
        EpiZ E{a.x, zbuf, sumsq};
        pg8::gemm_phase8<EpiZ, pg8::StaticOrder, true>(lds, DM, DM / 128, S, E);
    }
    SEAM(5);

    if (IN(6)) REP(6) { OPAQUE_TID;
        unsigned* ecnt_w = (rep_ | a.alt) ? ecnt + 32 : ecnt; int* elist_w = (rep_ | a.alt) ? (int*)(ws + 496 * MiB) : elist; float* wts_w = (rep_ | a.alt) ? (float*)(ws + 500 * MiB) : wts;
        LAS unsigned char* Ht = lds;
        LAS float* lg = (LAS float*)(lds + 32 * 2064);
        f32x8 gv[2], bv[2];
#pragma unroll
        for (int j = 0; j < 2; ++j) { gv[j] = *(const f32x8*)(a.ln1g + 8 * lane + 512 * j); bv[j] = *(const f32x8*)(a.ln1b + 8 * lane + 512 * j); }
        for (int u = bid; u < NTOK / 32; u += G) {
            __syncthreads();
            h8 zin[4][2];
#pragma unroll
            for (int rr = 0; rr < 4; ++rr)
#pragma unroll
                for (int j = 0; j < 2; ++j) zin[rr][j] = *(const h8*)(zbuf + ((size_t)u * 32 + 4 * wave + rr) * DM + 8 * lane + 512 * j);
#pragma unroll
            for (int rr = 0; rr < 4; ++rr) {
                const int rl = 4 * wave + rr; const size_t row = (size_t)u * 32 + rl;
                f32x8 v[2]; float s = 0.f;
#pragma unroll
                for (int j = 0; j < 2; ++j) { v[j] = __builtin_convertvector(zin[rr][j], f32x8);
#pragma unroll
                    for (int e = 0; e < 8; ++e) s += v[j][e]; }
                const float mean = wave_sum(s) * (1.0f / DM); float s2 = 0.f;
#pragma unroll
                for (int j = 0; j < 2; ++j) { v[j] = v[j] - mean;
#pragma unroll
                    for (int e = 0; e < 8; ++e) s2 += v[j][e] * v[j][e]; }
                const float rstd = 1.0f / sqrtf(wave_sum(s2) * (1.0f / DM) + LN_EPS);
#pragma unroll
                for (int j = 0; j < 2; ++j) { const h8 hv = __builtin_convertvector(v[j] * rstd * gv[j] + bv[j], h8);
                    *(h8*)(hh + row * DM + 8 * lane + 512 * j) = hv; *(LAS h8*)(Ht + rl * 2064 + 2 * (8 * lane + 512 * j)) = hv;
                    const f32x8 hf = __builtin_convertvector(hv, f32x8);
                    *(u32x2*)(hh8 + row * DM + 8 * lane + 512 * j) = cvt8_fp8((f32x4){hf[0], hf[1], hf[2], hf[3]}, (f32x4){hf[4], hf[5], hf[6], hf[7]}); }
            }
            __syncthreads();
            if (wave < 6) {
                const int rt = wave / 3, ct = wave % 3, fr = lane & 15, fq = lane >> 4;
                f32x4 acc = {0.f, 0.f, 0.f, 0.f};
#pragma unroll 8
                for (int ks = 0; ks < 32; ++ks) { const h8 af = *(const LAS h8*)(Ht + (16 * rt + fr) * 2064 + 2 * (32 * ks + 8 * fq));
                    const h8 bf = *(const h8*)(WrT + (size_t)(16 * ct + fr) * DM + 32 * ks + 8 * fq); acc = MFMA16(af, bf, acc); }
#pragma unroll
                for (int e = 0; e < 4; ++e) lg[(16 * rt + 4 * fq + e) * 48 + 16 * ct + fr] = acc[e];
            }
            __syncthreads();
            if (tid < 32) {
                LAS unsigned* eh = (LAS unsigned*)(lds + 80 * 1024);
                eh[tid] = 0u;
                const int tok = u * 32 + tid; LAS const float* L = lg + tid * 48;
                float g4[4]; int gi = 0; float gm = -3.0e38f;
#pragma unroll
                for (int k = 0; k < 4; ++k) { g4[k] = L[k] + a.brg[k]; if (g4[k] > gm) { gm = g4[k]; gi = k; } }
                float gs = 0.f;
#pragma unroll
                for (int k = 0; k < 4; ++k) gs += __expf(g4[k] - gm);
                const float gp = 1.0f / gs;
                float l1 = -3.0e38f, l2 = -3.0e38f; int i1 = 0, i2 = 0;
                for (int k = 0; k < 8; ++k) { const float v = L[4 + 8 * gi + k] + a.bre[8 * gi + k]; if (v > l1) { l2 = l1; i2 = i1; l1 = v; i1 = k; } else if (v > l2) { l2 = v; i2 = k; } }
                const float w1 = 1.0f / (1.0f + __expf(l2 - l1)), w2 = 1.0f - w1;
                const int e1 = 8 * gi + i1, e2 = 8 * gi + i2;
                LDS_WAIT();
                const unsigned r1 = __hip_atomic_fetch_add(eh + e1, 1u, __ATOMIC_RELAXED, __HIP_MEMORY_SCOPE_WORKGROUP);
                const unsigned r2 = __hip_atomic_fetch_add(eh + e2, 1u, __ATOMIC_RELAXED, __HIP_MEMORY_SCOPE_WORKGROUP);
                LDS_WAIT();
                { const unsigned n = eh[tid]; unsigned base = 0u; if (n) base = atomicAdd(ecnt_w + tid * 64, n); eh[32 + tid] = base; }
                LDS_WAIT();
                const unsigned p1 = eh[32 + e1] + r1, p2 = eh[32 + e2] + r2;
                elist_w[e1 * NTOK + (int)p1] = tok * 2; elist_w[e2 * NTOK + (int)p2] = tok * 2 + 1;
                wts_w[tok * 2] = gp * w1; wts_w[tok * 2 + 1] = gp * w2;
            }
        }
        __syncthreads();
    }
    SEAM(6);

    LAS int* mtab = (LAS int*)(lds + pg8::STAGE_BYTES + 1024);
    LAS int* utab = mtab + 128;
    LAS int* rtab = (LAS int*)(lds + pg8::STAGE_BYTES + 12288);
    LAS float* wtab = (LAS float*)(rtab + MOE_MAXU * 256);
    if (IN(7) || IN(8)) {
        if (tid == 0) { int acc = 0; for (int e = 0; e < 32; ++e) { const int c = (int)ecnt[e * 64]; mtab[e] = c; mtab[32 + e] = acc; acc += (c + 255) >> 8; } mtab[64] = acc; }
        __syncthreads();
    }
    if (IN(7)) { OPAQUE_TID;
        moe_tables(mtab, utab, rtab, wtab, elist, wts, G, bid, false, tid);
        MoeSched<true> S{utab, rtab, (const char*)hh8, (const char*)WguT, (size_t)DM * DM, DM, DM};
        EpiGU E{hid};
        pg8::gemm_phase8<EpiGU, MoeSched<true>, true>(lds, DM, DM / 128, S, E);
    }
    SEAM(7);
    if (IN(8)) { OPAQUE_TID;
        moe_tables(mtab, utab, rtab, wtab, elist, wts, G, bid, true, tid);
        MoeSched<false> S{utab, rtab, (const char*)hid, (const char*)WdnT, (size_t)DM * DE, DE, DE};
        EpiDown E{ybuf, rtab, wtab};
        pg8::gemm_phase8<EpiDown, MoeSched<false>, true>(lds, DE, DE / 128, S, E);
    }
    SEAM(8);

#ifdef CHECK_MOE
    if (IN(9)) { OPAQUE_TID;
        if (bid < 64) {
            const int e = bid & 31, idx = bid >> 5;
            LAS float* hv = (LAS float*)lds; LAS float* hd = hv + 1024; LAS float* red = hd + 512; LAS int* ired = (LAS int*)(red + 16);
            { const int cnt = (int)ecnt[e * 64]; int best = idx ? -1 : 0x7fffffff;
              for (int k = tid; k < cnt; k += 512) { const int v = elist[e * NTOK + k]; best = idx ? (v > best ? v : best) : (v < best ? v : best); }
#pragma unroll
              for (int o = 1; o < 64; o <<= 1) { const int t = __shfl_xor(best, o); best = idx ? (t > best ? t : best) : (t < best ? t : best); }
              if (lane == 0) ired[wave] = best;
              __syncthreads();
              best = ired[0];
              for (int k = 1; k < 8; ++k) { const int t = ired[k]; best = idx ? (t > best ? t : best) : (t < best ? t : best); }
              ired[8] = best; }
            __syncthreads();
            const int ent = ired[8], tok = ent >> 1; const float w = wts[ent];
            for (int k = tid; k < DM; k += 512) hv[k] = (float)hh[(size_t)tok * DM + k];
            __syncthreads();
            { const float* wg = a.wgu + (size_t)e * DM * DM + tid; float g = 0.f, up = 0.f;
              for (int k = 0; k < DM; ++k) { g += hv[k] * wg[(size_t)k * DM]; up += hv[k] * wg[(size_t)k * DM + 512]; }
              hd[tid] = g / (1.0f + __expf(-g)) * up; }
            __syncthreads();
            float e2 = 0.f, r2 = 0.f;
            for (int n = tid; n < DM; n += 512) { const float* wd = a.wdn + (size_t)e * DE * DM + n; float y = 0.f;
                for (int j = 0; j < DE; ++j) y += hd[j] * wd[(size_t)j * DM];
                y *= w; const float d = __builtin_amdgcn_cvt_f32_fp8((int)ybuf[(size_t)ent * DM + n], 0) * (1.0f / 64.0f) - y; e2 += d * d; r2 += y * y; }
            e2 = wave_sum(e2); r2 = wave_sum(r2);
            if (lane == 0) { red[wave] = e2; red[8 + wave] = r2; }
            __syncthreads();
            if (tid == 0) { float se = 0.f, sr = 0.f; for (int k = 0; k < 8; ++k) { se += red[k]; sr += red[8 + k]; }
                __hip_atomic_store(ctl + 24580 + 2 * bid, __float_as_uint(se), __ATOMIC_RELAXED, __HIP_MEMORY_SCOPE_AGENT); __hip_atomic_store(ctl + 24581 + 2 * bid, __float_as_uint(sr), __ATOMIC_RELAXED, __HIP_MEMORY_SCOPE_AGENT); }
        }
        xcd_barrier(bar);
        float se = 0.f, sr = 0.f;
        for (int k = 0; k < 64; ++k) { se += __uint_as_float(__hip_atomic_load(ctl + 24580 + 2 * k, __ATOMIC_RELAXED, __HIP_MEMORY_SCOPE_AGENT)); sr += __uint_as_float(__hip_atomic_load(ctl + 24581 + 2 * k, __ATOMIC_RELAXED, __HIP_MEMORY_SCOPE_AGENT)); }
        const float cval = sqrtf(1.0e6f * se / sr);
        for (size_t i = (size_t)bid * 512 + tid; i < (size_t)NTOK * DM / 4; i += (size_t)G * 512) ((f32x4*)a.out)[i] = (f32x4){cval, cval, cval, cval};
    }
    if (false) {
#elif defined(DIAG_PHASE)
    if (IN(9)) { OPAQUE_TID; xcd_barrier(bar); const float cval = sqrtf((float)__hip_atomic_load(ctl + 24576, __ATOMIC_RELAXED, __HIP_MEMORY_SCOPE_AGENT) * 0.01f);
        for (size_t i = (size_t)bid * 512 + tid; i < (size_t)NTOK * DM / 4; i += (size_t)G * 512) ((f32x4*)a.out)[i] = (f32x4){cval, cval, cval, cval}; }
    if (false) {
#else
    if (IN(9)) REP(9) { OPAQUE_TID;
#endif
        f32x4 gv[4], bv[4];
#pragma unroll
        for (int j = 0; j < 4; ++j) { gv[j] = *(const f32x4*)(a.ln2g + 4 * lane + 256 * j); bv[j] = *(const f32x4*)(a.ln2b + 4 * lane + 256 * j); }
        for (int row = bid * 8 + wave; row < NTOK; row += G * 8) {
            f32x4 v[4]; float s = 0.f;
#pragma unroll
            for (int j = 0; j < 4; ++j) { const size_t c = 4 * lane + 256 * j;
                const f32x4 hv = __builtin_convertvector(*(const h4*)(hh + (size_t)row * DM + c), f32x4);
                const int w0 = *(const int*)(ybuf + (size_t)(2 * row) * DM + c), w1 = *(const int*)(ybuf + (size_t)(2 * row + 1) * DM + c);
                const f32x4 y0 = (f32x4){__builtin_amdgcn_cvt_f32_fp8(w0, 0), __builtin_amdgcn_cvt_f32_fp8(w0, 1), __builtin_amdgcn_cvt_f32_fp8(w0, 2), __builtin_amdgcn_cvt_f32_fp8(w0, 3)} * (1.0f / 64.0f);
                const f32x4 y1 = (f32x4){__builtin_amdgcn_cvt_f32_fp8(w1, 0), __builtin_amdgcn_cvt_f32_fp8(w1, 1), __builtin_amdgcn_cvt_f32_fp8(w1, 2), __builtin_amdgcn_cvt_f32_fp8(w1, 3)} * (1.0f / 64.0f);
                v[j] = hv * ALPHA + (y0 + y1); s += (v[j][0] + v[j][1]) + (v[j][2] + v[j][3]); }
            const float mean = wave_sum(s) * (1.0f / DM); float s2 = 0.f;
#pragma unroll
            for (int j = 0; j < 4; ++j) { v[j] = v[j] - mean; s2 += (v[j][0] * v[j][0] + v[j][1] * v[j][1]) + (v[j][2] * v[j][2] + v[j][3] * v[j][3]); }
            const float rstd = 1.0f / sqrtf(wave_sum(s2) * (1.0f / DM) + LN_EPS);
#pragma unroll
            for (int j = 0; j < 4; ++j) *(f32x4*)(a.out + (size_t)row * DM + 4 * lane + 256 * j) = v[j] * rstd * gv[j] + bv[j];
        }
    }
#if defined(PROF_SEG) && PROF_SEG >= 60 && PROF_SEG <= 62
    if (bid == 0 && wave == 0) {
        i32x8 fa, fb; for (int i = 0; i < 8; ++i) { fa[i] = 0x38383838 + lane; fb[i] = 0x38383838 + i; }
        f32x4 c0 = {0.f, 0.f, 0.f, 0.f}, c1 = c0, c2 = c0, c3 = c0; f32x16 d0; for (int i = 0; i < 16; ++i) d0[i] = 0.f; f32x16 d1 = d0;
        const int scl = 0x7F7F7F7F;
        const h8 ha = __builtin_bit_cast(h8, (f32x4){1.f, 2.f, 3.f, 4.f}), hb = ha;
        PROF_B(PROF_SEG);
        for (int it = 0; it < 2048; ++it) {
#if PROF_SEG == 60
            c0 = MFMA16(ha, hb, c0); c1 = MFMA16(ha, hb, c1); c2 = MFMA16(ha, hb, c2); c3 = MFMA16(ha, hb, c3);
#elif PROF_SEG == 61
            asm volatile("v_mfma_scale_f32_16x16x128_f8f6f4 %0, %1, %2, %0, %3, %3 op_sel_hi:[0,0,0]" : "+v"(c0) : "v"(fa), "v"(fb), "v"(scl));
            asm volatile("v_mfma_scale_f32_16x16x128_f8f6f4 %0, %1, %2, %0, %3, %3 op_sel_hi:[0,0,0]" : "+v"(c1) : "v"(fa), "v"(fb), "v"(scl));
            asm volatile("v_mfma_scale_f32_16x16x128_f8f6f4 %0, %1, %2, %0, %3, %3 op_sel_hi:[0,0,0]" : "+v"(c2) : "v"(fa), "v"(fb), "v"(scl));
            asm volatile("v_mfma_scale_f32_16x16x128_f8f6f4 %0, %1, %2, %0, %3, %3 op_sel_hi:[0,0,0]" : "+v"(c3) : "v"(fa), "v"(fb), "v"(scl));
#else
            asm volatile("v_mfma_scale_f32_32x32x64_f8f6f4 %0, %1, %2, %0, %3, %3 op_sel_hi:[0,0,0]" : "+v"(d0) : "v"(fa), "v"(fb), "v"(scl));
            asm volatile("v_mfma_scale_f32_32x32x64_f8f6f4 %0, %1, %2, %0, %3, %3 op_sel_hi:[0,0,0]" : "+v"(d1) : "v"(fa), "v"(fb), "v"(scl));
            asm volatile("v_mfma_scale_f32_32x32x64_f8f6f4 %0, %1, %2, %0, %3, %3 op_sel_hi:[0,0,0]" : "+v"(d0) : "v"(fa), "v"(fb), "v"(scl));
            asm volatile("v_mfma_scale_f32_32x32x64_f8f6f4 %0, %1, %2, %0, %3, %3 op_sel_hi:[0,0,0]" : "+v"(d1) : "v"(fa), "v"(fb), "v"(scl));
#endif
        }
        asm volatile("s_nop 15\n\ts_nop 15" ::: "memory");
        PROF_E(PROF_SEG);
        asm volatile("" :: "v"(c0), "v"(c1), "v"(c2), "v"(c3), "v"(d0), "v"(d1));
    }
#endif
#ifdef PROF_SEG
    PROF_E(19);
#if PROF_SEG == 51
    prof_acc = MISC[16];
#endif
    if (prof_on) { const unsigned long long t0 = __builtin_amdgcn_s_memrealtime(), dt = (unsigned long long)PROF_K * prof_acc; while (__builtin_amdgcn_s_memrealtime() - t0 < dt) __builtin_amdgcn_s_sleep(8); }
#endif
#undef IN
#undef SEAM
}

extern "C" void kernel_launch(void* const* d_in, const int* in_sizes, int n_in, void* d_out, int out_size, void* d_ws, size_t ws_size, hipStream_t stream) {
    static int grid = 0;
    if (grid == 0) {
        if (n_in != 15 || in_sizes[0] != NTOK * DM || out_size != NTOK * DM || ws_size < WS_END) { fprintf(stderr, "kernel_launch: unexpected problem (n_in %d, ws %zu)\n", n_in, ws_size); grid = -1; return; }
        int dev = 0, cus = 0, per_cu = 0;
        if (hipGetDevice(&dev) != hipSuccess || hipDeviceGetAttribute(&cus, hipDeviceAttributeMultiprocessorCount, dev) != hipSuccess) { grid = -1; return; }
        if (hipFuncSetAttribute((const void*)fwd, hipFuncAttributeMaxDynamicSharedMemorySize, LDS_BYTES) != hipSuccess) { fprintf(stderr, "kernel_launch: hipFuncSetAttribute failed\n"); grid = -1; return; }
        if (hipOccupancyMaxActiveBlocksPerMultiprocessor(&per_cu, (const void*)fwd, 512, LDS_BYTES) != hipSuccess || per_cu < 1) { fprintf(stderr, "kernel_launch: occupancy query says %d\n", per_cu); (void)hipGetLastError(); grid = -1; return; }
        grid = cus;
    }
    if (grid < 0) return;
    (void)hipMemsetAsync((char*)d_ws + WS_CTL, 0, CTL_ZERO_BYTES, stream);
    Args a{};
    a.x = (const float*)d_in[0]; a.w_in = (const float*)d_in[1]; a.gain = (const float*)d_in[2]; a.rel = (const float*)d_in[3]; a.w_out = (const float*)d_in[4];
    a.ln1g = (const float*)d_in[5]; a.ln1b = (const float*)d_in[6]; a.wrg = (const float*)d_in[7]; a.brg = (const float*)d_in[8]; a.wre = (const float*)d_in[9];
    a.bre = (const float*)d_in[10]; a.wgu = (const float*)d_in[11]; a.wdn = (const float*)d_in[12]; a.ln2g = (const float*)d_in[13]; a.ln2b = (const float*)d_in[14];
    a.out = (float*)d_out; a.ws = (unsigned char*)d_ws;
#if MK_LAUNCHES == 1
    a.ph_lo = 0; a.ph_hi = NPHASE;
    hipLaunchKernelGGL(fwd, dim3(grid), dim3(512), LDS_BYTES, stream, a);
#else
    for (int p = 0; p < NPHASE; ++p) { a.ph_lo = p; a.ph_hi = p + 1; a.alt = 0; hipLaunchKernelGGL(fwd, dim3(grid), dim3(512), LDS_BYTES, stream, a);
#ifdef HOST_DUP
#ifndef HOST_ALT
#define HOST_ALT 1
#endif
        if (p == HOST_DUP) { a.alt = HOST_ALT; hipLaunchKernelGGL(fwd, dim3(grid), dim3(512), LDS_BYTES, stream, a); }
#endif
    }
#endif
}
```

```cpp
#include <hip/hip_runtime.h>
#include <cstdint>
#include <cstdio>

#ifndef MK_LAUNCHES
#define MK_LAUNCHES 1
#endif

#define DI __device__ __forceinline__
#define OPAQUE_TID int tid_o_ = threadIdx.x; asm volatile("" : "+v"(tid_o_)); const int tid = tid_o_, lane = tid & 63; (void)lane
#define LAS __attribute__((address_space(3)))
typedef _Float16 f16;
typedef _Float16 h8 __attribute__((ext_vector_type(8)));
typedef _Float16 h4 __attribute__((ext_vector_type(4)));
typedef short s4v __attribute__((ext_vector_type(4)));
typedef float f32x2 __attribute__((ext_vector_type(2)));
typedef float f32x4 __attribute__((ext_vector_type(4)));
typedef float f32x8 __attribute__((ext_vector_type(8)));
typedef float f32x16 __attribute__((ext_vector_type(16)));
typedef int i32x8 __attribute__((ext_vector_type(8)));
typedef int i32x4v __attribute__((ext_vector_type(4)));
typedef unsigned u32x2 __attribute__((ext_vector_type(2)));
typedef unsigned u32x4 __attribute__((ext_vector_type(4)));

constexpr int NB = 2, SEQ = 16384, DM = 1024, NTOK = NB * SEQ, NPJ = 3584;
constexpr int C_AQ = 0, C_AK = 512, C_AV = 1024, C_RQ = 1536, C_RK = 2048, C_RV = 2560, C_RG = 3072;
constexpr int NBLK = SEQ / 256;
constexpr int NE = 32, DE = 512;
constexpr float ALPHA = 1.189207115002721f, LN_EPS = 1e-5f, LOG2E = 1.4426950408889634f;
constexpr int NPHASE = 10;

constexpr size_t MiB = 1u << 20;
constexpr size_t WS_CTL = 0, CTL_ZERO_BYTES = 256 * 1024;
constexpr size_t WS_ROPEC = 1 * MiB, WS_ROPES = 5 * MiB, WS_XSUM = 9 * MiB, WS_KMEAN = 10 * MiB, WS_WRT = 10 * MiB + 512 * 1024;
constexpr size_t WS_SUMSQ = 11 * MiB, WS_WTS = 12 * MiB, WS_ELIST = 13 * MiB, WS_MLIST = 17 * MiB, WS_PML = 33 * MiB;
constexpr size_t WS_WINT = 39 * MiB, WS_WOT = 46 * MiB, WS_WGUT = 48 * MiB, WS_WDNT = 80 * MiB, WS_HH8 = 96 * MiB;
constexpr size_t WS_PJ = 144 * MiB, WS_XH = 368 * MiB, WS_CAT = 432 * MiB  , WS_KV = 432 * MiB, WS_R = 464 * MiB;
constexpr size_t WS_X8 = 432 * MiB;
constexpr size_t WS_WINT8 = 41 * MiB;
constexpr size_t WS_HH = 144 * MiB, WS_HID = 208 * MiB, WS_Y = 280 * MiB, WS_END = 480 * MiB;
constexpr int MLIST_PER_BH = 516096;
constexpr int CW_QH = 26624  , CW_BAR = 4096, CW_LCNT = 32768  , CW_ECNT = 12288;

constexpr int SCR_BYTES = 155648;
constexpr int BIAS_OFF = SCR_BYTES;
constexpr int BTP = 224;
constexpr int MISC_OFF = BIAS_OFF + 8 * BTP * 4 + 128;
constexpr int LDS_BYTES = MISC_OFF + 256;
static_assert(LDS_BYTES <= 163840, "LDS");

__device__ const unsigned char T5_BUCKET[129] = {0,1,2,3,4,5,6,7,8,9,10,11,12,13,14,15,16,16,16,17,17,18,18,18,19,19,19,20,20,20,20,21,21,21,21,22,22,22,22,22,23,23,23,23,23,23,24,24,24,24,24,24,25,25,25,25,25,25,25,26,26,26,26,26,26,26,26,27,27,27,27,27,27,27,27,27,27,28,28,28,28,28,28,28,28,28,28,29,29,29,29,29,29,29,29,29,29,29,29,30,30,30,30,30,30,30,30,30,30,30,30,30,30,31,31,31,31,31,31,31,31,31,31,31,31,31,31,31,31};
__device__ const float ROPE_INV[64] = {1.0f,0.865964353f,0.749894202f,0.649381638f,0.562341332f,0.486967534f,0.421696514f,0.365174115f,0.316227764f,0.273841977f,0.237137377f,0.2053525f,0.177827939f,0.153992653f,0.133352146f,0.115478195f,0.100000001f,0.0865964293f,0.0749894232f,0.0649381652f,0.0562341325f,0.0486967526f,0.0421696492f,0.0365174115f,0.0316227749f,0.0273841955f,0.0237137377f,0.0205352511f,0.0177827943f,0.0153992651f,0.013335214f,0.0115478197f,0.00999999978f,0.00865964312f,0.00749894232f,0.00649381615f,0.00562341325f,0.00486967526f,0.00421696482f,0.00365174119f,0.00316227763f,0.00273841969f,0.00237137382f,0.00205352507f,0.00177827943f,0.00153992651f,0.00133352145f,0.00115478202f,0.00100000005f,0.000865964335f,0.000749894185f,0.000649381604f,0.000562341302f,0.000486967532f,0.000421696517f,0.000365174114f,0.000316227757f,0.000273841957f,0.00023713737f,0.00020535251f,0.00017782794f,0.00015399266f,0.00013335215f,0.0001154782f};

constexpr size_t PJ_SLICE = (size_t)NTOK * 512;
DI f16* att_ptr(f16* PJ, int sl, int bh, int s) { return PJ + (size_t)sl * PJ_SLICE + ((size_t)bh * SEQ + s) * 64; }
DI unsigned char* att8_ptr(f16* PJ, int sl, int bh, int s) { return (unsigned char*)(PJ + (size_t)sl * PJ_SLICE) + ((size_t)bh * SEQ + s) * 64; }
DI f16* ret_ptr(f16* PJ, int sl, int bh, int s) { return PJ + (size_t)sl * PJ_SLICE + ((size_t)bh * SEQ + s) * 128; }
DI unsigned char* ret8_ptr(f16* PJ, int sl, int bh, int s) { return (unsigned char*)(PJ + (size_t)sl * PJ_SLICE) + ((size_t)bh * SEQ + s) * 128; }

struct Args {
    const float *x, *w_in, *gain, *rel, *w_out, *ln1g, *ln1b, *wrg, *brg, *wre, *bre, *wgu, *wdn, *ln2g, *ln2b;
    float* out; unsigned char* ws; int ph_lo, ph_hi, alt, pad;
};

#define LDS_WAIT() asm volatile("s_waitcnt lgkmcnt(0)" ::: "memory")
#define MFMA32(a, b, c) __builtin_amdgcn_mfma_f32_32x32x16_f16((a), (b), (c), 0, 0, 0)
#define MFMA16(a, b, c) __builtin_amdgcn_mfma_f32_16x16x32_f16((a), (b), (c), 0, 0, 0)
DI int crow(int reg, int hp) { return (reg & 3) + 8 * (reg >> 2) + 4 * hp; }
DI h8 cvt8(f32x4 a, f32x4 b) { const f32x8 v = {a[0], a[1], a[2], a[3], b[0], b[1], b[2], b[3]}; return __builtin_convertvector(v, h8); }
DI float wave_sum(float v) {
#pragma unroll
    for (int o = 1; o < 64; o <<= 1) v += __shfl_xor(v, o);
    return v;
}
DI h4 tr_read(LAS const unsigned char* p) {
    typedef LAS s4v lds_s4;
    const s4v v = __builtin_amdgcn_ds_read_tr16_b64_v4i16((lds_s4*)p);
    return __builtin_bit_cast(h4, v);
}
DI h8 cat44(h4 a, h4 b) { return __builtin_shufflevector(a, b, 0, 1, 2, 3, 4, 5, 6, 7); }
DI float fexp2(float x) { return __builtin_amdgcn_exp2f(x); }
DI int cvt4_fp8(f32x4 a) { int w = 0; w = __builtin_amdgcn_cvt_pk_fp8_f32(a[0], a[1], w, false); w = __builtin_amdgcn_cvt_pk_fp8_f32(a[2], a[3], w, true); return w; }
DI u32x2 cvt8_fp8(f32x4 a, f32x4 b) {
    int w0 = 0, w1 = 0;
    w0 = __builtin_amdgcn_cvt_pk_fp8_f32(a[0], a[1], w0, false); w0 = __builtin_amdgcn_cvt_pk_fp8_f32(a[2], a[3], w0, true);
    w1 = __builtin_amdgcn_cvt_pk_fp8_f32(b[0], b[1], w1, false); w1 = __builtin_amdgcn_cvt_pk_fp8_f32(b[2], b[3], w1, true);
    return (u32x2){(unsigned)w0, (unsigned)w1};
}
DI float gamma_log2(int h) { return __builtin_log2f(1.0f - fexp2(-(5.0f + (4.0f / 3.0f) * (float)h))); }

#define XB_TMO      128
#define XB_XCNT(j)  (256  + 64 * (j))
#define XB_XSUB(j)  (1280 + 64 * (j))
#define XB_XGEN(j)  (2304 + 64 * (j))
#define XB_TOP      3328
#define XB_TOPGEN   3392
#define XCD_BAR_WORDS 3456
#define XB_SPIN_CAP (1u << 18)
__device__ __forceinline__ unsigned xb_ld(unsigned* p)              { return __hip_atomic_load(p, __ATOMIC_RELAXED, __HIP_MEMORY_SCOPE_AGENT); }
__device__ __forceinline__ unsigned xb_add(unsigned* p, unsigned v) { return __hip_atomic_fetch_add(p, v, __ATOMIC_RELAXED, __HIP_MEMORY_SCOPE_AGENT); }
__device__ __forceinline__ unsigned xb_xcc_id() { return (unsigned)__builtin_amdgcn_s_getreg((3 << 11) | 20) & 0xFu; }
#define XB_SPIN(cond, bar) do { unsigned _sp = 0; while (cond) { __builtin_amdgcn_s_sleep(1); \
    if ((++_sp & 255u) == 0u) { if (xb_ld(&(bar)[XB_TMO])) break; if (_sp > XB_SPIN_CAP) { atomicAdd(&(bar)[XB_TMO], 1u); break; } } } } while (0)
struct XcdBarrier { unsigned* bar; unsigned x; volatile LAS unsigned* st; };
__device__ __forceinline__ XcdBarrier xcd_barrier_post(unsigned* bar, volatile LAS unsigned* st) {
    XcdBarrier b; b.bar = bar; b.x = xb_xcc_id(); b.st = st;
    if (threadIdx.x == 0) (void)xb_add(&bar[XB_XCNT(b.x)], 1u);
    return b;
}
__device__ __forceinline__ void xcd_barrier_complete(unsigned* bar, unsigned x, unsigned& nloc, unsigned& nx) {
    const unsigned G = gridDim.x * gridDim.y * gridDim.z;
    unsigned sum, cnt, mine, sp = 0u;
    for (;;) {
        sum = 0u; cnt = 0u; mine = 0u;
#pragma unroll
        for (unsigned j = 0; j < 16; ++j) { const unsigned c = xb_ld(&bar[XB_XCNT(j)]); sum += c; cnt += (c > 0u) ? 1u : 0u; mine = (j == x) ? c : mine; }
        if (sum == G) break;
        __builtin_amdgcn_s_sleep(1);
        if ((++sp & 255u) == 0u) { if (xb_ld(&bar[XB_TMO])) break; if (sp > XB_SPIN_CAP) { atomicAdd(&bar[XB_TMO], 1u); break; } }
    }
    nloc = mine > 0u ? mine : 1u; nx = cnt > 0u ? cnt : 1u;
}
__device__ __forceinline__ void xcd_barrier(const XcdBarrier& b) {
    asm volatile("s_waitcnt vmcnt(0)" ::: "memory");
    __syncthreads();
    if (threadIdx.x == 0) {
        unsigned* bar = b.bar;
        __builtin_amdgcn_s_waitcnt(0);
        unsigned nloc = b.st[0], nx = b.st[1];
        if (nloc == 0u) { xcd_barrier_complete(bar, b.x, nloc, nx); b.st[0] = nloc; b.st[1] = nx; }
        const unsigned old = xb_add(&bar[XB_XSUB(b.x)], 1u);
        const unsigned gen = old / nloc;
        if (old + 1u == (gen + 1u) * nloc) {
            __builtin_amdgcn_fence(__ATOMIC_RELEASE, "agent");
            asm volatile("s_waitcnt vmcnt(0)" ::: "memory");
            const unsigned og = xb_add(&bar[XB_TOP], 1u);
            const unsigned tg = og / nx;
            if (og + 1u == (tg + 1u) * nx) xb_add(&bar[XB_TOPGEN], 1u);
            else XB_SPIN(xb_ld(&bar[XB_TOPGEN]) == tg, bar);
            __builtin_amdgcn_fence(__ATOMIC_ACQUIRE, "agent");
            xb_add(&bar[XB_XGEN(b.x)], 1u);
            asm volatile("s_waitcnt vmcnt(0)" ::: "memory");
        } else {
            XB_SPIN(xb_ld(&bar[XB_XGEN(b.x)]) == gen, bar);
            __builtin_amdgcn_fence(__ATOMIC_ACQUIRE, "agent");
            asm volatile("s_waitcnt vmcnt(0)" ::: "memory");
        }
    }
    __syncthreads();
}

namespace pg8 {
constexpr int BM = 256, BK = 64, HALF = 128, HTB = HALF * BK * 2, STAGE_BYTES = 8 * HTB, NXCD = 8, WGM = 8;
DI int lds_byte(int r, int c) { const int st = (r >> 4) * 2 + (c >> 5), rr = r & 15, cc = c & 31, ob = rr * 64 + cc * 2; return st * 1024 + (ob ^ (((ob >> 9) & 1) << 5)); }
DI void stage_rc(int b, int& R, int& C) { const int st = b / 1024, sb = b % 1024, swz = sb ^ (((sb >> 9) & 1) << 5); R = (st >> 1) * 16 + swz / 64; C = (st & 1) * 32 + (swz % 64) / 2; }
DI int swz16(int r) { return (((r >> 2) & 1) << 1) | (((r >> 1) & 1) << 2); }
DI void stage_rc16(int b, int& R, int& C) { R = b >> 7; C = 8 * (((b >> 4) & 7) ^ swz16(R & 15)); }
DI int swz8(int r) { return ((r >> 2) & 1) | (((r >> 1) & 1) << 2); }
DI void stage_rc8(int b, int& R, int& Cb) { R = b >> 7; Cb = 16 * (((b >> 4) & 7) ^ swz8(R & 15)); }
DI int perm32(int rho) { const int n = rho >> 4, i = rho & 15; return 8 * (i >> 2) + 4 * n + (i & 3); }

struct Unit { const char* a; const char* b; int i0, i1, i2, i3, i4; };

struct StaticOrder {
    static constexpr bool VARY_A = false, HALF_UNITS = false;
    const char* A; const char* Bt; int lda, ldb, nM, nN, nwg, G, c, esz;
    DI void init(const void* A_, const void* Bt_, int lda_, int ldb_, int M, int N, int G_, int c_, int esz_ = 2) { A = (const char*)A_; Bt = (const char*)Bt_; lda = lda_; ldb = ldb_; nM = M / BM; nN = N / BM; nwg = nM * nN; G = G_; c = c_; esz = esz_; }
    DI bool next(int i, Unit& u) const {
        const long L = (long)i * G + c; if (L >= nwg) return false;
        int wgid = (int)L; { const int q = nwg / NXCD, r = nwg % NXCD, xcd = wgid % NXCD, off = wgid / NXCD; wgid = (xcd < r ? xcd * (q + 1) : r * (q + 1) + (xcd - r) * q) + off; }
        const int nig = WGM * nN, gid = wgid / nig, fm = gid * WGM, gsz = (nM - fm) < WGM ? (nM - fm) : WGM;
        u.i0 = fm + ((wgid % nig) % gsz); u.i1 = (wgid % nig) / gsz; u.i2 = 0; u.i3 = 0; u.i4 = i;
        u.a = A + (size_t)u.i0 * BM * lda * esz; u.b = Bt + (size_t)u.i1 * BM * ldb * esz; return true;
    }
    DI void aoff(const Unit&, unsigned (&vo)[2][2]) const {
#pragma unroll
        for (int i = 0; i < 2; ++i) { int R, C; if (esz == 1) stage_rc8((int)threadIdx.x * 16 + i * 8192, R, C); else { stage_rc16((int)threadIdx.x * 16 + i * 8192, R, C); C *= 2; }
#pragma unroll
            for (int h = 0; h < 2; ++h) vo[h][i] = (unsigned)((h * HALF + R) * lda * esz + C); }
    }
};

template <class Epi, class Sched, bool ALIGN_EPI>
DI void gemm_phase(LAS unsigned char* lds, const int ldb, const int nt, const Sched& S, const Epi& E) {
    int tid_o_ = threadIdx.x; asm volatile("" : "+v"(tid_o_));
    const int tid = tid_o_, wid = __builtin_amdgcn_readfirstlane(tid >> 6), lane = tid & 63, wr = wid >> 2, wc = wid & 3, fr = lane & 15, fq = lane >> 4;
    unsigned voffB[2];
#pragma unroll
    for (int i = 0; i < 2; ++i) { int R, C; stage_rc16(tid * 16 + i * 8192, R, C); const int Rb = (R & ~31) + perm32(R & 31); voffB[i] = (unsigned)(Rb * ldb + C) * 2u; }
    const size_t kstep = (size_t)(BK * 2);
    const size_t hstep = (size_t)HALF * ldb * 2;
    const unsigned ldsw = (unsigned)wid * 1024u;
    const int aoff = (wr * 64 + fr) * 128 + 16 * (fq ^ swz16(fr)), boff = (wc * 32 + fr) * 128 + 16 * (fq ^ swz16(fr));
    const int aoff2 = aoff ^ 64, boff2 = boff ^ 64;
#define PG8_SA(b, h) (((b) * 2 + (h)) * HTB)
#define PG8_SB(b, h) ((4 + (b) * 2 + (h)) * HTB)
#define PG8_STAGE(bufoff, gbase, voff) do { _Pragma("unroll") for (int _i = 0; _i < 2; ++_i) \
        __builtin_amdgcn_global_load_lds((const unsigned*)((const char*)(gbase) + (voff)[_i]), (LAS unsigned*)(lds + (bufoff) + ldsw + _i * 8192), 16, 0, 0); } while (0)
#define PG8_LDA(dst, b, h) do { _Pragma("unroll") for (int m = 0; m < 4; ++m) _Pragma("unroll") for (int k = 0; k < 2; ++k) dst[m][k] = *(const LAS h8*)(lds + PG8_SA(b, h) + (k ? aoff2 : aoff) + m * 2048); } while (0)
#define PG8_LDB(dst, b, h) do { _Pragma("unroll") for (int n = 0; n < 2; ++n) _Pragma("unroll") for (int k = 0; k < 2; ++k) dst[n][k] = *(const LAS h8*)(lds + PG8_SB(b, h) + (k ? boff2 : boff) + n * 2048); } while (0)
#define PG8_MMA(ai, bj, At, Bt) do { __builtin_amdgcn_s_setprio(1); _Pragma("unroll") for (int m = 0; m < 4; ++m) _Pragma("unroll") for (int n = 0; n < 2; ++n) _Pragma("unroll") for (int k = 0; k < 2; ++k) \
        acc[ai][bj][m][n] = __builtin_amdgcn_mfma_f32_16x16x32_f16(Bt[n][k], At[m][k], acc[ai][bj][m][n], 0, 0, 0); __builtin_amdgcn_s_setprio(0); } while (0)
#define PG8_WAIT_V(n) asm volatile("s_waitcnt vmcnt(" #n ")" ::: "memory")
#define PG8_WAIT_L(n) asm volatile("s_waitcnt lgkmcnt(" #n ")" ::: "memory")
#define PG8_BAR __builtin_amdgcn_s_barrier()
#define PG8_SCHED __builtin_amdgcn_sched_barrier(0)
    Unit cur, nxt; int ui = 0;
    if (!S.next(0, cur)) return;
    f32x4 acc[2][2][4][2];
#pragma unroll
    for (int a = 0; a < 2; ++a)
#pragma unroll
        for (int b = 0; b < 2; ++b)
#pragma unroll
            for (int m = 0; m < 4; ++m)
#pragma unroll
                for (int n = 0; n < 2; ++n) acc[a][b][m][n] = (f32x4){0.f, 0.f, 0.f, 0.f};
    h8 At[4][2], B0[2][2], B1[2][2];
    unsigned voc[2][2], von[2][2];
    S.aoff(cur, voc);
    const char* cA = cur.a; const char* cB = cur.b;
    PG8_STAGE(PG8_SB(0, 0), cB, voffB); PG8_STAGE(PG8_SB(0, 1), cB + hstep, voffB); PG8_STAGE(PG8_SA(0, 0), cA, voc[0]); PG8_STAGE(PG8_SA(0, 1), cA, voc[1]);
    if (wr == 1) PG8_BAR;
    PG8_WAIT_V(2); PG8_BAR;
    PG8_STAGE(PG8_SB(1, 0), cB + kstep, voffB); PG8_STAGE(PG8_SA(1, 0), cA + kstep, voc[0]); PG8_STAGE(PG8_SB(1, 1), cB + hstep + kstep, voffB);
    PG8_WAIT_V(6); PG8_BAR;
    for (;;) {
        const bool has_next = S.next(ui + 1, nxt);
        const char* nA = has_next ? nxt.a : cA; const char* nB = has_next ? nxt.b : cB;
        if (has_next) S.aoff(nxt, von);
        else {
#pragma unroll
            for (int h = 0; h < 2; ++h)
#pragma unroll
                for (int i = 0; i < 2; ++i) von[h][i] = voc[h][i]; }
#pragma unroll 1
        for (int t = 0; t < nt; t += 2) {
            if constexpr (Epi::MIDK > 0) { if (t == Epi::MIDK) E.midk(acc, cur, wr, wc, fr, fq); }
            const bool last = (t == nt - 2);
            const char* a1 = cA + (size_t)(t + 1) * kstep;
            const char* a2 = last ? nA : cA + (size_t)(t + 2) * kstep; const char* b2 = last ? nB : cB + (size_t)(t + 2) * kstep;
            const char* a3 = a2 + kstep; const char* b3 = b2 + kstep;
            unsigned v2[2][2];
#pragma unroll
            for (int h = 0; h < 2; ++h)
#pragma unroll
                for (int i = 0; i < 2; ++i) v2[h][i] = last ? von[h][i] : voc[h][i];
            PG8_LDB(B0, 0, 0); PG8_LDB(B1, 0, 1); PG8_SCHED; PG8_LDA(At, 0, 0); PG8_STAGE(PG8_SA(1, 1), a1, voc[1]);
            PG8_WAIT_V(8); PG8_WAIT_L(0); PG8_BAR; PG8_MMA(0, 0, At, B0); PG8_MMA(0, 1, At, B1); PG8_BAR; PG8_SCHED;
            PG8_LDA(At, 0, 1); PG8_STAGE(PG8_SB(0, 0), b2, voffB); PG8_STAGE(PG8_SB(0, 1), b2 + hstep, voffB); PG8_STAGE(PG8_SA(0, 0), a2, v2[0]);
            PG8_WAIT_V(8); PG8_WAIT_L(0); PG8_BAR; PG8_MMA(1, 0, At, B0); PG8_MMA(1, 1, At, B1); PG8_BAR; PG8_SCHED;
            PG8_LDB(B0, 1, 0); PG8_LDB(B1, 1, 1); PG8_SCHED; PG8_LDA(At, 1, 0); PG8_STAGE(PG8_SA(0, 1), a2, v2[1]);
            PG8_WAIT_V(8); PG8_WAIT_L(0); PG8_BAR; PG8_MMA(0, 0, At, B0); PG8_MMA(0, 1, At, B1); PG8_BAR; PG8_SCHED;
            PG8_LDA(At, 1, 1); PG8_STAGE(PG8_SB(1, 0), b3, voffB); PG8_STAGE(PG8_SB(1, 1), b3 + hstep, voffB); PG8_STAGE(PG8_SA(1, 0), a3, v2[0]);
            PG8_WAIT_V(8); PG8_WAIT_L(0); PG8_BAR; PG8_MMA(1, 0, At, B0); PG8_MMA(1, 1, At, B1); PG8_BAR; PG8_SCHED;
        }
        if constexpr (ALIGN_EPI) { if (wr == 0) PG8_BAR; }
        { int tz = threadIdx.x; asm volatile("" : "+v"(tz)); const int l2 = tz & 63; E(acc, cur, wr, wc, l2 & 15, l2 >> 4); }
        if (!has_next) break;
#pragma unroll
        for (int a = 0; a < 2; ++a)
#pragma unroll
            for (int b = 0; b < 2; ++b)
#pragma unroll
                for (int m = 0; m < 4; ++m)
#pragma unroll
                    for (int n = 0; n < 2; ++n) acc[a][b][m][n] = (f32x4){0.f, 0.f, 0.f, 0.f};
        cur = nxt; cA = nA; cB = nB; ++ui;
#pragma unroll
        for (int h = 0; h < 2; ++h)
#pragma unroll
            for (int i = 0; i < 2; ++i) voc[h][i] = von[h][i];
        if constexpr (ALIGN_EPI) { if (wr == 1) PG8_BAR; }
    }
    PG8_WAIT_V(0);
    if constexpr (!ALIGN_EPI) { if (wr == 0) PG8_BAR; }
    PG8_BAR;
#undef PG8_SA
#undef PG8_SB
#undef PG8_STAGE
#undef PG8_LDA
#undef PG8_LDB
#undef PG8_MMA
#undef PG8_WAIT_V
#undef PG8_WAIT_L
#undef PG8_BAR
#undef PG8_SCHED
}
template <class Epi, class Sched, bool ALIGN_EPI>
DI void gemm_phase8(LAS unsigned char* lds, const int ldb  , const int nt  , const Sched& S, const Epi& E) {
    int tid_o_ = threadIdx.x; asm volatile("" : "+v"(tid_o_));
    const int tid = tid_o_, wid = __builtin_amdgcn_readfirstlane(tid >> 6), lane = tid & 63, wr = wid >> 2, wc = wid & 3, fr = lane & 15, fq = lane >> 4;
    unsigned voffB[2];
#pragma unroll
    for (int i = 0; i < 2; ++i) { int R, C; stage_rc8(tid * 16 + i * 8192, R, C); const int Rb = (R & ~31) + perm32(R & 31); voffB[i] = (unsigned)(Rb * ldb + C); }
    const size_t kstep = (size_t)(BK * 2);
    const size_t hstep = (size_t)HALF * ldb;
    const unsigned ldsw = (unsigned)wid * 1024u;
    const int aoff = (wr * 64 + fr) * 128 + 16 * ((2 * fq) ^ swz8(fr)), boff = (wc * 32 + fr) * 128 + 16 * ((2 * fq) ^ swz8(fr));
    const int aoff2 = aoff ^ 16, boff2 = boff ^ 16;
#define PG8_SA(b, h) (((b) * 2 + (h)) * HTB)
#define PG8_SB(b, h) ((4 + (b) * 2 + (h)) * HTB)
#define PG8_STAGE(bufoff, gbase, voff) do { _Pragma("unroll") for (int _i = 0; _i < 2; ++_i) \
        __builtin_amdgcn_global_load_lds((const unsigned*)((const char*)(gbase) + (voff)[_i]), (LAS unsigned*)(lds + (bufoff) + ldsw + _i * 8192), 16, 0, 0); } while (0)
#define PG8_LD32(p, q) __builtin_shufflevector(*(const LAS i32x4v*)(p), *(const LAS i32x4v*)(q), 0, 1, 2, 3, 4, 5, 6, 7)
#define PG8_LDA(dst, b, h) do { _Pragma("unroll") for (int m = 0; m < 4; ++m) dst[m] = PG8_LD32(lds + PG8_SA(b, h) + aoff + m * 2048, lds + PG8_SA(b, h) + aoff2 + m * 2048); } while (0)
#define PG8_LDB(dst, b, h) do { _Pragma("unroll") for (int n = 0; n < 2; ++n) dst[n] = PG8_LD32(lds + PG8_SB(b, h) + boff + n * 2048, lds + PG8_SB(b, h) + boff2 + n * 2048); } while (0)
#define PG8_MMA(ai, bj, At, Bt) do { __builtin_amdgcn_s_setprio(1); _Pragma("unroll") for (int m = 0; m < 4; ++m) _Pragma("unroll") for (int n = 0; n < 2; ++n) \
        asm volatile("v_mfma_scale_f32_16x16x128_f8f6f4 %0, %1, %2, %0, %3, %3 op_sel_hi:[0,0,0]" : "+v"(acc[ai][bj][m][n]) : "v"(Bt[n]), "v"(At[m]), "v"(scl)); __builtin_amdgcn_s_setprio(0); } while (0)
#define PG8_WAIT_V(n) asm volatile("s_waitcnt vmcnt(" #n ")" ::: "memory")
#define PG8_WAIT_L(n) asm volatile("s_waitcnt lgkmcnt(" #n ")" ::: "memory")
#define PG8_BAR __builtin_amdgcn_s_barrier()
#define PG8_SCHED __builtin_amdgcn_sched_barrier(0)
#if defined(PROF_SEG) && PROF_SEG >= 51 && PROF_SEG <= 55
#define GP_T(var) const unsigned long long var = __builtin_amdgcn_s_memrealtime()
#define GP_ACC(t0, t1) do { if (tid == 0) { LAS unsigned* pw = (LAS unsigned*)(lds + 162944 + 64); if (pw[1]) pw[0] += (unsigned)((t1) - (t0)); } } while (0)
    unsigned long long tseam = 0ull; bool seam_pending = false;
#endif
    Unit cur, nxt; int ui = 0;
    if (!S.next(0, cur)) return;
    f32x4 acc[2][2][4][2];
#pragma unroll
    for (int a = 0; a < 2; ++a)
#pragma unroll
        for (int b = 0; b < 2; ++b)
#pragma unroll
            for (int m = 0; m < 4; ++m)
#pragma unroll
                for (int n = 0; n < 2; ++n) acc[a][b][m][n] = (f32x4){0.f, 0.f, 0.f, 0.f};
    i32x8 At[4], B0[2], B1[2];
    const int scl = 0x7F7F7F7F;
    unsigned voc[2][2];
    LAS unsigned* vsave = (LAS unsigned*)(lds + STAGE_BYTES + 4096) + 4 * tid;
    S.aoff(cur, voc);
    const char* cA = cur.a; const char* cB = cur.b;
    PG8_STAGE(PG8_SB(0, 0), cB, voffB); PG8_STAGE(PG8_SB(0, 1), cB + hstep, voffB); PG8_STAGE(PG8_SA(0, 0), cA, voc[0]); PG8_STAGE(PG8_SA(0, 1), cA, voc[1]);
    if (wr == 1) PG8_BAR;
    PG8_WAIT_V(2); PG8_BAR;
    PG8_STAGE(PG8_SB(1, 0), cB + kstep, voffB); PG8_STAGE(PG8_SA(1, 0), cA + kstep, voc[0]); PG8_STAGE(PG8_SB(1, 1), cB + hstep + kstep, voffB);
    PG8_WAIT_V(6); PG8_BAR;
    for (;;) {
        const bool has_next = S.next(ui + 1, nxt);
        const bool hf = Sched::HALF_UNITS && cur.i3 != 0;
        const char* nA = has_next ? nxt.a : cA; const char* nB = has_next ? nxt.b : cB;
        if constexpr (Sched::VARY_A) { if (has_next) { unsigned tmp[2][2]; S.aoff(nxt, tmp); vsave[0] = tmp[0][0]; vsave[1] = tmp[0][1]; vsave[2] = tmp[1][0]; vsave[3] = tmp[1][1]; } }
#pragma unroll 1
        for (int t = 0; t < nt; t += 2) {
            if constexpr (Epi::MIDK > 0) { if (t == Epi::MIDK) { asm volatile("s_nop 15\n\ts_nop 15" ::: "memory"); E.midk(acc, cur, wr, wc, fr, fq);
#pragma unroll
                for (int a_ = 0; a_ < 2; ++a_)
#pragma unroll
                    for (int b_ = 0; b_ < 2; ++b_)
#pragma unroll
                        for (int m_ = 0; m_ < 4; ++m_)
#pragma unroll
                            for (int n_ = 0; n_ < 2; ++n_) asm volatile("" : "+v"(acc[a_][b_][m_][n_]));
                asm volatile("s_nop 7" ::: "memory"); } }
            const bool last = (t == nt - 2);
            const char* a1 = cA + (size_t)(t + 1) * kstep;
            const char* a2 = last ? nA : cA + (size_t)(t + 2) * kstep; const char* b2 = last ? nB : cB + (size_t)(t + 2) * kstep;
            const char* a3 = a2 + kstep; const char* b3 = b2 + kstep;
            PG8_LDB(B0, 0, 0); PG8_LDB(B1, 0, 1); PG8_SCHED; PG8_LDA(At, 0, 0); PG8_STAGE(PG8_SA(1, 1), a1, voc[1]);
            PG8_WAIT_V(8); PG8_WAIT_L(0);
#if defined(PROF_SEG) && PROF_SEG == 54
            if (seam_pending) { GP_T(ts1); GP_ACC(tseam, ts1); seam_pending = false; }
#endif
            PG8_BAR; PG8_MMA(0, 0, At, B0); PG8_MMA(0, 1, At, B1); PG8_BAR; PG8_SCHED;
            if constexpr (Sched::VARY_A) { if (last && has_next) { voc[0][0] = vsave[0]; voc[0][1] = vsave[1]; voc[1][0] = vsave[2]; voc[1][1] = vsave[3]; } }
            if (!hf) PG8_LDA(At, 0, 1);
            PG8_STAGE(PG8_SB(0, 0), b2, voffB); PG8_STAGE(PG8_SB(0, 1), b2 + hstep, voffB); PG8_STAGE(PG8_SA(0, 0), a2, voc[0]);
            PG8_WAIT_V(8); PG8_WAIT_L(0); PG8_BAR; if (!hf) { PG8_MMA(1, 0, At, B0); PG8_MMA(1, 1, At, B1); } PG8_BAR; PG8_SCHED;
            PG8_LDB(B0, 1, 0); PG8_LDB(B1, 1, 1); PG8_SCHED; PG8_LDA(At, 1, 0); PG8_STAGE(PG8_SA(0, 1), a2, voc[1]);
            PG8_WAIT_V(8); PG8_WAIT_L(0); PG8_BAR; PG8_MMA(0, 0, At, B0); PG8_MMA(0, 1, At, B1); PG8_BAR; PG8_SCHED;
            if (!hf) PG8_LDA(At, 1, 1);
            PG8_STAGE(PG8_SB(1, 0), b3, voffB); PG8_STAGE(PG8_SB(1, 1), b3 + hstep, voffB); PG8_STAGE(PG8_SA(1, 0), a3, voc[0]);
            PG8_WAIT_V(8); PG8_WAIT_L(0); PG8_BAR; if (!hf) { PG8_MMA(1, 0, At, B0); PG8_MMA(1, 1, At, B1); } PG8_BAR; PG8_SCHED;
        }
#if defined(PROF_SEG) && PROF_SEG >= 51 && PROF_SEG <= 55
        GP_T(te0);
#endif
        asm volatile("s_nop 15\n\ts_nop 15" ::: "memory");
        if constexpr (ALIGN_EPI) { if (wr == 0) PG8_BAR; }
#if defined(PROF_SEG) && PROF_SEG >= 51 && PROF_SEG <= 55
        GP_T(te1);
#endif
        { int tz = threadIdx.x; asm volatile("" : "+v"(tz)); const int l2 = tz & 63;
          E(acc, cur, wr, wc, l2 & 15, l2 >> 4); }
#if defined(PROF_SEG) && PROF_SEG >= 51 && PROF_SEG <= 55
        { GP_T(te2);
#if PROF_SEG == 52
          GP_ACC(te0, te1);
#elif PROF_SEG == 53
          GP_ACC(te1, te2);
#elif PROF_SEG == 51
          GP_ACC(te0, te2);
#endif
          tseam = te2; seam_pending = true; }
#endif

        if (!has_next) break;
#pragma unroll
        for (int a = 0; a < 2; ++a)
#pragma unroll
            for (int b = 0; b < 2; ++b)
#pragma unroll
                for (int m = 0; m < 4; ++m)
#pragma unroll
                    for (int n = 0; n < 2; ++n) acc[a][b][m][n] = (f32x4){0.f, 0.f, 0.f, 0.f};
        cur = nxt; cA = nA; cB = nB; ++ui;
        if constexpr (ALIGN_EPI) { if (wr == 1) PG8_BAR; }
    }
    PG8_WAIT_V(0);
    if constexpr (!ALIGN_EPI) { if (wr == 0) PG8_BAR; }
    PG8_BAR;
#undef PG8_SA
#undef PG8_SB
#undef PG8_STAGE
#undef PG8_LDA
#undef PG8_LD32
#undef PG8_LDB
#undef PG8_MMA
#undef PG8_WAIT_V
#undef PG8_WAIT_L
#undef PG8_BAR
#undef PG8_SCHED
}
}

struct EpiProj {
    static constexpr int MIDK = 0;
    f16* PJ; const float* cosT; const float* sinT; int pn_off; float osc; LAS unsigned char* scr;
    DI void midk(f32x4 (&)[2][2][4][2], const pg8::Unit&, int, int, int, int) const {}
    DI void operator()(const f32x4 (&acc)[2][2][4][2], const pg8::Unit& u, int wr, int wc, int fr, int fq) const {
        const int pn = u.i1 + pn_off, row0 = u.i0 * 256 + wr * 64 + fr, sl = pn >> 1;
        const int b = row0 >> 14, s0 = row0 & (SEQ - 1);
        if ((pn >= 2 && pn < 6) || pn >= 10) {
            LAS unsigned char* sw = scr + (wr * 4 + wc) * 2048; const int L = 16 * fq + fr, rr = L >> 2, ch = L & 3;
            const int sb = (u.i0 * 256 + wr * 64) & (SEQ - 1);
            unsigned char* dst; int pitch;
            if (pn < 6) { dst = att8_ptr(PJ, sl, b * 8 + (pn & 1) * 4 + wc, sb) + 16 * ch; pitch = 64; }
            else { dst = ret8_ptr(PJ, sl, b * 4 + (pn & 1) * 2 + (wc >> 1), sb) + 64 * (wc & 1) + 16 * ch; pitch = 128; }
#pragma unroll
            for (int ai = 0; ai < 2; ++ai)
#pragma unroll
                for (int m = 0; m < 4; ++m) {
                    *(LAS u32x2*)(sw + fr * 64 + 8 * fq) = cvt8_fp8(acc[ai][0][m][0] * osc, acc[ai][0][m][1] * osc);
                    *(LAS u32x2*)(sw + fr * 64 + 32 + 8 * fq) = cvt8_fp8(acc[ai][1][m][0] * osc, acc[ai][1][m][1] * osc);
                    asm volatile("" ::: "memory");
                    const u32x4 v0 = *(const LAS u32x4*)(sw + rr * 64 + 16 * ch);
                    asm volatile("" ::: "memory");
                    __builtin_nontemporal_store(v0, (u32x4*)(dst + (size_t)(ai * 128 + m * 16 + rr) * pitch)); }
        } else if (pn < 6 || pn > 9) {
            LAS unsigned char* sw = scr + (wr * 4 + wc) * 2048; const int L = 16 * fq + fr, rr = L >> 3, ch = L & 7;
            const int sb = (u.i0 * 256 + wr * 64) & (SEQ - 1);
            f16* dst; int pitch;
            if (pn < 6) { dst = att_ptr(PJ, sl, b * 8 + (pn & 1) * 4 + wc, sb) + 8 * ch; pitch = 64; }
            else { dst = ret_ptr(PJ, sl, b * 4 + (pn & 1) * 2 + (wc >> 1), sb) + 64 * (wc & 1) + 8 * ch; pitch = 128; }
#pragma unroll
            for (int ai = 0; ai < 2; ++ai)
#pragma unroll
                for (int m = 0; m < 4; ++m) {
                    *(LAS h8*)(sw + fr * 128 + 16 * (fq ^ (fr & 7))) = cvt8(acc[ai][0][m][0] * osc, acc[ai][0][m][1] * osc);
                    *(LAS h8*)(sw + fr * 128 + 16 * ((4 + fq) ^ (fr & 7))) = cvt8(acc[ai][1][m][0] * osc, acc[ai][1][m][1] * osc);
                    asm volatile("" ::: "memory");
                    const h8 v0 = *(const LAS h8*)(sw + rr * 128 + 16 * (ch ^ (rr & 7))), v1 = *(const LAS h8*)(sw + (rr + 8) * 128 + 16 * (ch ^ (rr & 7)));
                    asm volatile("" ::: "memory");
                    f16* p0 = dst + (size_t)(ai * 128 + m * 16 + rr) * pitch;
                    __builtin_nontemporal_store(v0, (h8*)p0); __builtin_nontemporal_store(v1, (h8*)(p0 + (size_t)8 * pitch)); }
        } else {
            const float sc = ((pn >= 8) ? 0.7071067811865476f : 1.0f) * osc;
            const int i0 = 32 * (wc & 1) + 8 * fq;
            unsigned char* hp_ = ret8_ptr(PJ, sl, b * 4 + (pn & 1) * 2 + (wc >> 1), s0) + i0;
#pragma unroll
            for (int ai = 0; ai < 2; ++ai)
#pragma unroll
                for (int m = 0; m < 4; ++m) { const int pos = s0 + ai * 128 + m * 16;
                    const f32x4 c0 = *(const f32x4*)(cosT + pos * 64 + i0) * sc, c1 = *(const f32x4*)(cosT + pos * 64 + i0 + 4) * sc;
                    const f32x4 s0v = *(const f32x4*)(sinT + pos * 64 + i0) * sc, s1v = *(const f32x4*)(sinT + pos * 64 + i0 + 4) * sc;
                    const f32x4 x10 = acc[ai][0][m][0], x11 = acc[ai][0][m][1], x20 = acc[ai][1][m][0], x21 = acc[ai][1][m][1];
                    unsigned char* rowp = hp_ + (size_t)(ai * 128 + m * 16) * 128;
                    *(u32x2*)(rowp) = cvt8_fp8(x10 * c0 - x20 * s0v, x11 * c1 - x21 * s1v);
                    *(u32x2*)(rowp + 64) = cvt8_fp8(x10 * s0v + x20 * c0, x11 * s1v + x21 * c1); }
        }
    }
};
struct EpiZ {
    static constexpr int MIDK = 4;
    const f16* x; f16* z; const f16* sumsq; LAS unsigned char* scr;
    DI void midk(f32x4 (&acc)[2][2][4][2], const pg8::Unit& u, int wr, int wc, int fr, int fq) const {
#pragma unroll
        for (int ai = 0; ai < 2; ++ai)
#pragma unroll
            for (int m = 0; m < 4; ++m) { const int row = u.i0 * 256 + ai * 128 + wr * 64 + m * 16 + fr;
                const f32x8 sv = __builtin_convertvector(*(const h8*)(sumsq + (size_t)row * 8), f32x8);
                const float ss = ((sv[0] + sv[1]) + (sv[2] + sv[3])) + ((sv[4] + sv[5]) + (sv[6] + sv[7]));
                const float rinv = (1.0f / 16.0f) / sqrtf(ss * (1.0f / 512.0f) + LN_EPS);
#pragma unroll
                for (int bj = 0; bj < 2; ++bj)
#pragma unroll
                    for (int n = 0; n < 2; ++n) acc[ai][bj][m][n] *= rinv; }
    }
    DI void operator()(const f32x4 (&acc)[2][2][4][2], const pg8::Unit& u, int wr, int wc, int fr, int fq) const {
        LAS unsigned char* sw = scr + (wr * 4 + wc) * 2048; const int L = 16 * fq + fr, rr = L >> 3, ch = L & 7;
        const size_t base = (size_t)(u.i0 * 256 + wr * 64) * DM + u.i1 * 256 + 64 * wc + 8 * ch;
#pragma unroll
        for (int ai = 0; ai < 2; ++ai)
#pragma unroll
            for (int m = 0; m < 4; ++m) {
                *(LAS h8*)(sw + fr * 128 + 16 * (fq ^ (fr & 7))) = cvt8(acc[ai][0][m][0] * (1.0f / 64.0f), acc[ai][0][m][1] * (1.0f / 64.0f));
                *(LAS h8*)(sw + fr * 128 + 16 * ((4 + fq) ^ (fr & 7))) = cvt8(acc[ai][1][m][0] * (1.0f / 64.0f), acc[ai][1][m][1] * (1.0f / 64.0f));
                asm volatile("" ::: "memory");
                const h8 v0 = *(const LAS h8*)(sw + rr * 128 + 16 * (ch ^ (rr & 7))), v1 = *(const LAS h8*)(sw + (rr + 8) * 128 + 16 * (ch ^ (rr & 7)));
                asm volatile("" ::: "memory");
                const size_t o0 = base + (size_t)(ai * 128 + m * 16 + rr) * DM, o1 = o0 + (size_t)8 * DM;
                const f32x8 x0 = __builtin_convertvector(*(const h8*)(x + o0), f32x8), x1 = __builtin_convertvector(*(const h8*)(x + o1), f32x8);
                *(h8*)(z + o0) = __builtin_convertvector(x0 * ALPHA + __builtin_convertvector(v0, f32x8), h8);
                *(h8*)(z + o1) = __builtin_convertvector(x1 * ALPHA + __builtin_convertvector(v1, f32x8), h8); }
    }
};
constexpr int MOE_MAXU = 6;
template <bool GATHER>
struct MoeSched {
    static constexpr bool VARY_A = GATHER, HALF_UNITS = true;
    LAS const int* utab; LAS const int* rtab; const char* A; const char* Bt; size_t b_expert_bytes; int lda, ldb;
    DI bool next(int i, pg8::Unit& u) const {
        if (i >= MOE_MAXU) return false;
        const int g = utab[4 * i]; if (g < 0) return false;
        const int v = utab[4 * i + 1];
        u.i0 = g; u.i1 = v & 15; u.i2 = utab[4 * i + 2]; u.i3 = v >> 4; u.i4 = i;
        u.a = GATHER ? A : A + ((size_t)g * 256 + (u.i3 == 2 ? 128 : 0)) * lda;
        u.b = Bt + (size_t)u.i2 * b_expert_bytes + (size_t)u.i1 * 256 * ldb; return true;
    }
    DI void aoff(const pg8::Unit& u, unsigned (&vo)[2][2]) const {
#pragma unroll
        for (int i = 0; i < 2; ++i) { int R, C; pg8::stage_rc8((int)threadIdx.x * 16 + i * 8192, R, C);
#pragma unroll
            for (int h = 0; h < 2; ++h) {
                if (GATHER) { const int tok = rtab[u.i4 * 256 + h * 128 + R]; vo[h][i] = (unsigned)(tok * lda + C); }
                else vo[h][i] = (unsigned)((h * 128 + R) * lda + C); } }
    }
};
DI void moe_tables(LAS const int* mtab, LAS int* utab, LAS int* rtab, LAS float* wtab, const int* elist_, const float* wts_, int G, int c, bool down, int tid) {
    if (tid < MOE_MAXU) {
        const int MT = mtab[64]; const int wpx = G >> 3, xcd = c & 7, w = c >> 3;
        const int Mx = MT > xcd ? (MT - xcd + 7) >> 3 : 0, Ux = 4 * Mx, F = Ux / wpx, R = Ux - F * wpx;
        const bool split = R > 0 && 2 * R <= wpx && tid == F;
        const int q = split ? (w < 2 * R ? F * wpx + (w >> 1) : Ux) : w + wpx * tid, hc = split ? 1 + (w & 1) : 0;
        const int g = (q >> 2) * 8 + xcd, nt = q & 3;
        int e = 0;
        for (int k = 1; k < 32; ++k) e += (mtab[32 + k] <= g) ? 1 : 0;
        const bool ok = q < Ux;
        utab[4 * tid] = ok ? g : -1; utab[4 * tid + 1] = nt | (hc << 4); utab[4 * tid + 2] = e; utab[4 * tid + 3] = g - mtab[32 + e];
    }
    __syncthreads();
    for (int i = tid >> 8; i < MOE_MAXU; i += 2) {
        if (utab[4 * i] < 0) continue;
        const int e = utab[4 * i + 2], mi = utab[4 * i + 3], hc = utab[4 * i + 1] >> 4, cnt = mtab[e], row = tid & 255, idx = mi * 256 + (hc == 2 ? 128 : 0) + row;
        const bool rv = idx < cnt && (hc == 0 || row < 128);
        if (!down) rtab[i * 256 + row] = elist_[e * NTOK + (rv ? idx : 0)] >> 1;
        else { const int ent = rv ? elist_[e * NTOK + idx] : -1; rtab[i * 256 + row] = ent; wtab[i * 256 + row] = ent >= 0 ? wts_[ent] * (1.0f / 256.0f) : 0.f; }
    }
    __syncthreads();
}
struct EpiGU {
    static constexpr int MIDK = 0;
    unsigned char* hid;
    DI void midk(f32x4 (&)[2][2][4][2], const pg8::Unit&, int, int, int, int) const {}
    DI void operator()(const f32x4 (&acc)[2][2][4][2], const pg8::Unit& u, int wr, int wc, int fr, int fq) const {
        const int row0 = u.i0 * 256 + (u.i3 == 2 ? 128 : 0) + wr * 64 + fr, col0 = u.i1 * 128 + wc * 32 + 8 * fq;
#pragma unroll
        for (int ai = 0; ai < 2; ++ai) if (ai == 0 || u.i3 == 0)
#pragma unroll
            for (int m = 0; m < 4; ++m) { f32x4 o[2];
#pragma unroll
                for (int n = 0; n < 2; ++n) { const f32x4 g = acc[ai][0][m][n], up = acc[ai][1][m][n];
#pragma unroll
                    for (int e = 0; e < 4; ++e) { const float gg = g[e] * (1.0f / 64.0f); o[n][e] = gg * up[e] * (8.0f / 64.0f) / (1.0f + fexp2(-gg * LOG2E)); } }
                *(u32x2*)(hid + (size_t)(row0 + ai * 128 + m * 16) * DE + col0) = cvt8_fp8(o[0], o[1]); }
    }
};
struct EpiDown {
    static constexpr int MIDK = 0;
    unsigned char* y; LAS const int* rtab; LAS const float* wtab;
    DI void midk(f32x4 (&)[2][2][4][2], const pg8::Unit&, int, int, int, int) const {}
    DI void operator()(const f32x4 (&acc)[2][2][4][2], const pg8::Unit& u, int wr, int wc, int fr, int fq) const {
        const int col0 = u.i1 * 256 + wc * 32 + 8 * fq;
#pragma unroll
        for (int ai = 0; ai < 2; ++ai)
#pragma unroll
            for (int m = 0; m < 4; ++m) { const int row = u.i4 * 256 + ai * 128 + wr * 64 + m * 16 + fr; const int ent = rtab[row];
                if (ent >= 0) { const float w = wtab[row] * 64.0f; unsigned char* rowp = y + (size_t)ent * DM + col0;
#pragma unroll
                    for (int bj = 0; bj < 2; ++bj) *(u32x2*)(rowp + bj * 128) = cvt8_fp8(acc[ai][bj][m][0] * w, acc[ai][bj][m][1] * w); } }
    }
};

template <bool F8>
DI void tr_item64(const float* W, int ldw, int k0, int nsrc0, int nsrc1, void* WT, int ldt, int prow0, float scale, const float* ks, LAS float* scr, int lane) {
    const float gl = ks ? ks[k0 + lane] * scale : scale;
    const int ncol = lane < 32 ? nsrc0 + lane : nsrc1 + lane - 32;
#pragma unroll
    for (int kk = 0; kk < 64; ++kk) scr[kk * 65 + lane] = __builtin_nontemporal_load(W + (size_t)(k0 + kk) * ldw + ncol) * __builtin_amdgcn_readlane(gl, kk);
    LDS_WAIT(); asm volatile("" ::: "memory");
    const int c = lane & 7;
#pragma unroll
    for (int j = 0; j < 8; ++j) { const int n = (lane >> 3) + 8 * j; const LAS float* sp = scr + (8 * c) * 65 + n;
        const f32x4 lo = {sp[0], sp[65], sp[130], sp[195]}, hi = {sp[260], sp[325], sp[390], sp[455]};
        if (F8) __builtin_nontemporal_store(cvt8_fp8(lo, hi), (u32x2*)((unsigned char*)WT + (size_t)(prow0 + n) * ldt + k0 + 8 * c));
        else *(h8*)((f16*)WT + (size_t)(prow0 + n) * ldt + k0 + 8 * c) = cvt8(lo, hi); }
    LDS_WAIT(); asm volatile("" ::: "memory");
}

constexpr int KP64 = 144, VP64 = 192;
typedef _Float16 h2v __attribute__((ext_vector_type(2)));
template <bool OWN>
DI void attn_tile(LAS const unsigned char* Kl, LAS const unsigned char* Vl, LAS const float* biasd, const h8 (&qf)[4], int rel, int w, int lane, float& m2, float& lsum, f32x16 (&o)[2]) {
    const int r = lane & 31, hp = lane >> 5;
    h2v sx[8][8];
    const float b31 = biasd[31 + 160];
    const h2v c2h = {(f16)(0.125f * LOG2E), (f16)(0.125f * LOG2E)}, b31h = {(f16)b31, (f16)b31};
    h2v hmx = {(f16)-60000.0f, (f16)-60000.0f};
#pragma unroll
    for (int kt = 0; kt < 8; ++kt) {
        if (!OWN || kt <= w) {
            f32x16 a;
#pragma unroll
            for (int i = 0; i < 16; ++i) a[i] = 0.f;
#pragma unroll
            for (int ks = 0; ks < 4; ++ks) { const h8 kf = *(const LAS h8*)(Kl + (32 * kt + r) * KP64 + 32 * ks + 16 * hp); a = MFMA32(kf, qf[ks], a); }
            const bool far = __all(rel - (32 * kt + 31) >= 128) != 0;
            if (far) {
#pragma unroll
                for (int i = 0; i < 8; ++i) { const f32x2 v = {a[2 * i], a[2 * i + 1]}; sx[kt][i] = __builtin_convertvector(v, h2v) * c2h + b31h; }
            } else {
                int base = rel - 32 * kt - 4 * hp; base = base > 187 ? 187 : base;
                LAS const float* tp = biasd + (base + 4);
#pragma unroll
                for (int i = 0; i < 8; ++i) { const int i0 = 2 * i, i1 = 2 * i + 1;
                    const f32x2 v = {a[i0], a[i1]}; const h2v bp = {(f16)tp[27 - ((i0 & 3) + 8 * (i0 >> 2))], (f16)tp[27 - ((i1 & 3) + 8 * (i1 >> 2))]};
                    sx[kt][i] = __builtin_convertvector(v, h2v) * c2h + bp; }
            }
#pragma unroll
            for (int i = 0; i < 8; ++i) hmx = __builtin_elementwise_max(hmx, sx[kt][i]);
        }
    }
    float mx = fmaxf((float)hmx[0], (float)hmx[1]);
    mx = fmaxf(mx, __shfl_xor(mx, 32));
    const h2v mh = {(f16)mx, (f16)mx}, one = {(f16)1.0f, (f16)1.0f};
    float ls = 0.f;
#pragma unroll
    for (int dt = 0; dt < 2; ++dt)
#pragma unroll
        for (int i = 0; i < 16; ++i) o[dt][i] = 0.f;
    const int i16 = lane & 15, q4 = i16 >> 2, p4 = i16 & 3, cb = (lane >> 4) & 1;
    LAS const unsigned char* vbase = Vl + (4 * hp + q4) * VP64 + 2 * (16 * cb + 4 * p4);
#pragma unroll
    for (int kt = 0; kt < 8; ++kt) {
        if (!OWN || kt <= w) {
            h2v p[8];
#pragma unroll
            for (int i = 0; i < 8; ++i) { p[i] = __builtin_elementwise_exp2(sx[kt][i] - mh); ls = __builtin_amdgcn_fdot2(p[i], one, ls, false); }
#pragma unroll
            for (int s = 0; s < 2; ++s) {
                const h8 pf = {p[4 * s][0], p[4 * s][1], p[4 * s + 1][0], p[4 * s + 1][1], p[4 * s + 2][0], p[4 * s + 2][1], p[4 * s + 3][0], p[4 * s + 3][1]};
#pragma unroll
                for (int dt = 0; dt < 2; ++dt) {
                    LAS const unsigned char* vp = vbase + (32 * kt + 16 * s) * VP64 + 64 * dt;
                    const h8 vf = cat44(tr_read(vp), tr_read(vp + 8 * VP64));
                    o[dt] = MFMA32(vf, pf, o[dt]);
                }
            }
        }
    }
    ls += __shfl_xor(ls, 32);
    m2 = mx; lsum = ls;
}
template <int P>
DI void stage64(LAS unsigned char* dst, const f16* src, int src_ld, int tid) {
#pragma unroll
    for (int i = 0; i < 4; ++i) { const int q = tid + 512 * i, row = q >> 3, ch = q & 7; *(LAS h8*)(dst + row * P + 16 * ch) = *(const h8*)(src + (size_t)row * src_ld + 8 * ch); }
}

DI void cvt16_fp8_h(const u32x4 w, h8& lo, h8& hi) {
    f32x8 a, b;
#pragma unroll
    for (int k = 0; k < 2; ++k) { a[4 * k] = __builtin_amdgcn_cvt_f32_fp8((int)w[k], 0); a[4 * k + 1] = __builtin_amdgcn_cvt_f32_fp8((int)w[k], 1); a[4 * k + 2] = __builtin_amdgcn_cvt_f32_fp8((int)w[k], 2); a[4 * k + 3] = __builtin_amdgcn_cvt_f32_fp8((int)w[k], 3);
        b[4 * k] = __builtin_amdgcn_cvt_f32_fp8((int)w[2 + k], 0); b[4 * k + 1] = __builtin_amdgcn_cvt_f32_fp8((int)w[2 + k], 1); b[4 * k + 2] = __builtin_amdgcn_cvt_f32_fp8((int)w[2 + k], 2); b[4 * k + 3] = __builtin_amdgcn_cvt_f32_fp8((int)w[2 + k], 3); }
    lo = __builtin_convertvector(a, h8); hi = __builtin_convertvector(b, h8);
}
template <int P>
DI void stage64_8(LAS unsigned char* dst, const unsigned char* src, int tid) {
#pragma unroll
    for (int i = 0; i < 2; ++i) { const int q = tid + 512 * i, row = q >> 2, ch = q & 3; const u32x4 w = *(const u32x4*)(src + (size_t)row * 64 + 16 * ch);
        h8 lo, hi; cvt16_fp8_h(w, lo, hi); *(LAS h8*)(dst + row * P + 32 * ch) = lo; *(LAS h8*)(dst + row * P + 32 * ch + 16) = hi; }
}

DI void own_scores(LAS const unsigned char* Kl, LAS const float* biasd, const h8 (&qf)[4], int ql, int kt, int w, int r, int hp, f32x16& a) {
#pragma unroll
    for (int i = 0; i < 16; ++i) a[i] = 0.f;
#pragma unroll
    for (int ks = 0; ks < 4; ++ks) { const h8 kf = *(const LAS h8*)(Kl + (32 * kt + r) * KP64 + 32 * ks + 16 * hp); a = MFMA32(kf, qf[ks], a); }
    const int delta = w - kt;
    if (delta >= 5) {
        const float b31 = biasd[31 + 160];
#pragma unroll
        for (int i = 0; i < 16; ++i) a[i] = a[i] * (0.125f * LOG2E) + b31;
    } else {
        const int base = ql - 32 * kt - 4 * hp;
        LAS const float* tp = biasd + (base + 4);
        if (delta == 0) {
#pragma unroll
            for (int i = 0; i < 16; ++i) { const int ci = (i & 3) + 8 * (i >> 2); const float v = a[i] * (0.125f * LOG2E) + tp[27 - ci]; a[i] = (base - ci < 0) ? -3.0e38f : v; }
        } else {
#pragma unroll
            for (int i = 0; i < 16; ++i) a[i] = a[i] * (0.125f * LOG2E) + tp[27 - ((i & 3) + 8 * (i >> 2))];
        }
    }
}
DI void attn_own(LAS const unsigned char* Kl, LAS const unsigned char* Vl, LAS const float* biasd, const h8 (&qf)[4], int ql, int w, int lane, float& m2, float& lsum, f32x16 (&o)[2]) {
    const int r = lane & 31, hp = lane >> 5;
    float mx = -3.0e38f;
#pragma unroll 2
    for (int kt = 0; kt <= w; ++kt) { f32x16 a; own_scores(Kl, biasd, qf, ql, kt, w, r, hp, a);
#pragma unroll
        for (int i = 0; i < 16; ++i) mx = fmaxf(mx, a[i]); }
    mx = fmaxf(mx, __shfl_xor(mx, 32));
    float ls = 0.f;
#pragma unroll
    for (int dt = 0; dt < 2; ++dt)
#pragma unroll
        for (int i = 0; i < 16; ++i) o[dt][i] = 0.f;
    const int i16 = lane & 15, q4 = i16 >> 2, p4 = i16 & 3, cb = (lane >> 4) & 1;
    LAS const unsigned char* vbase = Vl + (4 * hp + q4) * VP64 + 2 * (16 * cb + 4 * p4);
#pragma unroll 2
    for (int kt = 0; kt <= w; ++kt) {
        f32x16 p; own_scores(Kl, biasd, qf, ql, kt, w, r, hp, p);
#pragma unroll
        for (int i = 0; i < 16; ++i) { p[i] = fexp2(p[i] - mx); ls += p[i]; }
#pragma unroll
        for (int s = 0; s < 2; ++s) {
            const f32x8 pv = {p[8 * s], p[8 * s + 1], p[8 * s + 2], p[8 * s + 3], p[8 * s + 4], p[8 * s + 5], p[8 * s + 6], p[8 * s + 7]};
            const h8 pf = __builtin_convertvector(pv, h8);
#pragma unroll
            for (int dt = 0; dt < 2; ++dt) {
                LAS const unsigned char* vp = vbase + (32 * kt + 16 * s) * VP64 + 64 * dt;
                const h8 vf = cat44(tr_read(vp), tr_read(vp + 8 * VP64));
                o[dt] = MFMA32(vf, pf, o[dt]);
            }
        }
    }
    ls += __shfl_xor(ls, 32);
    m2 = mx; lsum = ls;
}
__global__ void __launch_bounds__(512, 2) fwd(Args a) {
    extern __shared__ __attribute__((aligned(16))) unsigned char smem[];
    LAS unsigned char* lds = (LAS unsigned char*)smem;
    volatile LAS unsigned* MISC = (volatile LAS unsigned*)(lds + MISC_OFF);
    LAS float* biasl = (LAS float*)(lds + BIAS_OFF);
    const int tid = threadIdx.x, lane = tid & 63, wave = __builtin_amdgcn_readfirstlane(tid >> 6);
    const int G = gridDim.x, bid = blockIdx.x;
    unsigned char* ws = a.ws;
    unsigned* ctl = (unsigned*)(ws + WS_CTL);
#define ropeC ((float*)(ws + WS_ROPEC))
#define ropeS ((float*)(ws + WS_ROPES))
#define xsum ((float*)(ws + WS_XSUM))
#define kmean ((f16*)(ws + WS_KMEAN))
#define WrT ((f16*)(ws + WS_WRT))
#define sumsq ((f16*)(ws + WS_SUMSQ))
#define wts ((float*)(ws + WS_WTS))
#define elist ((int*)(ws + WS_ELIST))
#define mlist ((unsigned short*)(ws + WS_MLIST))
#define pml ((f32x2*)(ws + WS_PML))
#define WinT ((f16*)(ws + WS_WINT))
#define WoT8 ((unsigned char*)(ws + WS_WOT))
#define x8 ((unsigned char*)(ws + WS_X8))
#define WinT8 ((unsigned char*)(ws + WS_WINT8))
#define WguT ((unsigned char*)(ws + WS_WGUT))
#define WdnT ((unsigned char*)(ws + WS_WDNT))
#define hh8 ((unsigned char*)(ws + WS_HH8))
#define PJ ((f16*)(ws + WS_PJ))
#define xh ((f16*)(ws + WS_XH))
#define cat8 ((unsigned char*)(ws + WS_CAT))
#define kvbuf ((float*)(ws + WS_KV))
#define Rbuf ((f16*)(ws + WS_R))
#define hh ((f16*)(ws + WS_HH))
#define hid ((unsigned char*)(ws + WS_HID))
#define ybuf ((unsigned char*)(ws + WS_Y))
#define pO ((unsigned char*)a.out)
#define zbuf ((f16*)a.out)
    unsigned* lcnt = ctl + CW_LCNT; unsigned* ecnt = ctl + CW_ECNT;

    if (tid < 64) MISC[tid] = 0u;
    __syncthreads();
    const int lo = a.ph_lo, hi = a.ph_hi;
    XcdBarrier bar; bar.bar = ctl + CW_BAR; bar.x = 0; bar.st = MISC + 8;
    if (hi - lo > 1) bar = xcd_barrier_post(ctl + CW_BAR, MISC + 8);
#ifndef PH_MASK
#define PH_MASK 0x3ff
#endif
#define IN(k) ((((PH_MASK) >> (k)) & 1) && lo <= (k) && (k) < hi)
#ifndef DUP_PHASE
#define DUP_PHASE -1
#endif
#define REP(k) for (int rep_ = 0; rep_ < ((DUP_PHASE) == (k) ? 2 : 1); ++rep_)
#ifdef PROF_SEG
#ifndef PROF_K
#define PROF_K 4
#endif
#ifndef PROF_WAVE
#define PROF_WAVE 0
#endif
    unsigned long long prof_acc = 0ull, prof_t0 = 0ull;
#ifndef PROF_BLOCK
#define PROF_BLOCK 0
#endif
    const bool prof_on = (bid == PROF_BLOCK && tid == 64 * PROF_WAVE);
#define PROF_B(seg) do { if ((seg) == PROF_SEG) { __builtin_amdgcn_sched_barrier(0); prof_t0 = __builtin_amdgcn_s_memrealtime(); __builtin_amdgcn_sched_barrier(0); } } while (0)
#define PROF_E(seg) do { if ((seg) == PROF_SEG) { __builtin_amdgcn_sched_barrier(0); prof_acc += __builtin_amdgcn_s_memrealtime() - prof_t0; __builtin_amdgcn_sched_barrier(0); } } while (0)
#else
#define PROF_B(seg) do { } while (0)
#define PROF_E(seg) do { } while (0)
#endif
#ifdef DIAG_PHASE
#ifndef DIAG_MODE
#define DIAG_MODE 0
#endif
    unsigned long long tdiag0 = 0ull;
#define DIAG_T0(k) do { if ((k) == DIAG_PHASE) tdiag0 = __builtin_amdgcn_s_memrealtime(); } while (0)
#define DIAG_T1(k, mode) do { if ((k) == DIAG_PHASE && (mode) == DIAG_MODE && bid == 0 && tid == 0) __hip_atomic_store(ctl + 24576, (unsigned)(__builtin_amdgcn_s_memrealtime() - tdiag0), __ATOMIC_RELAXED, __HIP_MEMORY_SCOPE_AGENT); } while (0)
#else
#define DIAG_T0(k) do { } while (0)
#define DIAG_T1(k, mode) do { } while (0)
#endif
#define SEAM(k) do { PROF_E(10 + (k)); PROF_B(20 + (k)); DIAG_T1(k, 1); if (IN(k) && IN((k) + 1)) xcd_barrier(bar); DIAG_T1(k, 0); DIAG_T0((k) + 1); PROF_E(20 + (k)); PROF_B(11 + (k)); } while (0)

    DIAG_T0(0); PROF_B(10);
    if (IN(0)) REP(0) { OPAQUE_TID;
        PROF_B(70);
        for (int hb = bid; hb < 256; hb += G) {
            const int c8 = tid & 127, rq = tid >> 7;
            const float* src = a.x + (size_t)hb * 128 * DM + c8 * 8; const size_t ob = (size_t)hb * 128 * DM + c8 * 8;
            f32x4 s0 = {0.f, 0.f, 0.f, 0.f}, s1 = s0;
#pragma unroll 8
            for (int r = rq; r < 128; r += 4) { const f32x4 v0 = __builtin_nontemporal_load((const f32x4*)(src + (size_t)r * DM)), v1 = __builtin_nontemporal_load((const f32x4*)(src + (size_t)r * DM + 4)); s0 += v0; s1 += v1;
                *(h8*)(xh + ob + (size_t)r * DM) = cvt8(v0, v1); *(u32x2*)(x8 + ob + (size_t)r * DM) = cvt8_fp8(v0, v1); }
            LAS f32x4* red = (LAS f32x4*)lds;
            red[(rq * 128 + c8) * 2] = s0; red[(rq * 128 + c8) * 2 + 1] = s1;
            __syncthreads();
            if (rq == 0) {
#pragma unroll
                for (int q = 1; q < 4; ++q) { s0 += red[(q * 128 + c8) * 2]; s1 += red[(q * 128 + c8) * 2 + 1]; }
                *(f32x4*)(xsum + (size_t)hb * DM + c8 * 8) = s0; *(f32x4*)(xsum + (size_t)hb * DM + c8 * 8 + 4) = s1; }
            __syncthreads();
        }
        PROF_E(70); PROF_B(71);
        for (int idx = bid * 512 + tid; idx < SEQ * 64; idx += G * 512) {
            const int pos = idx >> 6, i = idx & 63;
            const float ang = (float)pos * ROPE_INV[i];
            const double xd = (double)ang, kd = __builtin_rint(xd * 0.6366197723675814);
            double rr = __builtin_fma(-kd, 1.5707963267948966, xd); rr = __builtin_fma(-kd, 6.123233995736766e-17, rr);
            const double r2 = rr * rr;
            const double sp = rr * (1.0 + r2 * (-1.0 / 6 + r2 * (1.0 / 120 + r2 * (-1.0 / 5040 + r2 * (1.0 / 362880 + r2 * (-1.0 / 39916800 + r2 * (1.0 / 6227020800.0)))))));
            const double cp = 1.0 + r2 * (-0.5 + r2 * (1.0 / 24 + r2 * (-1.0 / 720 + r2 * (1.0 / 40320 + r2 * (-1.0 / 3628800 + r2 * (1.0 / 479001600.0 + r2 * (-1.0 / 87178291200.0)))))));
            const int q = (int)kd & 3;
            const double sv = (q == 0) ? sp : (q == 1) ? cp : (q == 2) ? -sp : -cp;
            const double cv = (q == 0) ? cp : (q == 1) ? -sp : (q == 2) ? -cp : sp;
            ropeC[idx] = (float)cv; ropeS[idx] = (float)sv;
        }
        for (int idx = bid * 512 + tid; idx < 48 * DM; idx += G * 512) {
            const int n = idx >> 10, k = idx & 1023;
            const float v = (n < 4) ? a.wrg[k * 4 + n] : (n < 36) ? a.wre[k * 32 + (n - 4)] : 0.f;
            WrT[idx] = (f16)v;
        }
        PROF_E(71); PROF_B(72);
        {
            LAS float* scr = (LAS float*)(lds + wave * 16640);
            constexpr int I_IN = 16 * 64, I_O = 16 * 16, I_GU = 32 * 256, I_DN = 32 * 128, NIT = I_IN + I_O + I_GU + I_DN;
            constexpr int NGRP = NIT / 8;
            static_assert(NIT % 8 == 0, "item groups");
            unsigned* qh = ctl + CW_QH;
            LAS int* qslot = (LAS int*)(lds + 8 * 16640);
            if (tid == 0) qslot[0] = (int)__hip_atomic_fetch_add(qh, 1u, __ATOMIC_RELAXED, __HIP_MEMORY_SCOPE_AGENT);
            __syncthreads();
            int grp = qslot[0];
            for (int rd = 1; grp < NGRP; ++rd) {
                int gn = 0; if (tid == 0) gn = (int)__hip_atomic_fetch_add(qh, 1u, __ATOMIC_RELAXED, __HIP_MEMORY_SCOPE_AGENT);
                int r = grp * 8 + wave;
                do {
                if (r < I_IN) { const int kb = r >> 6, nb2 = r & 63, nb = nb2 < 56 ? nb2 : nb2 - 48, pn = nb >> 2, g = nb & 3;
                    const bool rope = pn >= 6 && pn <= 9;
                    const int nsrc = rope ? pn * 256 + 128 * (g & 1) + 64 * (g >> 1) : pn * 256 + 128 * (g & 1) + 32 * (g >> 1);
                    const int nsrc1 = rope ? nsrc + 32 : nsrc + 64;
                    if (nb2 < 16) tr_item64<false>(a.w_in, NPJ, 64 * kb, nsrc, nsrc1, WinT, DM, 64 * nb, 1.0f, nullptr, scr, lane);
                    else tr_item64<true>(a.w_in, NPJ, 64 * kb, nsrc, nsrc1, WinT8, DM, 64 * nb - 512, 32.0f, nullptr, scr, lane);
                    break; } r -= I_IN;
                if (r < I_O) { const int kb = r / 16, nb = r % 16, pn = nb >> 2, g = nb & 3; const int nsrc = pn * 256 + 128 * (g & 1) + 32 * (g >> 1);
                    tr_item64<true>(a.w_out, DM, 64 * kb, nsrc, nsrc + 64, WoT8, DM, 64 * nb, 64.0f, kb < 8 ? a.gain : nullptr, scr, lane); break; } r -= I_O;
                if (r < I_GU) { const int e = r >> 8, rr = r & 255, kb = rr >> 4, nb = rr & 15, pn = nb >> 2, g = nb & 3;
                    const int nsrc = (g >> 1) * 512 + 128 * pn + 64 * (g & 1);
                    tr_item64<true>(a.wgu + (size_t)e * DM * DM, DM, 64 * kb, nsrc, nsrc + 32, WguT + (size_t)e * DM * DM, DM, 64 * nb, 64.0f, nullptr, scr, lane); break; } r -= I_GU;
                { const int e = r >> 7, rr = r & 127, kb = rr >> 4, nb = rr & 15;
                    tr_item64<true>(a.wdn + (size_t)e * DE * DM, DM, 64 * kb, 64 * nb, 64 * nb + 32, WdnT + (size_t)e * DM * DE, DE, 64 * nb, 32.0f, nullptr, scr, lane); }
                } while (0);
                if (tid == 0) qslot[rd & 1] = gn;
                __syncthreads();
                grp = qslot[rd & 1];
            }
        }
        PROF_E(72);
        __syncthreads();
    }
    SEAM(0);

    if (IN(1)) { OPAQUE_TID;
#ifdef PROF_GP_PHASE
        if (tid == 0) MISC[17] = (1 == PROF_GP_PHASE) ? 1u : 0u;
        __syncthreads();
#endif
        for (int job = bid; job < 256; job += G) { const int blk = job >> 1, hf = job & 1;
            LAS float* xm = (LAS float*)lds;
            for (int k = tid; k < DM; k += 512) xm[k] = (xsum[(size_t)(2 * blk) * DM + k] + xsum[(size_t)(2 * blk + 1) * DM + k]) * (1.0f / 256.0f);
            __syncthreads();
            f32x8 xv[2];
#pragma unroll
            for (int j = 0; j < 2; ++j)
#pragma unroll
                for (int e = 0; e < 8; ++e) xv[j][e] = xm[8 * lane + 512 * j + e];
            const int b = blk >> 6, jb = blk & 63;
#pragma unroll 8
            for (int r2 = 0; r2 < 32; ++r2) { const int rr = 32 * hf + r2, n = 64 * wave + rr;
                const int Lc = n & 255, prow = C_AK + (n & 256) + 128 * ((Lc >> 5) & 1) + 32 * (Lc >> 6) + (Lc & 31);
                const f16* wrow = WinT + (size_t)prow * DM + 8 * lane; float acc = 0.f;
#pragma unroll
                for (int j = 0; j < 2; ++j) { const f32x8 wv = __builtin_convertvector(*(const h8*)(wrow + 512 * j), f32x8);
#pragma unroll
                    for (int e = 0; e < 8; ++e) acc += wv[e] * xv[j][e]; }
                acc = wave_sum(acc);
                if (lane == 0) kmean[((size_t)(b * 8 + wave) * 64 + jb) * 64 + rr] = (f16)acc; }
            __syncthreads();
        }
        const int late16 = bid & 1;
        { pg8::StaticOrder S; S.init(xh, WinT, DM, DM, NTOK, 512, G, bid); if (late16) S.nwg = 0;
          EpiProj E{PJ, ropeC, ropeS, 0, 1.0f, lds + pg8::STAGE_BYTES + 4096};
          pg8::gemm_phase<EpiProj, pg8::StaticOrder, true>(lds, DM, DM / 64, S, E); }
        { pg8::StaticOrder S; S.init(x8, WinT8, DM, DM, NTOK, NPJ - 512, G, bid, 1);
          EpiProj E{PJ, ropeC, ropeS, 2, 1.0f / 32.0f, lds + pg8::STAGE_BYTES + 4096};
          pg8::gemm_phase8<EpiProj, pg8::StaticOrder, true>(lds, DM, DM / 128, S, E); }
        { pg8::StaticOrder S; S.init(xh, WinT, DM, DM, NTOK, 512, G, bid); if (!late16) S.nwg = 0;
          EpiProj E{PJ, ropeC, ropeS, 0, 1.0f, lds + pg8::STAGE_BYTES + 4096};
          pg8::gemm_phase<EpiProj, pg8::StaticOrder, true>(lds, DM, DM / 64, S, E); }
    }
    SEAM(1);

    if (IN(2)) REP(2) { OPAQUE_TID;
        constexpr int NU_G = 16 * 63, NU_KV = 8 * 64;
        unsigned* lcnt_w = (rep_ | a.alt) ? lcnt + 16 : lcnt; unsigned short* mlist_w = (rep_ | a.alt) ? (unsigned short*)(ws + 480 * MiB) : mlist;
        constexpr int P2_MAXG = 4;
        LAS unsigned* histA = (LAS unsigned*)(lds + 96 * 1024);
        LAS unsigned* pendA = (LAS unsigned*)(lds + 100 * 1024);
        LAS int* gmeta = (LAS int*)(lds + 114 * 1024);
        int gi = 0;
        for (int k = tid; k < P2_MAXG * 128; k += 512) histA[k] = 0u;
        auto flush = [&]() {
            __syncthreads();
            if (tid < 64 * gi) { const int g2 = tid >> 6, blk = tid & 63; const unsigned n = histA[g2 * 128 + blk]; unsigned base = 0u; if (n) base = atomicAdd(lcnt_w + (gmeta[g2] * 64 + blk) * 32, n); histA[g2 * 128 + 64 + blk] = base; }
            __syncthreads();
            for (int idx = tid; idx < gi * 768; idx += 512) { const unsigned v = pendA[idx];
                if (v != 0xFFFFFFFFu) { const int g2 = idx / 768, bh2 = gmeta[g2], lb = (int)((v >> 16) & 63u); const unsigned pos = histA[g2 * 128 + 64 + lb] + (v >> 22);
                    mlist_w[(size_t)bh2 * MLIST_PER_BH + (size_t)lb * SEQ - 128 * lb * (lb + 1) + pos] = (unsigned short)(v & 0xFFFFu); } }
            __syncthreads();
            for (int k = tid; k < P2_MAXG * 128; k += 512) histA[k] = 0u;
            gi = 0;
            __syncthreads();
        };
        __syncthreads();
        const int nlast = bid < NU_G + NU_KV ? (NU_G + NU_KV - 1 - bid) / G : -1;
        for (int ku = 0; ku <= nlast; ++ku) { const int u = (bid & 1) ? bid + G * (nlast - ku) : bid + G * ku;
            if (u < NU_KV) {
                const int bh = u >> 6, ci = u & 63, b = bh >> 2, h = bh & 3;
                const float lg = gamma_log2(h);
                const unsigned char* kp = ret8_ptr(PJ, 4, bh, ci * 256);
                const unsigned char* vp = ret8_ptr(PJ, 5, bh, ci * 256);
                LAS unsigned char* Kl = lds; LAS unsigned char* Vl = lds + 128 * 320;
                const int dvt = wave & 3, dk0 = 2 * (wave >> 2);
                f32x16 acc[2];
#pragma unroll
                for (int t = 0; t < 2; ++t)
#pragma unroll
                    for (int i = 0; i < 16; ++i) acc[t][i] = 0.f;
                const int r = lane & 31, hp = lane >> 5, i16 = lane & 15, q4 = i16 >> 2, p4 = i16 & 3, cb = (lane >> 4) & 1;
                for (int half = 0; half < 2; ++half) {
#pragma unroll
                    for (int i = 0; i < 2; ++i) { const int q = tid + 512 * i, row = q >> 3, ch = q & 7; const int key = half * 128 + row; h8 lo, hi;
                        cvt16_fp8_h(*(const u32x4*)(kp + (size_t)key * 128 + 16 * ch), lo, hi); const float sc = fexp2(lg * (float)(255 - key) - 3.0f);
                        const f32x8 kl = __builtin_convertvector(lo, f32x8) * sc, kh = __builtin_convertvector(hi, f32x8) * sc;
                        *(LAS h8*)(Kl + row * 320 + 32 * ch) = __builtin_convertvector(kl, h8); *(LAS h8*)(Kl + row * 320 + 32 * ch + 16) = __builtin_convertvector(kh, h8); }
#pragma unroll
                    for (int i = 0; i < 2; ++i) { const int q = tid + 512 * i, row = q >> 3, ch = q & 7; const int key = half * 128 + row; h8 lo, hi;
                        cvt16_fp8_h(*(const u32x4*)(vp + (size_t)key * 128 + 16 * ch), lo, hi); *(LAS h8*)(Vl + row * 320 + 32 * ch) = lo; *(LAS h8*)(Vl + row * 320 + 32 * ch + 16) = hi; }
                    __syncthreads();
#pragma unroll
                    for (int s = 0; s < 8; ++s) {
                        LAS const unsigned char* ap = Vl + (16 * s + 8 * hp + q4) * 320 + 2 * (32 * dvt + 16 * cb + 4 * p4);
                        const h8 af = cat44(tr_read(ap), tr_read(ap + 4 * 320));
#pragma unroll
                        for (int t = 0; t < 2; ++t) {
                            LAS const unsigned char* bp = Kl + (16 * s + 8 * hp + q4) * 320 + 2 * (32 * (dk0 + t) + 16 * cb + 4 * p4);
                            const h8 bf = cat44(tr_read(bp), tr_read(bp + 4 * 320));
                            acc[t] = MFMA32(af, bf, acc[t]);
                        }
                    }
                    __syncthreads();
                }
                float* dst = kvbuf + (size_t)u * 128 * 128;
#pragma unroll
                for (int t = 0; t < 2; ++t)
#pragma unroll
                    for (int i = 0; i < 16; ++i) dst[(32 * dvt + crow(i, hp)) * 128 + 32 * (dk0 + t) + r] = acc[t][i];
            } else {
                const int uu = u - NU_KV, bh = uu / 63, c = 1 + uu % 63, b = bh >> 3, h = bh & 7;
                const int r = lane & 31, hp = lane >> 5;
                const int s = 256 * c + 32 * wave + r;
                const f16* qrow = att_ptr(PJ, 0, bh, s);
                h8 qf[4];
#pragma unroll
                for (int ks = 0; ks < 4; ++ks) qf[ks] = *(const h8*)(qrow + 16 * ks + 8 * hp);
                const f16* km = kmean + (size_t)bh * 64 * 64;
                float v[2][16];
#pragma unroll
                for (int t = 0; t < 2; ++t) {
                    f32x16 g;
#pragma unroll
                    for (int i = 0; i < 16; ++i) g[i] = 0.f;
                    if (t == 0 || c > 32) {
#pragma unroll
                        for (int ks = 0; ks < 4; ++ks) { const h8 kf = *(const h8*)(km + (32 * t + r) * 64 + 16 * ks + 8 * hp); g = MFMA32(kf, qf[ks], g); }
                    }
#pragma unroll
                    for (int i = 0; i < 16; ++i) v[t][i] = (32 * t + crow(i, hp) < c) ? g[i] : -3.0e38f;
                }
                int sel[3]; bool sval[3];
#pragma unroll
                for (int rd = 0; rd < 3; ++rd) {
                    float mv = -3.0e38f; int mi = 1 << 20;
#pragma unroll
                    for (int t = 0; t < 2; ++t)
#pragma unroll
                        for (int i = 0; i < 16; ++i) { const int idx = 32 * t + crow(i, hp); const float val = v[t][i]; if (val > mv || (val == mv && idx < mi)) { mv = val; mi = idx; } }
                    const float ov = __shfl_xor(mv, 32); const int oi = __shfl_xor(mi, 32);
                    if (ov > mv || (ov == mv && oi < mi)) { mv = ov; mi = oi; }
                    sel[rd] = mi; sval[rd] = mv > -1.0e38f;
#pragma unroll
                    for (int t = 0; t < 2; ++t)
#pragma unroll
                        for (int i = 0; i < 16; ++i) if (32 * t + crow(i, hp) == mi) v[t][i] = -3.0e38f;
                }
                if (tid == 0) gmeta[gi] = bh;
                if (hp == 0) {
#pragma unroll
                    for (int rd = 0; rd < 3; ++rd) { unsigned v = 0xFFFFFFFFu;
                        if (sval[rd]) { const unsigned rank = __hip_atomic_fetch_add(histA + gi * 128 + sel[rd], 1u, __ATOMIC_RELAXED, __HIP_MEMORY_SCOPE_WORKGROUP); v = (unsigned)((s << 2) | rd) | ((unsigned)sel[rd] << 16) | (rank << 22); }
                        pendA[gi * 768 + (32 * wave + r) * 3 + rd] = v; } }
                ++gi;
                if (gi == P2_MAXG) flush();
            }
        }
        if (gi > 0) flush();
    }
    if (IN(3)) { int tq = threadIdx.x; asm volatile("" : "+v"(tq));
        for (int idx = tq; idx < 8 * BTP; idx += 512) { const int h = idx / BTP, d = idx % BTP - 31, dd = d > 128 ? 128 : d; biasl[idx] = d < 0 ? 0.f : a.rel[(int)T5_BUCKET[dd] * 8 + h] * LOG2E; } }
    SEAM(2);

    if (IN(3)) REP(3) { OPAQUE_TID;
        const int c0 = (int)lcnt[(2 * tid) * 32], c1 = (int)lcnt[(2 * tid + 1) * 32];
        PROF_B(33);
        auto scan_states = [&]() __attribute__((always_inline)) {
        if (!(a.alt & 2)) for (int gid = bid * 512 + tid; gid < 8 * 16384; gid += G * 512) {
            const int bh = gid >> 14, e = gid & 16383, h = bh & 3;
            const float cd = fexp2(256.0f * gamma_log2(h));
            const float* src = kvbuf + (size_t)bh * 64 * 16384 + e; f16* dst = Rbuf + (size_t)bh * 64 * 16384 + e;
            float run = 0.f;
#pragma unroll 32
            for (int i = 0; i < 64; ++i) { dst[(size_t)i * 16384] = (f16)run; run = run * cd + src[(size_t)i * 16384]; }
        }
        };
        const bool scan_late = (bid & 1) != 0;
        if (!scan_late) scan_states();
        PROF_E(33); PROF_B(32);
        LAS int* pre = (LAS int*)(lds + 96 * 1024);
        LAS int* cpre = pre + 1032;
        LAS int* wsum = cpre + 1032;
        {
            const int n0 = (c0 + 255) >> 8, n1 = (c1 + 255) >> 8;
            const int k0 = n0 ? 5 * n0 + 1 : 0, k1 = n1 ? 5 * n1 + 1 : 0;
            int v = n0 + n1, incl = v, cv = k0 + k1, cincl = cv;
#pragma unroll
            for (int o = 1; o < 64; o <<= 1) { const int t = __shfl_up(incl, o), ct = __shfl_up(cincl, o); if (lane >= o) { incl += t; cincl += ct; } }
            if (lane == 63) { wsum[wave] = incl; wsum[8 + wave] = cincl; }
            __syncthreads();
            int woff = 0, cwoff = 0;
            for (int k = 0; k < wave; ++k) { woff += wsum[k]; cwoff += wsum[8 + k]; }
            const int ex = woff + incl - v, cex = cwoff + cincl - cv;
            pre[2 * tid] = ex; pre[2 * tid + 1] = ex + n0; cpre[2 * tid] = cex; cpre[2 * tid + 1] = cex + k0;
            if (tid == 511) { pre[1024] = ex + v; cpre[1024] = cex + cv; }
            __syncthreads();
        }
        PROF_E(32);
        const int U = pre[1024], CT = cpre[1024];
        int ubnd[2];
#pragma unroll
        for (int e = 0; e < 2; ++e) {
            const int x = (int)(((long)CT * (bid + e)) / G);
            int l = 0;
#pragma unroll 1
            for (int step = 512; step > 0; step >>= 1) if (l + step <= 1023 && cpre[l + step] <= x) l += step;
            const int rem = x - cpre[l], n = pre[l + 1] - pre[l];
            int ch = rem <= 0 ? 0 : (rem - 1 + 4) / 5; ch = (rem > 0 && ch < 1) ? 1 : ch; ch = ch > n ? n : ch;
            ubnd[e] = (x >= CT) ? U : pre[l] + ch;
        }
        const int u_lo = ubnd[0], u_hi = (a.alt & 4) ? u_lo : ubnd[1];
        LAS unsigned char* Kl = lds; LAS unsigned char* Vl = lds + 256 * KP64;
        constexpr int NUB = 32;
        LAS int* uinf = (LAS int*)(lds + 108 * 1024);
        LAS unsigned short* uent = (LAS unsigned short*)(lds + 112 * 1024);
        int staged = -1, pref = -1;
        u32x4 kr[2], vr[2];
        const int r = lane & 31, hp = lane >> 5;
        if (u_lo < u_hi) {
            int l0 = 0;
#pragma unroll 1
            for (int step = 512; step > 0; step >>= 1) if (l0 + step <= 1023 && pre[l0 + step] <= u_lo) l0 += step;
            const unsigned char* kp0 = att8_ptr(PJ, 1, l0 >> 6, (l0 & 63) * 256);
#pragma unroll
            for (int k = 0; k < 2; ++k) { const int q = tid + 512 * k, row = q >> 2, ch = q & 3; kr[k] = *(const u32x4*)(kp0 + (size_t)row * 64 + 16 * ch); vr[k] = *(const u32x4*)(kp0 + 2 * PJ_SLICE + (size_t)row * 64 + 16 * ch); }
            pref = l0; }
        for (int ub = u_lo; ub < u_hi; ub += NUB) {
            const int nu = (u_hi - ub) < NUB ? (u_hi - ub) : NUB;
            __syncthreads();
            if (tid < nu) { const int u = ub + tid; int l = 0;
#pragma unroll 1
                for (int step = 512; step > 0; step >>= 1) if (l + step <= 1023 && pre[l + step] <= u) l += step;
                const int chunk = u - pre[l]; int rows = (int)lcnt[l * 32] - 256 * chunk; rows = rows > 256 ? 256 : rows;
                uinf[4 * tid] = l; uinf[4 * tid + 1] = chunk; uinf[4 * tid + 2] = rows; }
            __syncthreads();
            for (int i = tid >> 8; i < nu; i += 2) { const int l = uinf[4 * i], chunk = uinf[4 * i + 1], rows = uinf[4 * i + 2], ri = tid & 255, bh = l >> 6, j = l & 63;
                uent[i * 256 + ri] = mlist[(size_t)bh * MLIST_PER_BH + (size_t)j * SEQ - 128 * j * (j + 1) + 256 * chunk + (ri < rows ? ri : 0)]; }
            __syncthreads();
            h8 qn[4];
            { const int l = uinf[0], bh = l >> 6; const unsigned ent = uent[32 * wave + r]; const int s = (int)(ent >> 2);
              const f16* qrow = att_ptr(PJ, 0, bh, s);
#pragma unroll
              for (int ks = 0; ks < 4; ++ks) qn[ks] = *(const h8*)(qrow + 16 * ks + 8 * hp); }
            for (int i = 0; i < nu; ++i) {
                const int l = uinf[4 * i], rows = uinf[4 * i + 2], bh = l >> 6, j = l & 63, b = bh >> 3, h = bh & 7;
                const unsigned ent = uent[i * 256 + 32 * wave + r];
                h8 qf[4];
#pragma unroll
                for (int ks = 0; ks < 4; ++ks) qf[ks] = qn[ks];
                if (i + 1 < nu) { const int l2 = uinf[4 * (i + 1)], bh2 = l2 >> 6; const unsigned e2 = uent[(i + 1) * 256 + 32 * wave + r]; const int s2 = (int)(e2 >> 2);
                    const f16* qrow = att_ptr(PJ, 0, bh2, s2);
#pragma unroll
                    for (int ks = 0; ks < 4; ++ks) qn[ks] = *(const h8*)(qrow + 16 * ks + 8 * hp); }
                PROF_B(30);
                if (l != staged) {
                    __syncthreads();
                    if (l == pref) {
#pragma unroll
                        for (int k = 0; k < 2; ++k) { const int q = tid + 512 * k, row = q >> 2, ch = q & 3; h8 lo, hi;
                            cvt16_fp8_h(kr[k], lo, hi); *(LAS h8*)(Kl + row * KP64 + 32 * ch) = lo; *(LAS h8*)(Kl + row * KP64 + 32 * ch + 16) = hi;
                            cvt16_fp8_h(vr[k], lo, hi); *(LAS h8*)(Vl + row * VP64 + 32 * ch) = lo; *(LAS h8*)(Vl + row * VP64 + 32 * ch + 16) = hi; }
                    } else {
                        stage64_8<KP64>(Kl, att8_ptr(PJ, 1, bh, j * 256), tid);
                        stage64_8<VP64>(Vl, att8_ptr(PJ, 2, bh, j * 256), tid);
                    }
                    __syncthreads();
                    staged = l;
                }
                PROF_E(30); PROF_B(31);
                if (i + 1 < nu) { const int l2 = uinf[4 * (i + 1)];
                    if (l2 != staged && l2 != pref) { const unsigned char* kp2 = att8_ptr(PJ, 1, l2 >> 6, (l2 & 63) * 256);
#pragma unroll
                        for (int k = 0; k < 2; ++k) { const int q = tid + 512 * k, row = q >> 2, ch = q & 3; kr[k] = *(const u32x4*)(kp2 + (size_t)row * 64 + 16 * ch); vr[k] = *(const u32x4*)(kp2 + 2 * PJ_SLICE + (size_t)row * 64 + 16 * ch); }
                        pref = l2; } }
                if (32 * wave < rows) {
                    const bool valid = 32 * wave + r < rows;
                    const int s = (int)(ent >> 2), slot = (int)(ent & 3u);
                    float m2, ls; f32x16 o[2];
                    attn_tile<false>(Kl, Vl, biasl + h * BTP, qf, s - 256 * j, 0, lane, m2, ls, o);
                    if (valid) {
                        const size_t pidx = ((size_t)bh * SEQ + s) * 3 + slot;
                        if (hp == 0) pml[pidx] = (f32x2){m2, ls};
                        const float inv = 16.0f / ls; unsigned char* po = pO + pidx * 64 + 16 * hp;
#pragma unroll
                        for (int dt = 0; dt < 2; ++dt) { u32x2 w2[2];
#pragma unroll
                            for (int g2 = 0; g2 < 2; ++g2) w2[g2] = cvt8_fp8((f32x4){o[dt][8 * g2] * inv, o[dt][8 * g2 + 1] * inv, o[dt][8 * g2 + 2] * inv, o[dt][8 * g2 + 3] * inv}, (f32x4){o[dt][8 * g2 + 4] * inv, o[dt][8 * g2 + 5] * inv, o[dt][8 * g2 + 6] * inv, o[dt][8 * g2 + 7] * inv});
                            *(u32x4*)(po + 32 * dt) = (u32x4){w2[0][0], w2[0][1], w2[1][0], w2[1][1]}; }
                    }
                }
                PROF_E(31);
            }
        }
        if (scan_late) scan_states();
        __syncthreads();
    }
    SEAM(3);

    if (IN(4)) REP(4) { OPAQUE_TID;
        if (lo == 4) { for (int idx = tid; idx < 8 * BTP; idx += 512) { const int h = idx / BTP, d = idx % BTP - 31, dd = d > 128 ? 128 : d; biasl[idx] = d < 0 ? 0.f : a.rel[(int)T5_BUCKET[dd] * 8 + h] * LOG2E; } __syncthreads(); }
        constexpr int NU_A = 16 * 64, NU_R = 8 * 64;
        const int r = lane & 31, hp = lane >> 5;
        u32x4 kr[2], vr[2]; h8 qn[4];
        const int qt = wave < 4 ? wave : 11 - wave;
        int uu = (a.alt & 4) ? NU_A : bid;
        if (uu < NU_A) { const int bh = uu >> 6, c = uu & 63; const unsigned char* kp = att8_ptr(PJ, 1, bh, c * 256);
#pragma unroll
            for (int i = 0; i < 2; ++i) { const int q = tid + 512 * i, row = q >> 2, ch = q & 3; kr[i] = *(const u32x4*)(kp + (size_t)row * 64 + 16 * ch); vr[i] = *(const u32x4*)(kp + 2 * PJ_SLICE + (size_t)row * 64 + 16 * ch); } }
        for (int u = (a.alt & 2) ? NU_R : bid; u < NU_R; u += G) {
            __syncthreads();
            {
                const int bh = u >> 6, ci = u & 63, b = bh >> 2, h = bh & 3;
                const float lg = gamma_log2(h);
                const size_t row0 = (size_t)b * SEQ + ci * 256;
                LAS unsigned char* Rl = lds; LAS unsigned char* Kl = lds + 128 * 272; LAS unsigned char* Vl = lds + 2 * 128 * 272;
                PROF_B(40);
                const int r = lane & 31, hp = lane >> 5, i16 = lane & 15, q4 = i16 >> 2, p4 = i16 & 3, cb = (lane >> 4) & 1;
                const int qt = wave < 4 ? wave : 11 - wave;
                const int ql = 32 * qt + r;
                const f16* Rt = Rbuf + (size_t)u * 128 * 128;
                const unsigned char* kg = ret8_ptr(PJ, 4, bh, ci * 256); const unsigned char* vg = ret8_ptr(PJ, 5, bh, ci * 256);
#pragma unroll
                for (int i = 0; i < 4; ++i) { const int q = tid + 512 * i, row = q >> 4, ch = q & 15;
                    *(LAS h8*)(Rl + row * 272 + 16 * ch) = *(const h8*)(Rt + row * 128 + 8 * ch); }
#pragma unroll
                for (int i = 0; i < 2; ++i) { const int q = tid + 512 * i, row = q >> 3, ch = q & 7; h8 lo, hi;
                    cvt16_fp8_h(*(const u32x4*)(kg + (size_t)row * 128 + 16 * ch), lo, hi); *(LAS h8*)(Kl + row * 272 + 32 * ch) = lo; *(LAS h8*)(Kl + row * 272 + 32 * ch + 16) = hi;
                    cvt16_fp8_h(*(const u32x4*)(vg + (size_t)row * 128 + 16 * ch), lo, hi); *(LAS h8*)(Vl + row * 320 + 32 * ch) = lo; *(LAS h8*)(Vl + row * 320 + 32 * ch + 16) = hi; }
                const unsigned char* qrow = ret8_ptr(PJ, 3, bh, ci * 256 + ql);
                h8 qf[8];
                { u32x2 qw[8];
#pragma unroll
                  for (int ks = 0; ks < 8; ++ks) qw[ks] = *(const u32x2*)(qrow + 16 * ks + 8 * hp);
#pragma unroll
                  for (int ks = 0; ks < 8; ++ks) { const int w0 = (int)qw[ks][0], w1 = (int)qw[ks][1];
                      const f32x8 qv = {__builtin_amdgcn_cvt_f32_fp8(w0, 0), __builtin_amdgcn_cvt_f32_fp8(w0, 1), __builtin_amdgcn_cvt_f32_fp8(w0, 2), __builtin_amdgcn_cvt_f32_fp8(w0, 3),
                                        __builtin_amdgcn_cvt_f32_fp8(w1, 0), __builtin_amdgcn_cvt_f32_fp8(w1, 1), __builtin_amdgcn_cvt_f32_fp8(w1, 2), __builtin_amdgcn_cvt_f32_fp8(w1, 3)};
                      qf[ks] = __builtin_convertvector(qv, h8); } }
                __syncthreads();
                PROF_E(40); PROF_B(41);
                const unsigned char* grow = ret8_ptr(PJ, 6, bh, ci * 256 + ql);
                unsigned rgv[16];
                f32x16 o[4];
#pragma unroll
                for (int t = 0; t < 4; ++t)
#pragma unroll
                    for (int i = 0; i < 16; ++i) o[t][i] = 0.f;
#pragma unroll
                for (int t = 0; t < 4; ++t)
#pragma unroll
                    for (int ks = 0; ks < 8; ++ks) { const h8 rf = *(const LAS h8*)(Rl + (32 * t + r) * 272 + 32 * ks + 16 * hp); o[t] = MFMA32(rf, qf[ks], o[t]); }
                const float qd = fexp2(lg * (float)(ql + 1));
#pragma unroll
                for (int t = 0; t < 4; ++t)
#pragma unroll
                    for (int i = 0; i < 16; ++i) o[t][i] *= qd;
                PROF_E(41); PROF_B(42);
                u32x4 k2[2], v2[2];
                asm volatile("" ::: "memory");
#pragma unroll
                for (int i = 0; i < 2; ++i) { const int q = tid + 512 * i, row = 128 + (q >> 3), ch = q & 7; k2[i] = *(const u32x4*)(kg + (size_t)row * 128 + 16 * ch); v2[i] = *(const u32x4*)(vg + (size_t)row * 128 + 16 * ch); }
                LAS const unsigned char* vbase = Vl + (4 * hp + q4) * 320 + 2 * (16 * cb + 4 * p4);
#pragma unroll 1
                for (int half = 0; half < 2; ++half) {
                    if (half == 1) {
                        __syncthreads();
#pragma unroll
                        for (int i = 0; i < 2; ++i) { const int q = tid + 512 * i, row = q >> 3, ch = q & 7; h8 lo, hi; cvt16_fp8_h(k2[i], lo, hi); *(LAS h8*)(Kl + row * 272 + 32 * ch) = lo; *(LAS h8*)(Kl + row * 272 + 32 * ch + 16) = hi; }
#pragma unroll
                        for (int i = 0; i < 2; ++i) { const int q = tid + 512 * i, row = q >> 3, ch = q & 7; h8 lo, hi; cvt16_fp8_h(v2[i], lo, hi); *(LAS h8*)(Vl + row * 320 + 32 * ch) = lo; *(LAS h8*)(Vl + row * 320 + 32 * ch + 16) = hi; }
#pragma unroll
                        for (int g = 0; g < 16; ++g) rgv[g] = *(const unsigned*)(grow + 8 * g + 4 * hp);
                        __syncthreads();
                    }
                    const int kt_hi = qt < 4 * half + 3 ? qt : 4 * half + 3;
                    for (int kt = 4 * half; kt <= kt_hi; ++kt) {
                        const int kl = kt - 4 * half;
                        f32x16 st;
#pragma unroll
                        for (int i = 0; i < 16; ++i) st[i] = 0.f;
#pragma unroll
                        for (int ks = 0; ks < 8; ++ks) { const h8 kf = *(const LAS h8*)(Kl + (32 * kl + r) * 272 + 32 * ks + 16 * hp); st = MFMA32(kf, qf[ks], st); }
#pragma unroll
                        for (int i = 0; i < 16; ++i) { const int dist = ql - (32 * kt + crow(i, hp)); st[i] = dist >= 0 ? st[i] * fexp2(lg * (float)dist - 3.0f) : 0.f; }
#pragma unroll
                        for (int s = 0; s < 2; ++s) {
                            const f32x8 pv = {st[8 * s], st[8 * s + 1], st[8 * s + 2], st[8 * s + 3], st[8 * s + 4], st[8 * s + 5], st[8 * s + 6], st[8 * s + 7]};
                            const h8 pf = __builtin_convertvector(pv, h8);
#pragma unroll
                            for (int t = 0; t < 4; ++t) {
                                LAS const unsigned char* vp = vbase + (32 * kl + 16 * s) * 320 + 64 * t;
                                const h8 vf = cat44(tr_read(vp), tr_read(vp + 8 * 320));
                                o[t] = MFMA32(vf, pf, o[t]);
                            }
                        }
                    }
                }
                PROF_E(42); PROF_B(43);
                float sm = 0.f;
#pragma unroll
                for (int t = 0; t < 4; ++t)
#pragma unroll
                    for (int i = 0; i < 16; ++i) sm += o[t][i];
                sm += __shfl_xor(sm, 32);
                const float mu = sm * (1.0f / 128.0f);
                float sq = 0.f;
#pragma unroll
                for (int t = 0; t < 4; ++t)
#pragma unroll
                    for (int i = 0; i < 16; ++i) { const float d = o[t][i] - mu; sq += d * d; }
                sq += __shfl_xor(sq, 32);
                const float rstd = 1.0f / sqrtf(sq * (1.0f / 128.0f) + LN_EPS);
                unsigned char* crow_ = cat8 + (row0 + ql) * DM + 512 + h * 128 + 16 * hp;
#pragma unroll
                for (int t = 0; t < 4; ++t) {
                    int wd[4];
#pragma unroll
                    for (int g = 0; g < 4; ++g) { const int gw = (int)rgv[4 * t + g]; const f32x4 gv = {__builtin_amdgcn_cvt_f32_fp8(gw, 0), __builtin_amdgcn_cvt_f32_fp8(gw, 1), __builtin_amdgcn_cvt_f32_fp8(gw, 2), __builtin_amdgcn_cvt_f32_fp8(gw, 3)}; f32x4 ov;
#pragma unroll
                        for (int e = 0; e < 4; ++e) { const float gg = gv[e]; const float sl = gg / (1.0f + fexp2(-gg * LOG2E)); ov[e] = sl * (o[t][4 * g + e] - mu) * rstd; }
                        wd[g] = cvt4_fp8(ov); }
                    const int r0 = __shfl_xor(hp ? wd[0] : wd[2], 32), r1 = __shfl_xor(hp ? wd[1] : wd[3], 32);
                    const i32x4v pk = hp ? (i32x4v){r0, wd[2], r1, wd[3]} : (i32x4v){wd[0], r0, wd[1], r1};
                    *(i32x4v*)(crow_ + 32 * t) = pk; }
                PROF_E(43);
            }
        }
        {
            LAS unsigned char* Kl = lds; LAS unsigned char* Vl = lds + 256 * KP64;
            if (uu < NU_A) { const int bh = uu >> 6, c = uu & 63; const f16* qrow = att_ptr(PJ, 0, bh, 256 * c + 32 * qt + r);
#pragma unroll
                for (int ks = 0; ks < 4; ++ks) qn[ks] = *(const h8*)(qrow + 16 * ks + 8 * hp); }
            for (; uu < NU_A; uu += G) {
                const int bh = uu >> 6, c = uu & 63, b = bh >> 3, h = bh & 7;
                PROF_B(44);
                __syncthreads();
#pragma unroll
                for (int i = 0; i < 2; ++i) { const int q = tid + 512 * i, row = q >> 2, ch = q & 3; h8 lo, hi;
                    cvt16_fp8_h(kr[i], lo, hi); *(LAS h8*)(Kl + row * KP64 + 32 * ch) = lo; *(LAS h8*)(Kl + row * KP64 + 32 * ch + 16) = hi;
                    cvt16_fp8_h(vr[i], lo, hi); *(LAS h8*)(Vl + row * VP64 + 32 * ch) = lo; *(LAS h8*)(Vl + row * VP64 + 32 * ch + 16) = hi; }
                __syncthreads();
                h8 qf[4];
#pragma unroll
                for (int ks = 0; ks < 4; ++ks) qf[ks] = qn[ks];
                if (uu + G < NU_A) { const int u2 = uu + G, bh2 = u2 >> 6, c2 = u2 & 63; const unsigned char* kp = att8_ptr(PJ, 1, bh2, c2 * 256);
                    { const f16* qrow = att_ptr(PJ, 0, bh2, 256 * c2 + 32 * qt + r);
#pragma unroll
                      for (int ks = 0; ks < 4; ++ks) qn[ks] = *(const h8*)(qrow + 16 * ks + 8 * hp); }
#pragma unroll
                    for (int i = 0; i < 2; ++i) { const int q = tid + 512 * i, row = q >> 2, ch = q & 3; kr[i] = *(const u32x4*)(kp + (size_t)row * 64 + 16 * ch); vr[i] = *(const u32x4*)(kp + 2 * PJ_SLICE + (size_t)row * 64 + 16 * ch); } }
                const int ql = 32 * qt + r, s = 256 * c + ql;
                const int nsel = c < 3 ? c : 3;
                const size_t pidx = ((size_t)bh * SEQ + s) * 3;
                float pm[3], pl[3]; u32x4 pv[3][2];
#pragma unroll
                for (int t = 0; t < 3; ++t) { const f32x2 v = pml[pidx + t]; pm[t] = v[0]; pl[t] = v[1]; const unsigned char* po = pO + (pidx + t) * 64 + 16 * hp;
#pragma unroll
                    for (int k = 0; k < 2; ++k) pv[t][k] = *(const u32x4*)(po + 32 * k); }
                PROF_E(44); PROF_B(45);
                float m2, ls; f32x16 o[2];
                attn_own(Kl, Vl, biasl + h * BTP, qf, ql, qt, lane, m2, ls, o);
                PROF_E(45); PROF_B(46);
#pragma unroll
                for (int t = 0; t < 3; ++t) { const bool ok = t < nsel; pm[t] = ok ? pm[t] : -3.0e38f; pl[t] = ok ? pl[t] : 0.f;
#pragma unroll
                    for (int k = 0; k < 2; ++k) pv[t][k] = ok ? pv[t][k] : (u32x4){0u, 0u, 0u, 0u}; }
                float M = m2;
#pragma unroll
                for (int t = 0; t < 3; ++t) M = fmaxf(M, pm[t]);
                const float e0 = fexp2(m2 - M); float L = ls * e0;
#pragma unroll
                for (int dt = 0; dt < 2; ++dt)
#pragma unroll
                    for (int i = 0; i < 16; ++i) o[dt][i] *= e0;
#pragma unroll
                for (int t = 0; t < 3; ++t) { const float wt = pl[t] * fexp2(pm[t] - M), wt16 = wt * (1.0f / 16.0f); L += wt;
#pragma unroll
                    for (int k = 0; k < 2; ++k)
#pragma unroll
                        for (int w = 0; w < 4; ++w) { const int wd = (int)pv[t][k][w];
                            o[k][4 * w] += wt16 * __builtin_amdgcn_cvt_f32_fp8(wd, 0); o[k][4 * w + 1] += wt16 * __builtin_amdgcn_cvt_f32_fp8(wd, 1);
                            o[k][4 * w + 2] += wt16 * __builtin_amdgcn_cvt_f32_fp8(wd, 2); o[k][4 * w + 3] += wt16 * __builtin_amdgcn_cvt_f32_fp8(wd, 3); } }
                const float invL = 1.0f / L; float sq = 0.f;
                unsigned char* crow_ = cat8 + (size_t)(b * SEQ + s) * DM + h * 64 + 16 * hp;
#pragma unroll
                for (int dt = 0; dt < 2; ++dt) {
                    int wd[4];
#pragma unroll
                    for (int g = 0; g < 4; ++g) { f32x4 ov;
#pragma unroll
                        for (int e = 0; e < 4; ++e) { ov[e] = o[dt][4 * g + e] * invL; sq += ov[e] * ov[e]; }
                        wd[g] = cvt4_fp8(ov * 16.0f); }
                    const int r0 = __shfl_xor(hp ? wd[0] : wd[2], 32), r1 = __shfl_xor(hp ? wd[1] : wd[3], 32);
                    const i32x4v pk = hp ? (i32x4v){r0, wd[2], r1, wd[3]} : (i32x4v){wd[0], r0, wd[1], r1};
                    *(i32x4v*)(crow_ + 32 * dt) = pk; }
                sq += __shfl_xor(sq, 32);
                if (hp == 0) sumsq[(size_t)(b * SEQ + s) * 8 + h] = (f16)sq;
                PROF_E(46);
            }
        }
        __syncthreads();
    }
    SEAM(4);

    if (IN(5)) { OPAQUE_TID;
#ifdef PROF_GP_PHASE
        if (tid == 0) MISC[17] = (5 == PROF_GP_PHASE) ? 1u : 0u;
        __syncthreads();
#endif
        pg8::StaticOrder S; S.init(cat8, WoT8, DM, DM, NTOK, DM, G, bid, 1);
        EpiZ E{xh, zbuf, sumsq, lds + pg8::STAGE_BYTES + 4096};
        pg8::gemm_phase8<EpiZ, pg8::StaticOrder, true>(lds, DM, DM / 128, S, E);
    }
    if (IN(6)) {
        int tq = threadIdx.x; asm volatile("" : "+v"(tq));
        for (int q = tq; q < 36 * 128; q += 512) { const int n = q >> 7, ch = q & 127; *(LAS h8*)(lds + 72704 + n * 2064 + 16 * ch) = *(const h8*)(WrT + (size_t)n * DM + 8 * ch); }
    }
    SEAM(5);

    if (IN(6)) REP(6) { OPAQUE_TID;
        unsigned* ecnt_w = (rep_ | a.alt) ? ecnt + 32 : ecnt; int* elist_w = (rep_ | a.alt) ? (int*)(ws + 496 * MiB) : elist; float* wts_w = (rep_ | a.alt) ? (float*)(ws + 500 * MiB) : wts;
        LAS unsigned char* Ht = lds;
        LAS float* lg = (LAS float*)(lds + 32 * 2064);
        LAS unsigned* eh = (LAS unsigned*)(lds + 72192);
        constexpr int P6_MAXENT = 1024;
        LAS unsigned* pend = (LAS unsigned*)(lds + 147456);
        if (tid < 64) eh[tid] = 0u;
        int nloc = 0;
        LAS unsigned char* Wl = lds + 72704;
        f32x8 gv[2], bv[2];
#pragma unroll
        for (int j = 0; j < 2; ++j) { gv[j] = *(const f32x8*)(a.ln1g + 8 * lane + 512 * j); bv[j] = *(const f32x8*)(a.ln1b + 8 * lane + 512 * j); }
        h8 zin[4][2];
        if (bid < NTOK / 32) {
#pragma unroll
            for (int rr = 0; rr < 4; ++rr)
#pragma unroll
                for (int j = 0; j < 2; ++j) zin[rr][j] = *(const h8*)(zbuf + ((size_t)bid * 32 + 4 * wave + rr) * DM + 8 * lane + 512 * j); }
        for (int u = bid; u < NTOK / 32; u += G) {
            __syncthreads();
#pragma unroll
            for (int rr = 0; rr < 4; ++rr) {
                const int rl = 4 * wave + rr; const size_t row = (size_t)u * 32 + rl;
                f32x8 v[2]; float s = 0.f;
#pragma unroll
                for (int j = 0; j < 2; ++j) { v[j] = __builtin_convertvector(zin[rr][j], f32x8);
#pragma unroll
                    for (int e = 0; e < 8; ++e) s += v[j][e]; }
                const float mean = wave_sum(s) * (1.0f / DM); float s2 = 0.f;
#pragma unroll
                for (int j = 0; j < 2; ++j) { v[j] = v[j] - mean;
#pragma unroll
                    for (int e = 0; e < 8; ++e) s2 += v[j][e] * v[j][e]; }
                const float rstd = 1.0f / sqrtf(wave_sum(s2) * (1.0f / DM) + LN_EPS);
#pragma unroll
                for (int j = 0; j < 2; ++j) { const h8 hv = __builtin_convertvector(v[j] * rstd * gv[j] + bv[j], h8);
                    *(h8*)(hh + row * DM + 8 * lane + 512 * j) = hv; *(LAS h8*)(Ht + rl * 2064 + 2 * (8 * lane + 512 * j)) = hv;
                    const f32x8 hf = __builtin_convertvector(hv, f32x8);
                    *(u32x2*)(hh8 + row * DM + 8 * lane + 512 * j) = cvt8_fp8((f32x4){hf[0], hf[1], hf[2], hf[3]}, (f32x4){hf[4], hf[5], hf[6], hf[7]}); }
            }
            if (u + G < NTOK / 32) {
#pragma unroll
                for (int rr = 0; rr < 4; ++rr)
#pragma unroll
                    for (int j = 0; j < 2; ++j) zin[rr][j] = *(const h8*)(zbuf + ((size_t)(u + G) * 32 + 4 * wave + rr) * DM + 8 * lane + 512 * j); }
            __syncthreads();
            if (wave < 6) {
                const int rt = wave / 3, ct = wave % 3, fr = lane & 15, fq = lane >> 4;
                f32x4 acc = {0.f, 0.f, 0.f, 0.f};
#pragma unroll 8
                for (int ks = 0; ks < 32; ++ks) { const h8 af = *(const LAS h8*)(Ht + (16 * rt + fr) * 2064 + 2 * (32 * ks + 8 * fq));
                    const int nrow = 16 * ct + fr < 36 ? 16 * ct + fr : 35;
                    const h8 bf = *(const LAS h8*)(Wl + nrow * 2064 + 2 * (32 * ks + 8 * fq)); acc = MFMA16(af, bf, acc); }
#pragma unroll
                for (int e = 0; e < 4; ++e) lg[(16 * rt + 4 * fq + e) * 48 + 16 * ct + fr] = acc[e];
            }
            __syncthreads();
            if (tid < 32) {
                const int tok = u * 32 + tid; LAS const float* L = lg + tid * 48;
                float g4[4]; int gi = 0; float gm = -3.0e38f;
#pragma unroll
                for (int k = 0; k < 4; ++k) { g4[k] = L[k] + a.brg[k]; if (g4[k] > gm) { gm = g4[k]; gi = k; } }
                float gs = 0.f;
#pragma unroll
                for (int k = 0; k < 4; ++k) gs += __expf(g4[k] - gm);
                const float gp = 1.0f / gs;
                float l1 = -3.0e38f, l2 = -3.0e38f; int i1 = 0, i2 = 0;
                for (int k = 0; k < 8; ++k) { const float v = L[4 + 8 * gi + k] + a.bre[8 * gi + k]; if (v > l1) { l2 = l1; i2 = i1; l1 = v; i1 = k; } else if (v > l2) { l2 = v; i2 = k; } }
                const float w1 = 1.0f / (1.0f + __expf(l2 - l1)), w2 = 1.0f - w1;
                const int e1 = 8 * gi + i1, e2 = 8 * gi + i2;
                const unsigned r1 = __hip_atomic_fetch_add(eh + e1, 1u, __ATOMIC_RELAXED, __HIP_MEMORY_SCOPE_WORKGROUP);
                const unsigned r2 = __hip_atomic_fetch_add(eh + e2, 1u, __ATOMIC_RELAXED, __HIP_MEMORY_SCOPE_WORKGROUP);
                const int slot0 = nloc * 64 + 2 * tid;
                if (slot0 + 1 < P6_MAXENT) { pend[slot0] = (unsigned)(tok * 2) | ((unsigned)e1 << 17) | (r1 << 22); pend[slot0 + 1] = (unsigned)(tok * 2 + 1) | ((unsigned)e2 << 17) | (r2 << 22); }
                wts_w[tok * 2] = gp * w1; wts_w[tok * 2 + 1] = gp * w2;
            }
            ++nloc;
        }
        __syncthreads();
        if (tid < 32) { const unsigned n = eh[tid]; unsigned base = 0u; if (n) base = atomicAdd(ecnt_w + tid * 64, n); eh[32 + tid] = base; }
        __syncthreads();
        { const int nent = (nloc * 64) < P6_MAXENT ? nloc * 64 : P6_MAXENT;
          for (int i = tid; i < nent; i += 512) { const unsigned v = pend[i]; const int e = (v >> 17) & 31; elist_w[e * NTOK + (int)(eh[32 + e] + (v >> 22))] = (int)(v & 0x1ffffu); } }
        __syncthreads();
    }
    SEAM(6);

    LAS int* mtab = (LAS int*)(lds + pg8::STAGE_BYTES + 1024);
    LAS int* utab = mtab + 128;
    LAS int* rtab = (LAS int*)(lds + pg8::STAGE_BYTES + 12288);
    LAS float* wtab = (LAS float*)(rtab + MOE_MAXU * 256);
    if (IN(7) || IN(8)) {
        if (tid == 0) { int acc = 0; for (int e = 0; e < 32; ++e) { const int c = (int)ecnt[e * 64]; mtab[e] = c; mtab[32 + e] = acc; acc += (c + 255) >> 8; } mtab[64] = acc; }
        __syncthreads();
    }
    if (IN(7)) { OPAQUE_TID;
#ifdef PROF_GP_PHASE
        if (tid == 0) MISC[17] = (7 == PROF_GP_PHASE) ? 1u : 0u;
        __syncthreads();
#endif
        moe_tables(mtab, utab, rtab, wtab, elist, wts, G, bid, false, tid);
        MoeSched<true> S{utab, rtab, (const char*)hh8, (const char*)WguT, (size_t)DM * DM, DM, DM};
        EpiGU E{hid};
        pg8::gemm_phase8<EpiGU, MoeSched<true>, true>(lds, DM, DM / 128, S, E);
    }
    if (IN(8)) { int tq = threadIdx.x; asm volatile("" : "+v"(tq)); moe_tables(mtab, utab, rtab, wtab, elist, wts, G, bid, true, tq); }
    SEAM(7);
    if (IN(8)) { OPAQUE_TID;
#ifdef PROF_GP_PHASE
        if (tid == 0) MISC[17] = (8 == PROF_GP_PHASE) ? 1u : 0u;
        __syncthreads();
#endif
        MoeSched<false> S{utab, rtab, (const char*)hid, (const char*)WdnT, (size_t)DM * DE, DE, DE};
        EpiDown E{ybuf, rtab, wtab};
        pg8::gemm_phase8<EpiDown, MoeSched<false>, true>(lds, DE, DE / 128, S, E);
    }
    SEAM(8);

#ifdef CHECK_MOE
    if (IN(9)) { OPAQUE_TID;
        if (bid < 64) {
            const int e = bid & 31, idx = bid >> 5;
            LAS float* hv = (LAS float*)lds; LAS float* hd = hv + 1024; LAS float* red = hd + 512; LAS int* ired = (LAS int*)(red + 16);
            { const int cnt = (int)ecnt[e * 64]; int best = idx ? -1 : 0x7fffffff;
              for (int k = tid; k < cnt; k += 512) { const int v = elist[e * NTOK + k]; best = idx ? (v > best ? v : best) : (v < best ? v : best); }
#pragma unroll
              for (int o = 1; o < 64; o <<= 1) { const int t = __shfl_xor(best, o); best = idx ? (t > best ? t : best) : (t < best ? t : best); }
              if (lane == 0) ired[wave] = best;
              __syncthreads();
              best = ired[0];
              for (int k = 1; k < 8; ++k) { const int t = ired[k]; best = idx ? (t > best ? t : best) : (t < best ? t : best); }
              ired[8] = best; }
            __syncthreads();
            const int ent = ired[8], tok = ent >> 1; const float w = wts[ent];
            for (int k = tid; k < DM; k += 512) hv[k] = (float)hh[(size_t)tok * DM + k];
            __syncthreads();
            { const float* wg = a.wgu + (size_t)e * DM * DM + tid; float g = 0.f, up = 0.f;
              for (int k = 0; k < DM; ++k) { g += hv[k] * wg[(size_t)k * DM]; up += hv[k] * wg[(size_t)k * DM + 512]; }
              hd[tid] = g / (1.0f + __expf(-g)) * up; }
            __syncthreads();
            float e2 = 0.f, r2 = 0.f;
            for (int n = tid; n < DM; n += 512) { const float* wd = a.wdn + (size_t)e * DE * DM + n; float y = 0.f;
                for (int j = 0; j < DE; ++j) y += hd[j] * wd[(size_t)j * DM];
                y *= w; const float d = __builtin_amdgcn_cvt_f32_fp8((int)ybuf[(size_t)ent * DM + n], 0) * (1.0f / 64.0f) - y; e2 += d * d; r2 += y * y; }
            e2 = wave_sum(e2); r2 = wave_sum(r2);
            if (lane == 0) { red[wave] = e2; red[8 + wave] = r2; }
            __syncthreads();
            if (tid == 0) { float se = 0.f, sr = 0.f; for (int k = 0; k < 8; ++k) { se += red[k]; sr += red[8 + k]; }
                __hip_atomic_store(ctl + 24580 + 2 * bid, __float_as_uint(se), __ATOMIC_RELAXED, __HIP_MEMORY_SCOPE_AGENT); __hip_atomic_store(ctl + 24581 + 2 * bid, __float_as_uint(sr), __ATOMIC_RELAXED, __HIP_MEMORY_SCOPE_AGENT); }
        }
        xcd_barrier(bar);
        float se = 0.f, sr = 0.f;
        for (int k = 0; k < 64; ++k) { se += __uint_as_float(__hip_atomic_load(ctl + 24580 + 2 * k, __ATOMIC_RELAXED, __HIP_MEMORY_SCOPE_AGENT)); sr += __uint_as_float(__hip_atomic_load(ctl + 24581 + 2 * k, __ATOMIC_RELAXED, __HIP_MEMORY_SCOPE_AGENT)); }
        const float cval = sqrtf(1.0e6f * se / sr);
        for (size_t i = (size_t)bid * 512 + tid; i < (size_t)NTOK * DM / 4; i += (size_t)G * 512) ((f32x4*)a.out)[i] = (f32x4){cval, cval, cval, cval};
    }
    if (false) {
#elif defined(DIAG_PHASE)
    if (IN(9)) { OPAQUE_TID; xcd_barrier(bar); const float cval = sqrtf((float)__hip_atomic_load(ctl + 24576, __ATOMIC_RELAXED, __HIP_MEMORY_SCOPE_AGENT) * 0.01f);
        for (size_t i = (size_t)bid * 512 + tid; i < (size_t)NTOK * DM / 4; i += (size_t)G * 512) ((f32x4*)a.out)[i] = (f32x4){cval, cval, cval, cval}; }
    if (false) {
#else
    if (IN(9)) REP(9) { OPAQUE_TID;
#endif
        f32x4 gv[4], bv[4];
#pragma unroll
        for (int j = 0; j < 4; ++j) { gv[j] = *(const f32x4*)(a.ln2g + 4 * lane + 256 * j); bv[j] = *(const f32x4*)(a.ln2b + 4 * lane + 256 * j); }
        for (int row = bid * 8 + wave; row < NTOK; row += G * 8) {
            f32x4 v[4]; float s = 0.f;
#pragma unroll
            for (int j = 0; j < 4; ++j) { const size_t c = 4 * lane + 256 * j;
                const f32x4 hv = __builtin_convertvector(*(const h4*)(hh + (size_t)row * DM + c), f32x4);
                const int w0 = *(const int*)(ybuf + (size_t)(2 * row) * DM + c), w1 = *(const int*)(ybuf + (size_t)(2 * row + 1) * DM + c);
                const f32x4 y0 = (f32x4){__builtin_amdgcn_cvt_f32_fp8(w0, 0), __builtin_amdgcn_cvt_f32_fp8(w0, 1), __builtin_amdgcn_cvt_f32_fp8(w0, 2), __builtin_amdgcn_cvt_f32_fp8(w0, 3)} * (1.0f / 64.0f);
                const f32x4 y1 = (f32x4){__builtin_amdgcn_cvt_f32_fp8(w1, 0), __builtin_amdgcn_cvt_f32_fp8(w1, 1), __builtin_amdgcn_cvt_f32_fp8(w1, 2), __builtin_amdgcn_cvt_f32_fp8(w1, 3)} * (1.0f / 64.0f);
                v[j] = hv * ALPHA + (y0 + y1); s += (v[j][0] + v[j][1]) + (v[j][2] + v[j][3]); }
            const float mean = wave_sum(s) * (1.0f / DM); float s2 = 0.f;
#pragma unroll
            for (int j = 0; j < 4; ++j) { v[j] = v[j] - mean; s2 += (v[j][0] * v[j][0] + v[j][1] * v[j][1]) + (v[j][2] * v[j][2] + v[j][3] * v[j][3]); }
            const float rstd = 1.0f / sqrtf(wave_sum(s2) * (1.0f / DM) + LN_EPS);
#pragma unroll
            for (int j = 0; j < 4; ++j) __builtin_nontemporal_store(v[j] * rstd * gv[j] + bv[j], (f32x4*)(a.out + (size_t)row * DM + 4 * lane + 256 * j));
        }
    }
#if defined(PROF_SEG) && PROF_SEG >= 60 && PROF_SEG <= 62
    if (bid == 0 && wave == 0) {
        i32x8 fa, fb; for (int i = 0; i < 8; ++i) { fa[i] = 0x38383838 + lane; fb[i] = 0x38383838 + i; }
        f32x4 c0 = {0.f, 0.f, 0.f, 0.f}, c1 = c0, c2 = c0, c3 = c0; f32x16 d0; for (int i = 0; i < 16; ++i) d0[i] = 0.f; f32x16 d1 = d0;
        const int scl = 0x7F7F7F7F;
        const h8 ha = __builtin_bit_cast(h8, (f32x4){1.f, 2.f, 3.f, 4.f}), hb = ha;
        PROF_B(PROF_SEG);
        for (int it = 0; it < 2048; ++it) {
#if PROF_SEG == 60
            c0 = MFMA16(ha, hb, c0); c1 = MFMA16(ha, hb, c1); c2 = MFMA16(ha, hb, c2); c3 = MFMA16(ha, hb, c3);
#elif PROF_SEG == 61
            asm volatile("v_mfma_scale_f32_16x16x128_f8f6f4 %0, %1, %2, %0, %3, %3 op_sel_hi:[0,0,0]" : "+v"(c0) : "v"(fa), "v"(fb), "v"(scl));
            asm volatile("v_mfma_scale_f32_16x16x128_f8f6f4 %0, %1, %2, %0, %3, %3 op_sel_hi:[0,0,0]" : "+v"(c1) : "v"(fa), "v"(fb), "v"(scl));
            asm volatile("v_mfma_scale_f32_16x16x128_f8f6f4 %0, %1, %2, %0, %3, %3 op_sel_hi:[0,0,0]" : "+v"(c2) : "v"(fa), "v"(fb), "v"(scl));
            asm volatile("v_mfma_scale_f32_16x16x128_f8f6f4 %0, %1, %2, %0, %3, %3 op_sel_hi:[0,0,0]" : "+v"(c3) : "v"(fa), "v"(fb), "v"(scl));
#else
            asm volatile("v_mfma_scale_f32_32x32x64_f8f6f4 %0, %1, %2, %0, %3, %3 op_sel_hi:[0,0,0]" : "+v"(d0) : "v"(fa), "v"(fb), "v"(scl));
            asm volatile("v_mfma_scale_f32_32x32x64_f8f6f4 %0, %1, %2, %0, %3, %3 op_sel_hi:[0,0,0]" : "+v"(d1) : "v"(fa), "v"(fb), "v"(scl));
            asm volatile("v_mfma_scale_f32_32x32x64_f8f6f4 %0, %1, %2, %0, %3, %3 op_sel_hi:[0,0,0]" : "+v"(d0) : "v"(fa), "v"(fb), "v"(scl));
            asm volatile("v_mfma_scale_f32_32x32x64_f8f6f4 %0, %1, %2, %0, %3, %3 op_sel_hi:[0,0,0]" : "+v"(d1) : "v"(fa), "v"(fb), "v"(scl));
#endif
        }
        asm volatile("s_nop 15\n\ts_nop 15" ::: "memory");
        PROF_E(PROF_SEG);
        asm volatile("" :: "v"(c0), "v"(c1), "v"(c2), "v"(c3), "v"(d0), "v"(d1));
    }
#endif
#ifdef PROF_SEG
    PROF_E(19);
#if PROF_SEG >= 51 && PROF_SEG <= 55
    prof_acc = MISC[16];
#endif
    if (prof_on) { const unsigned long long t0 = __builtin_amdgcn_s_memrealtime(), dt = (unsigned long long)PROF_K * prof_acc; while (__builtin_amdgcn_s_memrealtime() - t0 < dt) __builtin_amdgcn_s_sleep(8); }
#endif
#undef IN
#undef SEAM
}

extern "C" void kernel_launch(void* const* d_in, const int* in_sizes, int n_in, void* d_out, int out_size, void* d_ws, size_t ws_size, hipStream_t stream) {
    static int grid = 0;
    if (grid == 0) {
        if (n_in != 15 || in_sizes[0] != NTOK * DM || out_size != NTOK * DM || ws_size < WS_END) { fprintf(stderr, "kernel_launch: unexpected problem (n_in %d, ws %zu)\n", n_in, ws_size); grid = -1; return; }
        int dev = 0, cus = 0, per_cu = 0;
        if (hipGetDevice(&dev) != hipSuccess || hipDeviceGetAttribute(&cus, hipDeviceAttributeMultiprocessorCount, dev) != hipSuccess) { grid = -1; return; }
        if (hipFuncSetAttribute((const void*)fwd, hipFuncAttributeMaxDynamicSharedMemorySize, LDS_BYTES) != hipSuccess) { fprintf(stderr, "kernel_launch: hipFuncSetAttribute failed\n"); grid = -1; return; }
        if (hipOccupancyMaxActiveBlocksPerMultiprocessor(&per_cu, (const void*)fwd, 512, LDS_BYTES) != hipSuccess || per_cu < 1) { fprintf(stderr, "kernel_launch: occupancy query says %d\n", per_cu); (void)hipGetLastError(); grid = -1; return; }
        grid = cus;
    }
    if (grid < 0) return;
    (void)hipMemsetAsync((char*)d_ws + WS_CTL, 0, CTL_ZERO_BYTES, stream);
    Args a{};
    a.x = (const float*)d_in[0]; a.w_in = (const float*)d_in[1]; a.gain = (const float*)d_in[2]; a.rel = (const float*)d_in[3]; a.w_out = (const float*)d_in[4];
    a.ln1g = (const float*)d_in[5]; a.ln1b = (const float*)d_in[6]; a.wrg = (const float*)d_in[7]; a.brg = (const float*)d_in[8]; a.wre = (const float*)d_in[9];
    a.bre = (const float*)d_in[10]; a.wgu = (const float*)d_in[11]; a.wdn = (const float*)d_in[12]; a.ln2g = (const float*)d_in[13]; a.ln2b = (const float*)d_in[14];
    a.out = (float*)d_out; a.ws = (unsigned char*)d_ws;
#if MK_LAUNCHES == 1
    a.ph_lo = 0; a.ph_hi = NPHASE;
    hipLaunchKernelGGL(fwd, dim3(grid), dim3(512), LDS_BYTES, stream, a);
#else
    for (int p = 0; p < NPHASE; ++p) { a.ph_lo = p; a.ph_hi = p + 1; a.alt = 0; hipLaunchKernelGGL(fwd, dim3(grid), dim3(512), LDS_BYTES, stream, a);
#ifdef HOST_DUP
#ifndef HOST_ALT
#define HOST_ALT 1
#endif
        if (p == HOST_DUP) { a.alt = HOST_ALT; hipLaunchKernelGGL(fwd, dim3(grid), dim3(512), LDS_BYTES, stream, a); }
#endif
    }
#endif
}
```
